# Optimizing an MI355X kernel written in HIP

```python
import jax, jax.numpy as jnp
from jax import lax
import numpy as np

D_MODEL = 1024
BATCH = 8
SEQ = 2048
DEPTH = 1

N_META = 16
HEAD_DIM = 64
N_Q_HEADS = 8
N_KV_HEADS = 2
GROUP = N_Q_HEADS // N_KV_HEADS
ATTN_W = N_Q_HEADS * HEAD_DIM
KV_W = N_KV_HEADS * HEAD_DIM
CONV_W = D_MODEL - ATTN_W
IN_W = ATTN_W + 2 * KV_W + 2 * CONV_W
WINDOW = 128
BLOCK = 128
CONV_K = 31
CONV_PAD = CONV_K // 2
N_EXPERTS = 32
TOP_K = 4
D_FF = D_MODEL
SWIGLU_LIMIT = 7.0
SWIGLU_ALPHA = 1.702
RMS_EPS = 1e-6
LN_EPS = 1e-5
NEG_INF = -1e30

kernel_name = 'hymba_conformer_swa_moe_encoder_layer'


def rms_norm(x, g):
    xf = x.astype(jnp.float32)
    y = xf * lax.rsqrt(jnp.mean(xf * xf, axis=-1, keepdims=True) + RMS_EPS)
    return (y * g.astype(jnp.float32)).astype(x.dtype)


def layer_norm(x, g, b):
    xf = x.astype(jnp.float32)
    mu = jnp.mean(xf, axis=-1, keepdims=True)
    var = jnp.mean(jnp.square(xf - mu), axis=-1, keepdims=True)
    y = (xf - mu) * lax.rsqrt(var + LN_EPS)
    return (y * g.astype(jnp.float32) + b.astype(jnp.float32)).astype(x.dtype)


def alibi_slopes():
    return jnp.exp2(-8.0 * (jnp.arange(N_Q_HEADS, dtype=jnp.float32) + 1.0) / N_Q_HEADS)


def windowed_attention(q, k, v, sink):
    B, L = q.shape[0], q.shape[1]
    S = L - N_META
    nb = S // BLOCK
    scale = HEAD_DIM ** -0.5
    q5 = q.reshape(B, L, N_KV_HEADS, GROUP, HEAD_DIM)
    qm, qr = q5[:, :N_META], q5[:, N_META:]
    km, kr = k[:, :N_META], k[:, N_META:]
    vm, vr = v[:, :N_META], v[:, N_META:]
    sink_f = sink.astype(jnp.float32).reshape(N_KV_HEADS, GROUP)

    qb = qr.reshape(B, nb, BLOCK, N_KV_HEADS, GROUP, HEAD_DIM)
    pad = ((0, 0), (BLOCK, BLOCK), (0, 0), (0, 0))
    kb = jnp.pad(kr, pad).reshape(B, nb + 2, BLOCK, N_KV_HEADS, HEAD_DIM)
    vb = jnp.pad(vr, pad).reshape(B, nb + 2, BLOCK, N_KV_HEADS, HEAD_DIM)
    kwin = jnp.concatenate([kb[:, :-2], kb[:, 1:-1], kb[:, 2:]], axis=2)
    vwin = jnp.concatenate([vb[:, :-2], vb[:, 1:-1], vb[:, 2:]], axis=2)
    s_win = jnp.einsum('bnqhgd,bnkhd->bhgnqk', qb, kwin).astype(jnp.float32) * scale
    s_meta = jnp.einsum('bnqhgd,bmhd->bhgnqm', qb, km).astype(jnp.float32) * scale

    qpos = jnp.arange(nb)[:, None] * BLOCK + jnp.arange(BLOCK)[None, :]
    kpos = (jnp.arange(nb)[:, None] - 1) * BLOCK + jnp.arange(3 * BLOCK)[None, :]
    dist = jnp.abs(qpos[:, :, None] - kpos[:, None, :])
    valid = (kpos >= 0)[:, None, :] & (kpos < S)[:, None, :] & (dist <= WINDOW)
    slopes = alibi_slopes().reshape(N_KV_HEADS, GROUP)
    alibi = slopes[:, :, None, None, None] * dist.astype(jnp.float32)[None, None]
    s_win = jnp.where(valid, s_win - alibi, NEG_INF)
    sink_col = jnp.broadcast_to(sink_f[None, :, :, None, None, None], s_win.shape[:-1] + (1,))
    p = jax.nn.softmax(jnp.concatenate([s_meta, s_win, sink_col], axis=-1), axis=-1)
    p_meta = p[..., :N_META].astype(v.dtype)
    p_win = p[..., N_META:N_META + 3 * BLOCK].astype(v.dtype)
    o_real = (jnp.einsum('bhgnqm,bmhd->bnqhgd', p_meta, vm)
              + jnp.einsum('bhgnqk,bnkhd->bnqhgd', p_win, vwin))
    o_real = o_real.reshape(B, S, ATTN_W)

    s_g = jnp.einsum('bmhgd,blhd->bhgml', qm, k).astype(jnp.float32) * scale
    sink_g = jnp.broadcast_to(sink_f[None, :, :, None, None], s_g.shape[:-1] + (1,))
    p_g = jax.nn.softmax(jnp.concatenate([s_g, sink_g], axis=-1), axis=-1)[..., :L].astype(v.dtype)
    o_meta = jnp.einsum('bhgml,blhd->bmhgd', p_g, v).reshape(B, N_META, ATTN_W)
    return jnp.concatenate([o_meta, o_real], axis=1)


def conv_group(u, dw_w, dw_b, ln_g, ln_b):
    a, g = u[..., :CONV_W], u[..., CONV_W:]
    hc = a * jax.nn.sigmoid(g)
    hc = lax.conv_general_dilated(hc, dw_w, window_strides=(1,), padding=[(CONV_PAD, CONV_PAD)],
                                  dimension_numbers=('NWC', 'WIO', 'NWC'),
                                  feature_group_count=CONV_W) + dw_b
    hc = layer_norm(hc, ln_g, ln_b)
    return jax.nn.silu(hc)


def moe(hn, router_w, router_b, w_gate_up, b_gate_up, w_down, b_down):
    B, L, D = hn.shape
    t = hn.reshape(B * L, D)
    n_tok = t.shape[0]
    logits = t.astype(jnp.float32) @ router_w.astype(jnp.float32) + router_b.astype(jnp.float32)
    top_val, top_idx = lax.top_k(logits, TOP_K)
    gates = jax.nn.softmax(top_val, axis=-1)
    flat_e = top_idx.reshape(-1)
    order = jnp.argsort(flat_e)
    tok = order // TOP_K
    e_sorted = flat_e[order]
    group_sizes = jnp.bincount(flat_e, length=N_EXPERTS).astype(jnp.int32)
    xs = t[tok]
    gu = lax.ragged_dot(xs, w_gate_up, group_sizes) + b_gate_up[e_sorted]
    gate = jnp.minimum(gu[:, :D_FF], SWIGLU_LIMIT)
    up = jnp.clip(gu[:, D_FF:], -SWIGLU_LIMIT, SWIGLU_LIMIT)
    act = gate * jax.nn.sigmoid(SWIGLU_ALPHA * gate) * (up + 1.0)
    y = lax.ragged_dot(act, w_down, group_sizes) + b_down[e_sorted]
    y = y * gates.reshape(-1)[order][:, None].astype(y.dtype)
    out = jax.ops.segment_sum(y, tok, num_segments=n_tok)
    return out.reshape(B, L, D)


def setup_inputs(seed: int = 0) -> dict:
    key = jax.random.key(seed)
    ks = jax.random.split(key, 20)
    f = jnp.float32
    nrm = lambda k, s, sc: jax.random.normal(k, s, f) * sc
    return {
        'x': nrm(ks[0], (BATCH, SEQ, D_MODEL), 1.0),
        'meta_tokens': nrm(ks[1], (N_META, D_MODEL), 1.0),
        'norm1_g': 1.0 + nrm(ks[2], (DEPTH, D_MODEL), 0.02),
        'w_in': nrm(ks[3], (DEPTH, D_MODEL, IN_W), D_MODEL ** -0.5),
        'q_norm_g': 1.0 + nrm(ks[4], (DEPTH, HEAD_DIM), 0.02),
        'k_norm_g': 1.0 + nrm(ks[5], (DEPTH, HEAD_DIM), 0.02),
        'attn_sink': nrm(ks[6], (DEPTH, N_Q_HEADS), 0.5),
        'dw_w': nrm(ks[7], (DEPTH, CONV_K, 1, CONV_W), CONV_K ** -0.5),
        'dw_b': nrm(ks[8], (DEPTH, CONV_W), 0.02),
        'conv_ln_g': 1.0 + nrm(ks[9], (DEPTH, CONV_W), 0.02),
        'conv_ln_b': nrm(ks[10], (DEPTH, CONV_W), 0.02),
        'w_out': nrm(ks[11], (DEPTH, D_MODEL, D_MODEL), D_MODEL ** -0.5),
        'norm2_g': 1.0 + nrm(ks[12], (DEPTH, D_MODEL), 0.02),
        'router_w': nrm(ks[13], (DEPTH, D_MODEL, N_EXPERTS), D_MODEL ** -0.5),
        'router_b': nrm(ks[14], (DEPTH, N_EXPERTS), 0.01),
        'w_gate_up': nrm(ks[15], (DEPTH, N_EXPERTS, D_MODEL, 2 * D_FF), D_MODEL ** -0.5),
        'b_gate_up': nrm(ks[16], (DEPTH, N_EXPERTS, 2 * D_FF), 0.02),
        'w_down': nrm(ks[17], (DEPTH, N_EXPERTS, D_FF, D_MODEL), D_FF ** -0.5),
        'b_down': nrm(ks[18], (DEPTH, N_EXPERTS, D_MODEL), 0.02),
    }


def reference(x, meta_tokens, norm1_g, w_in, q_norm_g, k_norm_g, attn_sink, dw_w, dw_b,
              conv_ln_g, conv_ln_b, w_out, norm2_g, router_w, router_b, w_gate_up, b_gate_up,
              w_down, b_down):
    B = x.shape[0]
    meta = jnp.broadcast_to(meta_tokens[None].astype(x.dtype), (B, N_META, D_MODEL))
    h = jnp.concatenate([meta, x], axis=1)
    L = h.shape[1]
    for l in range(DEPTH):
        n = rms_norm(h, norm1_g[l])
        proj = n @ w_in[l]
        q = proj[..., :ATTN_W].reshape(B, L, N_Q_HEADS, HEAD_DIM)
        k = proj[..., ATTN_W:ATTN_W + KV_W].reshape(B, L, N_KV_HEADS, HEAD_DIM)
        v = proj[..., ATTN_W + KV_W:ATTN_W + 2 * KV_W].reshape(B, L, N_KV_HEADS, HEAD_DIM)
        u = proj[..., ATTN_W + 2 * KV_W:]
        q = rms_norm(q, q_norm_g[l])
        k = rms_norm(k, k_norm_g[l])
        attn = windowed_attention(q, k, v, attn_sink[l])
        conv = conv_group(u, dw_w[l], dw_b[l], conv_ln_g[l], conv_ln_b[l])
        h = h + jnp.concatenate([attn, conv], axis=-1) @ w_out[l]
        h = h + moe(rms_norm(h, norm2_g[l]), router_w[l], router_b[l], w_gate_up[l],
                    b_gate_up[l], w_down[l], b_down[l])
    return h[:, N_META:]
```

```cpp
#include <hip/hip_runtime.h>
#include <cstdio>
#include <cstdint>

#ifndef MK_PER_PHASE
#define MK_PER_PHASE 1
#endif
#ifndef FAST_P1
#define FAST_P1 0
#endif
#ifndef FAST_ATT
#define FAST_ATT 0
#endif
#ifndef FAST_CONV
#define FAST_CONV 0
#endif
#ifndef FAST_P3
#define FAST_P3 0
#endif
#ifndef FAST_P4
#define FAST_P4 0
#endif
#ifndef FAST_P5
#define FAST_P5 0
#endif
#ifndef FAST_P6
#define FAST_P6 0
#endif

#define GAS __attribute__((address_space(1)))
#define LAS __attribute__((address_space(3)))
typedef unsigned short bf16_t;
typedef short bf16x8 __attribute__((ext_vector_type(8)));
typedef float f32x4 __attribute__((ext_vector_type(4)));
typedef float f32x16 __attribute__((ext_vector_type(16)));
typedef unsigned u32x4 __attribute__((ext_vector_type(4)));
typedef unsigned u32x2 __attribute__((ext_vector_type(2)));
typedef GAS unsigned gu32;
#define RLX_AGENT __ATOMIC_RELAXED, __HIP_MEMORY_SCOPE_AGENT

constexpr int NB = 8, SEQ = 2048, D = 1024, NMETA = 16, LSEQ = NMETA + SEQ;
constexpr int M_REAL = NB * SEQ, M_ALL = NB * LSEQ, M_PAD = 16640;
constexpr int IN_W = 1792, HD = 64, NQH = 8, NKV = 2, CONV_W = 512, CONV_K = 31;
constexpr int NE = 32, CAP = 16384, ACT_ROWS = 4 * M_REAL + NE * 256;
constexpr float LOG2E = 1.4426950408889634f;
constexpr float QSCALE = 0.125f * LOG2E;
constexpr int VT_PITCH = LSEQ;

constexpr size_t MiB = 1u << 20;
constexpr size_t WS_CTL = 0, CTL_ZERO_BYTES = 1 * MiB;
constexpr size_t WS_WIN_T = 2 * MiB;
constexpr size_t WS_WO_T = 6 * MiB;
constexpr size_t WS_WR_T = 8 * MiB;
constexpr size_t WS_RSTD = 9 * MiB;
constexpr size_t WS_WHERE = 9 * MiB + 512 * 1024;
constexpr size_t WS_LTOK = 10 * MiB;
constexpr size_t WS_LGATE = 12 * MiB;
constexpr size_t WS_LRSTD = 14 * MiB;
constexpr size_t WS_WD_T = 16 * MiB;
constexpr size_t WS_WGU_T = 80 * MiB;
constexpr size_t WS_XN = 208 * MiB;
constexpr size_t WS_Q = 241 * MiB;
constexpr size_t WS_K = 258 * MiB;
constexpr size_t WS_VT = 263 * MiB;
constexpr size_t WS_HC = 268 * MiB;
constexpr size_t WS_MIX = 285 * MiB;
constexpr size_t WS_XN2 = 317 * MiB;
constexpr size_t WS_ACT = 349 * MiB;
constexpr size_t WS_Y = 493 * MiB;
constexpr size_t WS_END = 637 * MiB;
constexpr int CW_CNT = 64;
constexpr int CW_BAR = 4096;

constexpr int RING_BYTES = 131072;
constexpr int LX_BAR = RING_BYTES;
constexpr int LX_TB = RING_BYTES + 64;
constexpr int LX_CNT = RING_BYTES + 256;
constexpr int LX_LCNT = RING_BYTES + 512;
constexpr int LX_GBASE = RING_BYTES + 768;
constexpr int LDS_BYTES = 147456;

constexpr int NWAVES = 8, NTHR = 512;

__device__ __forceinline__ unsigned f2bf(float f) { unsigned u = __builtin_bit_cast(unsigned, f); return (u + 0x7fffu + ((u >> 16) & 1u)) >> 16; }
__device__ __forceinline__ unsigned pk2(float lo, float hi) { return f2bf(lo) | (f2bf(hi) << 16); }
__device__ __forceinline__ float bf2f(unsigned b) { return __builtin_bit_cast(float, b << 16); }
__device__ __forceinline__ float bflo(unsigned w) { return __builtin_bit_cast(float, w << 16); }
__device__ __forceinline__ float bfhi(unsigned w) { return __builtin_bit_cast(float, w & 0xffff0000u); }
__device__ __forceinline__ float wave_sum(float v) {
#pragma unroll
    for (int o = 1; o < 64; o <<= 1) v += __shfl_xor(v, o);
    return v;
}
__device__ __forceinline__ float sigmoidf_fast(float x) { return __builtin_amdgcn_rcpf(1.0f + __builtin_amdgcn_exp2f(-x * LOG2E)); }
__device__ __forceinline__ int row_of(int b, int s) { return s < NMETA ? M_REAL + b * NMETA + s : b * SEQ + (s - NMETA); }

#define XB_TMO      128
#define XB_XCNT(j)  (256  + 64 * (j))
#define XB_XSUB(j)  (1280 + 64 * (j))
#define XB_XGEN(j)  (2304 + 64 * (j))
#define XB_TOP      3328
#define XB_TOPGEN   3392
#define XCD_BAR_WORDS 3456
#define XB_SPIN_CAP (1u << 18)
__device__ __forceinline__ unsigned xb_ld(unsigned* p)              { return __hip_atomic_load(p, __ATOMIC_RELAXED, __HIP_MEMORY_SCOPE_AGENT); }
__device__ __forceinline__ unsigned xb_add(unsigned* p, unsigned v) { return __hip_atomic_fetch_add(p, v, __ATOMIC_RELAXED, __HIP_MEMORY_SCOPE_AGENT); }
__device__ __forceinline__ unsigned xb_xcc_id() { return (unsigned)__builtin_amdgcn_s_getreg((3 << 11) | 20) & 0xFu; }
#define XB_SPIN(cond, bar) do { unsigned _sp = 0; while (cond) { __builtin_amdgcn_s_sleep(1); \
    if ((++_sp & 255u) == 0u) { if (xb_ld(&(bar)[XB_TMO])) break; if (_sp > XB_SPIN_CAP) { atomicAdd(&(bar)[XB_TMO], 1u); break; } } } } while (0)
struct XcdBarrier { unsigned* bar; unsigned x; volatile LAS unsigned* st; };
__device__ __forceinline__ XcdBarrier xcd_barrier_post(unsigned* bar, volatile LAS unsigned* st) {
    XcdBarrier b; b.bar = bar; b.x = xb_xcc_id(); b.st = st;
    if (threadIdx.x == 0) (void)xb_add(&bar[XB_XCNT(b.x)], 1u);
    return b;
}
__device__ __forceinline__ void xcd_barrier_complete(unsigned* bar, unsigned x, unsigned& nloc, unsigned& nx) {
    const unsigned G = gridDim.x * gridDim.y * gridDim.z;
    unsigned sum, cnt, mine, sp = 0u;
    for (;;) {
        sum = 0u; cnt = 0u; mine = 0u;
#pragma unroll
        for (unsigned j = 0; j < 16; ++j) { const unsigned c = xb_ld(&bar[XB_XCNT(j)]); sum += c; cnt += (c > 0u) ? 1u : 0u; mine = (j == x) ? c : mine; }
        if (sum == G) break;
        __builtin_amdgcn_s_sleep(1);
        if ((++sp & 255u) == 0u) { if (xb_ld(&bar[XB_TMO])) break; if (sp > XB_SPIN_CAP) { atomicAdd(&bar[XB_TMO], 1u); break; } }
    }
    nloc = mine > 0u ? mine : 1u; nx = cnt > 0u ? cnt : 1u;
}
__device__ __forceinline__ void xcd_barrier(const XcdBarrier& b) {
    asm volatile("s_waitcnt vmcnt(0)" ::: "memory");
    __syncthreads();
    if (threadIdx.x == 0) {
        unsigned* bar = b.bar;
        __builtin_amdgcn_s_waitcnt(0);
        unsigned nloc = b.st[0], nx = b.st[1];
        if (nloc == 0u) { xcd_barrier_complete(bar, b.x, nloc, nx); b.st[0] = nloc; b.st[1] = nx; }
        const unsigned old = xb_add(&bar[XB_XSUB(b.x)], 1u);
        const unsigned gen = old / nloc;
        if (old + 1u == (gen + 1u) * nloc) {
            __builtin_amdgcn_fence(__ATOMIC_RELEASE, "agent");
            asm volatile("s_waitcnt vmcnt(0)" ::: "memory");
            const unsigned og = xb_add(&bar[XB_TOP], 1u);
            const unsigned tg = og / nx;
            if (og + 1u == (tg + 1u) * nx) xb_add(&bar[XB_TOPGEN], 1u);
            else XB_SPIN(xb_ld(&bar[XB_TOPGEN]) == tg, bar);
            __builtin_amdgcn_fence(__ATOMIC_ACQUIRE, "agent");
            xb_add(&bar[XB_XGEN(b.x)], 1u);
            asm volatile("s_waitcnt vmcnt(0)" ::: "memory");
        } else {
            XB_SPIN(xb_ld(&bar[XB_XGEN(b.x)]) == gen, bar);
            __builtin_amdgcn_fence(__ATOMIC_ACQUIRE, "agent");
            asm volatile("s_waitcnt vmcnt(0)" ::: "memory");
        }
    }
    __syncthreads();
}

struct Args { const float* in[19]; float* out; unsigned char* ws; int ph_lo, ph_hi; };
struct Frame {
    LAS unsigned char* lds;
    int tid, lane, wave, G, bid;
    const float *x, *meta, *n1g, *w_in, *qg, *kg, *sink, *dw_w, *dw_b, *lng, *lnb, *w_out, *n2g, *wr, *rb, *wgu, *bgu, *wd, *bd;
    float* out;
    unsigned char* ws;
    gu32* ctl;
    bf16_t *WinT, *WoT, *WrT, *WdT, *WguT, *XN, *Qb, *Kb, *VT, *HC, *MIX, *XN2, *ACT, *Y;
    int* where; int* ltok; float* lgate; float* lrstd;
};

__device__ __forceinline__ int perm32(int rho) { const int n = rho >> 4, i = rho & 15; return 8 * (i >> 2) + 4 * n + (i & 3); }
__device__ __forceinline__ int lbase_nat(int pg) { return 32 * pg; }
__device__ __forceinline__ int lbase_in(int pg) { const int tile = pg >> 3, bj = (pg >> 2) & 1, wc = pg & 3; return tile <= 2 ? tile * 256 + 64 * wc + 32 * bj : 768 + bj * 512 + (tile - 3) * 128 + 32 * wc; }
__device__ __forceinline__ int lbase_gu(int pg) { const int tile = pg >> 3, bj = (pg >> 2) & 1, wc = pg & 3; return bj * 1024 + tile * 128 + 32 * wc; }
__device__ __forceinline__ void p0_transpose_item(const float* W, int K, int N, bf16_t* WT, int pg, int n0, int kb, const float* g, LAS float* scr, int lane, bool permute) {
    const int k0 = 64 * kb;
#pragma unroll 8
    for (int i = 0; i < 32; ++i) { const int kk = 2 * i + (lane >> 5); float v = W[(size_t)(k0 + kk) * N + n0 + (lane & 31)]; if (g) v *= g[k0 + kk]; scr[kk * 33 + (lane & 31)] = v; }
    asm volatile("s_waitcnt lgkmcnt(0)" ::: "memory");
    const int c = lane & 7;
#pragma unroll
    for (int j = 0; j < 4; ++j) { const int r = (lane >> 3) + 8 * j; const int sc = permute ? perm32(r) : r; const LAS float* s = scr + (8 * c) * 33 + sc;
        u32x4 o; o.x = pk2(s[0 * 33], s[1 * 33]); o.y = pk2(s[2 * 33], s[3 * 33]); o.z = pk2(s[4 * 33], s[5 * 33]); o.w = pk2(s[6 * 33], s[7 * 33]);
        *(GAS u32x4*)(WT + (size_t)(32 * pg + r) * K + k0 + 8 * c) = o; }
    asm volatile("s_waitcnt lgkmcnt(0)" ::: "memory");
}
__device__ __forceinline__ void p0_prologue(Frame& F) {
    LAS float* scr = (LAS float*)(F.lds + F.wave * 16384);
    const int gw = F.bid * NWAVES + F.wave, NGW = F.G * NWAVES, lane = F.lane;
    for (int m = gw; m < M_PAD; m += NGW) {
        GAS unsigned long long* o8 = (GAS unsigned long long*)(F.XN + (size_t)m * D) + lane;
        if (m >= M_ALL) {
#pragma unroll
            for (int j = 0; j < 4; ++j) o8[64 * j] = 0ull;
            continue; }
        const float* src = m < M_REAL ? F.x + (size_t)m * D : F.meta + (size_t)((m - M_REAL) & (NMETA - 1)) * D;
        const GAS f32x4* xr = (const GAS f32x4*)src + lane; const GAS f32x4* gr = (const GAS f32x4*)F.n1g + lane;
        f32x4 v[4]; float s = 0.f;
#pragma unroll
        for (int j = 0; j < 4; ++j) { v[j] = xr[64 * j]; s += (v[j].x * v[j].x + v[j].y * v[j].y) + (v[j].z * v[j].z + v[j].w * v[j].w); }
        const float rstd = 1.f / sqrtf(wave_sum(s) * (1.f / D) + 1e-6f);
#pragma unroll
        for (int j = 0; j < 4; ++j) { const f32x4 g = gr[64 * j]; o8[64 * j] = (unsigned long long)pk2(v[j].x * rstd * g.x, v[j].y * rstd * g.y) | ((unsigned long long)pk2(v[j].z * rstd * g.z, v[j].w * rstd * g.w) << 32); }
    }
    constexpr int I_IN = 16 * 56, I_O = 16 * 32, I_R = 16, I_GU = NE * 16 * 64, I_D = NE * 16 * 32;
    constexpr int NITEMS = I_IN + I_O + I_R + I_GU + I_D;
    for (int it = gw; it < NITEMS; it += NGW) {
        int r = it;
        if (r < I_IN) { const int pg = r % 56, kb = r / 56; p0_transpose_item(F.w_in, D, IN_W, F.WinT, pg, lbase_in(pg), kb, nullptr, scr, lane, true); continue; } r -= I_IN;
        if (r < I_O) { const int pg = r % 32, kb = r / 32; p0_transpose_item(F.w_out, D, D, F.WoT, pg, lbase_nat(pg), kb, nullptr, scr, lane, true); continue; } r -= I_O;
        if (r < I_R) { p0_transpose_item(F.wr, D, NE, F.WrT, 0, 0, r, F.n2g, scr, lane, false); continue; } r -= I_R;
        if (r < I_GU) { const int e = r / (16 * 64), q = r % (16 * 64), pg = q % 64, kb = q / 64;
            p0_transpose_item(F.wgu + (size_t)e * D * 2048, D, 2048, F.WguT + (size_t)e * 2048 * D, pg, lbase_gu(pg), kb, F.n2g, scr, lane, true); continue; } r -= I_GU;
        { const int e = r / (16 * 32), q = r % (16 * 32), pg = q % 32, kb = q / 32;
            p0_transpose_item(F.wd + (size_t)e * D * D, D, D, F.WdT + (size_t)e * D * D, pg, lbase_nat(pg), kb, nullptr, scr, lane, true); }
    }
}

__device__ __forceinline__ void p1_naive(Frame& F) {
    const int gw = F.bid * NWAVES + F.wave, NGW = F.G * NWAVES, lane = F.lane;
    for (int it = gw; it < M_ALL * 20; it += NGW) {
        const int row = it / 20, grp = it % 20;
        const bf16_t* xr = F.XN + (size_t)row * D;
        if (grp < 12) {
            const int col = grp * 64 + lane; float acc = 0.f;
            _Pragma("unroll 4") for (int k = 0; k < D; ++k) acc += bf2f(xr[k]) * F.w_in[(size_t)k * IN_W + col];
            if (grp < 10) {
                const float ssq = wave_sum(acc * acc); const float r = 1.f / sqrtf(ssq * (1.f / 64.f) + 1e-6f);
                if (grp < 8) F.Qb[(size_t)row * 512 + col] = (bf16_t)f2bf(acc * r * F.qg[lane] * QSCALE);
                else F.Kb[(size_t)row * 128 + (col - 512)] = (bf16_t)f2bf(acc * r * F.kg[lane]);
            } else {
                const int hk = grp - 10; int b, kx;
                if (row < M_REAL) { b = row >> 11; kx = NMETA + (row & 2047); } else { b = (row - M_REAL) >> 4; kx = (row - M_REAL) & 15; }
                F.VT[((size_t)(b * 2 + hk) * 64 + lane) * VT_PITCH + kx] = (bf16_t)f2bf(acc);
            }
        } else {
            const int c = (grp - 12) * 64 + lane; float a = 0.f, g = 0.f;
            for (int k = 0; k < D; ++k) { const float xv = bf2f(xr[k]); a += xv * F.w_in[(size_t)k * IN_W + 768 + c]; g += xv * F.w_in[(size_t)k * IN_W + 1280 + c]; }
            F.HC[(size_t)row * 512 + c] = (bf16_t)f2bf(a * sigmoidf_fast(g));
        }
    }
}
__device__ __forceinline__ void att_naive(Frame& F) {
    const int gw = F.bid * NWAVES + F.wave, NGW = F.G * NWAVES, lane = F.lane;
    for (int it = gw; it < M_REAL * NQH; it += NGW) {
        const int row = it >> 3, h = it & 7, hk = h >> 2, b = row >> 11, qp = row & 2047;
        const float q = bf2f(F.Qb[(size_t)row * 512 + h * 64 + lane]);
        const float slope2 = exp2f(-(float)(h + 1)) * LOG2E;
        float m = F.sink[h] * LOG2E, l = 1.f, acc = 0.f;
        const bf16_t* vt = F.VT + ((size_t)(b * 2 + hk) * 64 + lane) * VT_PITCH;
        for (int j = 0; j < NMETA; ++j) {
            const float kv = bf2f(F.Kb[(size_t)(M_REAL + b * NMETA + j) * 128 + hk * 64 + lane]);
            const float s = wave_sum(q * kv);
            const float mn = fmaxf(m, s), al = exp2f(m - mn), p = exp2f(s - mn);
            l = l * al + p; acc = acc * al + p * bf2f(vt[j]); m = mn;
        }
        const int k0 = qp - 128 < 0 ? 0 : qp - 128, k1 = qp + 128 > SEQ - 1 ? SEQ - 1 : qp + 128;
        for (int kp = k0; kp <= k1; ++kp) {
            const float kv = bf2f(F.Kb[(size_t)(b * SEQ + kp) * 128 + hk * 64 + lane]);
            const float dist = (float)(qp > kp ? qp - kp : kp - qp);
            const float s = wave_sum(q * kv) - slope2 * dist;
            const float mn = fmaxf(m, s), al = exp2f(m - mn), p = exp2f(s - mn);
            l = l * al + p; acc = acc * al + p * bf2f(vt[NMETA + kp]); m = mn;
        }
        F.MIX[(size_t)row * D + h * 64 + lane] = (bf16_t)f2bf(acc / l);
    }
}
__device__ __forceinline__ void conv_naive(Frame& F) {
    const int gw = F.bid * NWAVES + F.wave, NGW = F.G * NWAVES, lane = F.lane;
    for (int row = gw; row < M_REAL; row += NGW) {
        const int b = row >> 11, s0 = NMETA + (row & 2047);
        float v[8]; float sum = 0.f;
#pragma unroll
        for (int j = 0; j < 8; ++j) { const int c = lane + 64 * j; float a = F.dw_b[c];
            _Pragma("unroll 1") for (int t = 0; t < CONV_K; ++t) { const int s = s0 - 15 + t; if (s >= 0 && s < LSEQ) a += F.dw_w[t * CONV_W + c] * bf2f(F.HC[(size_t)row_of(b, s) * 512 + c]); }
            v[j] = a; sum += a; }
        const float mu = wave_sum(sum) * (1.f / 512.f); float q = 0.f;
#pragma unroll
        for (int j = 0; j < 8; ++j) { const float d = v[j] - mu; q += d * d; }
        const float rstd = 1.f / sqrtf(wave_sum(q) * (1.f / 512.f) + 1e-5f);
#pragma unroll
        for (int j = 0; j < 8; ++j) { const int c = lane + 64 * j; const float y = (v[j] - mu) * rstd * F.lng[c] + F.lnb[c];
            F.MIX[(size_t)row * D + 512 + c] = (bf16_t)f2bf(y * sigmoidf_fast(y)); }
    }
}
__device__ __forceinline__ void p3_naive(Frame& F) {
    const int gw = F.bid * NWAVES + F.wave, NGW = F.G * NWAVES, lane = F.lane;
    for (int it = gw; it < M_REAL * 16; it += NGW) {
        const int row = it >> 4, col = (it & 15) * 64 + lane; const bf16_t* mr = F.MIX + (size_t)row * D; float acc = 0.f;
        for (int k = 0; k < D; ++k) acc += bf2f(mr[k]) * F.w_out[(size_t)k * D + col];
        const float h2 = F.x[(size_t)row * D + col] + acc;
        F.out[(size_t)row * D + col] = h2; F.XN2[(size_t)row * D + col] = (bf16_t)f2bf(h2);
    }
}
__device__ __forceinline__ void p4_naive(Frame& F) {
    const int gw = F.bid * NWAVES + F.wave, NGW = F.G * NWAVES, lane = F.lane, e = lane & 31;
    for (int t = gw; t < M_REAL; t += NGW) {
        const bf16_t* xr = F.XN2 + (size_t)t * D; float acc = 0.f, ss = 0.f;
        for (int k = 0; k < D; ++k) { const float xv = bf2f(xr[k]); acc += xv * F.n2g[k] * F.wr[k * NE + e]; ss += xv * xv; }
        const float rstd = 1.f / sqrtf(ss * (1.f / D) + 1e-6f);
        float lg = acc * rstd + F.rb[e];
        float tv[4]; int te[4];
#pragma unroll
        for (int kk = 0; kk < 4; ++kk) {
            float bv = lg; int be = e;
#pragma unroll
            for (int o = 1; o < 32; o <<= 1) { const float pv = __shfl_xor(bv, o); const int pe = __shfl_xor(be, o); if (pv > bv || (pv == bv && pe < be)) { bv = pv; be = pe; } }
            tv[kk] = bv; te[kk] = be; if (e == be) lg = -INFINITY;
        }
        float p[4], ps = 0.f;
#pragma unroll
        for (int kk = 0; kk < 4; ++kk) { p[kk] = __expf(tv[kk] - tv[0]); ps += p[kk]; }
        if (lane < 4) {
            const int ee = lane == 0 ? te[0] : lane == 1 ? te[1] : lane == 2 ? te[2] : te[3];
            const float gg = (lane == 0 ? p[0] : lane == 1 ? p[1] : lane == 2 ? p[2] : p[3]) / ps;
            const unsigned slot = __hip_atomic_fetch_add((unsigned*)(F.ctl + CW_CNT + ee), 1u, RLX_AGENT);
            F.ltok[ee * CAP + slot] = t; F.lgate[ee * CAP + slot] = gg; F.lrstd[ee * CAP + slot] = rstd; F.where[t * 4 + lane] = ee * CAP + (int)slot;
        }
    }
}
__device__ __forceinline__ void build_tile_table(Frame& F) {
    LAS int* tb = (LAS int*)(F.lds + LX_TB); LAS int* cn = (LAS int*)(F.lds + LX_CNT);
    __syncthreads();
    if (F.tid == 0) { int acc = 0; for (int e = 0; e < NE; ++e) { int c = (int)__hip_atomic_load(F.ctl + CW_CNT + e, RLX_AGENT); if (c > CAP) c = CAP; if (c < 0) c = 0; cn[e] = c; tb[e] = acc; acc += (c + 255) >> 8; } tb[NE] = acc; }
    __syncthreads();
}
__device__ __forceinline__ int find_expert(const LAS int* tb, int tile) { int e = 0;
#pragma unroll 1
    for (int j = 1; j < NE; ++j) if (tb[j] <= tile) e = j;
    return e; }
__device__ __forceinline__ void p5_naive(Frame& F) {
    build_tile_table(F);
    const LAS int* tb = (const LAS int*)(F.lds + LX_TB); const LAS int* cn = (const LAS int*)(F.lds + LX_CNT);
    const int gw = F.bid * NWAVES + F.wave, NGW = F.G * NWAVES, lane = F.lane, total = tb[NE] * 256;
    for (int it = gw; it < total * 16; it += NGW) {
        const int sr = it >> 4, c = (it & 15) * 64 + lane, e = find_expert(tb, sr >> 8), slot = sr - tb[e] * 256;
        if (slot >= cn[e]) continue;
        const int tok = F.ltok[e * CAP + slot]; const float rstd = F.lrstd[e * CAP + slot];
        const bf16_t* xr = F.XN2 + (size_t)tok * D; const float* W = F.wgu + (size_t)e * D * 2048; float g = 0.f, u = 0.f;
        for (int k = 0; k < D; ++k) { const float xv = bf2f(xr[k]) * F.n2g[k]; g += xv * W[(size_t)k * 2048 + c]; u += xv * W[(size_t)k * 2048 + 1024 + c]; }
        g = g * rstd + F.bgu[e * 2048 + c]; u = u * rstd + F.bgu[e * 2048 + 1024 + c];
        g = fminf(g, 7.f); u = fminf(fmaxf(u, -7.f), 7.f);
        F.ACT[(size_t)sr * D + c] = (bf16_t)f2bf(g * sigmoidf_fast(1.702f * g) * (u + 1.f));
    }
}
__device__ __forceinline__ void p6_naive(Frame& F) {
    build_tile_table(F);
    const LAS int* tb = (const LAS int*)(F.lds + LX_TB); const LAS int* cn = (const LAS int*)(F.lds + LX_CNT);
    const int gw = F.bid * NWAVES + F.wave, NGW = F.G * NWAVES, lane = F.lane, total = tb[NE] * 256;
    for (int it = gw; it < total * 16; it += NGW) {
        const int sr = it >> 4, c = (it & 15) * 64 + lane, e = find_expert(tb, sr >> 8), slot = sr - tb[e] * 256;
        if (slot >= cn[e]) continue;
        const bf16_t* ar = F.ACT + (size_t)sr * D; const float* W = F.wd + (size_t)e * D * D; float acc = 0.f;
        for (int k = 0; k < D; ++k) acc += bf2f(ar[k]) * W[(size_t)k * D + c];
        F.Y[(size_t)sr * D + c] = (bf16_t)f2bf((acc + F.bd[e * D + c]) * F.lgate[e * CAP + slot]);
    }
}
__device__ __forceinline__ void p7_combine(Frame& F) {
    build_tile_table(F);
    const LAS int* tb = (const LAS int*)(F.lds + LX_TB);
    const int gw = F.bid * NWAVES + F.wave, NGW = F.G * NWAVES, lane = F.lane;
    for (int t = gw; t < M_REAL; t += NGW) {
        GAS f32x4* o = (GAS f32x4*)(F.out + (size_t)t * D) + lane * 4;
        f32x4 a[4];
#pragma unroll
        for (int j = 0; j < 4; ++j) a[j] = o[j];
#pragma unroll
        for (int k = 0; k < 4; ++k) {
            const int w = F.where[t * 4 + k], e = w / CAP, slot = w - e * CAP;
            const GAS u32x4* y = (const GAS u32x4*)(F.Y + (size_t)(tb[e] * 256 + slot) * D) + lane * 2;
            const u32x4 y0 = y[0], y1 = y[1];
            a[0] += (f32x4){bflo(y0.x), bfhi(y0.x), bflo(y0.y), bfhi(y0.y)}; a[1] += (f32x4){bflo(y0.z), bfhi(y0.z), bflo(y0.w), bfhi(y0.w)};
            a[2] += (f32x4){bflo(y1.x), bfhi(y1.x), bflo(y1.y), bfhi(y1.y)}; a[3] += (f32x4){bflo(y1.z), bfhi(y1.z), bflo(y1.w), bfhi(y1.w)};
        }
#pragma unroll
        for (int j = 0; j < 4; ++j) o[j] = a[j];
    }
}

__global__ void __launch_bounds__(NTHR, 2) mega(Args args) {
    extern __shared__ __attribute__((aligned(16))) unsigned char lds_raw[];
    Frame F;
    F.lds = (LAS unsigned char*)lds_raw;
    F.tid = threadIdx.x; F.lane = F.tid & 63; F.wave = __builtin_amdgcn_readfirstlane(F.tid >> 6); F.G = gridDim.x; F.bid = blockIdx.x;
    F.x = args.in[0]; F.meta = args.in[1]; F.n1g = args.in[2]; F.w_in = args.in[3]; F.qg = args.in[4]; F.kg = args.in[5]; F.sink = args.in[6];
    F.dw_w = args.in[7]; F.dw_b = args.in[8]; F.lng = args.in[9]; F.lnb = args.in[10]; F.w_out = args.in[11]; F.n2g = args.in[12];
    F.wr = args.in[13]; F.rb = args.in[14]; F.wgu = args.in[15]; F.bgu = args.in[16]; F.wd = args.in[17]; F.bd = args.in[18];
    F.out = args.out; F.ws = args.ws; unsigned char* ws = args.ws;
    F.ctl = (gu32*)(ws + WS_CTL);
    F.WinT = (bf16_t*)(ws + WS_WIN_T); F.WoT = (bf16_t*)(ws + WS_WO_T); F.WrT = (bf16_t*)(ws + WS_WR_T); F.WdT = (bf16_t*)(ws + WS_WD_T); F.WguT = (bf16_t*)(ws + WS_WGU_T);
    F.XN = (bf16_t*)(ws + WS_XN); F.Qb = (bf16_t*)(ws + WS_Q); F.Kb = (bf16_t*)(ws + WS_K); F.VT = (bf16_t*)(ws + WS_VT); F.HC = (bf16_t*)(ws + WS_HC);
    F.MIX = (bf16_t*)(ws + WS_MIX); F.XN2 = (bf16_t*)(ws + WS_XN2); F.ACT = (bf16_t*)(ws + WS_ACT); F.Y = (bf16_t*)(ws + WS_Y);
    F.where = (int*)(ws + WS_WHERE); F.ltok = (int*)(ws + WS_LTOK); F.lgate = (float*)(ws + WS_LGATE); F.lrstd = (float*)(ws + WS_LRSTD);
    for (int u = F.tid; u < (LDS_BYTES - RING_BYTES) / 4; u += NTHR) ((LAS unsigned*)(F.lds + RING_BYTES))[u] = 0u;
    __syncthreads();
    const int lo = args.ph_lo, hi = args.ph_hi;
    XcdBarrier bar; bar.bar = (unsigned*)(F.ctl + CW_BAR); bar.x = 0; bar.st = nullptr;
    if (hi - lo > 1) bar = xcd_barrier_post((unsigned*)(F.ctl + CW_BAR), (volatile LAS unsigned*)(F.lds + LX_BAR));
#ifndef PH_MASK
#define PH_MASK 0xFF
#endif
#define IN(k) (((PH_MASK >> (k)) & 1) && lo <= (k) && (k) < hi)
#define SEAM(k) do { if (IN(k) && IN((k) + 1)) xcd_barrier(bar); } while (0)
    if (IN(0)) { p0_prologue(F); } SEAM(0);
    if (IN(1)) { p1_naive(F); } SEAM(1);
    if (IN(2)) { att_naive(F); conv_naive(F); } SEAM(2);
    if (IN(3)) { p3_naive(F); } SEAM(3);
    if (IN(4)) { p4_naive(F); } SEAM(4);
    if (IN(5)) { p5_naive(F); } SEAM(5);
    if (IN(6)) { p6_naive(F); } SEAM(6);
    if (IN(7)) { p7_combine(F); }
#undef IN
#undef SEAM
}

extern "C" void kernel_launch(void* const* d_in, const int* in_sizes, int n_in, void* d_out, int out_size, void* d_ws, size_t ws_size, hipStream_t stream) {
    static int grid = 0;
    if (grid == 0) {
        if (n_in != 19 || in_sizes[0] != M_REAL * D || out_size != M_REAL * D || ws_size < WS_END) {
            fprintf(stderr, "kernel_launch: unexpected shapes/workspace: n_in %d in0 %d out %d ws %zu (need %zu)\n", n_in, n_in > 0 ? in_sizes[0] : -1, out_size, ws_size, (size_t)WS_END); grid = -1; return; }
        int dev = 0, cus = 0, per_cu = 0;
        if (hipGetDevice(&dev) != hipSuccess || hipDeviceGetAttribute(&cus, hipDeviceAttributeMultiprocessorCount, dev) != hipSuccess) { grid = -1; return; }
        if (hipFuncSetAttribute((const void*)mega, hipFuncAttributeMaxDynamicSharedMemorySize, LDS_BYTES) != hipSuccess) { fprintf(stderr, "kernel_launch: hipFuncSetAttribute failed\n"); grid = -1; return; }
        if (hipOccupancyMaxActiveBlocksPerMultiprocessor(&per_cu, (const void*)mega, NTHR, LDS_BYTES) != hipSuccess || per_cu < 1) { fprintf(stderr, "kernel_launch: occupancy query says %d blocks/CU\n", per_cu); (void)hipGetLastError(); grid = -1; return; }
        grid = cus;
    }
    if (grid < 0) return;
    (void)hipMemsetAsync((char*)d_ws + WS_CTL, 0, CTL_ZERO_BYTES, stream);
    Args a{};
    for (int i = 0; i < 19; ++i) a.in[i] = (const float*)d_in[i];
    a.out = (float*)d_out; a.ws = (unsigned char*)d_ws;
#if MK_PER_PHASE
    for (int p = 0; p < 8; ++p) { a.ph_lo = p; a.ph_hi = p + 1; hipLaunchKernelGGL(mega, dim3(grid), dim3(NTHR), LDS_BYTES, stream, a); }
#else
    a.ph_lo = 0; a.ph_hi = 8; hipLaunchKernelGGL(mega, dim3(grid), dim3(NTHR), LDS_BYTES, stream, a);
#endif
}
```

```cpp
#include <hip/hip_runtime.h>
#include <cstdio>
#include <cstdint>

#ifndef MK_PER_PHASE
#define MK_PER_PHASE 0
#endif
#ifndef FAST_P1
#define FAST_P1 1
#endif
#ifndef FAST_ATT
#define FAST_ATT 0
#endif
#ifndef FAST_CONV
#define FAST_CONV 0
#endif
#ifndef FAST_P3
#define FAST_P3 1
#endif
#ifndef FAST_P4
#define FAST_P4 0
#endif
#ifndef FAST_P5
#define FAST_P5 1
#endif
#ifndef FAST_P6
#define FAST_P6 1
#endif

#define GAS __attribute__((address_space(1)))
#define LAS __attribute__((address_space(3)))
typedef unsigned short bf16_t;
typedef short bf16x8 __attribute__((ext_vector_type(8)));
typedef float f32x4 __attribute__((ext_vector_type(4)));
typedef float f32x16 __attribute__((ext_vector_type(16)));
typedef unsigned u32x4 __attribute__((ext_vector_type(4)));
typedef unsigned u32x2 __attribute__((ext_vector_type(2)));
typedef GAS unsigned gu32;
#define RLX_AGENT __ATOMIC_RELAXED, __HIP_MEMORY_SCOPE_AGENT

constexpr int NB = 8, SEQ = 2048, D = 1024, NMETA = 16, LSEQ = NMETA + SEQ;
constexpr int M_REAL = NB * SEQ, M_ALL = NB * LSEQ, M_PAD = 16640;
constexpr int IN_W = 1792, HD = 64, NQH = 8, NKV = 2, CONV_W = 512, CONV_K = 31;
constexpr int NE = 32, CAP = 16384, ACT_ROWS = 4 * M_REAL + NE * 256;
constexpr float LOG2E = 1.4426950408889634f;
constexpr float QSCALE = 0.125f * LOG2E;
constexpr int VT_PITCH = LSEQ;

constexpr size_t MiB = 1u << 20;
constexpr size_t WS_CTL = 0, CTL_ZERO_BYTES = 1 * MiB;
constexpr size_t WS_WIN_T = 2 * MiB;
constexpr size_t WS_WO_T = 6 * MiB;
constexpr size_t WS_WR_T = 8 * MiB;
constexpr size_t WS_RSTD = 9 * MiB;
constexpr size_t WS_WHERE = 9 * MiB + 512 * 1024;
constexpr size_t WS_LTOK = 10 * MiB;
constexpr size_t WS_LGATE = 12 * MiB;
constexpr size_t WS_LRSTD = 14 * MiB;
constexpr size_t WS_WD_T = 16 * MiB;
constexpr size_t WS_WGU_T = 80 * MiB;
constexpr size_t WS_XN = 208 * MiB;
constexpr size_t WS_Q = 241 * MiB;
constexpr size_t WS_K = 258 * MiB;
constexpr size_t WS_VT = 263 * MiB;
constexpr size_t WS_HC = 268 * MiB;
constexpr size_t WS_MIX = 285 * MiB;
constexpr size_t WS_XN2 = 317 * MiB;
constexpr size_t WS_ACT = 349 * MiB;
constexpr size_t WS_Y = 493 * MiB;
constexpr size_t WS_END = 637 * MiB;
constexpr int CW_CNT = 64;
constexpr int CW_BAR = 4096;

constexpr int RING_BYTES = 131072;
constexpr int LX_BAR = RING_BYTES;
constexpr int LX_TB = RING_BYTES + 64;
constexpr int LX_CNT = RING_BYTES + 256;
constexpr int LX_LCNT = RING_BYTES + 512;
constexpr int LX_GBASE = RING_BYTES + 768;
constexpr int LDS_BYTES = 147456;

constexpr int NWAVES = 8, NTHR = 512;

__device__ __forceinline__ unsigned f2bf(float f) { unsigned u = __builtin_bit_cast(unsigned, f); return (u + 0x7fffu + ((u >> 16) & 1u)) >> 16; }
__device__ __forceinline__ unsigned pk2(float lo, float hi) { return f2bf(lo) | (f2bf(hi) << 16); }
__device__ __forceinline__ float bf2f(unsigned b) { return __builtin_bit_cast(float, b << 16); }
__device__ __forceinline__ float bflo(unsigned w) { return __builtin_bit_cast(float, w << 16); }
__device__ __forceinline__ float bfhi(unsigned w) { return __builtin_bit_cast(float, w & 0xffff0000u); }
__device__ __forceinline__ float wave_sum(float v) {
#pragma unroll
    for (int o = 1; o < 64; o <<= 1) v += __shfl_xor(v, o);
    return v;
}
__device__ __forceinline__ float sigmoidf_fast(float x) { return __builtin_amdgcn_rcpf(1.0f + __builtin_amdgcn_exp2f(-x * LOG2E)); }
__device__ __forceinline__ int row_of(int b, int s) { return s < NMETA ? M_REAL + b * NMETA + s : b * SEQ + (s - NMETA); }

#define XB_TMO      128
#define XB_XCNT(j)  (256  + 64 * (j))
#define XB_XSUB(j)  (1280 + 64 * (j))
#define XB_XGEN(j)  (2304 + 64 * (j))
#define XB_TOP      3328
#define XB_TOPGEN   3392
#define XCD_BAR_WORDS 3456
#define XB_SPIN_CAP (1u << 18)
__device__ __forceinline__ unsigned xb_ld(unsigned* p)              { return __hip_atomic_load(p, __ATOMIC_RELAXED, __HIP_MEMORY_SCOPE_AGENT); }
__device__ __forceinline__ unsigned xb_add(unsigned* p, unsigned v) { return __hip_atomic_fetch_add(p, v, __ATOMIC_RELAXED, __HIP_MEMORY_SCOPE_AGENT); }
__device__ __forceinline__ unsigned xb_xcc_id() { return (unsigned)__builtin_amdgcn_s_getreg((3 << 11) | 20) & 0xFu; }
#define XB_SPIN(cond, bar) do { unsigned _sp = 0; while (cond) { __builtin_amdgcn_s_sleep(1); \
    if ((++_sp & 255u) == 0u) { if (xb_ld(&(bar)[XB_TMO])) break; if (_sp > XB_SPIN_CAP) { atomicAdd(&(bar)[XB_TMO], 1u); break; } } } } while (0)
struct XcdBarrier { unsigned* bar; unsigned x; volatile LAS unsigned* st; };
__device__ __forceinline__ XcdBarrier xcd_barrier_post(unsigned* bar, volatile LAS unsigned* st) {
    XcdBarrier b; b.bar = bar; b.x = xb_xcc_id(); b.st = st;
    if (threadIdx.x == 0) (void)xb_add(&bar[XB_XCNT(b.x)], 1u);
    return b;
}
__device__ __forceinline__ void xcd_barrier_complete(unsigned* bar, unsigned x, unsigned& nloc, unsigned& nx) {
    const unsigned G = gridDim.x * gridDim.y * gridDim.z;
    unsigned sum, cnt, mine, sp = 0u;
    for (;;) {
        sum = 0u; cnt = 0u; mine = 0u;
#pragma unroll
        for (unsigned j = 0; j < 16; ++j) { const unsigned c = xb_ld(&bar[XB_XCNT(j)]); sum += c; cnt += (c > 0u) ? 1u : 0u; mine = (j == x) ? c : mine; }
        if (sum == G) break;
        __builtin_amdgcn_s_sleep(1);
        if ((++sp & 255u) == 0u) { if (xb_ld(&bar[XB_TMO])) break; if (sp > XB_SPIN_CAP) { atomicAdd(&bar[XB_TMO], 1u); break; } }
    }
    nloc = mine > 0u ? mine : 1u; nx = cnt > 0u ? cnt : 1u;
}
__device__ __forceinline__ void xcd_barrier(const XcdBarrier& b) {
    asm volatile("s_waitcnt vmcnt(0)" ::: "memory");
    __syncthreads();
    if (threadIdx.x == 0) {
        unsigned* bar = b.bar;
        __builtin_amdgcn_s_waitcnt(0);
        unsigned nloc = b.st[0], nx = b.st[1];
        if (nloc == 0u) { xcd_barrier_complete(bar, b.x, nloc, nx); b.st[0] = nloc; b.st[1] = nx; }
        const unsigned old = xb_add(&bar[XB_XSUB(b.x)], 1u);
        const unsigned gen = old / nloc;
        if (old + 1u == (gen + 1u) * nloc) {
            __builtin_amdgcn_fence(__ATOMIC_RELEASE, "agent");
            asm volatile("s_waitcnt vmcnt(0)" ::: "memory");
            const unsigned og = xb_add(&bar[XB_TOP], 1u);
            const unsigned tg = og / nx;
            if (og + 1u == (tg + 1u) * nx) xb_add(&bar[XB_TOPGEN], 1u);
            else XB_SPIN(xb_ld(&bar[XB_TOPGEN]) == tg, bar);
            __builtin_amdgcn_fence(__ATOMIC_ACQUIRE, "agent");
            xb_add(&bar[XB_XGEN(b.x)], 1u);
            asm volatile("s_waitcnt vmcnt(0)" ::: "memory");
        } else {
            XB_SPIN(xb_ld(&bar[XB_XGEN(b.x)]) == gen, bar);
            __builtin_amdgcn_fence(__ATOMIC_ACQUIRE, "agent");
            asm volatile("s_waitcnt vmcnt(0)" ::: "memory");
        }
    }
    __syncthreads();
}

struct Args { const float* in[19]; float* out; unsigned char* ws; int ph_lo, ph_hi; };
struct Frame {
    LAS unsigned char* lds;
    int tid, lane, wave, G, bid;
    const float *x, *meta, *n1g, *w_in, *qg, *kg, *sink, *dw_w, *dw_b, *lng, *lnb, *w_out, *n2g, *wr, *rb, *wgu, *bgu, *wd, *bd;
    float* out;
    unsigned char* ws;
    gu32* ctl;
    bf16_t *WinT, *WoT, *WrT, *WdT, *WguT, *XN, *Qb, *Kb, *VT, *HC, *MIX, *XN2, *ACT, *Y;
    int* where; int* ltok; float* lgate; float* lrstd;
};

__device__ __forceinline__ int perm32(int rho) { const int n = rho >> 4, i = rho & 15; return 8 * (i >> 2) + 4 * n + (i & 3); }
__device__ __forceinline__ int lbase_nat(int pg) { return 32 * pg; }
__device__ __forceinline__ int lbase_in(int pg) { const int tile = pg >> 3, bj = (pg >> 2) & 1, wc = pg & 3; return tile <= 2 ? tile * 256 + 64 * wc + 32 * bj : 768 + bj * 512 + (tile - 3) * 128 + 32 * wc; }
__device__ __forceinline__ int lbase_gu(int pg) { const int tile = pg >> 3, bj = (pg >> 2) & 1, wc = pg & 3; return bj * 1024 + tile * 128 + 32 * wc; }
__device__ __forceinline__ void p0_transpose_item(const float* W, int K, int N, bf16_t* WT, int pg, int n0, int kb, const float* g, LAS float* scr, int lane, bool permute) {
    const int k0 = 64 * kb;
#pragma unroll 8
    for (int i = 0; i < 32; ++i) { const int kk = 2 * i + (lane >> 5); float v = W[(size_t)(k0 + kk) * N + n0 + (lane & 31)]; if (g) v *= g[k0 + kk]; scr[kk * 33 + (lane & 31)] = v; }
    asm volatile("s_waitcnt lgkmcnt(0)" ::: "memory");
    const int c = lane & 7;
#pragma unroll
    for (int j = 0; j < 4; ++j) { const int r = (lane >> 3) + 8 * j; const int sc = permute ? perm32(r) : r; const LAS float* s = scr + (8 * c) * 33 + sc;
        u32x4 o; o.x = pk2(s[0 * 33], s[1 * 33]); o.y = pk2(s[2 * 33], s[3 * 33]); o.z = pk2(s[4 * 33], s[5 * 33]); o.w = pk2(s[6 * 33], s[7 * 33]);
        *(GAS u32x4*)(WT + (size_t)(32 * pg + r) * K + k0 + 8 * c) = o; }
    asm volatile("s_waitcnt lgkmcnt(0)" ::: "memory");
}
__device__ __forceinline__ void p0_prologue(Frame& F) {
    LAS float* scr = (LAS float*)(F.lds + F.wave * 16384);
    const int gw = F.bid * NWAVES + F.wave, NGW = F.G * NWAVES, lane = F.lane;
    for (int m = gw; m < M_PAD; m += NGW) {
        GAS unsigned long long* o8 = (GAS unsigned long long*)(F.XN + (size_t)m * D) + lane;
        if (m >= M_ALL) {
#pragma unroll
            for (int j = 0; j < 4; ++j) o8[64 * j] = 0ull;
            continue; }
        const float* src = m < M_REAL ? F.x + (size_t)m * D : F.meta + (size_t)((m - M_REAL) & (NMETA - 1)) * D;
        const GAS f32x4* xr = (const GAS f32x4*)src + lane; const GAS f32x4* gr = (const GAS f32x4*)F.n1g + lane;
        f32x4 v[4]; float s = 0.f;
#pragma unroll
        for (int j = 0; j < 4; ++j) { v[j] = xr[64 * j]; s += (v[j].x * v[j].x + v[j].y * v[j].y) + (v[j].z * v[j].z + v[j].w * v[j].w); }
        const float rstd = 1.f / sqrtf(wave_sum(s) * (1.f / D) + 1e-6f);
#pragma unroll
        for (int j = 0; j < 4; ++j) { const f32x4 g = gr[64 * j]; o8[64 * j] = (unsigned long long)pk2(v[j].x * rstd * g.x, v[j].y * rstd * g.y) | ((unsigned long long)pk2(v[j].z * rstd * g.z, v[j].w * rstd * g.w) << 32); }
    }
    constexpr int I_IN = 16 * 56, I_O = 16 * 32, I_R = 16, I_GU = NE * 16 * 64, I_D = NE * 16 * 32;
    constexpr int NITEMS = I_IN + I_O + I_R + I_GU + I_D;
    for (int it = gw; it < NITEMS; it += NGW) {
        int r = it;
        if (r < I_IN) { const int pg = r % 56, kb = r / 56; p0_transpose_item(F.w_in, D, IN_W, F.WinT, pg, lbase_in(pg), kb, nullptr, scr, lane, true); continue; } r -= I_IN;
        if (r < I_O) { const int pg = r % 32, kb = r / 32; p0_transpose_item(F.w_out, D, D, F.WoT, pg, lbase_nat(pg), kb, nullptr, scr, lane, true); continue; } r -= I_O;
        if (r < I_R) { p0_transpose_item(F.wr, D, NE, F.WrT, 0, 0, r, F.n2g, scr, lane, false); continue; } r -= I_R;
        if (r < I_GU) { const int e = r / (16 * 64), q = r % (16 * 64), pg = q % 64, kb = q / 64;
            p0_transpose_item(F.wgu + (size_t)e * D * 2048, D, 2048, F.WguT + (size_t)e * 2048 * D, pg, lbase_gu(pg), kb, F.n2g, scr, lane, true); continue; } r -= I_GU;
        { const int e = r / (16 * 32), q = r % (16 * 32), pg = q % 32, kb = q / 32;
            p0_transpose_item(F.wd + (size_t)e * D * D, D, D, F.WdT + (size_t)e * D * D, pg, lbase_nat(pg), kb, nullptr, scr, lane, true); }
    }
}


namespace pg8 {
constexpr int BM = 256, BK = 64, HALF = 128, HTB = HALF * BK * 2, STAGE_BYTES = 8 * HTB, NXCD = 8, WGM = 8, KD = 1024;
__device__ __forceinline__ int lds_byte(int r, int c) { const int st = (r >> 4) * 2 + (c >> 5), rr = r & 15, cc = c & 31, ob = rr * 64 + cc * 2; return st * 1024 + (ob ^ (((ob >> 9) & 1) << 5)); }
__device__ __forceinline__ void stage_rc(int b, int& R, int& C) { const int st = b / 1024, sb = b % 1024, swz = sb ^ (((sb >> 9) & 1) << 5); R = (st >> 1) * 16 + swz / 64; C = (st & 1) * 32 + (swz % 64) / 2; }
struct Unit { int pm, pn, e, slot0, nvalid; };
__device__ __forceinline__ unsigned cvt_pk_bf16(float lo, float hi) { unsigned r; asm volatile("v_cvt_pk_bf16_f32 %0, %1, %2" : "=v"(r) : "v"(lo), "v"(hi)); return r; }
__device__ __forceinline__ u32x4 pack8(const f32x4 a, const f32x4 b) { u32x4 w; w.x = cvt_pk_bf16(a[0], a[1]); w.y = cvt_pk_bf16(a[2], a[3]); w.z = cvt_pk_bf16(b[0], b[1]); w.w = cvt_pk_bf16(b[2], b[3]); return w; }

__device__ __forceinline__ bool tile_order(int i, int G, int c, int nM, int nN, int& pm, int& pn) {
    const int nwg = nM * nN; const long L = (long)i * G + c; if (L >= nwg) return false;
    int wgid = (int)L; { const int q = nwg / NXCD, r = nwg % NXCD, xcd = wgid % NXCD, off = wgid / NXCD; wgid = (xcd < r ? xcd * (q + 1) : r * (q + 1) + (xcd - r) * q) + off; }
    const int nig = WGM * nN, gid = wgid / nig, fm = gid * WGM, gsz = (nM - fm) < WGM ? (nM - fm) : WGM;
    pm = fm + ((wgid % nig) % gsz); pn = (wgid % nig) / gsz; return true;
}
struct DenseProb {
    const bf16_t* A; const bf16_t* Bt; int nM, nN, G, c;
    __device__ __forceinline__ bool next(int i, Unit& u) const { u.e = 0; u.slot0 = 0; u.nvalid = 256; return tile_order(i, G, c, nM, nN, u.pm, u.pn); }
    __device__ __forceinline__ void addr(const Unit& u, const int (&R)[2], const int (&C)[2], const char*& a, const char*& b, unsigned (&va0)[2], unsigned (&va1)[2]) const {
        a = (const char*)A + (size_t)u.pm * (BM * KD * 2); b = (const char*)Bt + (size_t)u.pn * (BM * KD * 2);
#pragma unroll
        for (int i = 0; i < 2; ++i) { va0[i] = (unsigned)(R[i] * KD + C[i]) * 2u; va1[i] = va0[i] + (unsigned)(HALF * KD * 2); }
    }
};
template <bool GATHER> struct GroupedProb {
    const bf16_t* A; const bf16_t* Bt; const int* ltok; const LAS int* tb; const LAS int* cn; int nN, G, c;
    __device__ __forceinline__ bool next(int i, Unit& u) const {
        const int nM = tb[NE]; if (!tile_order(i, G, c, nM, nN, u.pm, u.pn)) return false;
        int e = 0;
#pragma unroll 1
        for (int j = 1; j < NE; ++j) if (tb[j] <= u.pm) e = j;
        u.e = e; u.slot0 = (u.pm - tb[e]) * 256; const int rem = cn[e] - u.slot0; u.nvalid = rem < 256 ? rem : 256; return true;
    }
    __device__ __forceinline__ void addr(const Unit& u, const int (&R)[2], const int (&C)[2], const char*& a, const char*& b, unsigned (&va0)[2], unsigned (&va1)[2]) const {
        b = (const char*)Bt + ((size_t)u.e * nN + u.pn) * (BM * KD * 2);
        if (GATHER) {
            a = (const char*)A; const int* lt = ltok + u.e * CAP + u.slot0;
#pragma unroll
            for (int i = 0; i < 2; ++i) { const int r0 = R[i], r1 = R[i] + HALF; const int t0 = r0 < u.nvalid ? lt[r0] : 0, t1 = r1 < u.nvalid ? lt[r1] : 0;
                va0[i] = (unsigned)(t0 * KD + C[i]) * 2u; va1[i] = (unsigned)(t1 * KD + C[i]) * 2u; }
        } else {
            a = (const char*)A + (size_t)u.pm * (BM * KD * 2);
#pragma unroll
            for (int i = 0; i < 2; ++i) { va0[i] = (unsigned)(R[i] * KD + C[i]) * 2u; va1[i] = va0[i] + (unsigned)(HALF * KD * 2); }
        }
    }
};

template <class Prob, class Epi>
__device__ __forceinline__ void gemm_phase(LAS unsigned char* lds, const Prob& P, const Epi& E) {
    const int tid = threadIdx.x, wid = __builtin_amdgcn_readfirstlane(tid >> 6), lane = tid & 63, wr = wid >> 2, wc = wid & 3, fr = lane & 15, fq = lane >> 4;
    constexpr int nt = KD / BK;
    int R[2], C[2]; unsigned voffB[2];
#pragma unroll
    for (int i = 0; i < 2; ++i) { stage_rc(tid * 16 + i * 8192, R[i], C[i]); voffB[i] = (unsigned)(R[i] * KD + C[i]) * 2u; }
    constexpr size_t kstep = (size_t)(BK * 2);
    constexpr size_t hstep = (size_t)HALF * KD * 2;
    const unsigned ldsw = (unsigned)wid * 1024u;
    const int aoff = lds_byte(wr * 64 + fr, fq * 8), boff = lds_byte(wc * 32 + fr, fq * 8);
#define PG8_SA(b, h) (((b) * 2 + (h)) * HTB)
#define PG8_SB(b, h) ((4 + (b) * 2 + (h)) * HTB)
#define PG8_STAGE(bufoff, gbase, voff) do { _Pragma("unroll") for (int _i = 0; _i < 2; ++_i) \
        __builtin_amdgcn_global_load_lds((const unsigned*)((const char*)(gbase) + (voff)[_i]), (LAS unsigned*)(lds + (bufoff) + ldsw + _i * 8192), 16, 0, 0); } while (0)
#define PG8_LDA(dst, b, h) do { _Pragma("unroll") for (int m = 0; m < 4; ++m) _Pragma("unroll") for (int k = 0; k < 2; ++k) dst[m][k] = *(const LAS bf16x8*)(lds + PG8_SA(b, h) + aoff + m * 2048 + k * 1024); } while (0)
#define PG8_LDB(dst, b, h) do { _Pragma("unroll") for (int n = 0; n < 2; ++n) _Pragma("unroll") for (int k = 0; k < 2; ++k) dst[n][k] = *(const LAS bf16x8*)(lds + PG8_SB(b, h) + boff + n * 2048 + k * 1024); } while (0)
#define PG8_MMA(ai, bj, At, Bt) do { __builtin_amdgcn_s_setprio(1); _Pragma("unroll") for (int m = 0; m < 4; ++m) _Pragma("unroll") for (int n = 0; n < 2; ++n) _Pragma("unroll") for (int k = 0; k < 2; ++k) \
        acc[ai][bj][m][n] = __builtin_amdgcn_mfma_f32_16x16x32_bf16(Bt[n][k], At[m][k], acc[ai][bj][m][n], 0, 0, 0); __builtin_amdgcn_s_setprio(0); } while (0)
#define PG8_WAIT_V(n) asm volatile("s_waitcnt vmcnt(" #n ")" ::: "memory")
#define PG8_WAIT_L(n) asm volatile("s_waitcnt lgkmcnt(" #n ")" ::: "memory")
#define PG8_BAR __builtin_amdgcn_s_barrier()
#define PG8_SCHED __builtin_amdgcn_sched_barrier(0)
    Unit cur, nxt; int ui = 0;
    if (!P.next(0, cur)) return;
    bool has_next = P.next(1, nxt);
    const char *cA, *cB, *nA, *nB; unsigned va0[2], va1[2], nva0[2], nva1[2];
    P.addr(cur, R, C, cA, cB, va0, va1);
    if (has_next) P.addr(nxt, R, C, nA, nB, nva0, nva1);
    else { nA = cA; nB = cB; nva0[0] = va0[0]; nva0[1] = va0[1]; nva1[0] = va1[0]; nva1[1] = va1[1]; }
    f32x4 acc[2][2][4][2];
#pragma unroll
    for (int a = 0; a < 2; ++a)
#pragma unroll
        for (int b = 0; b < 2; ++b)
#pragma unroll
            for (int m = 0; m < 4; ++m)
#pragma unroll
                for (int n = 0; n < 2; ++n) acc[a][b][m][n] = (f32x4){0.f, 0.f, 0.f, 0.f};
    bf16x8 At[4][2], B0[2][2], B1[2][2];
    PG8_STAGE(PG8_SB(0, 0), cB, voffB); PG8_STAGE(PG8_SB(0, 1), cB + hstep, voffB); PG8_STAGE(PG8_SA(0, 0), cA, va0); PG8_STAGE(PG8_SA(0, 1), cA, va1);
    if (wr == 1) PG8_BAR;
    PG8_WAIT_V(2); PG8_BAR;
    PG8_STAGE(PG8_SB(1, 0), cB + kstep, voffB); PG8_STAGE(PG8_SA(1, 0), cA + kstep, va0); PG8_STAGE(PG8_SB(1, 1), cB + hstep + kstep, voffB);
    PG8_WAIT_V(6); PG8_BAR;
    for (;;) {
        for (int t = 0; t < nt; t += 2) {
            const bool last = (t == nt - 2);
            const char* a1 = cA + (size_t)(t + 1) * kstep;
            const char* a2 = last ? nA : cA + (size_t)(t + 2) * kstep; const char* b2 = last ? nB : cB + (size_t)(t + 2) * kstep;
            const char* a3 = a2 + kstep; const char* b3 = b2 + kstep;
            unsigned v2a0[2], v2a1[2];
            v2a0[0] = last ? nva0[0] : va0[0]; v2a0[1] = last ? nva0[1] : va0[1]; v2a1[0] = last ? nva1[0] : va1[0]; v2a1[1] = last ? nva1[1] : va1[1];
            PG8_LDB(B0, 0, 0); PG8_LDB(B1, 0, 1); PG8_SCHED; PG8_LDA(At, 0, 0); PG8_STAGE(PG8_SA(1, 1), a1, va1);
            PG8_WAIT_V(8); PG8_WAIT_L(0); PG8_BAR; PG8_MMA(0, 0, At, B0); PG8_MMA(0, 1, At, B1); PG8_BAR; PG8_SCHED;
            PG8_LDA(At, 0, 1); PG8_STAGE(PG8_SB(0, 0), b2, voffB); PG8_STAGE(PG8_SB(0, 1), b2 + hstep, voffB); PG8_STAGE(PG8_SA(0, 0), a2, v2a0);
            PG8_WAIT_V(8); PG8_WAIT_L(0); PG8_BAR; PG8_MMA(1, 0, At, B0); PG8_MMA(1, 1, At, B1); PG8_BAR; PG8_SCHED;
            PG8_LDB(B0, 1, 0); PG8_LDB(B1, 1, 1); PG8_SCHED; PG8_LDA(At, 1, 0); PG8_STAGE(PG8_SA(0, 1), a2, v2a1);
            PG8_WAIT_V(8); PG8_WAIT_L(0); PG8_BAR; PG8_MMA(0, 0, At, B0); PG8_MMA(0, 1, At, B1); PG8_BAR; PG8_SCHED;
            PG8_LDA(At, 1, 1); PG8_STAGE(PG8_SB(1, 0), b3, voffB); PG8_STAGE(PG8_SB(1, 1), b3 + hstep, voffB); PG8_STAGE(PG8_SA(1, 0), a3, v2a0);
            PG8_WAIT_V(8); PG8_WAIT_L(0); PG8_BAR; PG8_MMA(1, 0, At, B0); PG8_MMA(1, 1, At, B1); PG8_BAR; PG8_SCHED;
        }
        if (wr == 0) PG8_BAR;
        E(acc, cur, wr, wc, fr, fq);
        if (!has_next) break;
#pragma unroll
        for (int a = 0; a < 2; ++a)
#pragma unroll
            for (int b = 0; b < 2; ++b)
#pragma unroll
                for (int m = 0; m < 4; ++m)
#pragma unroll
                    for (int n = 0; n < 2; ++n) acc[a][b][m][n] = (f32x4){0.f, 0.f, 0.f, 0.f};
        cur = nxt; cA = nA; cB = nB; va0[0] = nva0[0]; va0[1] = nva0[1]; va1[0] = nva1[0]; va1[1] = nva1[1]; ++ui;
        has_next = P.next(ui + 1, nxt);
        if (has_next) P.addr(nxt, R, C, nA, nB, nva0, nva1);
        if (wr == 1) PG8_BAR;
    }
    PG8_WAIT_V(0);
    PG8_BAR;
#undef PG8_SA
#undef PG8_SB
#undef PG8_STAGE
#undef PG8_LDA
#undef PG8_LDB
#undef PG8_MMA
#undef PG8_WAIT_V
#undef PG8_WAIT_L
#undef PG8_BAR
#undef PG8_SCHED
}

struct EpiOut {
    const float* x; float* out; bf16_t* xn2;
    __device__ __forceinline__ void operator()(const f32x4 (&acc)[2][2][4][2], const Unit& u, int wr, int wc, int fr, int fq) const {
        const int row0 = u.pm * BM + wr * 64 + fr, col0 = u.pn * BM + wc * 32 + 8 * fq;
#pragma unroll
        for (int ai = 0; ai < 2; ++ai)
#pragma unroll
            for (int m = 0; m < 4; ++m) { const size_t off = (size_t)(row0 + ai * HALF + m * 16) * D + col0;
#pragma unroll
                for (int bj = 0; bj < 2; ++bj) { const float* xp = x + off + bj * HALF;
                    const f32x4 h0 = acc[ai][bj][m][0] + *(const f32x4*)xp, h1 = acc[ai][bj][m][1] + *(const f32x4*)(xp + 4);
                    *(f32x4*)(out + off + bj * HALF) = h0; *(f32x4*)(out + off + bj * HALF + 4) = h1;
                    *(u32x4*)(xn2 + off + bj * HALF) = pack8(h0, h1); }
                asm volatile("" ::: "memory"); }
    }
};
struct EpiIn {
    bf16_t *Qb, *Kb, *VT, *HC; const float *qg, *kg;
    __device__ __forceinline__ void operator()(const f32x4 (&acc)[2][2][4][2], const Unit& u, int wr, int wc, int fr, int fq) const {
        const int rowb = u.pm * BM + wr * 64 + fr;
        if (u.pn <= 2) {
            const bool isv = (u.pn == 2) && (wc >= 2);
            if (!isv) {
                const bool isq = u.pn < 2; const float* g = isq ? qg : kg; const float sc = isq ? QSCALE : 1.f;
                f32x4 gv[2][2];
#pragma unroll
                for (int bj = 0; bj < 2; ++bj)
#pragma unroll
                    for (int n = 0; n < 2; ++n) gv[bj][n] = *(const f32x4*)(g + 32 * bj + 8 * fq + 4 * n) * sc;
                bf16_t* dst = isq ? Qb + (u.pn * 256 + 64 * wc) : Kb + 64 * wc; const int ld = isq ? 512 : 128;
#pragma unroll
                for (int ai = 0; ai < 2; ++ai)
#pragma unroll
                    for (int m = 0; m < 4; ++m) { const int row = rowb + ai * HALF + m * 16; float ss = 0.f;
#pragma unroll
                        for (int bj = 0; bj < 2; ++bj)
#pragma unroll
                            for (int n = 0; n < 2; ++n) { const f32x4 v = acc[ai][bj][m][n]; ss += (v[0] * v[0] + v[1] * v[1]) + (v[2] * v[2] + v[3] * v[3]); }
                        ss += __shfl_xor(ss, 16); ss += __shfl_xor(ss, 32);
                        const float r = __builtin_amdgcn_rsqf(ss * (1.f / 64.f) + 1e-6f);
#pragma unroll
                        for (int bj = 0; bj < 2; ++bj) *(u32x4*)(dst + (size_t)row * ld + 32 * bj + 8 * fq) = pack8(acc[ai][bj][m][0] * r * gv[bj][0], acc[ai][bj][m][1] * r * gv[bj][1]); }
            } else {
                const int hk = wc - 2;
#pragma unroll
                for (int ai = 0; ai < 2; ++ai)
#pragma unroll
                    for (int m = 0; m < 4; ++m) { const int row = rowb + ai * HALF + m * 16;
                        if (row < M_ALL) { int b, kx; if (row < M_REAL) { b = row >> 11; kx = NMETA + (row & 2047); } else { b = (row - M_REAL) >> 4; kx = (row - M_REAL) & 15; }
                            bf16_t* base = VT + (size_t)(b * 2 + hk) * 64 * VT_PITCH + kx;
#pragma unroll
                            for (int bj = 0; bj < 2; ++bj)
#pragma unroll
                                for (int n = 0; n < 2; ++n)
#pragma unroll
                                    for (int e = 0; e < 4; ++e) base[(size_t)(32 * bj + 8 * fq + 4 * n + e) * VT_PITCH] = (bf16_t)f2bf(acc[ai][bj][m][n][e]); } }
            }
        } else {
            const int col = (u.pn - 3) * 128 + 32 * wc + 8 * fq;
#pragma unroll
            for (int ai = 0; ai < 2; ++ai)
#pragma unroll
                for (int m = 0; m < 4; ++m) { const int row = rowb + ai * HALF + m * 16; f32x4 h[2];
#pragma unroll
                    for (int n = 0; n < 2; ++n)
#pragma unroll
                        for (int e = 0; e < 4; ++e) h[n][e] = acc[ai][0][m][n][e] * sigmoidf_fast(acc[ai][1][m][n][e]);
                    *(u32x4*)(HC + (size_t)row * 512 + col) = pack8(h[0], h[1]); }
        }
    }
};
struct EpiGU {
    bf16_t* ACT; const float* lrstd; const float* bgu;
    __device__ __forceinline__ void operator()(const f32x4 (&acc)[2][2][4][2], const Unit& u, int wr, int wc, int fr, int fq) const {
        const int lr0 = wr * 64 + fr, col = u.pn * 128 + 32 * wc + 8 * fq;
        f32x4 bg[2], bu[2];
#pragma unroll
        for (int n = 0; n < 2; ++n) { bg[n] = *(const f32x4*)(bgu + u.e * 2048 + col + 4 * n); bu[n] = *(const f32x4*)(bgu + u.e * 2048 + 1024 + col + 4 * n); }
        const float* rs = lrstd + u.e * CAP + u.slot0;
#pragma unroll
        for (int ai = 0; ai < 2; ++ai)
#pragma unroll
            for (int m = 0; m < 4; ++m) { const int lr = lr0 + ai * HALF + m * 16; const float rstd = lr < u.nvalid ? rs[lr] : 0.f; f32x4 h[2];
#pragma unroll
                for (int n = 0; n < 2; ++n)
#pragma unroll
                    for (int e = 0; e < 4; ++e) { float gt = acc[ai][0][m][n][e] * rstd + bg[n][e], up = acc[ai][1][m][n][e] * rstd + bu[n][e];
                        gt = fminf(gt, 7.f); up = fminf(fmaxf(up, -7.f), 7.f); h[n][e] = gt * sigmoidf_fast(1.702f * gt) * (up + 1.f); }
                *(u32x4*)(ACT + (size_t)(u.pm * BM + lr) * D + col) = pack8(h[0], h[1]); }
    }
};
struct EpiDown {
    bf16_t* Y; const float* lgate; const float* bd;
    __device__ __forceinline__ void operator()(const f32x4 (&acc)[2][2][4][2], const Unit& u, int wr, int wc, int fr, int fq) const {
        const int lr0 = wr * 64 + fr, col0 = u.pn * BM + wc * 32 + 8 * fq;
        f32x4 bv[2][2];
#pragma unroll
        for (int bj = 0; bj < 2; ++bj)
#pragma unroll
            for (int n = 0; n < 2; ++n) bv[bj][n] = *(const f32x4*)(bd + u.e * D + col0 + bj * HALF + 4 * n);
        const float* gs = lgate + u.e * CAP + u.slot0;
#pragma unroll
        for (int ai = 0; ai < 2; ++ai)
#pragma unroll
            for (int m = 0; m < 4; ++m) { const int lr = lr0 + ai * HALF + m * 16; const float gt = lr < u.nvalid ? gs[lr] : 0.f;
#pragma unroll
                for (int bj = 0; bj < 2; ++bj) *(u32x4*)(Y + (size_t)(u.pm * BM + lr) * D + col0 + bj * HALF) = pack8((acc[ai][bj][m][0] + bv[bj][0]) * gt, (acc[ai][bj][m][1] + bv[bj][1]) * gt); }
    }
};
}

__device__ __forceinline__ void p1_naive(Frame& F) {
    const int gw = F.bid * NWAVES + F.wave, NGW = F.G * NWAVES, lane = F.lane;
    for (int it = gw; it < M_ALL * 20; it += NGW) {
        const int row = it / 20, grp = it % 20;
        const bf16_t* xr = F.XN + (size_t)row * D;
        if (grp < 12) {
            const int col = grp * 64 + lane; float acc = 0.f;
            _Pragma("unroll 4") for (int k = 0; k < D; ++k) acc += bf2f(xr[k]) * F.w_in[(size_t)k * IN_W + col];
            if (grp < 10) {
                const float ssq = wave_sum(acc * acc); const float r = 1.f / sqrtf(ssq * (1.f / 64.f) + 1e-6f);
                if (grp < 8) F.Qb[(size_t)row * 512 + col] = (bf16_t)f2bf(acc * r * F.qg[lane] * QSCALE);
                else F.Kb[(size_t)row * 128 + (col - 512)] = (bf16_t)f2bf(acc * r * F.kg[lane]);
            } else {
                const int hk = grp - 10; int b, kx;
                if (row < M_REAL) { b = row >> 11; kx = NMETA + (row & 2047); } else { b = (row - M_REAL) >> 4; kx = (row - M_REAL) & 15; }
                F.VT[((size_t)(b * 2 + hk) * 64 + lane) * VT_PITCH + kx] = (bf16_t)f2bf(acc);
            }
        } else {
            const int c = (grp - 12) * 64 + lane; float a = 0.f, g = 0.f;
            for (int k = 0; k < D; ++k) { const float xv = bf2f(xr[k]); a += xv * F.w_in[(size_t)k * IN_W + 768 + c]; g += xv * F.w_in[(size_t)k * IN_W + 1280 + c]; }
            F.HC[(size_t)row * 512 + c] = (bf16_t)f2bf(a * sigmoidf_fast(g));
        }
    }
}
__device__ __forceinline__ void att_naive(Frame& F) {
    const int gw = F.bid * NWAVES + F.wave, NGW = F.G * NWAVES, lane = F.lane;
    for (int it = gw; it < M_REAL * NQH; it += NGW) {
        const int row = it >> 3, h = it & 7, hk = h >> 2, b = row >> 11, qp = row & 2047;
        const float q = bf2f(F.Qb[(size_t)row * 512 + h * 64 + lane]);
        const float slope2 = exp2f(-(float)(h + 1)) * LOG2E;
        float m = F.sink[h] * LOG2E, l = 1.f, acc = 0.f;
        const bf16_t* vt = F.VT + ((size_t)(b * 2 + hk) * 64 + lane) * VT_PITCH;
        for (int j = 0; j < NMETA; ++j) {
            const float kv = bf2f(F.Kb[(size_t)(M_REAL + b * NMETA + j) * 128 + hk * 64 + lane]);
            const float s = wave_sum(q * kv);
            const float mn = fmaxf(m, s), al = exp2f(m - mn), p = exp2f(s - mn);
            l = l * al + p; acc = acc * al + p * bf2f(vt[j]); m = mn;
        }
        const int k0 = qp - 128 < 0 ? 0 : qp - 128, k1 = qp + 128 > SEQ - 1 ? SEQ - 1 : qp + 128;
        for (int kp = k0; kp <= k1; ++kp) {
            const float kv = bf2f(F.Kb[(size_t)(b * SEQ + kp) * 128 + hk * 64 + lane]);
            const float dist = (float)(qp > kp ? qp - kp : kp - qp);
            const float s = wave_sum(q * kv) - slope2 * dist;
            const float mn = fmaxf(m, s), al = exp2f(m - mn), p = exp2f(s - mn);
            l = l * al + p; acc = acc * al + p * bf2f(vt[NMETA + kp]); m = mn;
        }
        F.MIX[(size_t)row * D + h * 64 + lane] = (bf16_t)f2bf(acc / l);
    }
}
__device__ __forceinline__ void conv_naive(Frame& F) {
    const int gw = F.bid * NWAVES + F.wave, NGW = F.G * NWAVES, lane = F.lane;
    for (int row = gw; row < M_REAL; row += NGW) {
        const int b = row >> 11, s0 = NMETA + (row & 2047);
        float v[8]; float sum = 0.f;
#pragma unroll
        for (int j = 0; j < 8; ++j) { const int c = lane + 64 * j; float a = F.dw_b[c];
            _Pragma("unroll 1") for (int t = 0; t < CONV_K; ++t) { const int s = s0 - 15 + t; if (s >= 0 && s < LSEQ) a += F.dw_w[t * CONV_W + c] * bf2f(F.HC[(size_t)row_of(b, s) * 512 + c]); }
            v[j] = a; sum += a; }
        const float mu = wave_sum(sum) * (1.f / 512.f); float q = 0.f;
#pragma unroll
        for (int j = 0; j < 8; ++j) { const float d = v[j] - mu; q += d * d; }
        const float rstd = 1.f / sqrtf(wave_sum(q) * (1.f / 512.f) + 1e-5f);
#pragma unroll
        for (int j = 0; j < 8; ++j) { const int c = lane + 64 * j; const float y = (v[j] - mu) * rstd * F.lng[c] + F.lnb[c];
            F.MIX[(size_t)row * D + 512 + c] = (bf16_t)f2bf(y * sigmoidf_fast(y)); }
    }
}
__device__ __forceinline__ void p3_naive(Frame& F) {
    const int gw = F.bid * NWAVES + F.wave, NGW = F.G * NWAVES, lane = F.lane;
    for (int it = gw; it < M_REAL * 16; it += NGW) {
        const int row = it >> 4, col = (it & 15) * 64 + lane; const bf16_t* mr = F.MIX + (size_t)row * D; float acc = 0.f;
        for (int k = 0; k < D; ++k) acc += bf2f(mr[k]) * F.w_out[(size_t)k * D + col];
        const float h2 = F.x[(size_t)row * D + col] + acc;
        F.out[(size_t)row * D + col] = h2; F.XN2[(size_t)row * D + col] = (bf16_t)f2bf(h2);
    }
}
__device__ __forceinline__ void p4_naive(Frame& F) {
    const int gw = F.bid * NWAVES + F.wave, NGW = F.G * NWAVES, lane = F.lane, e = lane & 31;
    for (int t = gw; t < M_REAL; t += NGW) {
        const bf16_t* xr = F.XN2 + (size_t)t * D; float acc = 0.f, ss = 0.f;
        for (int k = 0; k < D; ++k) { const float xv = bf2f(xr[k]); acc += xv * F.n2g[k] * F.wr[k * NE + e]; ss += xv * xv; }
        const float rstd = 1.f / sqrtf(ss * (1.f / D) + 1e-6f);
        float lg = acc * rstd + F.rb[e];
        float tv[4]; int te[4];
#pragma unroll
        for (int kk = 0; kk < 4; ++kk) {
            float bv = lg; int be = e;
#pragma unroll
            for (int o = 1; o < 32; o <<= 1) { const float pv = __shfl_xor(bv, o); const int pe = __shfl_xor(be, o); if (pv > bv || (pv == bv && pe < be)) { bv = pv; be = pe; } }
            tv[kk] = bv; te[kk] = be; if (e == be) lg = -INFINITY;
        }
        float p[4], ps = 0.f;
#pragma unroll
        for (int kk = 0; kk < 4; ++kk) { p[kk] = __expf(tv[kk] - tv[0]); ps += p[kk]; }
        if (lane < 4) {
            const int ee = lane == 0 ? te[0] : lane == 1 ? te[1] : lane == 2 ? te[2] : te[3];
            const float gg = (lane == 0 ? p[0] : lane == 1 ? p[1] : lane == 2 ? p[2] : p[3]) / ps;
            const unsigned slot = __hip_atomic_fetch_add((unsigned*)(F.ctl + CW_CNT + ee), 1u, RLX_AGENT);
            F.ltok[ee * CAP + slot] = t; F.lgate[ee * CAP + slot] = gg; F.lrstd[ee * CAP + slot] = rstd; F.where[t * 4 + lane] = ee * CAP + (int)slot;
        }
    }
}
__device__ __forceinline__ void build_tile_table(Frame& F) {
    LAS int* tb = (LAS int*)(F.lds + LX_TB); LAS int* cn = (LAS int*)(F.lds + LX_CNT);
    __syncthreads();
    if (F.tid == 0) { int acc = 0; for (int e = 0; e < NE; ++e) { int c = (int)__hip_atomic_load(F.ctl + CW_CNT + e, RLX_AGENT); if (c > CAP) c = CAP; if (c < 0) c = 0; cn[e] = c; tb[e] = acc; acc += (c + 255) >> 8; } tb[NE] = acc; }
    __syncthreads();
}
__device__ __forceinline__ int find_expert(const LAS int* tb, int tile) { int e = 0;
#pragma unroll 1
    for (int j = 1; j < NE; ++j) if (tb[j] <= tile) e = j;
    return e; }
__device__ __forceinline__ void p5_naive(Frame& F) {
    build_tile_table(F);
    const LAS int* tb = (const LAS int*)(F.lds + LX_TB); const LAS int* cn = (const LAS int*)(F.lds + LX_CNT);
    const int gw = F.bid * NWAVES + F.wave, NGW = F.G * NWAVES, lane = F.lane, total = tb[NE] * 256;
    for (int it = gw; it < total * 16; it += NGW) {
        const int sr = it >> 4, c = (it & 15) * 64 + lane, e = find_expert(tb, sr >> 8), slot = sr - tb[e] * 256;
        if (slot >= cn[e]) continue;
        const int tok = F.ltok[e * CAP + slot]; const float rstd = F.lrstd[e * CAP + slot];
        const bf16_t* xr = F.XN2 + (size_t)tok * D; const float* W = F.wgu + (size_t)e * D * 2048; float g = 0.f, u = 0.f;
        for (int k = 0; k < D; ++k) { const float xv = bf2f(xr[k]) * F.n2g[k]; g += xv * W[(size_t)k * 2048 + c]; u += xv * W[(size_t)k * 2048 + 1024 + c]; }
        g = g * rstd + F.bgu[e * 2048 + c]; u = u * rstd + F.bgu[e * 2048 + 1024 + c];
        g = fminf(g, 7.f); u = fminf(fmaxf(u, -7.f), 7.f);
        F.ACT[(size_t)sr * D + c] = (bf16_t)f2bf(g * sigmoidf_fast(1.702f * g) * (u + 1.f));
    }
}
__device__ __forceinline__ void p6_naive(Frame& F) {
    build_tile_table(F);
    const LAS int* tb = (const LAS int*)(F.lds + LX_TB); const LAS int* cn = (const LAS int*)(F.lds + LX_CNT);
    const int gw = F.bid * NWAVES + F.wave, NGW = F.G * NWAVES, lane = F.lane, total = tb[NE] * 256;
    for (int it = gw; it < total * 16; it += NGW) {
        const int sr = it >> 4, c = (it & 15) * 64 + lane, e = find_expert(tb, sr >> 8), slot = sr - tb[e] * 256;
        if (slot >= cn[e]) continue;
        const bf16_t* ar = F.ACT + (size_t)sr * D; const float* W = F.wd + (size_t)e * D * D; float acc = 0.f;
        for (int k = 0; k < D; ++k) acc += bf2f(ar[k]) * W[(size_t)k * D + c];
        F.Y[(size_t)sr * D + c] = (bf16_t)f2bf((acc + F.bd[e * D + c]) * F.lgate[e * CAP + slot]);
    }
}
__device__ __forceinline__ void p7_combine(Frame& F) {
    build_tile_table(F);
    const LAS int* tb = (const LAS int*)(F.lds + LX_TB);
    const int gw = F.bid * NWAVES + F.wave, NGW = F.G * NWAVES, lane = F.lane;
    for (int t = gw; t < M_REAL; t += NGW) {
        GAS f32x4* o = (GAS f32x4*)(F.out + (size_t)t * D) + lane * 4;
        f32x4 a[4];
#pragma unroll
        for (int j = 0; j < 4; ++j) a[j] = o[j];
#pragma unroll
        for (int k = 0; k < 4; ++k) {
            const int w = F.where[t * 4 + k], e = w / CAP, slot = w - e * CAP;
            const GAS u32x4* y = (const GAS u32x4*)(F.Y + (size_t)(tb[e] * 256 + slot) * D) + lane * 2;
            const u32x4 y0 = y[0], y1 = y[1];
            a[0] += (f32x4){bflo(y0.x), bfhi(y0.x), bflo(y0.y), bfhi(y0.y)}; a[1] += (f32x4){bflo(y0.z), bfhi(y0.z), bflo(y0.w), bfhi(y0.w)};
            a[2] += (f32x4){bflo(y1.x), bfhi(y1.x), bflo(y1.y), bfhi(y1.y)}; a[3] += (f32x4){bflo(y1.z), bfhi(y1.z), bflo(y1.w), bfhi(y1.w)};
        }
#pragma unroll
        for (int j = 0; j < 4; ++j) o[j] = a[j];
    }
}

__global__ void __launch_bounds__(NTHR, 2) mega(Args args) {
    extern __shared__ __attribute__((aligned(16))) unsigned char lds_raw[];
    Frame F;
    F.lds = (LAS unsigned char*)lds_raw;
    F.tid = threadIdx.x; F.lane = F.tid & 63; F.wave = __builtin_amdgcn_readfirstlane(F.tid >> 6); F.G = gridDim.x; F.bid = blockIdx.x;
    F.x = args.in[0]; F.meta = args.in[1]; F.n1g = args.in[2]; F.w_in = args.in[3]; F.qg = args.in[4]; F.kg = args.in[5]; F.sink = args.in[6];
    F.dw_w = args.in[7]; F.dw_b = args.in[8]; F.lng = args.in[9]; F.lnb = args.in[10]; F.w_out = args.in[11]; F.n2g = args.in[12];
    F.wr = args.in[13]; F.rb = args.in[14]; F.wgu = args.in[15]; F.bgu = args.in[16]; F.wd = args.in[17]; F.bd = args.in[18];
    F.out = args.out; F.ws = args.ws; unsigned char* ws = args.ws;
    F.ctl = (gu32*)(ws + WS_CTL);
    F.WinT = (bf16_t*)(ws + WS_WIN_T); F.WoT = (bf16_t*)(ws + WS_WO_T); F.WrT = (bf16_t*)(ws + WS_WR_T); F.WdT = (bf16_t*)(ws + WS_WD_T); F.WguT = (bf16_t*)(ws + WS_WGU_T);
    F.XN = (bf16_t*)(ws + WS_XN); F.Qb = (bf16_t*)(ws + WS_Q); F.Kb = (bf16_t*)(ws + WS_K); F.VT = (bf16_t*)(ws + WS_VT); F.HC = (bf16_t*)(ws + WS_HC);
    F.MIX = (bf16_t*)(ws + WS_MIX); F.XN2 = (bf16_t*)(ws + WS_XN2); F.ACT = (bf16_t*)(ws + WS_ACT); F.Y = (bf16_t*)(ws + WS_Y);
    F.where = (int*)(ws + WS_WHERE); F.ltok = (int*)(ws + WS_LTOK); F.lgate = (float*)(ws + WS_LGATE); F.lrstd = (float*)(ws + WS_LRSTD);
    for (int u = F.tid; u < (LDS_BYTES - RING_BYTES) / 4; u += NTHR) ((LAS unsigned*)(F.lds + RING_BYTES))[u] = 0u;
    __syncthreads();
    const int lo = args.ph_lo, hi = args.ph_hi;
    XcdBarrier bar; bar.bar = (unsigned*)(F.ctl + CW_BAR); bar.x = 0; bar.st = nullptr;
    if (hi - lo > 1) bar = xcd_barrier_post((unsigned*)(F.ctl + CW_BAR), (volatile LAS unsigned*)(F.lds + LX_BAR));
#ifndef PH_MASK
#define PH_MASK 0xFF
#endif
#define IN(k) (((PH_MASK >> (k)) & 1) && lo <= (k) && (k) < hi)
#define SEAM(k) do { if (IN(k) && IN((k) + 1)) xcd_barrier(bar); } while (0)
    if (IN(0)) { p0_prologue(F); } SEAM(0);
#if FAST_P1
    if (IN(1)) { pg8::DenseProb P{F.XN, F.WinT, M_PAD / 256, IN_W / 256, F.G, F.bid}; pg8::EpiIn E{F.Qb, F.Kb, F.VT, F.HC, F.qg, F.kg}; pg8::gemm_phase(F.lds, P, E); } SEAM(1);
#else
    if (IN(1)) { p1_naive(F); } SEAM(1);
#endif
    if (IN(2)) { att_naive(F); conv_naive(F); } SEAM(2);
#if FAST_P3
    if (IN(3)) { pg8::DenseProb P{F.MIX, F.WoT, M_REAL / 256, D / 256, F.G, F.bid}; pg8::EpiOut E{F.x, F.out, F.XN2}; pg8::gemm_phase(F.lds, P, E); } SEAM(3);
#else
    if (IN(3)) { p3_naive(F); } SEAM(3);
#endif
    if (IN(4)) { p4_naive(F); } SEAM(4);
#if FAST_P5
    if (IN(5)) { build_tile_table(F); pg8::GroupedProb<true> P{F.XN2, F.WguT, F.ltok, (const LAS int*)(F.lds + LX_TB), (const LAS int*)(F.lds + LX_CNT), 8, F.G, F.bid};
        pg8::EpiGU E{F.ACT, F.lrstd, F.bgu}; pg8::gemm_phase(F.lds, P, E); } SEAM(5);
#else
    if (IN(5)) { p5_naive(F); } SEAM(5);
#endif
#if FAST_P6
    if (IN(6)) { build_tile_table(F); pg8::GroupedProb<false> P{F.ACT, F.WdT, F.ltok, (const LAS int*)(F.lds + LX_TB), (const LAS int*)(F.lds + LX_CNT), 4, F.G, F.bid};
        pg8::EpiDown E{F.Y, F.lgate, F.bd}; pg8::gemm_phase(F.lds, P, E); } SEAM(6);
#else
    if (IN(6)) { p6_naive(F); } SEAM(6);
#endif
    if (IN(7)) { p7_combine(F); }
#undef IN
#undef SEAM
}

extern "C" void kernel_launch(void* const* d_in, const int* in_sizes, int n_in, void* d_out, int out_size, void* d_ws, size_t ws_size, hipStream_t stream) {
    static int grid = 0;
    if (grid == 0) {
        if (n_in != 19 || in_sizes[0] != M_REAL * D || out_size != M_REAL * D || ws_size < WS_END) {
            fprintf(stderr, "kernel_launch: unexpected shapes/workspace: n_in %d in0 %d out %d ws %zu (need %zu)\n", n_in, n_in > 0 ? in_sizes[0] : -1, out_size, ws_size, (size_t)WS_END); grid = -1; return; }
        int dev = 0, cus = 0, per_cu = 0;
        if (hipGetDevice(&dev) != hipSuccess || hipDeviceGetAttribute(&cus, hipDeviceAttributeMultiprocessorCount, dev) != hipSuccess) { grid = -1; return; }
        if (hipFuncSetAttribute((const void*)mega, hipFuncAttributeMaxDynamicSharedMemorySize, LDS_BYTES) != hipSuccess) { fprintf(stderr, "kernel_launch: hipFuncSetAttribute failed\n"); grid = -1; return; }
        if (hipOccupancyMaxActiveBlocksPerMultiprocessor(&per_cu, (const void*)mega, NTHR, LDS_BYTES) != hipSuccess || per_cu < 1) { fprintf(stderr, "kernel_launch: occupancy query says %d blocks/CU\n", per_cu); (void)hipGetLastError(); grid = -1; return; }
        grid = cus;
    }
    if (grid < 0) return;
    (void)hipMemsetAsync((char*)d_ws + WS_CTL, 0, CTL_ZERO_BYTES, stream);
    Args a{};
    for (int i = 0; i < 19; ++i) a.in[i] = (const float*)d_in[i];
    a.out = (float*)d_out; a.ws = (unsigned char*)d_ws;
#if MK_PER_PHASE
    for (int p = 0; p < 8; ++p) { a.ph_lo = p; a.ph_hi = p + 1; hipLaunchKernelGGL(mega, dim3(grid), dim3(NTHR), LDS_BYTES, stream, a); }
#else
    a.ph_lo = 0; a.ph_hi = 8; hipLaunchKernelGGL(mega, dim3(grid), dim3(NTHR), LDS_BYTES, stream, a);
#endif
}
```

```cpp
#include <hip/hip_runtime.h>
#include <cstdio>
#include <cstdint>

#ifndef MK_PER_PHASE
#define MK_PER_PHASE 0
#endif
#ifndef FAST_P1
#define FAST_P1 1
#endif
#ifndef FAST_ATT
#define FAST_ATT 1
#endif
#ifndef FAST_CONV
#define FAST_CONV 1
#endif
#ifndef FAST_P3
#define FAST_P3 1
#endif
#ifndef FAST_P4
#define FAST_P4 1
#endif
#ifndef FAST_P5
#define FAST_P5 1
#endif
#ifndef FAST_P6
#define FAST_P6 1
#endif

#define GAS __attribute__((address_space(1)))
#define LAS __attribute__((address_space(3)))
typedef unsigned short bf16_t;
typedef short bf16x8 __attribute__((ext_vector_type(8)));
typedef float f32x4 __attribute__((ext_vector_type(4)));
typedef float f32x16 __attribute__((ext_vector_type(16)));
typedef unsigned u32x4 __attribute__((ext_vector_type(4)));
typedef unsigned u32x2 __attribute__((ext_vector_type(2)));
typedef float f32x2 __attribute__((ext_vector_type(2)));
typedef GAS unsigned gu32;
#define RLX_AGENT __ATOMIC_RELAXED, __HIP_MEMORY_SCOPE_AGENT

constexpr int NB = 8, SEQ = 2048, D = 1024, NMETA = 16, LSEQ = NMETA + SEQ;
constexpr int M_REAL = NB * SEQ, M_ALL = NB * LSEQ, M_PAD = 16640;
constexpr int IN_W = 1792, HD = 64, NQH = 8, NKV = 2, CONV_W = 512, CONV_K = 31;
constexpr int NE = 32, CAP = 16384, ACT_ROWS = 4 * M_REAL + NE * 256;
constexpr float LOG2E = 1.4426950408889634f;
constexpr float QSCALE = 0.125f * LOG2E;
constexpr int VT_PITCH = LSEQ;

constexpr size_t MiB = 1u << 20;
constexpr size_t WS_CTL = 0, CTL_ZERO_BYTES = 1 * MiB;
constexpr size_t WS_WIN_T = 2 * MiB;
constexpr size_t WS_WO_T = 6 * MiB;
constexpr size_t WS_WR_T = 8 * MiB;
constexpr size_t WS_RSTD = 9 * MiB;
constexpr size_t WS_WHERE = 9 * MiB + 512 * 1024;
constexpr size_t WS_LTOK = 10 * MiB;
constexpr size_t WS_LGATE = 12 * MiB;
constexpr size_t WS_LRSTD = 14 * MiB;
constexpr size_t WS_WD_T = 16 * MiB;
constexpr size_t WS_WGU_T = 80 * MiB;
constexpr size_t WS_XN = 208 * MiB;
constexpr size_t WS_Q = 241 * MiB;
constexpr size_t WS_K = 258 * MiB;
constexpr size_t WS_VT = 263 * MiB;
constexpr size_t WS_HC = 268 * MiB;
constexpr size_t WS_MIX = 285 * MiB;
constexpr size_t WS_XN2 = 317 * MiB;
constexpr size_t WS_ACT = 349 * MiB;
constexpr size_t WS_Y = 493 * MiB;
constexpr size_t WS_END = 637 * MiB;
constexpr int CW_CNT = 64;
constexpr int CW_BAR = 4096;

constexpr int RING_BYTES = 131072;
constexpr int LX_BAR = RING_BYTES;
constexpr int LX_TB = RING_BYTES + 64;
constexpr int LX_CNT = RING_BYTES + 256;
constexpr int LX_LCNT = RING_BYTES + 512;
constexpr int LX_GBASE = RING_BYTES + 768;
constexpr int LDS_BYTES = 147456;

constexpr int NWAVES = 8, NTHR = 512;

__device__ __forceinline__ unsigned f2bf(float f) { unsigned u = __builtin_bit_cast(unsigned, f); return (u + 0x7fffu + ((u >> 16) & 1u)) >> 16; }
__device__ __forceinline__ unsigned pk2(float lo, float hi) { return f2bf(lo) | (f2bf(hi) << 16); }
__device__ __forceinline__ float bf2f(unsigned b) { return __builtin_bit_cast(float, b << 16); }
__device__ __forceinline__ float bflo(unsigned w) { return __builtin_bit_cast(float, w << 16); }
__device__ __forceinline__ float bfhi(unsigned w) { return __builtin_bit_cast(float, w & 0xffff0000u); }
__device__ __forceinline__ float wave_sum(float v) {
#pragma unroll
    for (int o = 1; o < 64; o <<= 1) v += __shfl_xor(v, o);
    return v;
}
__device__ __forceinline__ float sigmoidf_fast(float x) { return __builtin_amdgcn_rcpf(1.0f + __builtin_amdgcn_exp2f(-x * LOG2E)); }
__device__ __forceinline__ int row_of(int b, int s) { return s < NMETA ? M_REAL + b * NMETA + s : b * SEQ + (s - NMETA); }

#define XB_TMO      128
#define XB_XCNT(j)  (256  + 64 * (j))
#define XB_XSUB(j)  (1280 + 64 * (j))
#define XB_XGEN(j)  (2304 + 64 * (j))
#define XB_TOP      3328
#define XB_TOPGEN   3392
#define XCD_BAR_WORDS 3456
#define XB_SPIN_CAP (1u << 18)
__device__ __forceinline__ unsigned xb_ld(unsigned* p)              { return __hip_atomic_load(p, __ATOMIC_RELAXED, __HIP_MEMORY_SCOPE_AGENT); }
__device__ __forceinline__ unsigned xb_add(unsigned* p, unsigned v) { return __hip_atomic_fetch_add(p, v, __ATOMIC_RELAXED, __HIP_MEMORY_SCOPE_AGENT); }
__device__ __forceinline__ unsigned xb_xcc_id() { return (unsigned)__builtin_amdgcn_s_getreg((3 << 11) | 20) & 0xFu; }
#define XB_SPIN(cond, bar) do { unsigned _sp = 0; while (cond) { __builtin_amdgcn_s_sleep(1); \
    if ((++_sp & 255u) == 0u) { if (xb_ld(&(bar)[XB_TMO])) break; if (_sp > XB_SPIN_CAP) { atomicAdd(&(bar)[XB_TMO], 1u); break; } } } } while (0)
struct XcdBarrier { unsigned* bar; unsigned x; volatile LAS unsigned* st; };
__device__ __forceinline__ XcdBarrier xcd_barrier_post(unsigned* bar, volatile LAS unsigned* st) {
    XcdBarrier b; b.bar = bar; b.x = xb_xcc_id(); b.st = st;
    if (threadIdx.x == 0) (void)xb_add(&bar[XB_XCNT(b.x)], 1u);
    return b;
}
__device__ __forceinline__ void xcd_barrier_complete(unsigned* bar, unsigned x, unsigned& nloc, unsigned& nx) {
    const unsigned G = gridDim.x * gridDim.y * gridDim.z;
    unsigned sum, cnt, mine, sp = 0u;
    for (;;) {
        sum = 0u; cnt = 0u; mine = 0u;
#pragma unroll
        for (unsigned j = 0; j < 16; ++j) { const unsigned c = xb_ld(&bar[XB_XCNT(j)]); sum += c; cnt += (c > 0u) ? 1u : 0u; mine = (j == x) ? c : mine; }
        if (sum == G) break;
        __builtin_amdgcn_s_sleep(1);
        if ((++sp & 255u) == 0u) { if (xb_ld(&bar[XB_TMO])) break; if (sp > XB_SPIN_CAP) { atomicAdd(&bar[XB_TMO], 1u); break; } }
    }
    nloc = mine > 0u ? mine : 1u; nx = cnt > 0u ? cnt : 1u;
}
__device__ __forceinline__ void xcd_barrier(const XcdBarrier& b) {
    asm volatile("s_waitcnt vmcnt(0)" ::: "memory");
    __syncthreads();
    if (threadIdx.x == 0) {
        unsigned* bar = b.bar;
        __builtin_amdgcn_s_waitcnt(0);
        unsigned nloc = b.st[0], nx = b.st[1];
        if (nloc == 0u) { xcd_barrier_complete(bar, b.x, nloc, nx); b.st[0] = nloc; b.st[1] = nx; }
        const unsigned old = xb_add(&bar[XB_XSUB(b.x)], 1u);
        const unsigned gen = old / nloc;
        if (old + 1u == (gen + 1u) * nloc) {
            __builtin_amdgcn_fence(__ATOMIC_RELEASE, "agent");
            asm volatile("s_waitcnt vmcnt(0)" ::: "memory");
            const unsigned og = xb_add(&bar[XB_TOP], 1u);
            const unsigned tg = og / nx;
            if (og + 1u == (tg + 1u) * nx) xb_add(&bar[XB_TOPGEN], 1u);
            else XB_SPIN(xb_ld(&bar[XB_TOPGEN]) == tg, bar);
            __builtin_amdgcn_fence(__ATOMIC_ACQUIRE, "agent");
            xb_add(&bar[XB_XGEN(b.x)], 1u);
            asm volatile("s_waitcnt vmcnt(0)" ::: "memory");
        } else {
            XB_SPIN(xb_ld(&bar[XB_XGEN(b.x)]) == gen, bar);
            __builtin_amdgcn_fence(__ATOMIC_ACQUIRE, "agent");
            asm volatile("s_waitcnt vmcnt(0)" ::: "memory");
        }
    }
    __syncthreads();
}

struct Args { const float* in[19]; float* out; unsigned char* ws; int ph_lo, ph_hi; };
struct Frame {
    LAS unsigned char* lds;
    int tid, lane, wave, G, bid;
    const float *x, *meta, *n1g, *w_in, *qg, *kg, *sink, *dw_w, *dw_b, *lng, *lnb, *w_out, *n2g, *wr, *rb, *wgu, *bgu, *wd, *bd;
    float* out;
    unsigned char* ws;
    gu32* ctl;
    bf16_t *WinT, *WoT, *WrT, *WdT, *WguT, *XN, *Qb, *Kb, *VT, *HC, *MIX, *XN2, *ACT, *Y;
    int* where; int* ltok; float* lgate; float* lrstd;
};

__device__ __forceinline__ int perm32(int rho) { const int n = rho >> 4, i = rho & 15; return 8 * (i >> 2) + 4 * n + (i & 3); }
__device__ __forceinline__ int lbase_nat(int pg) { return 32 * pg; }
__device__ __forceinline__ int lbase_in(int pg) { const int tile = pg >> 3, bj = (pg >> 2) & 1, wc = pg & 3; return tile <= 2 ? tile * 256 + 64 * wc + 32 * bj : 768 + bj * 512 + (tile - 3) * 128 + 32 * wc; }
__device__ __forceinline__ int lbase_gu(int pg) { const int tile = pg >> 3, bj = (pg >> 2) & 1, wc = pg & 3; return bj * 1024 + tile * 128 + 32 * wc; }
__device__ __forceinline__ void p0_transpose_item(const float* W, int K, int N, bf16_t* WT, int pg, int n0, int kb, const float* g, LAS float* scr, int lane, bool permute) {
    const int k0 = 64 * kb;
#pragma unroll 8
    for (int i = 0; i < 32; ++i) { const int kk = 2 * i + (lane >> 5); float v = W[(size_t)(k0 + kk) * N + n0 + (lane & 31)]; if (g) v *= g[k0 + kk]; scr[kk * 33 + (lane & 31)] = v; }
    asm volatile("s_waitcnt lgkmcnt(0)" ::: "memory");
    const int c = lane & 7;
#pragma unroll
    for (int j = 0; j < 4; ++j) { const int r = (lane >> 3) + 8 * j; const int sc = permute ? perm32(r) : r; const LAS float* s = scr + (8 * c) * 33 + sc;
        u32x4 o; o.x = pk2(s[0 * 33], s[1 * 33]); o.y = pk2(s[2 * 33], s[3 * 33]); o.z = pk2(s[4 * 33], s[5 * 33]); o.w = pk2(s[6 * 33], s[7 * 33]);
        *(GAS u32x4*)(WT + (size_t)(32 * pg + r) * K + k0 + 8 * c) = o; }
    asm volatile("s_waitcnt lgkmcnt(0)" ::: "memory");
}
__device__ __forceinline__ void p0_prologue(Frame& F) {
    LAS float* scr = (LAS float*)(F.lds + F.wave * 16384);
    const int gw = F.bid * NWAVES + F.wave, NGW = F.G * NWAVES, lane = F.lane;
    for (int m = gw; m < M_PAD; m += NGW) {
        GAS unsigned long long* o8 = (GAS unsigned long long*)(F.XN + (size_t)m * D) + lane;
        if (m >= M_ALL) {
#pragma unroll
            for (int j = 0; j < 4; ++j) o8[64 * j] = 0ull;
            continue; }
        const float* src = m < M_REAL ? F.x + (size_t)m * D : F.meta + (size_t)((m - M_REAL) & (NMETA - 1)) * D;
        const GAS f32x4* xr = (const GAS f32x4*)src + lane; const GAS f32x4* gr = (const GAS f32x4*)F.n1g + lane;
        f32x4 v[4]; float s = 0.f;
#pragma unroll
        for (int j = 0; j < 4; ++j) { v[j] = xr[64 * j]; s += (v[j].x * v[j].x + v[j].y * v[j].y) + (v[j].z * v[j].z + v[j].w * v[j].w); }
        const float rstd = 1.f / sqrtf(wave_sum(s) * (1.f / D) + 1e-6f);
#pragma unroll
        for (int j = 0; j < 4; ++j) { const f32x4 g = gr[64 * j]; o8[64 * j] = (unsigned long long)pk2(v[j].x * rstd * g.x, v[j].y * rstd * g.y) | ((unsigned long long)pk2(v[j].z * rstd * g.z, v[j].w * rstd * g.w) << 32); }
    }
    constexpr int I_IN = 16 * 56, I_O = 16 * 32, I_R = 16, I_GU = NE * 16 * 64, I_D = NE * 16 * 32;
    constexpr int NITEMS = I_IN + I_O + I_R + I_GU + I_D;
    for (int it = gw; it < NITEMS; it += NGW) {
        int r = it;
        if (r < I_IN) { const int pg = r % 56, kb = r / 56; p0_transpose_item(F.w_in, D, IN_W, F.WinT, pg, lbase_in(pg), kb, nullptr, scr, lane, true); continue; } r -= I_IN;
        if (r < I_O) { const int pg = r % 32, kb = r / 32; p0_transpose_item(F.w_out, D, D, F.WoT, pg, lbase_nat(pg), kb, nullptr, scr, lane, true); continue; } r -= I_O;
        if (r < I_R) { p0_transpose_item(F.wr, D, NE, F.WrT, 0, 0, r, F.n2g, scr, lane, false); continue; } r -= I_R;
        if (r < I_GU) { const int e = r / (16 * 64), q = r % (16 * 64), pg = q % 64, kb = q / 64;
            p0_transpose_item(F.wgu + (size_t)e * D * 2048, D, 2048, F.WguT + (size_t)e * 2048 * D, pg, lbase_gu(pg), kb, F.n2g, scr, lane, true); continue; } r -= I_GU;
        { const int e = r / (16 * 32), q = r % (16 * 32), pg = q % 32, kb = q / 32;
            p0_transpose_item(F.wd + (size_t)e * D * D, D, D, F.WdT + (size_t)e * D * D, pg, lbase_nat(pg), kb, nullptr, scr, lane, true); }
    }
}


namespace pg8 {
constexpr int BM = 256, BK = 64, HALF = 128, HTB = HALF * BK * 2, STAGE_BYTES = 8 * HTB, NXCD = 8, WGM = 8, KD = 1024;
__device__ __forceinline__ int lds_byte(int r, int c) { const int st = (r >> 4) * 2 + (c >> 5), rr = r & 15, cc = c & 31, ob = rr * 64 + cc * 2; return st * 1024 + (ob ^ (((ob >> 9) & 1) << 5)); }
__device__ __forceinline__ void stage_rc(int b, int& R, int& C) { const int st = b / 1024, sb = b % 1024, swz = sb ^ (((sb >> 9) & 1) << 5); R = (st >> 1) * 16 + swz / 64; C = (st & 1) * 32 + (swz % 64) / 2; }
struct Unit { int pm, pn, e, slot0, nvalid; };
__device__ __forceinline__ unsigned cvt_pk_bf16(float lo, float hi) { unsigned r; asm volatile("v_cvt_pk_bf16_f32 %0, %1, %2" : "=v"(r) : "v"(lo), "v"(hi)); return r; }
__device__ __forceinline__ u32x4 pack8(const f32x4 a, const f32x4 b) { u32x4 w; w.x = cvt_pk_bf16(a[0], a[1]); w.y = cvt_pk_bf16(a[2], a[3]); w.z = cvt_pk_bf16(b[0], b[1]); w.w = cvt_pk_bf16(b[2], b[3]); return w; }

__device__ __forceinline__ bool tile_order(int i, int G, int c, int nM, int nN, int& pm, int& pn) {
    const int nwg = nM * nN; const long L = (long)i * G + c; if (L >= nwg) return false;
    int wgid = (int)L; { const int q = nwg / NXCD, r = nwg % NXCD, xcd = wgid % NXCD, off = wgid / NXCD; wgid = (xcd < r ? xcd * (q + 1) : r * (q + 1) + (xcd - r) * q) + off; }
    const int nig = WGM * nN, gid = wgid / nig, fm = gid * WGM, gsz = (nM - fm) < WGM ? (nM - fm) : WGM;
    pm = fm + ((wgid % nig) % gsz); pn = (wgid % nig) / gsz; return true;
}
struct DenseProb {
    const bf16_t* A; const bf16_t* Bt; int nM, nN, G, c;
    __device__ __forceinline__ bool next(int i, Unit& u) const { u.e = 0; u.slot0 = 0; u.nvalid = 256; return tile_order(i, G, c, nM, nN, u.pm, u.pn); }
    __device__ __forceinline__ void addr(const Unit& u, const int (&R)[2], const int (&C)[2], const char*& a, const char*& b, unsigned (&va0)[2], unsigned (&va1)[2]) const {
        a = (const char*)A + (size_t)u.pm * (BM * KD * 2); b = (const char*)Bt + (size_t)u.pn * (BM * KD * 2);
#pragma unroll
        for (int i = 0; i < 2; ++i) { va0[i] = (unsigned)(R[i] * KD + C[i]) * 2u; va1[i] = va0[i] + (unsigned)(HALF * KD * 2); }
    }
};
template <bool GATHER> struct GroupedProb {
    const bf16_t* A; const bf16_t* Bt; const int* ltok; const LAS int* tb; const LAS int* cn; int nN, G, c;
    __device__ __forceinline__ bool next(int i, Unit& u) const {
        const int nM = tb[NE]; if (!tile_order(i, G, c, nM, nN, u.pm, u.pn)) return false;
        int e = 0;
#pragma unroll 1
        for (int j = 1; j < NE; ++j) if (tb[j] <= u.pm) e = j;
        u.e = e; u.slot0 = (u.pm - tb[e]) * 256; const int rem = cn[e] - u.slot0; u.nvalid = rem < 256 ? rem : 256; return true;
    }
    __device__ __forceinline__ void addr(const Unit& u, const int (&R)[2], const int (&C)[2], const char*& a, const char*& b, unsigned (&va0)[2], unsigned (&va1)[2]) const {
        b = (const char*)Bt + ((size_t)u.e * nN + u.pn) * (BM * KD * 2);
        if (GATHER) {
            a = (const char*)A; const int* lt = ltok + u.e * CAP + u.slot0;
#pragma unroll
            for (int i = 0; i < 2; ++i) { const int r0 = R[i], r1 = R[i] + HALF; const int t0 = r0 < u.nvalid ? lt[r0] : 0, t1 = r1 < u.nvalid ? lt[r1] : 0;
                va0[i] = (unsigned)(t0 * KD + C[i]) * 2u; va1[i] = (unsigned)(t1 * KD + C[i]) * 2u; }
        } else {
            a = (const char*)A + (size_t)u.pm * (BM * KD * 2);
#pragma unroll
            for (int i = 0; i < 2; ++i) { va0[i] = (unsigned)(R[i] * KD + C[i]) * 2u; va1[i] = va0[i] + (unsigned)(HALF * KD * 2); }
        }
    }
};

template <class Prob, class Epi>
__device__ __forceinline__ void gemm_phase(LAS unsigned char* lds, const Prob& P, const Epi& E) {
    const int tid = threadIdx.x, wid = __builtin_amdgcn_readfirstlane(tid >> 6), lane = tid & 63, wr = wid >> 2, wc = wid & 3, fr = lane & 15, fq = lane >> 4;
    constexpr int nt = KD / BK;
    int R[2], C[2]; unsigned voffB[2];
#pragma unroll
    for (int i = 0; i < 2; ++i) { stage_rc(tid * 16 + i * 8192, R[i], C[i]); voffB[i] = (unsigned)(R[i] * KD + C[i]) * 2u; }
    constexpr size_t kstep = (size_t)(BK * 2);
    constexpr size_t hstep = (size_t)HALF * KD * 2;
    const unsigned ldsw = (unsigned)wid * 1024u;
    const int aoff = lds_byte(wr * 64 + fr, fq * 8), boff = lds_byte(wc * 32 + fr, fq * 8);
#define PG8_SA(b, h) (((b) * 2 + (h)) * HTB)
#define PG8_SB(b, h) ((4 + (b) * 2 + (h)) * HTB)
#define PG8_STAGE(bufoff, gbase, voff) do { _Pragma("unroll") for (int _i = 0; _i < 2; ++_i) \
        __builtin_amdgcn_global_load_lds((const unsigned*)((const char*)(gbase) + (voff)[_i]), (LAS unsigned*)(lds + (bufoff) + ldsw + _i * 8192), 16, 0, 0); } while (0)
#define PG8_LDA(dst, b, h) do { _Pragma("unroll") for (int m = 0; m < 4; ++m) _Pragma("unroll") for (int k = 0; k < 2; ++k) dst[m][k] = *(const LAS bf16x8*)(lds + PG8_SA(b, h) + aoff + m * 2048 + k * 1024); } while (0)
#define PG8_LDB(dst, b, h) do { _Pragma("unroll") for (int n = 0; n < 2; ++n) _Pragma("unroll") for (int k = 0; k < 2; ++k) dst[n][k] = *(const LAS bf16x8*)(lds + PG8_SB(b, h) + boff + n * 2048 + k * 1024); } while (0)
#define PG8_MMA(ai, bj, At, Bt) do { __builtin_amdgcn_s_setprio(1); _Pragma("unroll") for (int m = 0; m < 4; ++m) _Pragma("unroll") for (int n = 0; n < 2; ++n) _Pragma("unroll") for (int k = 0; k < 2; ++k) \
        acc[ai][bj][m][n] = __builtin_amdgcn_mfma_f32_16x16x32_bf16(Bt[n][k], At[m][k], acc[ai][bj][m][n], 0, 0, 0); __builtin_amdgcn_s_setprio(0); } while (0)
#define PG8_WAIT_V(n) asm volatile("s_waitcnt vmcnt(" #n ")" ::: "memory")
#define PG8_WAIT_L(n) asm volatile("s_waitcnt lgkmcnt(" #n ")" ::: "memory")
#define PG8_BAR __builtin_amdgcn_s_barrier()
#define PG8_SCHED __builtin_amdgcn_sched_barrier(0)
    Unit cur, nxt; int ui = 0;
    if (!P.next(0, cur)) return;
    bool has_next = P.next(1, nxt);
    const char *cA, *cB, *nA, *nB; unsigned va0[2], va1[2], nva0[2], nva1[2];
    P.addr(cur, R, C, cA, cB, va0, va1);
    if (has_next) P.addr(nxt, R, C, nA, nB, nva0, nva1);
    else { nA = cA; nB = cB; nva0[0] = va0[0]; nva0[1] = va0[1]; nva1[0] = va1[0]; nva1[1] = va1[1]; }
    f32x4 acc[2][2][4][2];
#pragma unroll
    for (int a = 0; a < 2; ++a)
#pragma unroll
        for (int b = 0; b < 2; ++b)
#pragma unroll
            for (int m = 0; m < 4; ++m)
#pragma unroll
                for (int n = 0; n < 2; ++n) acc[a][b][m][n] = (f32x4){0.f, 0.f, 0.f, 0.f};
    bf16x8 At[4][2], B0[2][2], B1[2][2];
    PG8_STAGE(PG8_SB(0, 0), cB, voffB); PG8_STAGE(PG8_SB(0, 1), cB + hstep, voffB); PG8_STAGE(PG8_SA(0, 0), cA, va0); PG8_STAGE(PG8_SA(0, 1), cA, va1);
    if (wr == 1) PG8_BAR;
    PG8_WAIT_V(2); PG8_BAR;
    PG8_STAGE(PG8_SB(1, 0), cB + kstep, voffB); PG8_STAGE(PG8_SA(1, 0), cA + kstep, va0); PG8_STAGE(PG8_SB(1, 1), cB + hstep + kstep, voffB);
    PG8_WAIT_V(6); PG8_BAR;
    for (;;) {
        for (int t = 0; t < nt; t += 2) {
            const bool last = (t == nt - 2);
            const char* a1 = cA + (size_t)(t + 1) * kstep;
            const char* a2 = last ? nA : cA + (size_t)(t + 2) * kstep; const char* b2 = last ? nB : cB + (size_t)(t + 2) * kstep;
            const char* a3 = a2 + kstep; const char* b3 = b2 + kstep;
            unsigned v2a0[2], v2a1[2];
            v2a0[0] = last ? nva0[0] : va0[0]; v2a0[1] = last ? nva0[1] : va0[1]; v2a1[0] = last ? nva1[0] : va1[0]; v2a1[1] = last ? nva1[1] : va1[1];
            PG8_LDB(B0, 0, 0); PG8_LDB(B1, 0, 1); PG8_SCHED; PG8_LDA(At, 0, 0); PG8_STAGE(PG8_SA(1, 1), a1, va1);
            PG8_WAIT_V(8); PG8_WAIT_L(0); PG8_BAR; PG8_MMA(0, 0, At, B0); PG8_MMA(0, 1, At, B1); PG8_BAR; PG8_SCHED;
            PG8_LDA(At, 0, 1); PG8_STAGE(PG8_SB(0, 0), b2, voffB); PG8_STAGE(PG8_SB(0, 1), b2 + hstep, voffB); PG8_STAGE(PG8_SA(0, 0), a2, v2a0);
            PG8_WAIT_V(8); PG8_WAIT_L(0); PG8_BAR; PG8_MMA(1, 0, At, B0); PG8_MMA(1, 1, At, B1); PG8_BAR; PG8_SCHED;
            PG8_LDB(B0, 1, 0); PG8_LDB(B1, 1, 1); PG8_SCHED; PG8_LDA(At, 1, 0); PG8_STAGE(PG8_SA(0, 1), a2, v2a1);
            PG8_WAIT_V(8); PG8_WAIT_L(0); PG8_BAR; PG8_MMA(0, 0, At, B0); PG8_MMA(0, 1, At, B1); PG8_BAR; PG8_SCHED;
            PG8_LDA(At, 1, 1); PG8_STAGE(PG8_SB(1, 0), b3, voffB); PG8_STAGE(PG8_SB(1, 1), b3 + hstep, voffB); PG8_STAGE(PG8_SA(1, 0), a3, v2a0);
            PG8_WAIT_V(8); PG8_WAIT_L(0); PG8_BAR; PG8_MMA(1, 0, At, B0); PG8_MMA(1, 1, At, B1); PG8_BAR; PG8_SCHED;
        }
        if (wr == 0) PG8_BAR;
        E(acc, cur, wr, wc, fr, fq);
        if (!has_next) break;
#pragma unroll
        for (int a = 0; a < 2; ++a)
#pragma unroll
            for (int b = 0; b < 2; ++b)
#pragma unroll
                for (int m = 0; m < 4; ++m)
#pragma unroll
                    for (int n = 0; n < 2; ++n) acc[a][b][m][n] = (f32x4){0.f, 0.f, 0.f, 0.f};
        cur = nxt; cA = nA; cB = nB; va0[0] = nva0[0]; va0[1] = nva0[1]; va1[0] = nva1[0]; va1[1] = nva1[1]; ++ui;
        has_next = P.next(ui + 1, nxt);
        if (has_next) P.addr(nxt, R, C, nA, nB, nva0, nva1);
        if (wr == 1) PG8_BAR;
    }
    PG8_WAIT_V(0);
    PG8_BAR;
#undef PG8_SA
#undef PG8_SB
#undef PG8_STAGE
#undef PG8_LDA
#undef PG8_LDB
#undef PG8_MMA
#undef PG8_WAIT_V
#undef PG8_WAIT_L
#undef PG8_BAR
#undef PG8_SCHED
}

struct EpiOut {
    const float* x; float* out; bf16_t* xn2;
    __device__ __forceinline__ void operator()(const f32x4 (&acc)[2][2][4][2], const Unit& u, int wr, int wc, int fr, int fq) const {
        const int row0 = u.pm * BM + wr * 64 + fr, col0 = u.pn * BM + wc * 32 + 8 * fq;
#pragma unroll
        for (int ai = 0; ai < 2; ++ai)
#pragma unroll
            for (int m = 0; m < 4; ++m) { const size_t off = (size_t)(row0 + ai * HALF + m * 16) * D + col0;
#pragma unroll
                for (int bj = 0; bj < 2; ++bj) { const float* xp = x + off + bj * HALF;
                    const f32x4 h0 = acc[ai][bj][m][0] + *(const f32x4*)xp, h1 = acc[ai][bj][m][1] + *(const f32x4*)(xp + 4);
                    *(f32x4*)(out + off + bj * HALF) = h0; *(f32x4*)(out + off + bj * HALF + 4) = h1;
                    *(u32x4*)(xn2 + off + bj * HALF) = pack8(h0, h1); }
                asm volatile("" ::: "memory"); }
    }
};
struct EpiIn {
    bf16_t *Qb, *Kb, *VT, *HC; const float *qg, *kg;
    __device__ __forceinline__ void operator()(const f32x4 (&acc)[2][2][4][2], const Unit& u, int wr, int wc, int fr, int fq) const {
        const int rowb = u.pm * BM + wr * 64 + fr;
        if (u.pn <= 2) {
            const bool isv = (u.pn == 2) && (wc >= 2);
            if (!isv) {
                const bool isq = u.pn < 2; const float* g = isq ? qg : kg; const float sc = isq ? QSCALE : 1.f;
                f32x4 gv[2][2];
#pragma unroll
                for (int bj = 0; bj < 2; ++bj)
#pragma unroll
                    for (int n = 0; n < 2; ++n) gv[bj][n] = *(const f32x4*)(g + 32 * bj + 8 * fq + 4 * n) * sc;
                bf16_t* dst = isq ? Qb + (u.pn * 256 + 64 * wc) : Kb + 64 * wc; const int ld = isq ? 512 : 128;
#pragma unroll
                for (int ai = 0; ai < 2; ++ai)
#pragma unroll
                    for (int m = 0; m < 4; ++m) { const int row = rowb + ai * HALF + m * 16; float ss = 0.f;
#pragma unroll
                        for (int bj = 0; bj < 2; ++bj)
#pragma unroll
                            for (int n = 0; n < 2; ++n) { const f32x4 v = acc[ai][bj][m][n]; ss += (v[0] * v[0] + v[1] * v[1]) + (v[2] * v[2] + v[3] * v[3]); }
                        ss += __shfl_xor(ss, 16); ss += __shfl_xor(ss, 32);
                        const float r = __builtin_amdgcn_rsqf(ss * (1.f / 64.f) + 1e-6f);
#pragma unroll
                        for (int bj = 0; bj < 2; ++bj) *(u32x4*)(dst + (size_t)row * ld + 32 * bj + 8 * fq) = pack8(acc[ai][bj][m][0] * r * gv[bj][0], acc[ai][bj][m][1] * r * gv[bj][1]); }
            } else {
                const int hk = wc - 2;
#pragma unroll
                for (int ai = 0; ai < 2; ++ai)
#pragma unroll
                    for (int m = 0; m < 4; ++m) { const int row = rowb + ai * HALF + m * 16;
                        if (row < M_ALL) { int b, kx; if (row < M_REAL) { b = row >> 11; kx = NMETA + (row & 2047); } else { b = (row - M_REAL) >> 4; kx = (row - M_REAL) & 15; }
                            bf16_t* base = VT + (size_t)(b * 2 + hk) * 64 * VT_PITCH + kx;
#pragma unroll
                            for (int bj = 0; bj < 2; ++bj)
#pragma unroll
                                for (int n = 0; n < 2; ++n)
#pragma unroll
                                    for (int e = 0; e < 4; ++e) base[(size_t)(32 * bj + 8 * fq + 4 * n + e) * VT_PITCH] = (bf16_t)f2bf(acc[ai][bj][m][n][e]); } }
            }
        } else {
            const int col = (u.pn - 3) * 128 + 32 * wc + 8 * fq;
#pragma unroll
            for (int ai = 0; ai < 2; ++ai)
#pragma unroll
                for (int m = 0; m < 4; ++m) { const int row = rowb + ai * HALF + m * 16; f32x4 h[2];
#pragma unroll
                    for (int n = 0; n < 2; ++n)
#pragma unroll
                        for (int e = 0; e < 4; ++e) h[n][e] = acc[ai][0][m][n][e] * sigmoidf_fast(acc[ai][1][m][n][e]);
                    *(u32x4*)(HC + (size_t)row * 512 + col) = pack8(h[0], h[1]); }
        }
    }
};
struct EpiGU {
    bf16_t* ACT; const float* lrstd; const float* bgu;
    __device__ __forceinline__ void operator()(const f32x4 (&acc)[2][2][4][2], const Unit& u, int wr, int wc, int fr, int fq) const {
        const int lr0 = wr * 64 + fr, col = u.pn * 128 + 32 * wc + 8 * fq;
        f32x4 bg[2], bu[2];
#pragma unroll
        for (int n = 0; n < 2; ++n) { bg[n] = *(const f32x4*)(bgu + u.e * 2048 + col + 4 * n); bu[n] = *(const f32x4*)(bgu + u.e * 2048 + 1024 + col + 4 * n); }
        const float* rs = lrstd + u.e * CAP + u.slot0;
#pragma unroll
        for (int ai = 0; ai < 2; ++ai)
#pragma unroll
            for (int m = 0; m < 4; ++m) { const int lr = lr0 + ai * HALF + m * 16; const float rstd = lr < u.nvalid ? rs[lr] : 0.f; f32x4 h[2];
#pragma unroll
                for (int n = 0; n < 2; ++n)
#pragma unroll
                    for (int e = 0; e < 4; ++e) { float gt = acc[ai][0][m][n][e] * rstd + bg[n][e], up = acc[ai][1][m][n][e] * rstd + bu[n][e];
                        gt = fminf(gt, 7.f); up = fminf(fmaxf(up, -7.f), 7.f); h[n][e] = gt * sigmoidf_fast(1.702f * gt) * (up + 1.f); }
                *(u32x4*)(ACT + (size_t)(u.pm * BM + lr) * D + col) = pack8(h[0], h[1]); }
    }
};
struct EpiDown {
    bf16_t* Y; const float* lgate; const float* bd;
    __device__ __forceinline__ void operator()(const f32x4 (&acc)[2][2][4][2], const Unit& u, int wr, int wc, int fr, int fq) const {
        const int lr0 = wr * 64 + fr, col0 = u.pn * BM + wc * 32 + 8 * fq;
        f32x4 bv[2][2];
#pragma unroll
        for (int bj = 0; bj < 2; ++bj)
#pragma unroll
            for (int n = 0; n < 2; ++n) bv[bj][n] = *(const f32x4*)(bd + u.e * D + col0 + bj * HALF + 4 * n);
        const float* gs = lgate + u.e * CAP + u.slot0;
#pragma unroll
        for (int ai = 0; ai < 2; ++ai)
#pragma unroll
            for (int m = 0; m < 4; ++m) { const int lr = lr0 + ai * HALF + m * 16; const float gt = lr < u.nvalid ? gs[lr] : 0.f;
#pragma unroll
                for (int bj = 0; bj < 2; ++bj) *(u32x4*)(Y + (size_t)(u.pm * BM + lr) * D + col0 + bj * HALF) = pack8((acc[ai][bj][m][0] + bv[bj][0]) * gt, (acc[ai][bj][m][1] + bv[bj][1]) * gt); }
    }
};
}


constexpr int ATT_KIMG = 0, ATT_VIMG = 53248, ATT_VP = 840;
constexpr float ATT_THR = 4.0f;
template <int MODE>
__device__ __forceinline__ void att_tile(const LAS unsigned char* kbase, const int (&koff)[4], const LAS unsigned char* vbase, const bf16x8 (&qf)[4], float slope2, float Bq,
                                         float& m, float& l, f32x16& O0, f32x16& O1) {
    f32x16 s;
#pragma unroll
    for (int r = 0; r < 16; ++r) s[r] = 0.f;
#pragma unroll
    for (int ks = 0; ks < 4; ++ks) { const bf16x8 kf = *(const LAS bf16x8*)(kbase + koff[ks]); s = __builtin_amdgcn_mfma_f32_32x32x16_bf16(kf, qf[ks], s, 0, 0, 0); }
    float tmax = -INFINITY;
#pragma unroll
    for (int r = 0; r < 16; ++r) {
        if (MODE == 0) { if (r >= 8) s[r] = -INFINITY; }
        else { const float dl = fabsf(Bq - (float)((r & 3) + 8 * (r >> 2))); float v = s[r] - slope2 * dl; if (MODE == 2) v = dl <= 128.f ? v : -INFINITY; s[r] = v; }
        tmax = fmaxf(tmax, s[r]);
    }
    tmax = fmaxf(tmax, __shfl_xor(tmax, 32));
    if (__any(tmax > m + ATT_THR)) { const float mn = fmaxf(m, tmax); const float al = __builtin_amdgcn_exp2f(m - mn); m = mn; l *= al;
#pragma unroll
        for (int r = 0; r < 16; ++r) { O0[r] *= al; O1[r] *= al; } }
    float ps = 0.f;
#pragma unroll
    for (int r = 0; r < 16; ++r) { s[r] = __builtin_amdgcn_exp2f(s[r] - m); ps += s[r]; }
    l += ps;
#pragma unroll
    for (int s2 = 0; s2 < 2; ++s2) {
        u32x4 pw; pw.x = pg8::cvt_pk_bf16(s[8 * s2 + 0], s[8 * s2 + 1]); pw.y = pg8::cvt_pk_bf16(s[8 * s2 + 2], s[8 * s2 + 3]); pw.z = pg8::cvt_pk_bf16(s[8 * s2 + 4], s[8 * s2 + 5]); pw.w = pg8::cvt_pk_bf16(s[8 * s2 + 6], s[8 * s2 + 7]);
        const bf16x8 pf = __builtin_bit_cast(bf16x8, pw);
        { const u32x2 lo = *(const LAS u32x2*)(vbase + s2 * 32), hi = *(const LAS u32x2*)(vbase + s2 * 32 + 16); const u32x4 vw = {lo.x, lo.y, hi.x, hi.y};
          O0 = __builtin_amdgcn_mfma_f32_32x32x16_bf16(__builtin_bit_cast(bf16x8, vw), pf, O0, 0, 0, 0); }
        { const u32x2 lo = *(const LAS u32x2*)(vbase + 32 * ATT_VP + s2 * 32), hi = *(const LAS u32x2*)(vbase + 32 * ATT_VP + s2 * 32 + 16); const u32x4 vw = {lo.x, lo.y, hi.x, hi.y};
          O1 = __builtin_amdgcn_mfma_f32_32x32x16_bf16(__builtin_bit_cast(bf16x8, vw), pf, O1, 0, 0, 0); }
    }
}
__device__ __forceinline__ void att_fast(Frame& F) {
    LAS unsigned char* Kimg = F.lds + ATT_KIMG; LAS unsigned char* Vimg = F.lds + ATT_VIMG;
    const int tid = F.tid, lane = F.lane, wid = F.wave, q = lane & 31, h = lane >> 5, qt = wid & 3, hsel = wid >> 2;
    int koff[4];
#pragma unroll
    for (int ks = 0; ks < 4; ++ks) koff[ks] = ((2 * ks + h) ^ ((q >> 1) & 7)) << 4;
    for (int item = F.bid; item < NB * 16 * 2; item += F.G) {
        const int hk = item & 1, i = (item >> 1) & 15, b = item >> 5;
        __syncthreads();
        for (int idx = tid; idx < 416 * 8; idx += NTHR) { const int kr = idx >> 3, c = idx & 7; if (kr >= 16 && kr < 32) continue;
            int row; if (kr < 16) row = M_REAL + b * NMETA + kr; else { const int pos = (i - 1) * 128 + kr - 32; if (pos < 0 || pos >= SEQ) continue; row = b * SEQ + pos; }
            const u32x4 v = *(const GAS u32x4*)(F.Kb + (size_t)row * 128 + hk * 64 + 8 * c);
            *(LAS u32x4*)(Kimg + kr * 128 + ((c ^ ((kr >> 1) & 7)) << 4)) = v; }
        for (int idx = tid; idx < 64 * 52; idx += NTHR) { const int d = idx / 52, c = idx % 52; const bf16_t* vrow = F.VT + (size_t)((b * 2 + hk) * 64 + d) * VT_PITCH;
            LAS u32x2* dst; const bf16_t* src;
            if (c < 2) { src = vrow + 8 * c; dst = (LAS u32x2*)(Vimg + d * ATT_VP + 16 * c); }
            else if (c < 4) { dst = (LAS u32x2*)(Vimg + d * ATT_VP + 32 + 16 * (c - 2)); dst[0] = (u32x2){0u, 0u}; dst[1] = (u32x2){0u, 0u}; continue; }
            else { const int cc = c - 4, blk = cc >> 4, w = cc & 15, pos0 = (i - 1 + blk) * 128; if (pos0 < 0 || pos0 >= SEQ) continue; src = vrow + NMETA + pos0 + 8 * w; dst = (LAS u32x2*)(Vimg + d * ATT_VP + (32 + blk * 128 + 8 * w) * 2); }
            const u32x4 v = *(const GAS u32x4*)src; dst[0] = (u32x2){v.x, v.y}; dst[1] = (u32x2){v.z, v.w}; }
        __syncthreads();
#pragma unroll 1
        for (int hp = 0; hp < 2; ++hp) {
            const int head = hk * 4 + hp * 2 + hsel, row = b * SEQ + i * 128 + 32 * qt + q;
            bf16x8 qf[4];
#pragma unroll
            for (int ks = 0; ks < 4; ++ks) qf[ks] = *(const GAS bf16x8*)(F.Qb + (size_t)row * 512 + head * 64 + 16 * ks + 8 * h);
            const float slope2 = exp2f(-(float)(head + 1)) * LOG2E;
            float m = F.sink[head] * LOG2E, l = h == 0 ? 1.f : 0.f;
            f32x16 O0, O1;
#pragma unroll
            for (int r = 0; r < 16; ++r) { O0[r] = 0.f; O1[r] = 0.f; }
            const LAS unsigned char* kb0 = Kimg + q * 128; const LAS unsigned char* vb0 = Vimg + q * ATT_VP + 8 * h;
            att_tile<0>(kb0, koff, vb0, qf, 0.f, 0.f, m, l, O0, O1);
#pragma unroll 1
            for (int kt = qt; kt <= qt + 8; ++kt) { const int blk = kt >> 2; if ((i == 0 && blk == 0) || (i == 15 && blk == 2)) continue;
                const int kr0 = 32 + 32 * kt; const float Bq = (float)(128 + 32 * (qt - kt) + q - 4 * h);
                if (kt == qt || kt == qt + 8) att_tile<2>(kb0 + kr0 * 128, koff, vb0 + kr0 * 2, qf, slope2, Bq, m, l, O0, O1);
                else att_tile<1>(kb0 + kr0 * 128, koff, vb0 + kr0 * 2, qf, slope2, Bq, m, l, O0, O1); }
            l += __shfl_xor(l, 32); const float inv = 1.f / l;
            bf16_t* orow = F.MIX + (size_t)row * D + head * 64 + 4 * h;
#pragma unroll
            for (int g = 0; g < 4; ++g) { *(GAS u32x2*)(orow + 8 * g) = (u32x2){pg8::cvt_pk_bf16(O0[4 * g] * inv, O0[4 * g + 1] * inv), pg8::cvt_pk_bf16(O0[4 * g + 2] * inv, O0[4 * g + 3] * inv)};
                *(GAS u32x2*)(orow + 32 + 8 * g) = (u32x2){pg8::cvt_pk_bf16(O1[4 * g] * inv, O1[4 * g + 1] * inv), pg8::cvt_pk_bf16(O1[4 * g + 2] * inv, O1[4 * g + 3] * inv)}; }
        }
    }
    __syncthreads();
}
__device__ __forceinline__ void conv_fast(Frame& F) {
    const int tid = F.tid, lane = F.lane, wid = F.wave, c2 = tid & 255, th = tid >> 8;
    LAS float* cout = (LAS float*)F.lds;
    float w0[CONV_K], w1[CONV_K];
#pragma unroll
    for (int j = 0; j < CONV_K; ++j) { const f32x2 w = *(const f32x2*)(F.dw_w + j * CONV_W + 2 * c2); w0[j] = w.x; w1[j] = w.y; }
    const f32x2 bias = *(const f32x2*)(F.dw_b + 2 * c2);
    for (int item = F.bid; item < NB * 64; item += F.G) {
        const int b = item >> 6, t0 = (item & 63) * 32;
        unsigned xin[46];
        const int s0 = NMETA + t0 + 16 * th - 15;
#pragma unroll
        for (int jj = 0; jj < 46; ++jj) { const int sq = s0 + jj; xin[jj] = sq < LSEQ ? *(const GAS unsigned*)(F.HC + (size_t)row_of(b, sq) * 512 + 2 * c2) : 0u; }
        __syncthreads();
#pragma unroll
        for (int t = 0; t < 16; ++t) { float a0 = bias.x, a1 = bias.y;
#pragma unroll
            for (int j = 0; j < CONV_K; ++j) { a0 += w0[j] * bflo(xin[t + j]); a1 += w1[j] * bfhi(xin[t + j]); }
            *(LAS f32x2*)(cout + (16 * th + t) * 512 + 2 * c2) = (f32x2){a0, a1}; }
        __syncthreads();
#pragma unroll 1
        for (int tt = 0; tt < 4; ++tt) { const int t = 4 * wid + tt; const LAS f32x4* rp = (const LAS f32x4*)(cout + t * 512 + 8 * lane); const f32x4 x0 = rp[0], x1 = rp[1];
            const float mu = wave_sum((x0[0] + x0[1]) + (x0[2] + x0[3]) + (x1[0] + x1[1]) + (x1[2] + x1[3])) * (1.f / 512.f);
            const f32x4 d0 = x0 - mu, d1 = x1 - mu;
            const float var = wave_sum((d0[0] * d0[0] + d0[1] * d0[1]) + (d0[2] * d0[2] + d0[3] * d0[3]) + (d1[0] * d1[0] + d1[1] * d1[1]) + (d1[2] * d1[2] + d1[3] * d1[3])) * (1.f / 512.f);
            const float rstd = __builtin_amdgcn_rsqf(var + 1e-5f);
            const f32x4 g0 = *(const f32x4*)(F.lng + 8 * lane), g1 = *(const f32x4*)(F.lng + 8 * lane + 4), b0 = *(const f32x4*)(F.lnb + 8 * lane), b1 = *(const f32x4*)(F.lnb + 8 * lane + 4);
            f32x4 y0 = d0 * rstd * g0 + b0, y1 = d1 * rstd * g1 + b1;
#pragma unroll
            for (int e = 0; e < 4; ++e) { y0[e] *= sigmoidf_fast(y0[e]); y1[e] *= sigmoidf_fast(y1[e]); }
            *(GAS u32x4*)(F.MIX + (size_t)(b * SEQ + t0 + t) * D + 512 + 8 * lane) = pg8::pack8(y0, y1); }
    }
    __syncthreads();
}
__device__ __forceinline__ void p4_fast(Frame& F) {
    LAS int* lcnt = (LAS int*)(F.lds + LX_LCNT); LAS int* gbase = (LAS int*)(F.lds + LX_GBASE);
    const int tid = F.tid, lane = F.lane, wid = F.wave, j = lane & 31, h = lane >> 5;
    for (int base = 0; base < M_REAL / 32; base += F.G * NWAVES) {
        const int tile = base + F.bid + F.G * wid; const bool active = tile < M_REAL / 32;
        if (tid < NE) lcnt[tid] = 0;
        __syncthreads();
        int ea = 0, eb = 0, sa = 0, sb = 0, tok = 0; float ga = 0.f, gb = 0.f, rstd = 0.f;
        if (active) {
            tok = tile * 32 + j;
            const bf16_t* xa = F.XN2 + (size_t)tok * D + 8 * h; const bf16_t* wa = F.WrT + (size_t)j * D + 8 * h;
            f32x16 acc;
#pragma unroll
            for (int r = 0; r < 16; ++r) acc[r] = 0.f;
            float ssq = 0.f;
#pragma unroll 8
            for (int ks = 0; ks < 64; ++ks) { const u32x4 xb = *(const GAS u32x4*)(xa + 16 * ks); const bf16x8 wf = *(const GAS bf16x8*)(wa + 16 * ks);
                acc = __builtin_amdgcn_mfma_f32_32x32x16_bf16(wf, __builtin_bit_cast(bf16x8, xb), acc, 0, 0, 0);
                ssq += (bflo(xb.x) * bflo(xb.x) + bfhi(xb.x) * bfhi(xb.x)) + (bflo(xb.y) * bflo(xb.y) + bfhi(xb.y) * bfhi(xb.y)) + (bflo(xb.z) * bflo(xb.z) + bfhi(xb.z) * bfhi(xb.z)) + (bflo(xb.w) * bflo(xb.w) + bfhi(xb.w) * bfhi(xb.w)); }
            ssq += __shfl_xor(ssq, 32);
            rstd = 1.f / sqrtf(ssq * (1.f / D) + 1e-6f);
            float lg[16];
#pragma unroll
            for (int r = 0; r < 16; ++r) lg[r] = acc[r] * rstd + F.rb[(r & 3) + 8 * (r >> 2) + 4 * h];
            float tv[4]; int te[4];
#pragma unroll
            for (int kk = 0; kk < 4; ++kk) { float bv = -INFINITY; int be = 0;
#pragma unroll
                for (int r = 0; r < 16; ++r) { const int er = (r & 3) + 8 * (r >> 2) + 4 * h; if (lg[r] > bv) { bv = lg[r]; be = er; } }
                const float pv = __shfl_xor(bv, 32); const int pe = __shfl_xor(be, 32);
                if (pv > bv || (pv == bv && pe < be)) { bv = pv; be = pe; }
#pragma unroll
                for (int r = 0; r < 16; ++r) { const int er = (r & 3) + 8 * (r >> 2) + 4 * h; if (er == be) lg[r] = -INFINITY; }
                tv[kk] = bv; te[kk] = be; }
            const float p1 = __expf(tv[1] - tv[0]), p2 = __expf(tv[2] - tv[0]), p3 = __expf(tv[3] - tv[0]); const float inv = 1.f / (1.f + p1 + p2 + p3);
            ea = h ? te[2] : te[0]; eb = h ? te[3] : te[1]; ga = (h ? p2 : 1.f) * inv; gb = (h ? p3 : p1) * inv;
            sa = __hip_atomic_fetch_add(lcnt + ea, 1, __ATOMIC_RELAXED, __HIP_MEMORY_SCOPE_WORKGROUP); sb = __hip_atomic_fetch_add(lcnt + eb, 1, __ATOMIC_RELAXED, __HIP_MEMORY_SCOPE_WORKGROUP);
        }
        __syncthreads();
        if (tid < NE) gbase[tid] = (int)__hip_atomic_fetch_add((unsigned*)(F.ctl + CW_CNT + tid), (unsigned)lcnt[tid], RLX_AGENT);
        __syncthreads();
        if (active) {
            sa += gbase[ea]; sb += gbase[eb];
            F.ltok[ea * CAP + sa] = tok; F.lgate[ea * CAP + sa] = ga; F.lrstd[ea * CAP + sa] = rstd; F.where[tok * 4 + 2 * h] = ea * CAP + sa;
            F.ltok[eb * CAP + sb] = tok; F.lgate[eb * CAP + sb] = gb; F.lrstd[eb * CAP + sb] = rstd; F.where[tok * 4 + 2 * h + 1] = eb * CAP + sb;
        }
        __syncthreads();
    }
}

__device__ __forceinline__ void p1_naive(Frame& F) {
    const int gw = F.bid * NWAVES + F.wave, NGW = F.G * NWAVES, lane = F.lane;
    for (int it = gw; it < M_ALL * 20; it += NGW) {
        const int row = it / 20, grp = it % 20;
        const bf16_t* xr = F.XN + (size_t)row * D;
        if (grp < 12) {
            const int col = grp * 64 + lane; float acc = 0.f;
            _Pragma("unroll 4") for (int k = 0; k < D; ++k) acc += bf2f(xr[k]) * F.w_in[(size_t)k * IN_W + col];
            if (grp < 10) {
                const float ssq = wave_sum(acc * acc); const float r = 1.f / sqrtf(ssq * (1.f / 64.f) + 1e-6f);
                if (grp < 8) F.Qb[(size_t)row * 512 + col] = (bf16_t)f2bf(acc * r * F.qg[lane] * QSCALE);
                else F.Kb[(size_t)row * 128 + (col - 512)] = (bf16_t)f2bf(acc * r * F.kg[lane]);
            } else {
                const int hk = grp - 10; int b, kx;
                if (row < M_REAL) { b = row >> 11; kx = NMETA + (row & 2047); } else { b = (row - M_REAL) >> 4; kx = (row - M_REAL) & 15; }
                F.VT[((size_t)(b * 2 + hk) * 64 + lane) * VT_PITCH + kx] = (bf16_t)f2bf(acc);
            }
        } else {
            const int c = (grp - 12) * 64 + lane; float a = 0.f, g = 0.f;
            for (int k = 0; k < D; ++k) { const float xv = bf2f(xr[k]); a += xv * F.w_in[(size_t)k * IN_W + 768 + c]; g += xv * F.w_in[(size_t)k * IN_W + 1280 + c]; }
            F.HC[(size_t)row * 512 + c] = (bf16_t)f2bf(a * sigmoidf_fast(g));
        }
    }
}
__device__ __forceinline__ void att_naive(Frame& F) {
    const int gw = F.bid * NWAVES + F.wave, NGW = F.G * NWAVES, lane = F.lane;
    for (int it = gw; it < M_REAL * NQH; it += NGW) {
        const int row = it >> 3, h = it & 7, hk = h >> 2, b = row >> 11, qp = row & 2047;
        const float q = bf2f(F.Qb[(size_t)row * 512 + h * 64 + lane]);
        const float slope2 = exp2f(-(float)(h + 1)) * LOG2E;
        float m = F.sink[h] * LOG2E, l = 1.f, acc = 0.f;
        const bf16_t* vt = F.VT + ((size_t)(b * 2 + hk) * 64 + lane) * VT_PITCH;
        for (int j = 0; j < NMETA; ++j) {
            const float kv = bf2f(F.Kb[(size_t)(M_REAL + b * NMETA + j) * 128 + hk * 64 + lane]);
            const float s = wave_sum(q * kv);
            const float mn = fmaxf(m, s), al = exp2f(m - mn), p = exp2f(s - mn);
            l = l * al + p; acc = acc * al + p * bf2f(vt[j]); m = mn;
        }
        const int k0 = qp - 128 < 0 ? 0 : qp - 128, k1 = qp + 128 > SEQ - 1 ? SEQ - 1 : qp + 128;
        for (int kp = k0; kp <= k1; ++kp) {
            const float kv = bf2f(F.Kb[(size_t)(b * SEQ + kp) * 128 + hk * 64 + lane]);
            const float dist = (float)(qp > kp ? qp - kp : kp - qp);
            const float s = wave_sum(q * kv) - slope2 * dist;
            const float mn = fmaxf(m, s), al = exp2f(m - mn), p = exp2f(s - mn);
            l = l * al + p; acc = acc * al + p * bf2f(vt[NMETA + kp]); m = mn;
        }
        F.MIX[(size_t)row * D + h * 64 + lane] = (bf16_t)f2bf(acc / l);
    }
}
__device__ __forceinline__ void conv_naive(Frame& F) {
    const int gw = F.bid * NWAVES + F.wave, NGW = F.G * NWAVES, lane = F.lane;
    for (int row = gw; row < M_REAL; row += NGW) {
        const int b = row >> 11, s0 = NMETA + (row & 2047);
        float v[8]; float sum = 0.f;
#pragma unroll
        for (int j = 0; j < 8; ++j) { const int c = lane + 64 * j; float a = F.dw_b[c];
            _Pragma("unroll 1") for (int t = 0; t < CONV_K; ++t) { const int s = s0 - 15 + t; if (s >= 0 && s < LSEQ) a += F.dw_w[t * CONV_W + c] * bf2f(F.HC[(size_t)row_of(b, s) * 512 + c]); }
            v[j] = a; sum += a; }
        const float mu = wave_sum(sum) * (1.f / 512.f); float q = 0.f;
#pragma unroll
        for (int j = 0; j < 8; ++j) { const float d = v[j] - mu; q += d * d; }
        const float rstd = 1.f / sqrtf(wave_sum(q) * (1.f / 512.f) + 1e-5f);
#pragma unroll
        for (int j = 0; j < 8; ++j) { const int c = lane + 64 * j; const float y = (v[j] - mu) * rstd * F.lng[c] + F.lnb[c];
            F.MIX[(size_t)row * D + 512 + c] = (bf16_t)f2bf(y * sigmoidf_fast(y)); }
    }
}
__device__ __forceinline__ void p3_naive(Frame& F) {
    const int gw = F.bid * NWAVES + F.wave, NGW = F.G * NWAVES, lane = F.lane;
    for (int it = gw; it < M_REAL * 16; it += NGW) {
        const int row = it >> 4, col = (it & 15) * 64 + lane; const bf16_t* mr = F.MIX + (size_t)row * D; float acc = 0.f;
        for (int k = 0; k < D; ++k) acc += bf2f(mr[k]) * F.w_out[(size_t)k * D + col];
        const float h2 = F.x[(size_t)row * D + col] + acc;
        F.out[(size_t)row * D + col] = h2; F.XN2[(size_t)row * D + col] = (bf16_t)f2bf(h2);
    }
}
__device__ __forceinline__ void p4_naive(Frame& F) {
    const int gw = F.bid * NWAVES + F.wave, NGW = F.G * NWAVES, lane = F.lane, e = lane & 31;
    for (int t = gw; t < M_REAL; t += NGW) {
        const bf16_t* xr = F.XN2 + (size_t)t * D; float acc = 0.f, ss = 0.f;
        for (int k = 0; k < D; ++k) { const float xv = bf2f(xr[k]); acc += xv * F.n2g[k] * F.wr[k * NE + e]; ss += xv * xv; }
        const float rstd = 1.f / sqrtf(ss * (1.f / D) + 1e-6f);
        float lg = acc * rstd + F.rb[e];
        float tv[4]; int te[4];
#pragma unroll
        for (int kk = 0; kk < 4; ++kk) {
            float bv = lg; int be = e;
#pragma unroll
            for (int o = 1; o < 32; o <<= 1) { const float pv = __shfl_xor(bv, o); const int pe = __shfl_xor(be, o); if (pv > bv || (pv == bv && pe < be)) { bv = pv; be = pe; } }
            tv[kk] = bv; te[kk] = be; if (e == be) lg = -INFINITY;
        }
        float p[4], ps = 0.f;
#pragma unroll
        for (int kk = 0; kk < 4; ++kk) { p[kk] = __expf(tv[kk] - tv[0]); ps += p[kk]; }
        if (lane < 4) {
            const int ee = lane == 0 ? te[0] : lane == 1 ? te[1] : lane == 2 ? te[2] : te[3];
            const float gg = (lane == 0 ? p[0] : lane == 1 ? p[1] : lane == 2 ? p[2] : p[3]) / ps;
            const unsigned slot = __hip_atomic_fetch_add((unsigned*)(F.ctl + CW_CNT + ee), 1u, RLX_AGENT);
            F.ltok[ee * CAP + slot] = t; F.lgate[ee * CAP + slot] = gg; F.lrstd[ee * CAP + slot] = rstd; F.where[t * 4 + lane] = ee * CAP + (int)slot;
        }
    }
}
__device__ __forceinline__ void build_tile_table(Frame& F) {
    LAS int* tb = (LAS int*)(F.lds + LX_TB); LAS int* cn = (LAS int*)(F.lds + LX_CNT);
    __syncthreads();
    if (F.tid == 0) { int acc = 0; for (int e = 0; e < NE; ++e) { int c = (int)__hip_atomic_load(F.ctl + CW_CNT + e, RLX_AGENT); if (c > CAP) c = CAP; if (c < 0) c = 0; cn[e] = c; tb[e] = acc; acc += (c + 255) >> 8; } tb[NE] = acc; }
    __syncthreads();
}
__device__ __forceinline__ int find_expert(const LAS int* tb, int tile) { int e = 0;
#pragma unroll 1
    for (int j = 1; j < NE; ++j) if (tb[j] <= tile) e = j;
    return e; }
__device__ __forceinline__ void p5_naive(Frame& F) {
    build_tile_table(F);
    const LAS int* tb = (const LAS int*)(F.lds + LX_TB); const LAS int* cn = (const LAS int*)(F.lds + LX_CNT);
    const int gw = F.bid * NWAVES + F.wave, NGW = F.G * NWAVES, lane = F.lane, total = tb[NE] * 256;
    for (int it = gw; it < total * 16; it += NGW) {
        const int sr = it >> 4, c = (it & 15) * 64 + lane, e = find_expert(tb, sr >> 8), slot = sr - tb[e] * 256;
        if (slot >= cn[e]) continue;
        const int tok = F.ltok[e * CAP + slot]; const float rstd = F.lrstd[e * CAP + slot];
        const bf16_t* xr = F.XN2 + (size_t)tok * D; const float* W = F.wgu + (size_t)e * D * 2048; float g = 0.f, u = 0.f;
        for (int k = 0; k < D; ++k) { const float xv = bf2f(xr[k]) * F.n2g[k]; g += xv * W[(size_t)k * 2048 + c]; u += xv * W[(size_t)k * 2048 + 1024 + c]; }
        g = g * rstd + F.bgu[e * 2048 + c]; u = u * rstd + F.bgu[e * 2048 + 1024 + c];
        g = fminf(g, 7.f); u = fminf(fmaxf(u, -7.f), 7.f);
        F.ACT[(size_t)sr * D + c] = (bf16_t)f2bf(g * sigmoidf_fast(1.702f * g) * (u + 1.f));
    }
}
__device__ __forceinline__ void p6_naive(Frame& F) {
    build_tile_table(F);
    const LAS int* tb = (const LAS int*)(F.lds + LX_TB); const LAS int* cn = (const LAS int*)(F.lds + LX_CNT);
    const int gw = F.bid * NWAVES + F.wave, NGW = F.G * NWAVES, lane = F.lane, total = tb[NE] * 256;
    for (int it = gw; it < total * 16; it += NGW) {
        const int sr = it >> 4, c = (it & 15) * 64 + lane, e = find_expert(tb, sr >> 8), slot = sr - tb[e] * 256;
        if (slot >= cn[e]) continue;
        const bf16_t* ar = F.ACT + (size_t)sr * D; const float* W = F.wd + (size_t)e * D * D; float acc = 0.f;
        for (int k = 0; k < D; ++k) acc += bf2f(ar[k]) * W[(size_t)k * D + c];
        F.Y[(size_t)sr * D + c] = (bf16_t)f2bf((acc + F.bd[e * D + c]) * F.lgate[e * CAP + slot]);
    }
}
__device__ __forceinline__ void p7_combine(Frame& F) {
    build_tile_table(F);
    const LAS int* tb = (const LAS int*)(F.lds + LX_TB);
    const int gw = F.bid * NWAVES + F.wave, NGW = F.G * NWAVES, lane = F.lane;
    for (int t = gw; t < M_REAL; t += NGW) {
        GAS f32x4* o = (GAS f32x4*)(F.out + (size_t)t * D) + lane * 4;
        f32x4 a[4];
#pragma unroll
        for (int j = 0; j < 4; ++j) a[j] = o[j];
#pragma unroll
        for (int k = 0; k < 4; ++k) {
            const int w = F.where[t * 4 + k], e = w / CAP, slot = w - e * CAP;
            const GAS u32x4* y = (const GAS u32x4*)(F.Y + (size_t)(tb[e] * 256 + slot) * D) + lane * 2;
            const u32x4 y0 = y[0], y1 = y[1];
            a[0] += (f32x4){bflo(y0.x), bfhi(y0.x), bflo(y0.y), bfhi(y0.y)}; a[1] += (f32x4){bflo(y0.z), bfhi(y0.z), bflo(y0.w), bfhi(y0.w)};
            a[2] += (f32x4){bflo(y1.x), bfhi(y1.x), bflo(y1.y), bfhi(y1.y)}; a[3] += (f32x4){bflo(y1.z), bfhi(y1.z), bflo(y1.w), bfhi(y1.w)};
        }
#pragma unroll
        for (int j = 0; j < 4; ++j) o[j] = a[j];
    }
}

__global__ void __launch_bounds__(NTHR, 2) mega(Args args) {
    extern __shared__ __attribute__((aligned(16))) unsigned char lds_raw[];
    Frame F;
    F.lds = (LAS unsigned char*)lds_raw;
    F.tid = threadIdx.x; F.lane = F.tid & 63; F.wave = __builtin_amdgcn_readfirstlane(F.tid >> 6); F.G = gridDim.x; F.bid = blockIdx.x;
    F.x = args.in[0]; F.meta = args.in[1]; F.n1g = args.in[2]; F.w_in = args.in[3]; F.qg = args.in[4]; F.kg = args.in[5]; F.sink = args.in[6];
    F.dw_w = args.in[7]; F.dw_b = args.in[8]; F.lng = args.in[9]; F.lnb = args.in[10]; F.w_out = args.in[11]; F.n2g = args.in[12];
    F.wr = args.in[13]; F.rb = args.in[14]; F.wgu = args.in[15]; F.bgu = args.in[16]; F.wd = args.in[17]; F.bd = args.in[18];
    F.out = args.out; F.ws = args.ws; unsigned char* ws = args.ws;
    F.ctl = (gu32*)(ws + WS_CTL);
    F.WinT = (bf16_t*)(ws + WS_WIN_T); F.WoT = (bf16_t*)(ws + WS_WO_T); F.WrT = (bf16_t*)(ws + WS_WR_T); F.WdT = (bf16_t*)(ws + WS_WD_T); F.WguT = (bf16_t*)(ws + WS_WGU_T);
    F.XN = (bf16_t*)(ws + WS_XN); F.Qb = (bf16_t*)(ws + WS_Q); F.Kb = (bf16_t*)(ws + WS_K); F.VT = (bf16_t*)(ws + WS_VT); F.HC = (bf16_t*)(ws + WS_HC);
    F.MIX = (bf16_t*)(ws + WS_MIX); F.XN2 = (bf16_t*)(ws + WS_XN2); F.ACT = (bf16_t*)(ws + WS_ACT); F.Y = (bf16_t*)(ws + WS_Y);
    F.where = (int*)(ws + WS_WHERE); F.ltok = (int*)(ws + WS_LTOK); F.lgate = (float*)(ws + WS_LGATE); F.lrstd = (float*)(ws + WS_LRSTD);
    for (int u = F.tid; u < (LDS_BYTES - RING_BYTES) / 4; u += NTHR) ((LAS unsigned*)(F.lds + RING_BYTES))[u] = 0u;
    __syncthreads();
    const int lo = args.ph_lo, hi = args.ph_hi;
    XcdBarrier bar; bar.bar = (unsigned*)(F.ctl + CW_BAR); bar.x = 0; bar.st = nullptr;
    if (hi - lo > 1) bar = xcd_barrier_post((unsigned*)(F.ctl + CW_BAR), (volatile LAS unsigned*)(F.lds + LX_BAR));
#ifndef PH_MASK
#define PH_MASK 0xFF
#endif
#define IN(k) (((PH_MASK >> (k)) & 1) && lo <= (k) && (k) < hi)
#define SEAM(k) do { if (IN(k) && IN((k) + 1)) xcd_barrier(bar); } while (0)
    if (IN(0)) { p0_prologue(F); } SEAM(0);
#if FAST_P1
    if (IN(1)) { pg8::DenseProb P{F.XN, F.WinT, M_PAD / 256, IN_W / 256, F.G, F.bid}; pg8::EpiIn E{F.Qb, F.Kb, F.VT, F.HC, F.qg, F.kg}; pg8::gemm_phase(F.lds, P, E); } SEAM(1);
#else
    if (IN(1)) { p1_naive(F); } SEAM(1);
#endif
    if (IN(2)) {
#if FAST_ATT
        att_fast(F);
#else
        att_naive(F);
#endif
#if FAST_CONV
        conv_fast(F);
#else
        conv_naive(F);
#endif
    } SEAM(2);
#if FAST_P3
    if (IN(3)) { pg8::DenseProb P{F.MIX, F.WoT, M_REAL / 256, D / 256, F.G, F.bid}; pg8::EpiOut E{F.x, F.out, F.XN2}; pg8::gemm_phase(F.lds, P, E); } SEAM(3);
#else
    if (IN(3)) { p3_naive(F); } SEAM(3);
#endif
#if FAST_P4
    if (IN(4)) { p4_fast(F); } SEAM(4);
#else
    if (IN(4)) { p4_naive(F); } SEAM(4);
#endif
#if FAST_P5
    if (IN(5)) { build_tile_table(F); pg8::GroupedProb<true> P{F.XN2, F.WguT, F.ltok, (const LAS int*)(F.lds + LX_TB), (const LAS int*)(F.lds + LX_CNT), 8, F.G, F.bid};
        pg8::EpiGU E{F.ACT, F.lrstd, F.bgu}; pg8::gemm_phase(F.lds, P, E); } SEAM(5);
#else
    if (IN(5)) { p5_naive(F); } SEAM(5);
#endif
#if FAST_P6
    if (IN(6)) { build_tile_table(F); pg8::GroupedProb<false> P{F.ACT, F.WdT, F.ltok, (const LAS int*)(F.lds + LX_TB), (const LAS int*)(F.lds + LX_CNT), 4, F.G, F.bid};
        pg8::EpiDown E{F.Y, F.lgate, F.bd}; pg8::gemm_phase(F.lds, P, E); } SEAM(6);
#else
    if (IN(6)) { p6_naive(F); } SEAM(6);
#endif
    if (IN(7)) { p7_combine(F); }
#undef IN
#undef SEAM
}

extern "C" void kernel_launch(void* const* d_in, const int* in_sizes, int n_in, void* d_out, int out_size, void* d_ws, size_t ws_size, hipStream_t stream) {
    static int grid = 0;
    if (grid == 0) {
        if (n_in != 19 || in_sizes[0] != M_REAL * D || out_size != M_REAL * D || ws_size < WS_END) {
            fprintf(stderr, "kernel_launch: unexpected shapes/workspace: n_in %d in0 %d out %d ws %zu (need %zu)\n", n_in, n_in > 0 ? in_sizes[0] : -1, out_size, ws_size, (size_t)WS_END); grid = -1; return; }
        int dev = 0, cus = 0, per_cu = 0;
        if (hipGetDevice(&dev) != hipSuccess || hipDeviceGetAttribute(&cus, hipDeviceAttributeMultiprocessorCount, dev) != hipSuccess) { grid = -1; return; }
        if (hipFuncSetAttribute((const void*)mega, hipFuncAttributeMaxDynamicSharedMemorySize, LDS_BYTES) != hipSuccess) { fprintf(stderr, "kernel_launch: hipFuncSetAttribute failed\n"); grid = -1; return; }
        if (hipOccupancyMaxActiveBlocksPerMultiprocessor(&per_cu, (const void*)mega, NTHR, LDS_BYTES) != hipSuccess || per_cu < 1) { fprintf(stderr, "kernel_launch: occupancy query says %d blocks/CU\n", per_cu); (void)hipGetLastError(); grid = -1; return; }
        grid = cus;
    }
    if (grid < 0) return;
    (void)hipMemsetAsync((char*)d_ws + WS_CTL, 0, CTL_ZERO_BYTES, stream);
    Args a{};
    for (int i = 0; i < 19; ++i) a.in[i] = (const float*)d_in[i];
    a.out = (float*)d_out; a.ws = (unsigned char*)d_ws;
#if MK_PER_PHASE
    for (int p = 0; p < 8; ++p) { a.ph_lo = p; a.ph_hi = p + 1; hipLaunchKernelGGL(mega, dim3(grid), dim3(NTHR), LDS_BYTES, stream, a); }
#else
    a.ph_lo = 0; a.ph_hi = 8; hipLaunchKernelGGL(mega, dim3(grid), dim3(NTHR), LDS_BYTES, stream, a);
#endif
}
```

```cpp
#include <hip/hip_runtime.h>
#include <cstdio>
#include <cstdint>

#ifndef MK_PER_PHASE
#define MK_PER_PHASE 0
#endif
#ifndef FAST_P1
#define FAST_P1 1
#endif
#ifndef FAST_ATT
#define FAST_ATT 1
#endif
#ifndef FAST_CONV
#define FAST_CONV 1
#endif
#ifndef FAST_P3
#define FAST_P3 1
#endif
#ifndef FAST_P4
#define FAST_P4 1
#endif
#ifndef FAST_P5
#define FAST_P5 1
#endif
#ifndef FAST_P6
#define FAST_P6 1
#endif

#define GAS __attribute__((address_space(1)))
#define LAS __attribute__((address_space(3)))
typedef unsigned short bf16_t;
typedef short bf16x8 __attribute__((ext_vector_type(8)));
typedef float f32x4 __attribute__((ext_vector_type(4)));
typedef float f32x16 __attribute__((ext_vector_type(16)));
typedef unsigned u32x4 __attribute__((ext_vector_type(4)));
typedef unsigned u32x2 __attribute__((ext_vector_type(2)));
typedef float f32x2 __attribute__((ext_vector_type(2)));
typedef GAS unsigned gu32;
#define RLX_AGENT __ATOMIC_RELAXED, __HIP_MEMORY_SCOPE_AGENT

constexpr int NB = 8, SEQ = 2048, D = 1024, NMETA = 16, LSEQ = NMETA + SEQ;
constexpr int M_REAL = NB * SEQ, M_ALL = NB * LSEQ, M_PAD = 16640;
constexpr int IN_W = 1792, HD = 64, NQH = 8, NKV = 2, CONV_W = 512, CONV_K = 31;
constexpr int NE = 32, CAP = 16384, ACT_ROWS = 4 * M_REAL + NE * 256;
constexpr float LOG2E = 1.4426950408889634f;
constexpr float QSCALE = 0.125f * LOG2E;
constexpr int VT_PITCH = LSEQ;

constexpr size_t MiB = 1u << 20;
constexpr size_t WS_CTL = 0, CTL_ZERO_BYTES = 1 * MiB;
constexpr size_t WS_WIN_T = 2 * MiB;
constexpr size_t WS_WO_T = 6 * MiB;
constexpr size_t WS_WR_T = 8 * MiB;
constexpr size_t WS_RSTD = 9 * MiB;
constexpr size_t WS_WHERE = 9 * MiB + 512 * 1024;
constexpr size_t WS_LTOK = 10 * MiB;
constexpr size_t WS_LGATE = 12 * MiB;
constexpr size_t WS_LRSTD = 14 * MiB;
constexpr size_t WS_WD_T = 16 * MiB;
constexpr size_t WS_WGU_T = 80 * MiB;
constexpr size_t WS_XN = 208 * MiB;
constexpr size_t WS_Q = 241 * MiB;
constexpr size_t WS_K = 258 * MiB;
constexpr size_t WS_VT = 263 * MiB;
constexpr size_t WS_HC = 268 * MiB;
constexpr size_t WS_MIX = 285 * MiB;
constexpr size_t WS_XN2 = 317 * MiB;
constexpr size_t WS_ACT = 349 * MiB;
constexpr size_t WS_Y = 493 * MiB;
constexpr size_t WS_END = 637 * MiB;
constexpr int CW_CNT = 64;
constexpr int CW_BAR = 4096;

constexpr int RING_BYTES = 131072;
constexpr int LX_BAR = RING_BYTES;
constexpr int LX_TB = RING_BYTES + 64;
constexpr int LX_CNT = RING_BYTES + 256;
constexpr int LX_LCNT = RING_BYTES + 512;
constexpr int LX_GBASE = RING_BYTES + 768;
constexpr int LDS_BYTES = 147456;

constexpr int NWAVES = 8, NTHR = 512;

__device__ __forceinline__ unsigned f2bf(float f) { unsigned u = __builtin_bit_cast(unsigned, f); return (u + 0x7fffu + ((u >> 16) & 1u)) >> 16; }
__device__ __forceinline__ unsigned pk2(float lo, float hi) { return f2bf(lo) | (f2bf(hi) << 16); }
__device__ __forceinline__ float bf2f(unsigned b) { return __builtin_bit_cast(float, b << 16); }
__device__ __forceinline__ float bflo(unsigned w) { return __builtin_bit_cast(float, w << 16); }
__device__ __forceinline__ float bfhi(unsigned w) { return __builtin_bit_cast(float, w & 0xffff0000u); }
__device__ __forceinline__ float wave_sum(float v) {
#pragma unroll
    for (int o = 1; o < 64; o <<= 1) v += __shfl_xor(v, o);
    return v;
}
__device__ __forceinline__ float sigmoidf_fast(float x) { return __builtin_amdgcn_rcpf(1.0f + __builtin_amdgcn_exp2f(-x * LOG2E)); }
__device__ __forceinline__ int row_of(int b, int s) { return s < NMETA ? M_REAL + b * NMETA + s : b * SEQ + (s - NMETA); }

#define XB_TMO      128
#define XB_XCNT(j)  (256  + 64 * (j))
#define XB_XSUB(j)  (1280 + 64 * (j))
#define XB_XGEN(j)  (2304 + 64 * (j))
#define XB_TOP      3328
#define XB_TOPGEN   3392
#define XCD_BAR_WORDS 3456
#define XB_SPIN_CAP (1u << 18)
__device__ __forceinline__ unsigned xb_ld(unsigned* p)              { return __hip_atomic_load(p, __ATOMIC_RELAXED, __HIP_MEMORY_SCOPE_AGENT); }
__device__ __forceinline__ unsigned xb_add(unsigned* p, unsigned v) { return __hip_atomic_fetch_add(p, v, __ATOMIC_RELAXED, __HIP_MEMORY_SCOPE_AGENT); }
__device__ __forceinline__ unsigned xb_xcc_id() { return (unsigned)__builtin_amdgcn_s_getreg((3 << 11) | 20) & 0xFu; }
#define XB_SPIN(cond, bar) do { unsigned _sp = 0; while (cond) { __builtin_amdgcn_s_sleep(1); \
    if ((++_sp & 255u) == 0u) { if (xb_ld(&(bar)[XB_TMO])) break; if (_sp > XB_SPIN_CAP) { atomicAdd(&(bar)[XB_TMO], 1u); break; } } } } while (0)
struct XcdBarrier { unsigned* bar; unsigned x; volatile LAS unsigned* st; };
__device__ __forceinline__ XcdBarrier xcd_barrier_post(unsigned* bar, volatile LAS unsigned* st) {
    XcdBarrier b; b.bar = bar; b.x = xb_xcc_id(); b.st = st;
    if (threadIdx.x == 0) (void)xb_add(&bar[XB_XCNT(b.x)], 1u);
    return b;
}
__device__ __forceinline__ void xcd_barrier_complete(unsigned* bar, unsigned x, unsigned& nloc, unsigned& nx) {
    const unsigned G = gridDim.x * gridDim.y * gridDim.z;
    unsigned sum, cnt, mine, sp = 0u;
    for (;;) {
        sum = 0u; cnt = 0u; mine = 0u;
#pragma unroll
        for (unsigned j = 0; j < 16; ++j) { const unsigned c = xb_ld(&bar[XB_XCNT(j)]); sum += c; cnt += (c > 0u) ? 1u : 0u; mine = (j == x) ? c : mine; }
        if (sum == G) break;
        __builtin_amdgcn_s_sleep(1);
        if ((++sp & 255u) == 0u) { if (xb_ld(&bar[XB_TMO])) break; if (sp > XB_SPIN_CAP) { atomicAdd(&bar[XB_TMO], 1u); break; } }
    }
    nloc = mine > 0u ? mine : 1u; nx = cnt > 0u ? cnt : 1u;
}
__device__ __forceinline__ void xcd_barrier(const XcdBarrier& b) {
    asm volatile("s_waitcnt vmcnt(0)" ::: "memory");
    __syncthreads();
    if (threadIdx.x == 0) {
        unsigned* bar = b.bar;
        __builtin_amdgcn_s_waitcnt(0);
        unsigned nloc = b.st[0], nx = b.st[1];
        if (nloc == 0u) { xcd_barrier_complete(bar, b.x, nloc, nx); b.st[0] = nloc; b.st[1] = nx; }
        const unsigned old = xb_add(&bar[XB_XSUB(b.x)], 1u);
        const unsigned gen = old / nloc;
        if (old + 1u == (gen + 1u) * nloc) {
            __builtin_amdgcn_fence(__ATOMIC_RELEASE, "agent");
            asm volatile("s_waitcnt vmcnt(0)" ::: "memory");
            const unsigned og = xb_add(&bar[XB_TOP], 1u);
            const unsigned tg = og / nx;
            if (og + 1u == (tg + 1u) * nx) xb_add(&bar[XB_TOPGEN], 1u);
            else XB_SPIN(xb_ld(&bar[XB_TOPGEN]) == tg, bar);
            __builtin_amdgcn_fence(__ATOMIC_ACQUIRE, "agent");
            xb_add(&bar[XB_XGEN(b.x)], 1u);
            asm volatile("s_waitcnt vmcnt(0)" ::: "memory");
        } else {
            XB_SPIN(xb_ld(&bar[XB_XGEN(b.x)]) == gen, bar);
            __builtin_amdgcn_fence(__ATOMIC_ACQUIRE, "agent");
            asm volatile("s_waitcnt vmcnt(0)" ::: "memory");
        }
    }
    __syncthreads();
}

struct Args { const float* in[19]; float* out; unsigned char* ws; int ph_lo, ph_hi; };
struct Frame {
    LAS unsigned char* lds;
    int tid, lane, wave, G, bid;
    const float *x, *meta, *n1g, *w_in, *qg, *kg, *sink, *dw_w, *dw_b, *lng, *lnb, *w_out, *n2g, *wr, *rb, *wgu, *bgu, *wd, *bd;
    float* out;
    unsigned char* ws;
    gu32* ctl;
    bf16_t *WinT, *WoT, *WrT, *WdT, *WguT, *XN, *Qb, *Kb, *VT, *HC, *MIX, *XN2, *ACT, *Y;
    int* where; int* ltok; float* lgate; float* lrstd;
};

__device__ __forceinline__ int perm32(int rho) { const int n = rho >> 4, i = rho & 15; return 8 * (i >> 2) + 4 * n + (i & 3); }
__device__ __forceinline__ int lbase_nat(int pg) { return 32 * pg; }
__device__ __forceinline__ int lbase_in(int pg) { const int tile = pg >> 3, bj = (pg >> 2) & 1, wc = pg & 3; return tile <= 2 ? tile * 256 + 64 * wc + 32 * bj : 768 + bj * 512 + (tile - 3) * 128 + 32 * wc; }
__device__ __forceinline__ int lbase_gu(int pg) { const int tile = pg >> 3, bj = (pg >> 2) & 1, wc = pg & 3; return bj * 1024 + tile * 128 + 32 * wc; }
struct P0Item { const float* W; bf16_t* WT; const float* g; int N, pg, n0, k0; bool permute; };
__device__ __forceinline__ bool p0_decode(const Frame& F, int it, P0Item& I) {
    constexpr int I_IN = 16 * 56, I_O = 16 * 32, I_R = 16, I_GU = NE * 16 * 64, I_D = NE * 16 * 32;
    int r = it;
    if (r < I_IN) { const int pg = r % 56, kb = r / 56; I = P0Item{F.w_in, F.WinT, nullptr, IN_W, pg, lbase_in(pg), 64 * kb, true}; return true; } r -= I_IN;
    if (r < I_O) { const int pg = r % 32, kb = r / 32; I = P0Item{F.w_out, F.WoT, nullptr, D, pg, lbase_nat(pg), 64 * kb, true}; return true; } r -= I_O;
    if (r < I_R) { I = P0Item{F.wr, F.WrT, F.n2g, NE, 0, 0, 64 * r, false}; return true; } r -= I_R;
    if (r < I_GU) { const int e = r / (16 * 64), q = r % (16 * 64), pg = q % 64, kb = q / 64; I = P0Item{F.wgu + (size_t)e * D * 2048, F.WguT + (size_t)e * 2048 * D, F.n2g, 2048, pg, lbase_gu(pg), 64 * kb, true}; return true; } r -= I_GU;
    if (r < I_D) { const int e = r / (16 * 32), q = r % (16 * 32), pg = q % 32, kb = q / 32; I = P0Item{F.wd + (size_t)e * D * D, F.WdT + (size_t)e * D * D, nullptr, D, pg, lbase_nat(pg), 64 * kb, true}; return true; }
    return false;
}
__device__ __forceinline__ void p0_load(const P0Item& I, int lane, f32x4 (&v)[8]) {
    const float* p = I.W + (size_t)(I.k0 + (lane >> 3)) * I.N + I.n0 + 4 * (lane & 7);
#pragma unroll
    for (int i = 0; i < 8; ++i) v[i] = __builtin_nontemporal_load((const f32x4*)(p + (size_t)(8 * i) * I.N));
}
__device__ __forceinline__ void p0_store(const P0Item& I, int lane, LAS float* scr, const f32x4 (&v)[8]) {
    LAS float* w = scr + (lane >> 3) * 33 + 4 * (lane & 7);
#pragma unroll
    for (int i = 0; i < 8; ++i) { w[(8 * i) * 33 + 0] = v[i][0]; w[(8 * i) * 33 + 1] = v[i][1]; w[(8 * i) * 33 + 2] = v[i][2]; w[(8 * i) * 33 + 3] = v[i][3]; }
    asm volatile("s_waitcnt lgkmcnt(0)" ::: "memory");
    const int c = lane & 7;
    f32x4 g0 = {1.f, 1.f, 1.f, 1.f}, g1 = g0;
    if (I.g) { g0 = *(const f32x4*)(I.g + I.k0 + 8 * c); g1 = *(const f32x4*)(I.g + I.k0 + 8 * c + 4); }
#pragma unroll
    for (int j = 0; j < 4; ++j) { const int r = (lane >> 3) + 8 * j; const int sc = I.permute ? perm32(r) : r; const LAS float* s = scr + (8 * c) * 33 + sc;
        u32x4 o; o.x = pk2(s[0 * 33] * g0[0], s[1 * 33] * g0[1]); o.y = pk2(s[2 * 33] * g0[2], s[3 * 33] * g0[3]); o.z = pk2(s[4 * 33] * g1[0], s[5 * 33] * g1[1]); o.w = pk2(s[6 * 33] * g1[2], s[7 * 33] * g1[3]);
        *(GAS u32x4*)(I.WT + (size_t)(32 * I.pg + r) * D + I.k0 + 8 * c) = o; }
    asm volatile("s_waitcnt lgkmcnt(0)" ::: "memory");
}
__device__ __forceinline__ void p0_prologue(Frame& F) {
    LAS float* scr = (LAS float*)(F.lds + F.wave * 16384);
    const int gw = F.bid * NWAVES + F.wave, NGW = F.G * NWAVES, lane = F.lane;
    {
        P0Item cur, nxt; f32x4 va[8], vb[8];
        int it = gw; bool valid = p0_decode(F, it, cur);
        if (valid) p0_load(cur, lane, va);
        while (valid) {
            it += NGW; const bool vn = p0_decode(F, it, nxt);
            if (vn) p0_load(nxt, lane, vb);
            p0_store(cur, lane, scr, va);
            cur = nxt; valid = vn;
#pragma unroll
            for (int i = 0; i < 8; ++i) va[i] = vb[i];
        }
    }
    const GAS f32x4* gr = (const GAS f32x4*)F.n1g + lane;
    for (int m0 = 2 * gw; m0 < M_PAD; m0 += 2 * NGW) {
        f32x4 v[2][4]; float ss[2];
#pragma unroll
        for (int u = 0; u < 2; ++u) { const int m = m0 + u; ss[u] = 0.f;
            if (m < M_ALL) { const float* src = m < M_REAL ? F.x + (size_t)m * D : F.meta + (size_t)((m - M_REAL) & (NMETA - 1)) * D; const GAS f32x4* xr = (const GAS f32x4*)src + lane;
#pragma unroll
                for (int j = 0; j < 4; ++j) v[u][j] = xr[64 * j]; }
            else {
#pragma unroll
                for (int j = 0; j < 4; ++j) v[u][j] = (f32x4){0.f, 0.f, 0.f, 0.f}; } }
#pragma unroll
        for (int u = 0; u < 2; ++u) {
#pragma unroll
            for (int j = 0; j < 4; ++j) ss[u] += (v[u][j].x * v[u][j].x + v[u][j].y * v[u][j].y) + (v[u][j].z * v[u][j].z + v[u][j].w * v[u][j].w);
            const float rstd = 1.f / sqrtf(wave_sum(ss[u]) * (1.f / D) + 1e-6f);
            GAS unsigned long long* o8 = (GAS unsigned long long*)(F.XN + (size_t)(m0 + u) * D) + lane;
#pragma unroll
            for (int j = 0; j < 4; ++j) { const f32x4 g = gr[64 * j]; o8[64 * j] = (unsigned long long)pk2(v[u][j].x * rstd * g.x, v[u][j].y * rstd * g.y) | ((unsigned long long)pk2(v[u][j].z * rstd * g.z, v[u][j].w * rstd * g.w) << 32); }
        }
    }
}

namespace pg8 {
constexpr int BM = 256, BK = 64, HALF = 128, HTB = HALF * BK * 2, STAGE_BYTES = 8 * HTB, NXCD = 8, WGM = 8, KD = 1024;
__device__ __forceinline__ int lds_byte(int r, int c) { const int st = (r >> 4) * 2 + (c >> 5), rr = r & 15, cc = c & 31, ob = rr * 64 + cc * 2; return st * 1024 + (ob ^ (((ob >> 9) & 1) << 5)); }
__device__ __forceinline__ void stage_rc(int b, int& R, int& C) { const int st = b / 1024, sb = b % 1024, swz = sb ^ (((sb >> 9) & 1) << 5); R = (st >> 1) * 16 + swz / 64; C = (st & 1) * 32 + (swz % 64) / 2; }
struct Unit { int pm, pn, e, slot0, nvalid; };
__device__ __forceinline__ unsigned cvt_pk_bf16(float lo, float hi) { unsigned r; asm volatile("v_cvt_pk_bf16_f32 %0, %1, %2" : "=v"(r) : "v"(lo), "v"(hi)); return r; }
__device__ __forceinline__ u32x4 pack8(const f32x4 a, const f32x4 b) { u32x4 w; w.x = cvt_pk_bf16(a[0], a[1]); w.y = cvt_pk_bf16(a[2], a[3]); w.z = cvt_pk_bf16(b[0], b[1]); w.w = cvt_pk_bf16(b[2], b[3]); return w; }

__device__ __forceinline__ bool tile_order(int i, int G, int c, int nM, int nN, int& pm, int& pn) {
    const int nwg = nM * nN; const long L = (long)i * G + c; if (L >= nwg) return false;
    int wgid = (int)L; { const int q = nwg / NXCD, r = nwg % NXCD, xcd = wgid % NXCD, off = wgid / NXCD; wgid = (xcd < r ? xcd * (q + 1) : r * (q + 1) + (xcd - r) * q) + off; }
    const int nig = WGM * nN, gid = wgid / nig, fm = gid * WGM, gsz = (nM - fm) < WGM ? (nM - fm) : WGM;
    pm = fm + ((wgid % nig) % gsz); pn = (wgid % nig) / gsz; return true;
}
struct DenseProb {
    const bf16_t* A; const bf16_t* Bt; int nM, nN, G, c;
    __device__ __forceinline__ bool next(int i, Unit& u) const { u.e = 0; u.slot0 = 0; u.nvalid = 256; return tile_order(i, G, c, nM, nN, u.pm, u.pn); }
    __device__ __forceinline__ void addr(const Unit& u, const int (&R)[2], const int (&C)[2], const char*& a, const char*& b, unsigned (&va0)[2], unsigned (&va1)[2]) const {
        a = (const char*)A + (size_t)u.pm * (BM * KD * 2); b = (const char*)Bt + (size_t)u.pn * (BM * KD * 2);
#pragma unroll
        for (int i = 0; i < 2; ++i) { va0[i] = (unsigned)(R[i] * KD + C[i]) * 2u; va1[i] = va0[i] + (unsigned)(HALF * KD * 2); }
    }
};
template <bool GATHER> struct GroupedProb {
    const bf16_t* A; const bf16_t* Bt; const int* ltok; const LAS int* tb; const LAS int* cn; int nN, G, c;
    __device__ __forceinline__ bool next(int i, Unit& u) const {
        const int nM = tb[NE]; if (!tile_order(i, G, c, nM, nN, u.pm, u.pn)) return false;
        int e = 0;
#pragma unroll 1
        for (int j = 1; j < NE; ++j) if (tb[j] <= u.pm) e = j;
        u.e = e; u.slot0 = (u.pm - tb[e]) * 256; const int rem = cn[e] - u.slot0; u.nvalid = rem < 256 ? rem : 256; return true;
    }
    __device__ __forceinline__ void addr(const Unit& u, const int (&R)[2], const int (&C)[2], const char*& a, const char*& b, unsigned (&va0)[2], unsigned (&va1)[2]) const {
        b = (const char*)Bt + ((size_t)u.e * nN + u.pn) * (BM * KD * 2);
        if (GATHER) {
            a = (const char*)A; const int* lt = ltok + u.e * CAP + u.slot0;
#pragma unroll
            for (int i = 0; i < 2; ++i) { const int r0 = R[i], r1 = R[i] + HALF; const int t0 = r0 < u.nvalid ? lt[r0] : 0, t1 = r1 < u.nvalid ? lt[r1] : 0;
                va0[i] = (unsigned)(t0 * KD + C[i]) * 2u; va1[i] = (unsigned)(t1 * KD + C[i]) * 2u; }
        } else {
            a = (const char*)A + (size_t)u.pm * (BM * KD * 2);
#pragma unroll
            for (int i = 0; i < 2; ++i) { va0[i] = (unsigned)(R[i] * KD + C[i]) * 2u; va1[i] = va0[i] + (unsigned)(HALF * KD * 2); }
        }
    }
};

template <class Prob, class Epi>
__device__ __forceinline__ void gemm_phase(LAS unsigned char* lds, const Prob& P, const Epi& E) {
    const int tid = threadIdx.x, wid = __builtin_amdgcn_readfirstlane(tid >> 6), lane = tid & 63, wr = wid >> 2, wc = wid & 3, fr = lane & 15, fq = lane >> 4;
    constexpr int nt = KD / BK;
    int R[2], C[2]; unsigned voffB[2];
#pragma unroll
    for (int i = 0; i < 2; ++i) { stage_rc(tid * 16 + i * 8192, R[i], C[i]); voffB[i] = (unsigned)(R[i] * KD + C[i]) * 2u; }
    constexpr size_t kstep = (size_t)(BK * 2);
    constexpr size_t hstep = (size_t)HALF * KD * 2;
    const unsigned ldsw = (unsigned)wid * 1024u;
    const int aoff = lds_byte(wr * 64 + fr, fq * 8), boff = lds_byte(wc * 32 + fr, fq * 8);
#define PG8_SA(b, h) (((b) * 2 + (h)) * HTB)
#define PG8_SB(b, h) ((4 + (b) * 2 + (h)) * HTB)
#define PG8_STAGE(bufoff, gbase, voff) do { _Pragma("unroll") for (int _i = 0; _i < 2; ++_i) \
        __builtin_amdgcn_global_load_lds((const unsigned*)((const char*)(gbase) + (voff)[_i]), (LAS unsigned*)(lds + (bufoff) + ldsw + _i * 8192), 16, 0, 0); } while (0)
#define PG8_LDA(dst, b, h) do { _Pragma("unroll") for (int m = 0; m < 4; ++m) _Pragma("unroll") for (int k = 0; k < 2; ++k) dst[m][k] = *(const LAS bf16x8*)(lds + PG8_SA(b, h) + aoff + m * 2048 + k * 1024); } while (0)
#define PG8_LDB(dst, b, h) do { _Pragma("unroll") for (int n = 0; n < 2; ++n) _Pragma("unroll") for (int k = 0; k < 2; ++k) dst[n][k] = *(const LAS bf16x8*)(lds + PG8_SB(b, h) + boff + n * 2048 + k * 1024); } while (0)
#define PG8_MMA(ai, bj, At, Bt) do { __builtin_amdgcn_s_setprio(1); _Pragma("unroll") for (int m = 0; m < 4; ++m) _Pragma("unroll") for (int n = 0; n < 2; ++n) _Pragma("unroll") for (int k = 0; k < 2; ++k) \
        acc[ai][bj][m][n] = __builtin_amdgcn_mfma_f32_16x16x32_bf16(Bt[n][k], At[m][k], acc[ai][bj][m][n], 0, 0, 0); __builtin_amdgcn_s_setprio(0); } while (0)
#define PG8_WAIT_V(n) asm volatile("s_waitcnt vmcnt(" #n ")" ::: "memory")
#define PG8_WAIT_L(n) asm volatile("s_waitcnt lgkmcnt(" #n ")" ::: "memory")
#define PG8_BAR __builtin_amdgcn_s_barrier()
#define PG8_SCHED __builtin_amdgcn_sched_barrier(0)
    Unit cur, nxt; int ui = 0;
    if (!P.next(0, cur)) return;
    bool has_next = P.next(1, nxt);
    const char *cA, *cB, *nA, *nB; unsigned va0[2], va1[2], nva0[2], nva1[2];
    P.addr(cur, R, C, cA, cB, va0, va1);
    if (has_next) P.addr(nxt, R, C, nA, nB, nva0, nva1);
    else { nA = cA; nB = cB; nva0[0] = va0[0]; nva0[1] = va0[1]; nva1[0] = va1[0]; nva1[1] = va1[1]; }
    f32x4 acc[2][2][4][2];
#pragma unroll
    for (int a = 0; a < 2; ++a)
#pragma unroll
        for (int b = 0; b < 2; ++b)
#pragma unroll
            for (int m = 0; m < 4; ++m)
#pragma unroll
                for (int n = 0; n < 2; ++n) acc[a][b][m][n] = (f32x4){0.f, 0.f, 0.f, 0.f};
    bf16x8 At[4][2], B0[2][2], B1[2][2];
    PG8_STAGE(PG8_SB(0, 0), cB, voffB); PG8_STAGE(PG8_SB(0, 1), cB + hstep, voffB); PG8_STAGE(PG8_SA(0, 0), cA, va0); PG8_STAGE(PG8_SA(0, 1), cA, va1);
    if (wr == 1) PG8_BAR;
    PG8_WAIT_V(2); PG8_BAR;
    PG8_STAGE(PG8_SB(1, 0), cB + kstep, voffB); PG8_STAGE(PG8_SA(1, 0), cA + kstep, va0); PG8_STAGE(PG8_SB(1, 1), cB + hstep + kstep, voffB);
    PG8_WAIT_V(6); PG8_BAR;
    for (;;) {
        for (int t = 0; t < nt; t += 2) {
            const bool last = (t == nt - 2);
            const char* a1 = cA + (size_t)(t + 1) * kstep;
            const char* a2 = last ? nA : cA + (size_t)(t + 2) * kstep; const char* b2 = last ? nB : cB + (size_t)(t + 2) * kstep;
            const char* a3 = a2 + kstep; const char* b3 = b2 + kstep;
            unsigned v2a0[2], v2a1[2];
            v2a0[0] = last ? nva0[0] : va0[0]; v2a0[1] = last ? nva0[1] : va0[1]; v2a1[0] = last ? nva1[0] : va1[0]; v2a1[1] = last ? nva1[1] : va1[1];
            PG8_LDB(B0, 0, 0); PG8_LDB(B1, 0, 1); PG8_SCHED; PG8_LDA(At, 0, 0); PG8_STAGE(PG8_SA(1, 1), a1, va1);
            PG8_WAIT_V(8); PG8_WAIT_L(0); PG8_BAR; PG8_MMA(0, 0, At, B0); PG8_MMA(0, 1, At, B1); PG8_BAR; PG8_SCHED;
            PG8_LDA(At, 0, 1); PG8_STAGE(PG8_SB(0, 0), b2, voffB); PG8_STAGE(PG8_SB(0, 1), b2 + hstep, voffB); PG8_STAGE(PG8_SA(0, 0), a2, v2a0);
            PG8_WAIT_V(8); PG8_WAIT_L(0); PG8_BAR; PG8_MMA(1, 0, At, B0); PG8_MMA(1, 1, At, B1); PG8_BAR; PG8_SCHED;
            PG8_LDB(B0, 1, 0); PG8_LDB(B1, 1, 1); PG8_SCHED; PG8_LDA(At, 1, 0); PG8_STAGE(PG8_SA(0, 1), a2, v2a1);
            PG8_WAIT_V(8); PG8_WAIT_L(0); PG8_BAR; PG8_MMA(0, 0, At, B0); PG8_MMA(0, 1, At, B1); PG8_BAR; PG8_SCHED;
            PG8_LDA(At, 1, 1); PG8_STAGE(PG8_SB(1, 0), b3, voffB); PG8_STAGE(PG8_SB(1, 1), b3 + hstep, voffB); PG8_STAGE(PG8_SA(1, 0), a3, v2a0);
            PG8_WAIT_V(8); PG8_WAIT_L(0); PG8_BAR; PG8_MMA(1, 0, At, B0); PG8_MMA(1, 1, At, B1); PG8_BAR; PG8_SCHED;
        }
        if (wr == 0) PG8_BAR;
        E(acc, cur, wr, wc, fr, fq);
        if (!has_next) break;
#pragma unroll
        for (int a = 0; a < 2; ++a)
#pragma unroll
            for (int b = 0; b < 2; ++b)
#pragma unroll
                for (int m = 0; m < 4; ++m)
#pragma unroll
                    for (int n = 0; n < 2; ++n) acc[a][b][m][n] = (f32x4){0.f, 0.f, 0.f, 0.f};
        cur = nxt; cA = nA; cB = nB; va0[0] = nva0[0]; va0[1] = nva0[1]; va1[0] = nva1[0]; va1[1] = nva1[1]; ++ui;
        has_next = P.next(ui + 1, nxt);
        if (has_next) P.addr(nxt, R, C, nA, nB, nva0, nva1);
        if (wr == 1) PG8_BAR;
    }
    PG8_WAIT_V(0);
    PG8_BAR;
#undef PG8_SA
#undef PG8_SB
#undef PG8_STAGE
#undef PG8_LDA
#undef PG8_LDB
#undef PG8_MMA
#undef PG8_WAIT_V
#undef PG8_WAIT_L
#undef PG8_BAR
#undef PG8_SCHED
}

struct EpiOut {
    const float* x; float* out; bf16_t* xn2;
    __device__ __forceinline__ void operator()(const f32x4 (&acc)[2][2][4][2], const Unit& u, int wr, int wc, int fr, int fq) const {
        const int row0 = u.pm * BM + wr * 64 + fr, col0 = u.pn * BM + wc * 32 + 8 * fq;
#pragma unroll
        for (int ai = 0; ai < 2; ++ai)
#pragma unroll
            for (int m = 0; m < 4; ++m) { const size_t off = (size_t)(row0 + ai * HALF + m * 16) * D + col0;
#pragma unroll
                for (int bj = 0; bj < 2; ++bj) { const float* xp = x + off + bj * HALF;
                    const f32x4 h0 = acc[ai][bj][m][0] + *(const f32x4*)xp, h1 = acc[ai][bj][m][1] + *(const f32x4*)(xp + 4);
                    *(f32x4*)(out + off + bj * HALF) = h0; *(f32x4*)(out + off + bj * HALF + 4) = h1;
                    *(u32x4*)(xn2 + off + bj * HALF) = pack8(h0, h1); }
                asm volatile("" ::: "memory"); }
    }
};
struct EpiIn {
    bf16_t *Qb, *Kb, *VT, *HC; const float *qg, *kg;
    __device__ __forceinline__ void operator()(const f32x4 (&acc)[2][2][4][2], const Unit& u, int wr, int wc, int fr, int fq) const {
        const int rowb = u.pm * BM + wr * 64 + fr;
        if (u.pn <= 2) {
            const bool isv = (u.pn == 2) && (wc >= 2);
            if (!isv) {
                const bool isq = u.pn < 2; const float* g = isq ? qg : kg; const float sc = isq ? QSCALE : 1.f;
                f32x4 gv[2][2];
#pragma unroll
                for (int bj = 0; bj < 2; ++bj)
#pragma unroll
                    for (int n = 0; n < 2; ++n) gv[bj][n] = *(const f32x4*)(g + 32 * bj + 8 * fq + 4 * n) * sc;
                bf16_t* dst = isq ? Qb + (u.pn * 256 + 64 * wc) : Kb + 64 * wc; const int ld = isq ? 512 : 128;
#pragma unroll
                for (int ai = 0; ai < 2; ++ai)
#pragma unroll
                    for (int m = 0; m < 4; ++m) { const int row = rowb + ai * HALF + m * 16; float ss = 0.f;
#pragma unroll
                        for (int bj = 0; bj < 2; ++bj)
#pragma unroll
                            for (int n = 0; n < 2; ++n) { const f32x4 v = acc[ai][bj][m][n]; ss += (v[0] * v[0] + v[1] * v[1]) + (v[2] * v[2] + v[3] * v[3]); }
                        ss += __shfl_xor(ss, 16); ss += __shfl_xor(ss, 32);
                        const float r = __builtin_amdgcn_rsqf(ss * (1.f / 64.f) + 1e-6f);
#pragma unroll
                        for (int bj = 0; bj < 2; ++bj) *(u32x4*)(dst + (size_t)row * ld + 32 * bj + 8 * fq) = pack8(acc[ai][bj][m][0] * r * gv[bj][0], acc[ai][bj][m][1] * r * gv[bj][1]); }
            } else {
                const int hk = wc - 2;
#pragma unroll
                for (int ai = 0; ai < 2; ++ai)
#pragma unroll
                    for (int m = 0; m < 4; ++m) { const int row = rowb + ai * HALF + m * 16;
                        if (row < M_ALL) { int b, kx; if (row < M_REAL) { b = row >> 11; kx = NMETA + (row & 2047); } else { b = (row - M_REAL) >> 4; kx = (row - M_REAL) & 15; }
                            bf16_t* base = VT + (size_t)(b * 2 + hk) * 64 * VT_PITCH + kx;
#pragma unroll
                            for (int bj = 0; bj < 2; ++bj)
#pragma unroll
                                for (int n = 0; n < 2; ++n)
#pragma unroll
                                    for (int e = 0; e < 4; ++e) base[(size_t)(32 * bj + 8 * fq + 4 * n + e) * VT_PITCH] = (bf16_t)f2bf(acc[ai][bj][m][n][e]); } }
            }
        } else {
            const int col = (u.pn - 3) * 128 + 32 * wc + 8 * fq;
#pragma unroll
            for (int ai = 0; ai < 2; ++ai)
#pragma unroll
                for (int m = 0; m < 4; ++m) { const int row = rowb + ai * HALF + m * 16; f32x4 h[2];
#pragma unroll
                    for (int n = 0; n < 2; ++n)
#pragma unroll
                        for (int e = 0; e < 4; ++e) h[n][e] = acc[ai][0][m][n][e] * sigmoidf_fast(acc[ai][1][m][n][e]);
                    *(u32x4*)(HC + (size_t)row * 512 + col) = pack8(h[0], h[1]); }
        }
    }
};
struct EpiGU {
    bf16_t* ACT; const float* lrstd; const float* bgu;
    __device__ __forceinline__ void operator()(const f32x4 (&acc)[2][2][4][2], const Unit& u, int wr, int wc, int fr, int fq) const {
        const int lr0 = wr * 64 + fr, col = u.pn * 128 + 32 * wc + 8 * fq;
        f32x4 bg[2], bu[2];
#pragma unroll
        for (int n = 0; n < 2; ++n) { bg[n] = *(const f32x4*)(bgu + u.e * 2048 + col + 4 * n); bu[n] = *(const f32x4*)(bgu + u.e * 2048 + 1024 + col + 4 * n); }
        const float* rs = lrstd + u.e * CAP + u.slot0;
#pragma unroll
        for (int ai = 0; ai < 2; ++ai)
#pragma unroll
            for (int m = 0; m < 4; ++m) { const int lr = lr0 + ai * HALF + m * 16; const float rstd = lr < u.nvalid ? rs[lr] : 0.f; f32x4 h[2];
#pragma unroll
                for (int n = 0; n < 2; ++n)
#pragma unroll
                    for (int e = 0; e < 4; ++e) { float gt = acc[ai][0][m][n][e] * rstd + bg[n][e], up = acc[ai][1][m][n][e] * rstd + bu[n][e];
                        gt = fminf(gt, 7.f); up = fminf(fmaxf(up, -7.f), 7.f); h[n][e] = gt * sigmoidf_fast(1.702f * gt) * (up + 1.f); }
                *(u32x4*)(ACT + (size_t)(u.pm * BM + lr) * D + col) = pack8(h[0], h[1]); }
    }
};
struct EpiDown {
    bf16_t* Y; const float* lgate; const float* bd;
    __device__ __forceinline__ void operator()(const f32x4 (&acc)[2][2][4][2], const Unit& u, int wr, int wc, int fr, int fq) const {
        const int lr0 = wr * 64 + fr, col0 = u.pn * BM + wc * 32 + 8 * fq;
        f32x4 bv[2][2];
#pragma unroll
        for (int bj = 0; bj < 2; ++bj)
#pragma unroll
            for (int n = 0; n < 2; ++n) bv[bj][n] = *(const f32x4*)(bd + u.e * D + col0 + bj * HALF + 4 * n);
        const float* gs = lgate + u.e * CAP + u.slot0;
#pragma unroll
        for (int ai = 0; ai < 2; ++ai)
#pragma unroll
            for (int m = 0; m < 4; ++m) { const int lr = lr0 + ai * HALF + m * 16; const float gt = lr < u.nvalid ? gs[lr] : 0.f;
#pragma unroll
                for (int bj = 0; bj < 2; ++bj) *(u32x4*)(Y + (size_t)(u.pm * BM + lr) * D + col0 + bj * HALF) = pack8((acc[ai][bj][m][0] + bv[bj][0]) * gt, (acc[ai][bj][m][1] + bv[bj][1]) * gt); }
    }
};
}


constexpr int ATT_KIMG = 0, ATT_VIMG = 53248, ATT_VP = 840;
constexpr float ATT_THR = 4.0f;
template <int MODE>
__device__ __forceinline__ void att_tile(const LAS unsigned char* kbase, const int (&koff)[4], const LAS unsigned char* vbase, const bf16x8 (&qf)[4], float slope2, float Bq,
                                         float& m, float& l, f32x16& O0, f32x16& O1) {
    f32x16 s;
#pragma unroll
    for (int r = 0; r < 16; ++r) s[r] = 0.f;
#pragma unroll
    for (int ks = 0; ks < 4; ++ks) { const bf16x8 kf = *(const LAS bf16x8*)(kbase + koff[ks]); s = __builtin_amdgcn_mfma_f32_32x32x16_bf16(kf, qf[ks], s, 0, 0, 0); }
    float tmax = -INFINITY;
#pragma unroll
    for (int r = 0; r < 16; ++r) {
        if (MODE == 0) { if (r >= 8) s[r] = -INFINITY; }
        else { const float dl = fabsf(Bq - (float)((r & 3) + 8 * (r >> 2))); float v = s[r] - slope2 * dl; if (MODE == 2) v = dl <= 128.f ? v : -INFINITY; s[r] = v; }
        tmax = fmaxf(tmax, s[r]);
    }
    tmax = fmaxf(tmax, __shfl_xor(tmax, 32));
    if (__any(tmax > m + ATT_THR)) { const float mn = fmaxf(m, tmax); const float al = __builtin_amdgcn_exp2f(m - mn); m = mn; l *= al;
#pragma unroll
        for (int r = 0; r < 16; ++r) { O0[r] *= al; O1[r] *= al; } }
    float ps = 0.f;
#pragma unroll
    for (int r = 0; r < 16; ++r) { s[r] = __builtin_amdgcn_exp2f(s[r] - m); ps += s[r]; }
    l += ps;
#pragma unroll
    for (int s2 = 0; s2 < 2; ++s2) {
        u32x4 pw; pw.x = pg8::cvt_pk_bf16(s[8 * s2 + 0], s[8 * s2 + 1]); pw.y = pg8::cvt_pk_bf16(s[8 * s2 + 2], s[8 * s2 + 3]); pw.z = pg8::cvt_pk_bf16(s[8 * s2 + 4], s[8 * s2 + 5]); pw.w = pg8::cvt_pk_bf16(s[8 * s2 + 6], s[8 * s2 + 7]);
        const bf16x8 pf = __builtin_bit_cast(bf16x8, pw);
        { const u32x2 lo = *(const LAS u32x2*)(vbase + s2 * 32), hi = *(const LAS u32x2*)(vbase + s2 * 32 + 16); const u32x4 vw = {lo.x, lo.y, hi.x, hi.y};
          O0 = __builtin_amdgcn_mfma_f32_32x32x16_bf16(__builtin_bit_cast(bf16x8, vw), pf, O0, 0, 0, 0); }
        { const u32x2 lo = *(const LAS u32x2*)(vbase + 32 * ATT_VP + s2 * 32), hi = *(const LAS u32x2*)(vbase + 32 * ATT_VP + s2 * 32 + 16); const u32x4 vw = {lo.x, lo.y, hi.x, hi.y};
          O1 = __builtin_amdgcn_mfma_f32_32x32x16_bf16(__builtin_bit_cast(bf16x8, vw), pf, O1, 0, 0, 0); }
    }
}
__device__ __forceinline__ void att_fast(Frame& F) {
    LAS unsigned char* Kimg = F.lds + ATT_KIMG; LAS unsigned char* Vimg = F.lds + ATT_VIMG;
    const int tid = F.tid, lane = F.lane, wid = F.wave, q = lane & 31, h = lane >> 5, qt = wid & 3, hsel = wid >> 2;
    int koff[4];
#pragma unroll
    for (int ks = 0; ks < 4; ++ks) koff[ks] = ((2 * ks + h) ^ ((q >> 1) & 7)) << 4;
    for (int item = F.bid; item < NB * 16 * 2; item += F.G) {
        const int hk = item & 1, i = (item >> 1) & 15, b = item >> 5;
        __syncthreads();
        for (int idx = tid; idx < 416 * 8; idx += NTHR) { const int kr = idx >> 3, c = idx & 7; if (kr >= 16 && kr < 32) continue;
            int row; if (kr < 16) row = M_REAL + b * NMETA + kr; else { const int pos = (i - 1) * 128 + kr - 32; if (pos < 0 || pos >= SEQ) continue; row = b * SEQ + pos; }
            const u32x4 v = *(const GAS u32x4*)(F.Kb + (size_t)row * 128 + hk * 64 + 8 * c);
            *(LAS u32x4*)(Kimg + kr * 128 + ((c ^ ((kr >> 1) & 7)) << 4)) = v; }
        for (int idx = tid; idx < 64 * 52; idx += NTHR) { const int d = idx / 52, c = idx % 52; const bf16_t* vrow = F.VT + (size_t)((b * 2 + hk) * 64 + d) * VT_PITCH;
            LAS u32x2* dst; const bf16_t* src;
            if (c < 2) { src = vrow + 8 * c; dst = (LAS u32x2*)(Vimg + d * ATT_VP + 16 * c); }
            else if (c < 4) { dst = (LAS u32x2*)(Vimg + d * ATT_VP + 32 + 16 * (c - 2)); dst[0] = (u32x2){0u, 0u}; dst[1] = (u32x2){0u, 0u}; continue; }
            else { const int cc = c - 4, blk = cc >> 4, w = cc & 15, pos0 = (i - 1 + blk) * 128; if (pos0 < 0 || pos0 >= SEQ) continue; src = vrow + NMETA + pos0 + 8 * w; dst = (LAS u32x2*)(Vimg + d * ATT_VP + (32 + blk * 128 + 8 * w) * 2); }
            const u32x4 v = *(const GAS u32x4*)src; dst[0] = (u32x2){v.x, v.y}; dst[1] = (u32x2){v.z, v.w}; }
        __syncthreads();
#pragma unroll 1
        for (int hp = 0; hp < 2; ++hp) {
            const int head = hk * 4 + hp * 2 + hsel, row = b * SEQ + i * 128 + 32 * qt + q;
            bf16x8 qf[4];
#pragma unroll
            for (int ks = 0; ks < 4; ++ks) qf[ks] = *(const GAS bf16x8*)(F.Qb + (size_t)row * 512 + head * 64 + 16 * ks + 8 * h);
            const float slope2 = exp2f(-(float)(head + 1)) * LOG2E;
            float m = F.sink[head] * LOG2E, l = h == 0 ? 1.f : 0.f;
            f32x16 O0, O1;
#pragma unroll
            for (int r = 0; r < 16; ++r) { O0[r] = 0.f; O1[r] = 0.f; }
            const LAS unsigned char* kb0 = Kimg + q * 128; const LAS unsigned char* vb0 = Vimg + q * ATT_VP + 8 * h;
            att_tile<0>(kb0, koff, vb0, qf, 0.f, 0.f, m, l, O0, O1);
#pragma unroll 1
            for (int kt = qt; kt <= qt + 8; ++kt) { const int blk = kt >> 2; if ((i == 0 && blk == 0) || (i == 15 && blk == 2)) continue;
                const int kr0 = 32 + 32 * kt; const float Bq = (float)(128 + 32 * (qt - kt) + q - 4 * h);
                if (kt == qt || kt == qt + 8) att_tile<2>(kb0 + kr0 * 128, koff, vb0 + kr0 * 2, qf, slope2, Bq, m, l, O0, O1);
                else att_tile<1>(kb0 + kr0 * 128, koff, vb0 + kr0 * 2, qf, slope2, Bq, m, l, O0, O1); }
            l += __shfl_xor(l, 32); const float inv = 1.f / l;
            bf16_t* orow = F.MIX + (size_t)row * D + head * 64 + 4 * h;
#pragma unroll
            for (int g = 0; g < 4; ++g) { *(GAS u32x2*)(orow + 8 * g) = (u32x2){pg8::cvt_pk_bf16(O0[4 * g] * inv, O0[4 * g + 1] * inv), pg8::cvt_pk_bf16(O0[4 * g + 2] * inv, O0[4 * g + 3] * inv)};
                *(GAS u32x2*)(orow + 32 + 8 * g) = (u32x2){pg8::cvt_pk_bf16(O1[4 * g] * inv, O1[4 * g + 1] * inv), pg8::cvt_pk_bf16(O1[4 * g + 2] * inv, O1[4 * g + 3] * inv)}; }
        }
    }
    __syncthreads();
}
__device__ __forceinline__ void conv_fast(Frame& F) {
    const int tid = F.tid, lane = F.lane, wid = F.wave, c2 = tid & 255, th = tid >> 8;
    LAS float* cout = (LAS float*)F.lds;
    float w0[CONV_K], w1[CONV_K];
#pragma unroll
    for (int j = 0; j < CONV_K; ++j) { const f32x2 w = *(const f32x2*)(F.dw_w + j * CONV_W + 2 * c2); w0[j] = w.x; w1[j] = w.y; }
    const f32x2 bias = *(const f32x2*)(F.dw_b + 2 * c2);
    for (int item = F.bid; item < NB * 64; item += F.G) {
        const int b = item >> 6, t0 = (item & 63) * 32;
        unsigned xin[46];
        const int s0 = NMETA + t0 + 16 * th - 15;
#pragma unroll
        for (int jj = 0; jj < 46; ++jj) { const int sq = s0 + jj; xin[jj] = sq < LSEQ ? *(const GAS unsigned*)(F.HC + (size_t)row_of(b, sq) * 512 + 2 * c2) : 0u; }
        __syncthreads();
#pragma unroll
        for (int t = 0; t < 16; ++t) { float a0 = bias.x, a1 = bias.y;
#pragma unroll
            for (int j = 0; j < CONV_K; ++j) { a0 += w0[j] * bflo(xin[t + j]); a1 += w1[j] * bfhi(xin[t + j]); }
            *(LAS f32x2*)(cout + (16 * th + t) * 512 + 2 * c2) = (f32x2){a0, a1}; }
        __syncthreads();
#pragma unroll 1
        for (int tt = 0; tt < 4; ++tt) { const int t = 4 * wid + tt; const LAS f32x4* rp = (const LAS f32x4*)(cout + t * 512 + 8 * lane); const f32x4 x0 = rp[0], x1 = rp[1];
            const float mu = wave_sum((x0[0] + x0[1]) + (x0[2] + x0[3]) + (x1[0] + x1[1]) + (x1[2] + x1[3])) * (1.f / 512.f);
            const f32x4 d0 = x0 - mu, d1 = x1 - mu;
            const float var = wave_sum((d0[0] * d0[0] + d0[1] * d0[1]) + (d0[2] * d0[2] + d0[3] * d0[3]) + (d1[0] * d1[0] + d1[1] * d1[1]) + (d1[2] * d1[2] + d1[3] * d1[3])) * (1.f / 512.f);
            const float rstd = __builtin_amdgcn_rsqf(var + 1e-5f);
            const f32x4 g0 = *(const f32x4*)(F.lng + 8 * lane), g1 = *(const f32x4*)(F.lng + 8 * lane + 4), b0 = *(const f32x4*)(F.lnb + 8 * lane), b1 = *(const f32x4*)(F.lnb + 8 * lane + 4);
            f32x4 y0 = d0 * rstd * g0 + b0, y1 = d1 * rstd * g1 + b1;
#pragma unroll
            for (int e = 0; e < 4; ++e) { y0[e] *= sigmoidf_fast(y0[e]); y1[e] *= sigmoidf_fast(y1[e]); }
            *(GAS u32x4*)(F.MIX + (size_t)(b * SEQ + t0 + t) * D + 512 + 8 * lane) = pg8::pack8(y0, y1); }
    }
    __syncthreads();
}
__device__ __forceinline__ void p4_fast(Frame& F) {
    LAS int* lcnt = (LAS int*)(F.lds + LX_LCNT); LAS int* gbase = (LAS int*)(F.lds + LX_GBASE);
    const int tid = F.tid, lane = F.lane, wid = F.wave, j = lane & 31, h = lane >> 5;
    for (int base = 0; base < M_REAL / 32; base += F.G * NWAVES) {
        const int tile = base + F.bid + F.G * wid; const bool active = tile < M_REAL / 32;
        if (tid < NE) lcnt[tid] = 0;
        __syncthreads();
        int ea = 0, eb = 0, sa = 0, sb = 0, tok = 0; float ga = 0.f, gb = 0.f, rstd = 0.f;
        if (active) {
            tok = tile * 32 + j;
            const bf16_t* xa = F.XN2 + (size_t)tok * D + 8 * h; const bf16_t* wa = F.WrT + (size_t)j * D + 8 * h;
            f32x16 acc;
#pragma unroll
            for (int r = 0; r < 16; ++r) acc[r] = 0.f;
            float ssq = 0.f;
#pragma unroll 8
            for (int ks = 0; ks < 64; ++ks) { const u32x4 xb = *(const GAS u32x4*)(xa + 16 * ks); const bf16x8 wf = *(const GAS bf16x8*)(wa + 16 * ks);
                acc = __builtin_amdgcn_mfma_f32_32x32x16_bf16(wf, __builtin_bit_cast(bf16x8, xb), acc, 0, 0, 0);
                ssq += (bflo(xb.x) * bflo(xb.x) + bfhi(xb.x) * bfhi(xb.x)) + (bflo(xb.y) * bflo(xb.y) + bfhi(xb.y) * bfhi(xb.y)) + (bflo(xb.z) * bflo(xb.z) + bfhi(xb.z) * bfhi(xb.z)) + (bflo(xb.w) * bflo(xb.w) + bfhi(xb.w) * bfhi(xb.w)); }
            ssq += __shfl_xor(ssq, 32);
            rstd = 1.f / sqrtf(ssq * (1.f / D) + 1e-6f);
            float lg[16];
#pragma unroll
            for (int r = 0; r < 16; ++r) lg[r] = acc[r] * rstd + F.rb[(r & 3) + 8 * (r >> 2) + 4 * h];
            float tv[4]; int te[4];
#pragma unroll
            for (int kk = 0; kk < 4; ++kk) { float bv = -INFINITY; int be = 0;
#pragma unroll
                for (int r = 0; r < 16; ++r) { const int er = (r & 3) + 8 * (r >> 2) + 4 * h; if (lg[r] > bv) { bv = lg[r]; be = er; } }
                const float pv = __shfl_xor(bv, 32); const int pe = __shfl_xor(be, 32);
                if (pv > bv || (pv == bv && pe < be)) { bv = pv; be = pe; }
#pragma unroll
                for (int r = 0; r < 16; ++r) { const int er = (r & 3) + 8 * (r >> 2) + 4 * h; if (er == be) lg[r] = -INFINITY; }
                tv[kk] = bv; te[kk] = be; }
            const float p1 = __expf(tv[1] - tv[0]), p2 = __expf(tv[2] - tv[0]), p3 = __expf(tv[3] - tv[0]); const float inv = 1.f / (1.f + p1 + p2 + p3);
            ea = h ? te[2] : te[0]; eb = h ? te[3] : te[1]; ga = (h ? p2 : 1.f) * inv; gb = (h ? p3 : p1) * inv;
            sa = __hip_atomic_fetch_add(lcnt + ea, 1, __ATOMIC_RELAXED, __HIP_MEMORY_SCOPE_WORKGROUP); sb = __hip_atomic_fetch_add(lcnt + eb, 1, __ATOMIC_RELAXED, __HIP_MEMORY_SCOPE_WORKGROUP);
        }
        __syncthreads();
        if (tid < NE) gbase[tid] = (int)__hip_atomic_fetch_add((unsigned*)(F.ctl + CW_CNT + tid), (unsigned)lcnt[tid], RLX_AGENT);
        __syncthreads();
        if (active) {
            sa += gbase[ea]; sb += gbase[eb];
            F.ltok[ea * CAP + sa] = tok; F.lgate[ea * CAP + sa] = ga; F.lrstd[ea * CAP + sa] = rstd; F.where[tok * 4 + 2 * h] = ea * CAP + sa;
            F.ltok[eb * CAP + sb] = tok; F.lgate[eb * CAP + sb] = gb; F.lrstd[eb * CAP + sb] = rstd; F.where[tok * 4 + 2 * h + 1] = eb * CAP + sb;
        }
        __syncthreads();
    }
}

__device__ __forceinline__ void p1_naive(Frame& F) {
    const int gw = F.bid * NWAVES + F.wave, NGW = F.G * NWAVES, lane = F.lane;
    for (int it = gw; it < M_ALL * 20; it += NGW) {
        const int row = it / 20, grp = it % 20;
        const bf16_t* xr = F.XN + (size_t)row * D;
        if (grp < 12) {
            const int col = grp * 64 + lane; float acc = 0.f;
            _Pragma("unroll 4") for (int k = 0; k < D; ++k) acc += bf2f(xr[k]) * F.w_in[(size_t)k * IN_W + col];
            if (grp < 10) {
                const float ssq = wave_sum(acc * acc); const float r = 1.f / sqrtf(ssq * (1.f / 64.f) + 1e-6f);
                if (grp < 8) F.Qb[(size_t)row * 512 + col] = (bf16_t)f2bf(acc * r * F.qg[lane] * QSCALE);
                else F.Kb[(size_t)row * 128 + (col - 512)] = (bf16_t)f2bf(acc * r * F.kg[lane]);
            } else {
                const int hk = grp - 10; int b, kx;
                if (row < M_REAL) { b = row >> 11; kx = NMETA + (row & 2047); } else { b = (row - M_REAL) >> 4; kx = (row - M_REAL) & 15; }
                F.VT[((size_t)(b * 2 + hk) * 64 + lane) * VT_PITCH + kx] = (bf16_t)f2bf(acc);
            }
        } else {
            const int c = (grp - 12) * 64 + lane; float a = 0.f, g = 0.f;
            for (int k = 0; k < D; ++k) { const float xv = bf2f(xr[k]); a += xv * F.w_in[(size_t)k * IN_W + 768 + c]; g += xv * F.w_in[(size_t)k * IN_W + 1280 + c]; }
            F.HC[(size_t)row * 512 + c] = (bf16_t)f2bf(a * sigmoidf_fast(g));
        }
    }
}
__device__ __forceinline__ void att_naive(Frame& F) {
    const int gw = F.bid * NWAVES + F.wave, NGW = F.G * NWAVES, lane = F.lane;
    for (int it = gw; it < M_REAL * NQH; it += NGW) {
        const int row = it >> 3, h = it & 7, hk = h >> 2, b = row >> 11, qp = row & 2047;
        const float q = bf2f(F.Qb[(size_t)row * 512 + h * 64 + lane]);
        const float slope2 = exp2f(-(float)(h + 1)) * LOG2E;
        float m = F.sink[h] * LOG2E, l = 1.f, acc = 0.f;
        const bf16_t* vt = F.VT + ((size_t)(b * 2 + hk) * 64 + lane) * VT_PITCH;
        for (int j = 0; j < NMETA; ++j) {
            const float kv = bf2f(F.Kb[(size_t)(M_REAL + b * NMETA + j) * 128 + hk * 64 + lane]);
            const float s = wave_sum(q * kv);
            const float mn = fmaxf(m, s), al = exp2f(m - mn), p = exp2f(s - mn);
            l = l * al + p; acc = acc * al + p * bf2f(vt[j]); m = mn;
        }
        const int k0 = qp - 128 < 0 ? 0 : qp - 128, k1 = qp + 128 > SEQ - 1 ? SEQ - 1 : qp + 128;
        for (int kp = k0; kp <= k1; ++kp) {
            const float kv = bf2f(F.Kb[(size_t)(b * SEQ + kp) * 128 + hk * 64 + lane]);
            const float dist = (float)(qp > kp ? qp - kp : kp - qp);
            const float s = wave_sum(q * kv) - slope2 * dist;
            const float mn = fmaxf(m, s), al = exp2f(m - mn), p = exp2f(s - mn);
            l = l * al + p; acc = acc * al + p * bf2f(vt[NMETA + kp]); m = mn;
        }
        F.MIX[(size_t)row * D + h * 64 + lane] = (bf16_t)f2bf(acc / l);
    }
}
__device__ __forceinline__ void conv_naive(Frame& F) {
    const int gw = F.bid * NWAVES + F.wave, NGW = F.G * NWAVES, lane = F.lane;
    for (int row = gw; row < M_REAL; row += NGW) {
        const int b = row >> 11, s0 = NMETA + (row & 2047);
        float v[8]; float sum = 0.f;
#pragma unroll
        for (int j = 0; j < 8; ++j) { const int c = lane + 64 * j; float a = F.dw_b[c];
            _Pragma("unroll 1") for (int t = 0; t < CONV_K; ++t) { const int s = s0 - 15 + t; if (s >= 0 && s < LSEQ) a += F.dw_w[t * CONV_W + c] * bf2f(F.HC[(size_t)row_of(b, s) * 512 + c]); }
            v[j] = a; sum += a; }
        const float mu = wave_sum(sum) * (1.f / 512.f); float q = 0.f;
#pragma unroll
        for (int j = 0; j < 8; ++j) { const float d = v[j] - mu; q += d * d; }
        const float rstd = 1.f / sqrtf(wave_sum(q) * (1.f / 512.f) + 1e-5f);
#pragma unroll
        for (int j = 0; j < 8; ++j) { const int c = lane + 64 * j; const float y = (v[j] - mu) * rstd * F.lng[c] + F.lnb[c];
            F.MIX[(size_t)row * D + 512 + c] = (bf16_t)f2bf(y * sigmoidf_fast(y)); }
    }
}
__device__ __forceinline__ void p3_naive(Frame& F) {
    const int gw = F.bid * NWAVES + F.wave, NGW = F.G * NWAVES, lane = F.lane;
    for (int it = gw; it < M_REAL * 16; it += NGW) {
        const int row = it >> 4, col = (it & 15) * 64 + lane; const bf16_t* mr = F.MIX + (size_t)row * D; float acc = 0.f;
        for (int k = 0; k < D; ++k) acc += bf2f(mr[k]) * F.w_out[(size_t)k * D + col];
        const float h2 = F.x[(size_t)row * D + col] + acc;
        F.out[(size_t)row * D + col] = h2; F.XN2[(size_t)row * D + col] = (bf16_t)f2bf(h2);
    }
}
__device__ __forceinline__ void p4_naive(Frame& F) {
    const int gw = F.bid * NWAVES + F.wave, NGW = F.G * NWAVES, lane = F.lane, e = lane & 31;
    for (int t = gw; t < M_REAL; t += NGW) {
        const bf16_t* xr = F.XN2 + (size_t)t * D; float acc = 0.f, ss = 0.f;
        for (int k = 0; k < D; ++k) { const float xv = bf2f(xr[k]); acc += xv * F.n2g[k] * F.wr[k * NE + e]; ss += xv * xv; }
        const float rstd = 1.f / sqrtf(ss * (1.f / D) + 1e-6f);
        float lg = acc * rstd + F.rb[e];
        float tv[4]; int te[4];
#pragma unroll
        for (int kk = 0; kk < 4; ++kk) {
            float bv = lg; int be = e;
#pragma unroll
            for (int o = 1; o < 32; o <<= 1) { const float pv = __shfl_xor(bv, o); const int pe = __shfl_xor(be, o); if (pv > bv || (pv == bv && pe < be)) { bv = pv; be = pe; } }
            tv[kk] = bv; te[kk] = be; if (e == be) lg = -INFINITY;
        }
        float p[4], ps = 0.f;
#pragma unroll
        for (int kk = 0; kk < 4; ++kk) { p[kk] = __expf(tv[kk] - tv[0]); ps += p[kk]; }
        if (lane < 4) {
            const int ee = lane == 0 ? te[0] : lane == 1 ? te[1] : lane == 2 ? te[2] : te[3];
            const float gg = (lane == 0 ? p[0] : lane == 1 ? p[1] : lane == 2 ? p[2] : p[3]) / ps;
            const unsigned slot = __hip_atomic_fetch_add((unsigned*)(F.ctl + CW_CNT + ee), 1u, RLX_AGENT);
            F.ltok[ee * CAP + slot] = t; F.lgate[ee * CAP + slot] = gg; F.lrstd[ee * CAP + slot] = rstd; F.where[t * 4 + lane] = ee * CAP + (int)slot;
        }
    }
}
__device__ __forceinline__ void build_tile_table(Frame& F) {
    LAS int* tb = (LAS int*)(F.lds + LX_TB); LAS int* cn = (LAS int*)(F.lds + LX_CNT);
    __syncthreads();
    if (F.tid == 0) { int acc = 0; for (int e = 0; e < NE; ++e) { int c = (int)__hip_atomic_load(F.ctl + CW_CNT + e, RLX_AGENT); if (c > CAP) c = CAP; if (c < 0) c = 0; cn[e] = c; tb[e] = acc; acc += (c + 255) >> 8; } tb[NE] = acc; }
    __syncthreads();
}
__device__ __forceinline__ int find_expert(const LAS int* tb, int tile) { int e = 0;
#pragma unroll 1
    for (int j = 1; j < NE; ++j) if (tb[j] <= tile) e = j;
    return e; }
__device__ __forceinline__ void p5_naive(Frame& F) {
    build_tile_table(F);
    const LAS int* tb = (const LAS int*)(F.lds + LX_TB); const LAS int* cn = (const LAS int*)(F.lds + LX_CNT);
    const int gw = F.bid * NWAVES + F.wave, NGW = F.G * NWAVES, lane = F.lane, total = tb[NE] * 256;
    for (int it = gw; it < total * 16; it += NGW) {
        const int sr = it >> 4, c = (it & 15) * 64 + lane, e = find_expert(tb, sr >> 8), slot = sr - tb[e] * 256;
        if (slot >= cn[e]) continue;
        const int tok = F.ltok[e * CAP + slot]; const float rstd = F.lrstd[e * CAP + slot];
        const bf16_t* xr = F.XN2 + (size_t)tok * D; const float* W = F.wgu + (size_t)e * D * 2048; float g = 0.f, u = 0.f;
        for (int k = 0; k < D; ++k) { const float xv = bf2f(xr[k]) * F.n2g[k]; g += xv * W[(size_t)k * 2048 + c]; u += xv * W[(size_t)k * 2048 + 1024 + c]; }
        g = g * rstd + F.bgu[e * 2048 + c]; u = u * rstd + F.bgu[e * 2048 + 1024 + c];
        g = fminf(g, 7.f); u = fminf(fmaxf(u, -7.f), 7.f);
        F.ACT[(size_t)sr * D + c] = (bf16_t)f2bf(g * sigmoidf_fast(1.702f * g) * (u + 1.f));
    }
}
__device__ __forceinline__ void p6_naive(Frame& F) {
    build_tile_table(F);
    const LAS int* tb = (const LAS int*)(F.lds + LX_TB); const LAS int* cn = (const LAS int*)(F.lds + LX_CNT);
    const int gw = F.bid * NWAVES + F.wave, NGW = F.G * NWAVES, lane = F.lane, total = tb[NE] * 256;
    for (int it = gw; it < total * 16; it += NGW) {
        const int sr = it >> 4, c = (it & 15) * 64 + lane, e = find_expert(tb, sr >> 8), slot = sr - tb[e] * 256;
        if (slot >= cn[e]) continue;
        const bf16_t* ar = F.ACT + (size_t)sr * D; const float* W = F.wd + (size_t)e * D * D; float acc = 0.f;
        for (int k = 0; k < D; ++k) acc += bf2f(ar[k]) * W[(size_t)k * D + c];
        F.Y[(size_t)sr * D + c] = (bf16_t)f2bf((acc + F.bd[e * D + c]) * F.lgate[e * CAP + slot]);
    }
}
__device__ __forceinline__ void p7_combine(Frame& F) {
    build_tile_table(F);
    const LAS int* tb = (const LAS int*)(F.lds + LX_TB);
    const int gw = F.bid * NWAVES + F.wave, NGW = F.G * NWAVES, lane = F.lane;
    for (int t = gw; t < M_REAL; t += NGW) {
        GAS f32x4* o = (GAS f32x4*)(F.out + (size_t)t * D) + lane * 4;
        f32x4 a[4];
#pragma unroll
        for (int j = 0; j < 4; ++j) a[j] = o[j];
#pragma unroll
        for (int k = 0; k < 4; ++k) {
            const int w = F.where[t * 4 + k], e = w / CAP, slot = w - e * CAP;
            const GAS u32x4* y = (const GAS u32x4*)(F.Y + (size_t)(tb[e] * 256 + slot) * D) + lane * 2;
            const u32x4 y0 = y[0], y1 = y[1];
            a[0] += (f32x4){bflo(y0.x), bfhi(y0.x), bflo(y0.y), bfhi(y0.y)}; a[1] += (f32x4){bflo(y0.z), bfhi(y0.z), bflo(y0.w), bfhi(y0.w)};
            a[2] += (f32x4){bflo(y1.x), bfhi(y1.x), bflo(y1.y), bfhi(y1.y)}; a[3] += (f32x4){bflo(y1.z), bfhi(y1.z), bflo(y1.w), bfhi(y1.w)};
        }
#pragma unroll
        for (int j = 0; j < 4; ++j) o[j] = a[j];
    }
}

__global__ void __launch_bounds__(NTHR, 2) mega(Args args) {
    extern __shared__ __attribute__((aligned(16))) unsigned char lds_raw[];
    Frame F;
    F.lds = (LAS unsigned char*)lds_raw;
    F.tid = threadIdx.x; F.lane = F.tid & 63; F.wave = __builtin_amdgcn_readfirstlane(F.tid >> 6); F.G = gridDim.x; F.bid = blockIdx.x;
    F.x = args.in[0]; F.meta = args.in[1]; F.n1g = args.in[2]; F.w_in = args.in[3]; F.qg = args.in[4]; F.kg = args.in[5]; F.sink = args.in[6];
    F.dw_w = args.in[7]; F.dw_b = args.in[8]; F.lng = args.in[9]; F.lnb = args.in[10]; F.w_out = args.in[11]; F.n2g = args.in[12];
    F.wr = args.in[13]; F.rb = args.in[14]; F.wgu = args.in[15]; F.bgu = args.in[16]; F.wd = args.in[17]; F.bd = args.in[18];
    F.out = args.out; F.ws = args.ws; unsigned char* ws = args.ws;
    F.ctl = (gu32*)(ws + WS_CTL);
    F.WinT = (bf16_t*)(ws + WS_WIN_T); F.WoT = (bf16_t*)(ws + WS_WO_T); F.WrT = (bf16_t*)(ws + WS_WR_T); F.WdT = (bf16_t*)(ws + WS_WD_T); F.WguT = (bf16_t*)(ws + WS_WGU_T);
    F.XN = (bf16_t*)(ws + WS_XN); F.Qb = (bf16_t*)(ws + WS_Q); F.Kb = (bf16_t*)(ws + WS_K); F.VT = (bf16_t*)(ws + WS_VT); F.HC = (bf16_t*)(ws + WS_HC);
    F.MIX = (bf16_t*)(ws + WS_MIX); F.XN2 = (bf16_t*)(ws + WS_XN2); F.ACT = (bf16_t*)(ws + WS_ACT); F.Y = (bf16_t*)(ws + WS_Y);
    F.where = (int*)(ws + WS_WHERE); F.ltok = (int*)(ws + WS_LTOK); F.lgate = (float*)(ws + WS_LGATE); F.lrstd = (float*)(ws + WS_LRSTD);
    for (int u = F.tid; u < (LDS_BYTES - RING_BYTES) / 4; u += NTHR) ((LAS unsigned*)(F.lds + RING_BYTES))[u] = 0u;
    __syncthreads();
    const int lo = args.ph_lo, hi = args.ph_hi;
    XcdBarrier bar; bar.bar = (unsigned*)(F.ctl + CW_BAR); bar.x = 0; bar.st = nullptr;
    if (hi - lo > 1) bar = xcd_barrier_post((unsigned*)(F.ctl + CW_BAR), (volatile LAS unsigned*)(F.lds + LX_BAR));
#ifndef PH_MASK
#define PH_MASK 0xFF
#endif
#define IN(k) (((PH_MASK >> (k)) & 1) && lo <= (k) && (k) < hi)
#define SEAM(k) do { if (IN(k) && IN((k) + 1)) xcd_barrier(bar); } while (0)
#ifndef REP_PH
#define REP_PH -1
#endif
#define REPS(k) _Pragma("unroll") for (int rep = 0; rep < ((REP_PH) == (k) ? 2 : 1); ++rep)
#define REPBAR() do { if (rep) xcd_barrier(bar); } while (0)
    if (IN(0)) { REPS(0) { REPBAR(); p0_prologue(F); } } SEAM(0);
    if (IN(1)) { REPS(1) { REPBAR();
#if FAST_P1
        pg8::DenseProb P{F.XN, F.WinT, M_PAD / 256, IN_W / 256, F.G, F.bid}; pg8::EpiIn E{F.Qb, F.Kb, F.VT, F.HC, F.qg, F.kg}; pg8::gemm_phase(F.lds, P, E);
#else
        p1_naive(F);
#endif
    } } SEAM(1);
    if (IN(2)) { REPS(2) { REPBAR();
#if FAST_ATT
        att_fast(F);
#else
        att_naive(F);
#endif
    } REPS(8) { REPBAR();
#if FAST_CONV
        conv_fast(F);
#else
        conv_naive(F);
#endif
    } } SEAM(2);
    if (IN(3)) { REPS(3) { REPBAR();
#if FAST_P3
        pg8::DenseProb P{F.MIX, F.WoT, M_REAL / 256, D / 256, F.G, F.bid}; pg8::EpiOut E{F.x, F.out, F.XN2}; pg8::gemm_phase(F.lds, P, E);
#else
        p3_naive(F);
#endif
    } } SEAM(3);
    if (IN(4)) {
#if FAST_P4
        p4_fast(F);
#else
        p4_naive(F);
#endif
    } SEAM(4);
    if (IN(5)) { REPS(5) { REPBAR();
#if FAST_P5
        build_tile_table(F); pg8::GroupedProb<true> P{F.XN2, F.WguT, F.ltok, (const LAS int*)(F.lds + LX_TB), (const LAS int*)(F.lds + LX_CNT), 8, F.G, F.bid};
        pg8::EpiGU E{F.ACT, F.lrstd, F.bgu}; pg8::gemm_phase(F.lds, P, E);
#else
        p5_naive(F);
#endif
    } } SEAM(5);
    if (IN(6)) { REPS(6) { REPBAR();
#if FAST_P6
        build_tile_table(F); pg8::GroupedProb<false> P{F.ACT, F.WdT, F.ltok, (const LAS int*)(F.lds + LX_TB), (const LAS int*)(F.lds + LX_CNT), 4, F.G, F.bid};
        pg8::EpiDown E{F.Y, F.lgate, F.bd}; pg8::gemm_phase(F.lds, P, E);
#else
        p6_naive(F);
#endif
    } } SEAM(6);
    if (IN(7)) { p7_combine(F); }
#undef IN
#undef SEAM
}

extern "C" void kernel_launch(void* const* d_in, const int* in_sizes, int n_in, void* d_out, int out_size, void* d_ws, size_t ws_size, hipStream_t stream) {
    static int grid = 0;
    if (grid == 0) {
        if (n_in != 19 || in_sizes[0] != M_REAL * D || out_size != M_REAL * D || ws_size < WS_END) {
            fprintf(stderr, "kernel_launch: unexpected shapes/workspace: n_in %d in0 %d out %d ws %zu (need %zu)\n", n_in, n_in > 0 ? in_sizes[0] : -1, out_size, ws_size, (size_t)WS_END); grid = -1; return; }
        int dev = 0, cus = 0, per_cu = 0;
        if (hipGetDevice(&dev) != hipSuccess || hipDeviceGetAttribute(&cus, hipDeviceAttributeMultiprocessorCount, dev) != hipSuccess) { grid = -1; return; }
        if (hipFuncSetAttribute((const void*)mega, hipFuncAttributeMaxDynamicSharedMemorySize, LDS_BYTES) != hipSuccess) { fprintf(stderr, "kernel_launch: hipFuncSetAttribute failed\n"); grid = -1; return; }
        if (hipOccupancyMaxActiveBlocksPerMultiprocessor(&per_cu, (const void*)mega, NTHR, LDS_BYTES) != hipSuccess || per_cu < 1) { fprintf(stderr, "kernel_launch: occupancy query says %d blocks/CU\n", per_cu); (void)hipGetLastError(); grid = -1; return; }
        grid = cus;
    }
    if (grid < 0) return;
    (void)hipMemsetAsync((char*)d_ws + WS_CTL, 0, CTL_ZERO_BYTES, stream);
    Args a{};
    for (int i = 0; i < 19; ++i) a.in[i] = (const float*)d_in[i];
    a.out = (float*)d_out; a.ws = (unsigned char*)d_ws;
#if MK_PER_PHASE
    for (int p = 0; p < 8; ++p) { a.ph_lo = p; a.ph_hi = p + 1; hipLaunchKernelGGL(mega, dim3(grid), dim3(NTHR), LDS_BYTES, stream, a); }
#else
    a.ph_lo = 0; a.ph_hi = 8; hipLaunchKernelGGL(mega, dim3(grid), dim3(NTHR), LDS_BYTES, stream, a);
#endif
}
```

```cpp
#include <hip/hip_runtime.h>
#include <cstdio>
#include <cstdint>

#ifndef MK_PER_PHASE
#define MK_PER_PHASE 0
#endif
#ifndef FAST_P1
#define FAST_P1 1
#endif
#ifndef FAST_ATT
#define FAST_ATT 1
#endif
#ifndef FAST_CONV
#define FAST_CONV 1
#endif
#ifndef FAST_P3
#define FAST_P3 1
#endif
#ifndef FAST_P4
#define FAST_P4 1
#endif
#ifndef FAST_P5
#define FAST_P5 1
#endif
#ifndef FAST_P6
#define FAST_P6 1
#endif

#define GAS __attribute__((address_space(1)))
#define LAS __attribute__((address_space(3)))
typedef unsigned short bf16_t;
typedef short bf16x8 __attribute__((ext_vector_type(8)));
typedef float f32x4 __attribute__((ext_vector_type(4)));
typedef float f32x16 __attribute__((ext_vector_type(16)));
typedef unsigned u32x4 __attribute__((ext_vector_type(4)));
typedef unsigned u32x2 __attribute__((ext_vector_type(2)));
typedef float f32x2 __attribute__((ext_vector_type(2)));
typedef GAS unsigned gu32;
#define RLX_AGENT __ATOMIC_RELAXED, __HIP_MEMORY_SCOPE_AGENT

constexpr int NB = 8, SEQ = 2048, D = 1024, NMETA = 16, LSEQ = NMETA + SEQ;
constexpr int M_REAL = NB * SEQ, M_ALL = NB * LSEQ, M_PAD = 16640;
constexpr int IN_W = 1792, HD = 64, NQH = 8, NKV = 2, CONV_W = 512, CONV_K = 31;
constexpr int NE = 32, CAP = 16384, ACT_ROWS = 4 * M_REAL + NE * 256;
constexpr float LOG2E = 1.4426950408889634f;
constexpr float QSCALE = 0.125f * LOG2E;
constexpr int VT_PITCH = LSEQ;

constexpr size_t MiB = 1u << 20;
constexpr size_t WS_CTL = 0, CTL_ZERO_BYTES = 1 * MiB;
constexpr size_t WS_WIN_T = 2 * MiB;
constexpr size_t WS_WO_T = 6 * MiB;
constexpr size_t WS_WR_T = 8 * MiB;
constexpr size_t WS_RSTD = 9 * MiB;
constexpr size_t WS_WHERE = 9 * MiB + 512 * 1024;
constexpr size_t WS_LTOK = 10 * MiB;
constexpr size_t WS_LGATE = 12 * MiB;
constexpr size_t WS_LRSTD = 14 * MiB;
constexpr size_t WS_WD_T = 16 * MiB;
constexpr size_t WS_WGU_T = 80 * MiB;
constexpr size_t WS_XN = 208 * MiB;
constexpr size_t WS_Q = 241 * MiB;
constexpr size_t WS_K = 258 * MiB;
constexpr size_t WS_VT = 263 * MiB;
constexpr size_t WS_HC = 268 * MiB;
constexpr size_t WS_MIX = 285 * MiB;
constexpr size_t WS_XN2 = 317 * MiB;
constexpr size_t WS_ACT = 349 * MiB;
constexpr size_t WS_Y = 493 * MiB;
constexpr size_t WS_END = 637 * MiB;
constexpr int CW_CNT = 64;
constexpr int CW_BAR = 4096;

constexpr int RING_BYTES = 131072;
constexpr int LX_BAR = RING_BYTES;
constexpr int LX_TB = RING_BYTES + 64;
constexpr int LX_CNT = RING_BYTES + 256;
constexpr int LX_LCNT = RING_BYTES + 512;
constexpr int LX_GBASE = RING_BYTES + 768;
constexpr int LDS_BYTES = 147456;

constexpr int NWAVES = 8, NTHR = 512;

__device__ __forceinline__ unsigned f2bf(float f) { unsigned u = __builtin_bit_cast(unsigned, f); return (u + 0x7fffu + ((u >> 16) & 1u)) >> 16; }
__device__ __forceinline__ unsigned pk2(float lo, float hi) { return f2bf(lo) | (f2bf(hi) << 16); }
__device__ __forceinline__ float bf2f(unsigned b) { return __builtin_bit_cast(float, b << 16); }
__device__ __forceinline__ float bflo(unsigned w) { return __builtin_bit_cast(float, w << 16); }
__device__ __forceinline__ float bfhi(unsigned w) { return __builtin_bit_cast(float, w & 0xffff0000u); }
__device__ __forceinline__ float wave_sum(float v) {
#pragma unroll
    for (int o = 1; o < 64; o <<= 1) v += __shfl_xor(v, o);
    return v;
}
__device__ __forceinline__ float sigmoidf_fast(float x) { return __builtin_amdgcn_rcpf(1.0f + __builtin_amdgcn_exp2f(-x * LOG2E)); }
__device__ __forceinline__ int row_of(int b, int s) { return s < NMETA ? M_REAL + b * NMETA + s : b * SEQ + (s - NMETA); }

#define XB_TMO      128
#define XB_XCNT(j)  (256  + 64 * (j))
#define XB_XSUB(j)  (1280 + 64 * (j))
#define XB_XGEN(j)  (2304 + 64 * (j))
#define XB_TOP      3328
#define XB_TOPGEN   3392
#define XCD_BAR_WORDS 3456
#define XB_SPIN_CAP (1u << 18)
__device__ __forceinline__ unsigned xb_ld(unsigned* p)              { return __hip_atomic_load(p, __ATOMIC_RELAXED, __HIP_MEMORY_SCOPE_AGENT); }
__device__ __forceinline__ unsigned xb_add(unsigned* p, unsigned v) { return __hip_atomic_fetch_add(p, v, __ATOMIC_RELAXED, __HIP_MEMORY_SCOPE_AGENT); }
__device__ __forceinline__ unsigned xb_xcc_id() { return (unsigned)__builtin_amdgcn_s_getreg((3 << 11) | 20) & 0xFu; }
#define XB_SPIN(cond, bar) do { unsigned _sp = 0; while (cond) { __builtin_amdgcn_s_sleep(1); \
    if ((++_sp & 255u) == 0u) { if (xb_ld(&(bar)[XB_TMO])) break; if (_sp > XB_SPIN_CAP) { atomicAdd(&(bar)[XB_TMO], 1u); break; } } } } while (0)
struct XcdBarrier { unsigned* bar; unsigned x; volatile LAS unsigned* st; };
__device__ __forceinline__ XcdBarrier xcd_barrier_post(unsigned* bar, volatile LAS unsigned* st) {
    XcdBarrier b; b.bar = bar; b.x = xb_xcc_id(); b.st = st;
    if (threadIdx.x == 0) (void)xb_add(&bar[XB_XCNT(b.x)], 1u);
    return b;
}
__device__ __forceinline__ void xcd_barrier_complete(unsigned* bar, unsigned x, unsigned& nloc, unsigned& nx) {
    const unsigned G = gridDim.x * gridDim.y * gridDim.z;
    unsigned sum, cnt, mine, sp = 0u;
    for (;;) {
        sum = 0u; cnt = 0u; mine = 0u;
#pragma unroll
        for (unsigned j = 0; j < 16; ++j) { const unsigned c = xb_ld(&bar[XB_XCNT(j)]); sum += c; cnt += (c > 0u) ? 1u : 0u; mine = (j == x) ? c : mine; }
        if (sum == G) break;
        __builtin_amdgcn_s_sleep(1);
        if ((++sp & 255u) == 0u) { if (xb_ld(&bar[XB_TMO])) break; if (sp > XB_SPIN_CAP) { atomicAdd(&bar[XB_TMO], 1u); break; } }
    }
    nloc = mine > 0u ? mine : 1u; nx = cnt > 0u ? cnt : 1u;
}
__device__ __forceinline__ void xcd_barrier(const XcdBarrier& b) {
    asm volatile("s_waitcnt vmcnt(0)" ::: "memory");
    __syncthreads();
    if (threadIdx.x == 0) {
        unsigned* bar = b.bar;
        __builtin_amdgcn_s_waitcnt(0);
        unsigned nloc = b.st[0], nx = b.st[1];
        if (nloc == 0u) { xcd_barrier_complete(bar, b.x, nloc, nx); b.st[0] = nloc; b.st[1] = nx; }
        const unsigned old = xb_add(&bar[XB_XSUB(b.x)], 1u);
        const unsigned gen = old / nloc;
        if (old + 1u == (gen + 1u) * nloc) {
            __builtin_amdgcn_fence(__ATOMIC_RELEASE, "agent");
            asm volatile("s_waitcnt vmcnt(0)" ::: "memory");
            const unsigned og = xb_add(&bar[XB_TOP], 1u);
            const unsigned tg = og / nx;
            if (og + 1u == (tg + 1u) * nx) xb_add(&bar[XB_TOPGEN], 1u);
            else XB_SPIN(xb_ld(&bar[XB_TOPGEN]) == tg, bar);
            __builtin_amdgcn_fence(__ATOMIC_ACQUIRE, "agent");
            xb_add(&bar[XB_XGEN(b.x)], 1u);
            asm volatile("s_waitcnt vmcnt(0)" ::: "memory");
        } else {
            XB_SPIN(xb_ld(&bar[XB_XGEN(b.x)]) == gen, bar);
            __builtin_amdgcn_fence(__ATOMIC_ACQUIRE, "agent");
            asm volatile("s_waitcnt vmcnt(0)" ::: "memory");
        }
    }
    __syncthreads();
}

struct Args { const float* in[19]; float* out; unsigned char* ws; int ph_lo, ph_hi; };
struct Frame {
    LAS unsigned char* lds;
    int tid, lane, wave, G, bid;
    const float *x, *meta, *n1g, *w_in, *qg, *kg, *sink, *dw_w, *dw_b, *lng, *lnb, *w_out, *n2g, *wr, *rb, *wgu, *bgu, *wd, *bd;
    float* out;
    unsigned char* ws;
    gu32* ctl;
    bf16_t *WinT, *WoT, *WrT, *WdT, *WguT, *XN, *Qb, *Kb, *VT, *HC, *MIX, *XN2, *ACT, *Y;
    int* where; int* ltok; float* lgate; float* lrstd;
};

__device__ __forceinline__ int perm32(int rho) { const int n = rho >> 4, i = rho & 15; return 8 * (i >> 2) + 4 * n + (i & 3); }
__device__ __forceinline__ int lbase_nat(int pg) { return 32 * pg; }
__device__ __forceinline__ int lbase_in(int pg) { const int tile = pg >> 3, bj = (pg >> 2) & 1, wc = pg & 3; return tile <= 2 ? tile * 256 + 64 * wc + 32 * bj : 768 + bj * 512 + (tile - 3) * 128 + 32 * wc; }
__device__ __forceinline__ int lbase_gu(int pg) { const int tile = pg >> 3, bj = (pg >> 2) & 1, wc = pg & 3; return bj * 1024 + tile * 128 + 32 * wc; }
struct P0Item { const float* W; bf16_t* WT; const float* g; int N, pg, n0, k0; bool permute; };
__device__ __forceinline__ bool p0_decode(const Frame& F, int it, P0Item& I) {
    constexpr int I_IN = 16 * 56, I_O = 16 * 32, I_R = 16, I_GU = NE * 16 * 64, I_D = NE * 16 * 32;
    int r = it;
    if (r < I_IN) { const int pg = r % 56, kb = r / 56; I = P0Item{F.w_in, F.WinT, nullptr, IN_W, pg, lbase_in(pg), 64 * kb, true}; return true; } r -= I_IN;
    if (r < I_O) { const int pg = r % 32, kb = r / 32; I = P0Item{F.w_out, F.WoT, nullptr, D, pg, lbase_nat(pg), 64 * kb, true}; return true; } r -= I_O;
    if (r < I_R) { I = P0Item{F.wr, F.WrT, F.n2g, NE, 0, 0, 64 * r, false}; return true; } r -= I_R;
    if (r < I_GU) { const int e = r / (16 * 64), q = r % (16 * 64), pg = q % 64, kb = q / 64; I = P0Item{F.wgu + (size_t)e * D * 2048, F.WguT + (size_t)e * 2048 * D, F.n2g, 2048, pg, lbase_gu(pg), 64 * kb, true}; return true; } r -= I_GU;
    if (r < I_D) { const int e = r / (16 * 32), q = r % (16 * 32), pg = q % 32, kb = q / 32; I = P0Item{F.wd + (size_t)e * D * D, F.WdT + (size_t)e * D * D, nullptr, D, pg, lbase_nat(pg), 64 * kb, true}; return true; }
    return false;
}
__device__ __forceinline__ void p0_load(const P0Item& I, int lane, f32x4 (&v)[8]) {
    const float* p = I.W + (size_t)(I.k0 + (lane >> 3)) * I.N + I.n0 + 4 * (lane & 7);
#pragma unroll
    for (int i = 0; i < 8; ++i) v[i] = __builtin_nontemporal_load((const f32x4*)(p + (size_t)(8 * i) * I.N));
}
__device__ __forceinline__ void p0_store(const P0Item& I, int lane, LAS float* scr, const f32x4 (&v)[8]) {
    LAS float* w = scr + (lane >> 3) * 33 + 4 * (lane & 7);
#pragma unroll
    for (int i = 0; i < 8; ++i) { w[(8 * i) * 33 + 0] = v[i][0]; w[(8 * i) * 33 + 1] = v[i][1]; w[(8 * i) * 33 + 2] = v[i][2]; w[(8 * i) * 33 + 3] = v[i][3]; }
    asm volatile("s_waitcnt lgkmcnt(0)" ::: "memory");
    const int c = lane & 7;
    f32x4 g0 = {1.f, 1.f, 1.f, 1.f}, g1 = g0;
    if (I.g) { g0 = *(const f32x4*)(I.g + I.k0 + 8 * c); g1 = *(const f32x4*)(I.g + I.k0 + 8 * c + 4); }
#pragma unroll
    for (int j = 0; j < 4; ++j) { const int r = (lane >> 3) + 8 * j; const int sc = I.permute ? perm32(r) : r; const LAS float* s = scr + (8 * c) * 33 + sc;
        u32x4 o; o.x = pk2(s[0 * 33] * g0[0], s[1 * 33] * g0[1]); o.y = pk2(s[2 * 33] * g0[2], s[3 * 33] * g0[3]); o.z = pk2(s[4 * 33] * g1[0], s[5 * 33] * g1[1]); o.w = pk2(s[6 * 33] * g1[2], s[7 * 33] * g1[3]);
        *(GAS u32x4*)(I.WT + (size_t)(32 * I.pg + r) * D + I.k0 + 8 * c) = o; }
    asm volatile("s_waitcnt lgkmcnt(0)" ::: "memory");
}
__device__ __forceinline__ void p0_prologue(Frame& F) {
    LAS float* scr = (LAS float*)(F.lds + F.wave * 16384);
    const int gw = F.bid * NWAVES + F.wave, NGW = F.G * NWAVES, lane = F.lane;
    {
        P0Item cur, nxt; f32x4 va[8], vb[8];
        int it = gw; bool valid = p0_decode(F, it, cur);
        if (valid) p0_load(cur, lane, va);
        while (valid) {
            it += NGW; const bool vn = p0_decode(F, it, nxt);
            if (vn) p0_load(nxt, lane, vb);
            p0_store(cur, lane, scr, va);
            cur = nxt; valid = vn;
#pragma unroll
            for (int i = 0; i < 8; ++i) va[i] = vb[i];
        }
    }
    const GAS f32x4* gr = (const GAS f32x4*)F.n1g + lane;
    for (int m0 = 2 * gw; m0 < M_PAD; m0 += 2 * NGW) {
        f32x4 v[2][4]; float ss[2];
#pragma unroll
        for (int u = 0; u < 2; ++u) { const int m = m0 + u; ss[u] = 0.f;
            if (m < M_ALL) { const float* src = m < M_REAL ? F.x + (size_t)m * D : F.meta + (size_t)((m - M_REAL) & (NMETA - 1)) * D; const GAS f32x4* xr = (const GAS f32x4*)src + lane;
#pragma unroll
                for (int j = 0; j < 4; ++j) v[u][j] = xr[64 * j]; }
            else {
#pragma unroll
                for (int j = 0; j < 4; ++j) v[u][j] = (f32x4){0.f, 0.f, 0.f, 0.f}; } }
#pragma unroll
        for (int u = 0; u < 2; ++u) {
#pragma unroll
            for (int j = 0; j < 4; ++j) ss[u] += (v[u][j].x * v[u][j].x + v[u][j].y * v[u][j].y) + (v[u][j].z * v[u][j].z + v[u][j].w * v[u][j].w);
            const float rstd = 1.f / sqrtf(wave_sum(ss[u]) * (1.f / D) + 1e-6f);
            GAS unsigned long long* o8 = (GAS unsigned long long*)(F.XN + (size_t)(m0 + u) * D) + lane;
#pragma unroll
            for (int j = 0; j < 4; ++j) { const f32x4 g = gr[64 * j]; o8[64 * j] = (unsigned long long)pk2(v[u][j].x * rstd * g.x, v[u][j].y * rstd * g.y) | ((unsigned long long)pk2(v[u][j].z * rstd * g.z, v[u][j].w * rstd * g.w) << 32); }
        }
    }
}

namespace pg8 {
constexpr int BM = 256, BK = 64, HALF = 128, HTB = HALF * BK * 2, STAGE_BYTES = 8 * HTB, NXCD = 8, WGM = 8, KD = 1024;
__device__ __forceinline__ int lds_byte(int r, int c) { const int st = (r >> 4) * 2 + (c >> 5), rr = r & 15, cc = c & 31, ob = rr * 64 + cc * 2; return st * 1024 + (ob ^ (((ob >> 9) & 1) << 5)); }
__device__ __forceinline__ void stage_rc(int b, int& R, int& C) { const int st = b / 1024, sb = b % 1024, swz = sb ^ (((sb >> 9) & 1) << 5); R = (st >> 1) * 16 + swz / 64; C = (st & 1) * 32 + (swz % 64) / 2; }
struct Unit { int pm, pn, e, slot0, nvalid, r0; };
__device__ __forceinline__ unsigned cvt_pk_bf16(float lo, float hi) { unsigned r; asm volatile("v_cvt_pk_bf16_f32 %0, %1, %2" : "=v"(r) : "v"(lo), "v"(hi)); return r; }
__device__ __forceinline__ u32x4 pack8(const f32x4 a, const f32x4 b) { u32x4 w; w.x = cvt_pk_bf16(a[0], a[1]); w.y = cvt_pk_bf16(a[2], a[3]); w.z = cvt_pk_bf16(b[0], b[1]); w.w = cvt_pk_bf16(b[2], b[3]); return w; }

template <bool HALVES>
__device__ __forceinline__ bool tile_order(int i, int G, int c, int nM, int nN, int& pm, int& pn, int& half) {
    const int nwg = nM * nN; long L = (long)i * G + c; half = -1;
    if (HALVES) { const int nfull = (nwg / G) * G, left = nwg - nfull; if (left > 0 && 2 * left <= G && L >= nfull) { const long hidx = L - nfull; if (hidx >= 2 * left) return false; L = nfull + (hidx >> 1); half = (int)(hidx & 1); } }
    if (L >= nwg) return false;
    int wgid = (int)L; { const int q = nwg / NXCD, r = nwg % NXCD, xcd = wgid % NXCD, off = wgid / NXCD; wgid = (xcd < r ? xcd * (q + 1) : r * (q + 1) + (xcd - r) * q) + off; }
    const int nig = WGM * nN, gid = wgid / nig, fm = gid * WGM, gsz = (nM - fm) < WGM ? (nM - fm) : WGM;
    pm = fm + ((wgid % nig) % gsz); pn = (wgid % nig) / gsz; return true;
}
struct DenseProb {
    const bf16_t* A; const bf16_t* Bt; int nM, nN, G, c;
    __device__ __forceinline__ bool next(int i, Unit& u) const { u.e = 0; u.slot0 = 0; u.nvalid = 256; u.r0 = 0; int half; return tile_order<false>(i, G, c, nM, nN, u.pm, u.pn, half); }
    __device__ __forceinline__ void addr_load(const Unit&, const int (&)[2], int (&)[4]) const {}
    __device__ __forceinline__ void addr_finish(const Unit& u, const int (&R)[2], const int (&C)[2], const int (&)[4], const char*& a, const char*& b, unsigned (&va0)[2], unsigned (&va1)[2]) const {
        a = (const char*)A + (size_t)u.pm * (BM * KD * 2); b = (const char*)Bt + (size_t)u.pn * (BM * KD * 2);
#pragma unroll
        for (int i = 0; i < 2; ++i) { va0[i] = (unsigned)(R[i] * KD + C[i]) * 2u; va1[i] = va0[i] + (unsigned)(HALF * KD * 2); }
    }
};
template <bool GATHER> struct GroupedProb {
    const bf16_t* A; const bf16_t* Bt; const int* ltok; const LAS int* tb; const LAS int* cn; int nN, G, c;
    __device__ __forceinline__ bool next(int i, Unit& u) const {
        const int nM = __builtin_amdgcn_readfirstlane(tb[NE]); int half;
        if (!tile_order<true>(i, G, c, nM, nN, u.pm, u.pn, half)) return false;
        int e = 0;
#pragma unroll 1
        for (int j = 1; j < NE; ++j) if (tb[j] <= u.pm) e = j;
        e = __builtin_amdgcn_readfirstlane(e);
        const int t0 = __builtin_amdgcn_readfirstlane(tb[e]), ce = __builtin_amdgcn_readfirstlane(cn[e]);
        u.e = e; u.r0 = half == 1 ? HALF : 0; u.slot0 = (u.pm - t0) * 256 + u.r0; int rem = ce - u.slot0; const int lim = half >= 0 ? HALF : 256; rem = rem < lim ? rem : lim; u.nvalid = rem < 0 ? 0 : rem; return true;
    }
    __device__ __forceinline__ void addr_load(const Unit& u, const int (&R)[2], int (&raw)[4]) const {
        if (GATHER) { const int* lt = ltok + u.e * CAP + u.slot0;
#pragma unroll
            for (int i = 0; i < 2; ++i) { const int r0 = R[i], r1 = R[i] + HALF; raw[2 * i] = r0 < u.nvalid ? lt[r0] : 0; raw[2 * i + 1] = r1 < u.nvalid ? lt[r1] : 0; } }
    }
    __device__ __forceinline__ void addr_finish(const Unit& u, const int (&R)[2], const int (&C)[2], const int (&raw)[4], const char*& a, const char*& b, unsigned (&va0)[2], unsigned (&va1)[2]) const {
        b = (const char*)Bt + ((size_t)u.e * nN + u.pn) * (BM * KD * 2);
        if (GATHER) { a = (const char*)A;
#pragma unroll
            for (int i = 0; i < 2; ++i) { va0[i] = (unsigned)(raw[2 * i] * KD + C[i]) * 2u; va1[i] = (unsigned)(raw[2 * i + 1] * KD + C[i]) * 2u; }
        } else { a = (const char*)A + (size_t)(u.pm * BM + u.r0) * (KD * 2);
#pragma unroll
            for (int i = 0; i < 2; ++i) { va0[i] = (unsigned)(R[i] * KD + C[i]) * 2u; va1[i] = va0[i] + (unsigned)(HALF * KD * 2); }
        }
    }
};

template <class Prob, class Epi>
__device__ __forceinline__ void gemm_phase(LAS unsigned char* lds, const Prob& P, const Epi& E) {
    const int tid = threadIdx.x, wid = __builtin_amdgcn_readfirstlane(tid >> 6), lane = tid & 63, wr = wid >> 2, wc = wid & 3, fr = lane & 15, fq = lane >> 4;
    constexpr int nt = KD / BK;
    int R[2], C[2]; unsigned voffB[2];
#pragma unroll
    for (int i = 0; i < 2; ++i) { stage_rc(tid * 16 + i * 8192, R[i], C[i]); voffB[i] = (unsigned)(R[i] * KD + C[i]) * 2u; }
    constexpr size_t kstep = (size_t)(BK * 2);
    constexpr size_t hstep = (size_t)HALF * KD * 2;
    const unsigned ldsw = (unsigned)wid * 1024u;
    const int aoff = lds_byte(wr * 64 + fr, fq * 8), boff = lds_byte(wc * 32 + fr, fq * 8);
#define PG8_SA(b, h) (((b) * 2 + (h)) * HTB)
#define PG8_SB(b, h) ((4 + (b) * 2 + (h)) * HTB)
#define PG8_STAGE(bufoff, gbase, voff) do { _Pragma("unroll") for (int _i = 0; _i < 2; ++_i) \
        __builtin_amdgcn_global_load_lds((const unsigned*)((const char*)(gbase) + (voff)[_i]), (LAS unsigned*)(lds + (bufoff) + ldsw + _i * 8192), 16, 0, 0); } while (0)
#define PG8_LDA(dst, b, h) do { _Pragma("unroll") for (int m = 0; m < 4; ++m) _Pragma("unroll") for (int k = 0; k < 2; ++k) dst[m][k] = *(const LAS bf16x8*)(lds + PG8_SA(b, h) + aoff + m * 2048 + k * 1024); } while (0)
#define PG8_LDB(dst, b, h) do { _Pragma("unroll") for (int n = 0; n < 2; ++n) _Pragma("unroll") for (int k = 0; k < 2; ++k) dst[n][k] = *(const LAS bf16x8*)(lds + PG8_SB(b, h) + boff + n * 2048 + k * 1024); } while (0)
#define PG8_MMA(ai, bj, At, Bt) do { __builtin_amdgcn_s_setprio(1); _Pragma("unroll") for (int m = 0; m < 4; ++m) _Pragma("unroll") for (int n = 0; n < 2; ++n) _Pragma("unroll") for (int k = 0; k < 2; ++k) \
        acc[ai][bj][m][n] = __builtin_amdgcn_mfma_f32_16x16x32_bf16(Bt[n][k], At[m][k], acc[ai][bj][m][n], 0, 0, 0); __builtin_amdgcn_s_setprio(0); } while (0)
#define PG8_WAIT_V(n) asm volatile("s_waitcnt vmcnt(" #n ")" ::: "memory")
#define PG8_WAIT_L(n) asm volatile("s_waitcnt lgkmcnt(" #n ")" ::: "memory")
#define PG8_BAR __builtin_amdgcn_s_barrier()
#define PG8_SCHED __builtin_amdgcn_sched_barrier(0)
    Unit cur, nxt, nn; int ui = 0; int raw[4] = {0, 0, 0, 0};
    if (!P.next(0, cur)) return;
    bool has_next = P.next(1, nxt);
    const char *cA, *cB, *nA, *nB; unsigned va0[2], va1[2], nva0[2], nva1[2];
    P.addr_load(cur, R, raw); P.addr_finish(cur, R, C, raw, cA, cB, va0, va1);
    if (has_next) { P.addr_load(nxt, R, raw); P.addr_finish(nxt, R, C, raw, nA, nB, nva0, nva1); }
    else { nA = cA; nB = cB; nva0[0] = va0[0]; nva0[1] = va0[1]; nva1[0] = va1[0]; nva1[1] = va1[1]; }
    f32x4 acc[2][2][4][2];
#pragma unroll
    for (int a = 0; a < 2; ++a)
#pragma unroll
        for (int b = 0; b < 2; ++b)
#pragma unroll
            for (int m = 0; m < 4; ++m)
#pragma unroll
                for (int n = 0; n < 2; ++n) acc[a][b][m][n] = (f32x4){0.f, 0.f, 0.f, 0.f};
    bf16x8 At[4][2], B0[2][2], B1[2][2];
    PG8_STAGE(PG8_SB(0, 0), cB, voffB); PG8_STAGE(PG8_SB(0, 1), cB + hstep, voffB); PG8_STAGE(PG8_SA(0, 0), cA, va0); PG8_STAGE(PG8_SA(0, 1), cA, va1);
    if (wr == 1) PG8_BAR;
    PG8_WAIT_V(2); PG8_BAR;
    PG8_STAGE(PG8_SB(1, 0), cB + kstep, voffB); PG8_STAGE(PG8_SA(1, 0), cA + kstep, va0); PG8_STAGE(PG8_SB(1, 1), cB + hstep + kstep, voffB);
    PG8_WAIT_V(6); PG8_BAR;
    for (;;) {
        const bool full = cur.nvalid > HALF;
        for (int t = 0; t < nt; t += 2) {
            const bool last = (t == nt - 2);
            const char* a1 = cA + (size_t)(t + 1) * kstep;
            const char* a2 = last ? nA : cA + (size_t)(t + 2) * kstep; const char* b2 = last ? nB : cB + (size_t)(t + 2) * kstep;
            const char* a3 = a2 + kstep; const char* b3 = b2 + kstep;
            unsigned v2a0[2], v2a1[2];
            v2a0[0] = last ? nva0[0] : va0[0]; v2a0[1] = last ? nva0[1] : va0[1]; v2a1[0] = last ? nva1[0] : va1[0]; v2a1[1] = last ? nva1[1] : va1[1];
            PG8_LDB(B0, 0, 0); PG8_LDB(B1, 0, 1); PG8_SCHED; PG8_LDA(At, 0, 0); PG8_STAGE(PG8_SA(1, 1), a1, va1);
            PG8_WAIT_V(8); PG8_WAIT_L(0); PG8_BAR; PG8_MMA(0, 0, At, B0); PG8_MMA(0, 1, At, B1); PG8_BAR; PG8_SCHED;
            PG8_LDA(At, 0, 1); PG8_STAGE(PG8_SB(0, 0), b2, voffB); PG8_STAGE(PG8_SB(0, 1), b2 + hstep, voffB); PG8_STAGE(PG8_SA(0, 0), a2, v2a0);
            PG8_WAIT_V(8); PG8_WAIT_L(0); PG8_BAR; if (full) { PG8_MMA(1, 0, At, B0); PG8_MMA(1, 1, At, B1); } PG8_BAR; PG8_SCHED;
            PG8_LDB(B0, 1, 0); PG8_LDB(B1, 1, 1); PG8_SCHED; PG8_LDA(At, 1, 0); PG8_STAGE(PG8_SA(0, 1), a2, v2a1);
            PG8_WAIT_V(8); PG8_WAIT_L(0); PG8_BAR; PG8_MMA(0, 0, At, B0); PG8_MMA(0, 1, At, B1); PG8_BAR; PG8_SCHED;
            PG8_LDA(At, 1, 1); PG8_STAGE(PG8_SB(1, 0), b3, voffB); PG8_STAGE(PG8_SB(1, 1), b3 + hstep, voffB); PG8_STAGE(PG8_SA(1, 0), a3, v2a0);
            PG8_WAIT_V(8); PG8_WAIT_L(0); PG8_BAR; if (full) { PG8_MMA(1, 0, At, B0); PG8_MMA(1, 1, At, B1); } PG8_BAR; PG8_SCHED;
        }
        const bool has_nn = has_next && P.next(ui + 2, nn);
        if (has_nn) P.addr_load(nn, R, raw);
        if (wr == 0) PG8_BAR;
        E(acc, cur, wr, wc, fr, fq);
        if (!has_next) break;
#pragma unroll
        for (int a = 0; a < 2; ++a)
#pragma unroll
            for (int b = 0; b < 2; ++b)
#pragma unroll
                for (int m = 0; m < 4; ++m)
#pragma unroll
                    for (int n = 0; n < 2; ++n) acc[a][b][m][n] = (f32x4){0.f, 0.f, 0.f, 0.f};
        cur = nxt; cA = nA; cB = nB; va0[0] = nva0[0]; va0[1] = nva0[1]; va1[0] = nva1[0]; va1[1] = nva1[1]; ++ui;
        nxt = nn; has_next = has_nn;
        if (has_next) P.addr_finish(nxt, R, C, raw, nA, nB, nva0, nva1);
        if (wr == 1) PG8_BAR;
    }
    PG8_WAIT_V(0);
    PG8_BAR;
#undef PG8_SA
#undef PG8_SB
#undef PG8_STAGE
#undef PG8_LDA
#undef PG8_LDB
#undef PG8_MMA
#undef PG8_WAIT_V
#undef PG8_WAIT_L
#undef PG8_BAR
#undef PG8_SCHED
}

struct EpiOut {
    const float* x; float* out; bf16_t* xn2;
    __device__ __forceinline__ void operator()(const f32x4 (&acc)[2][2][4][2], const Unit& u, int wr, int wc, int fr, int fq) const {
        const int row0 = u.pm * BM + wr * 64 + fr, col0 = u.pn * BM + wc * 32 + 8 * fq;
#pragma unroll
        for (int ai = 0; ai < 2; ++ai)
#pragma unroll
            for (int m = 0; m < 4; ++m) { const size_t off = (size_t)(row0 + ai * HALF + m * 16) * D + col0;
#pragma unroll
                for (int bj = 0; bj < 2; ++bj) { const float* xp = x + off + bj * HALF;
                    const f32x4 h0 = acc[ai][bj][m][0] + *(const f32x4*)xp, h1 = acc[ai][bj][m][1] + *(const f32x4*)(xp + 4);
                    *(u32x4*)(xn2 + off + bj * HALF) = pack8(h0, h1); }
                asm volatile("" ::: "memory"); }
    }
};
struct EpiIn {
    bf16_t *Qb, *Kb, *VT, *HC; const float *qg, *kg;
    __device__ __forceinline__ void operator()(const f32x4 (&acc)[2][2][4][2], const Unit& u, int wr, int wc, int fr, int fq) const {
        const int rowb = u.pm * BM + wr * 64 + fr;
        if (u.pn <= 2) {
            const bool isv = (u.pn == 2) && (wc >= 2);
            if (!isv) {
                const bool isq = u.pn < 2; const float* g = isq ? qg : kg; const float sc = isq ? QSCALE : 1.f;
                f32x4 gv[2][2];
#pragma unroll
                for (int bj = 0; bj < 2; ++bj)
#pragma unroll
                    for (int n = 0; n < 2; ++n) gv[bj][n] = *(const f32x4*)(g + 32 * bj + 8 * fq + 4 * n) * sc;
                bf16_t* dst = isq ? Qb + (u.pn * 256 + 64 * wc) : Kb + 64 * wc; const int ld = isq ? 512 : 128;
#pragma unroll
                for (int ai = 0; ai < 2; ++ai)
#pragma unroll
                    for (int m = 0; m < 4; ++m) { const int row = rowb + ai * HALF + m * 16; float ss = 0.f;
#pragma unroll
                        for (int bj = 0; bj < 2; ++bj)
#pragma unroll
                            for (int n = 0; n < 2; ++n) { const f32x4 v = acc[ai][bj][m][n]; ss += (v[0] * v[0] + v[1] * v[1]) + (v[2] * v[2] + v[3] * v[3]); }
                        ss += __shfl_xor(ss, 16); ss += __shfl_xor(ss, 32);
                        const float r = __builtin_amdgcn_rsqf(ss * (1.f / 64.f) + 1e-6f);
#pragma unroll
                        for (int bj = 0; bj < 2; ++bj) *(u32x4*)(dst + (size_t)row * ld + 32 * bj + 8 * fq) = pack8(acc[ai][bj][m][0] * r * gv[bj][0], acc[ai][bj][m][1] * r * gv[bj][1]); }
            } else {
                const int hk = wc - 2;
#pragma unroll
                for (int ai = 0; ai < 2; ++ai)
#pragma unroll
                    for (int m = 0; m < 4; ++m) { const int row = rowb + ai * HALF + m * 16;
                        if (row < M_ALL) { int b, kx; if (row < M_REAL) { b = row >> 11; kx = NMETA + (row & 2047); } else { b = (row - M_REAL) >> 4; kx = (row - M_REAL) & 15; }
                            bf16_t* base = VT + (size_t)(b * 2 + hk) * 64 * VT_PITCH + kx;
#pragma unroll
                            for (int bj = 0; bj < 2; ++bj)
#pragma unroll
                                for (int n = 0; n < 2; ++n)
#pragma unroll
                                    for (int e = 0; e < 4; ++e) base[(size_t)(32 * bj + 8 * fq + 4 * n + e) * VT_PITCH] = (bf16_t)f2bf(acc[ai][bj][m][n][e]); } }
            }
        } else {
            const int col = (u.pn - 3) * 128 + 32 * wc + 8 * fq;
#pragma unroll
            for (int ai = 0; ai < 2; ++ai)
#pragma unroll
                for (int m = 0; m < 4; ++m) { const int row = rowb + ai * HALF + m * 16; f32x4 h[2];
#pragma unroll
                    for (int n = 0; n < 2; ++n)
#pragma unroll
                        for (int e = 0; e < 4; ++e) h[n][e] = acc[ai][0][m][n][e] * sigmoidf_fast(acc[ai][1][m][n][e]);
                    *(u32x4*)(HC + (size_t)row * 512 + col) = pack8(h[0], h[1]); }
        }
    }
};
struct EpiGU {
    bf16_t* ACT; const float* lrstd; const float* bgu;
    __device__ __forceinline__ void operator()(const f32x4 (&acc)[2][2][4][2], const Unit& u, int wr, int wc, int fr, int fq) const {
        const int lr0 = wr * 64 + fr, col = u.pn * 128 + 32 * wc + 8 * fq;
        f32x4 bg[2], bu[2];
#pragma unroll
        for (int n = 0; n < 2; ++n) { bg[n] = *(const f32x4*)(bgu + u.e * 2048 + col + 4 * n); bu[n] = *(const f32x4*)(bgu + u.e * 2048 + 1024 + col + 4 * n); }
        const float* rs = lrstd + u.e * CAP + u.slot0;
#pragma unroll
        for (int ai = 0; ai < 2; ++ai)
#pragma unroll
            for (int m = 0; m < 4; ++m) { if (ai == 1 && u.nvalid <= HALF) continue; const int lr = lr0 + ai * HALF + m * 16; const float rstd = lr < u.nvalid ? rs[lr] : 0.f; f32x4 h[2];
#pragma unroll
                for (int n = 0; n < 2; ++n)
#pragma unroll
                    for (int e = 0; e < 4; ++e) { float gt = acc[ai][0][m][n][e] * rstd + bg[n][e], up = acc[ai][1][m][n][e] * rstd + bu[n][e];
                        gt = fminf(gt, 7.f); up = fminf(fmaxf(up, -7.f), 7.f); h[n][e] = gt * sigmoidf_fast(1.702f * gt) * (up + 1.f); }
                *(u32x4*)(ACT + (size_t)(u.pm * BM + u.r0 + lr) * D + col) = pack8(h[0], h[1]); }
    }
};
struct EpiDown {
    bf16_t* Y; const float* lgate; const float* bd;
    __device__ __forceinline__ void operator()(const f32x4 (&acc)[2][2][4][2], const Unit& u, int wr, int wc, int fr, int fq) const {
        const int lr0 = wr * 64 + fr, col0 = u.pn * BM + wc * 32 + 8 * fq;
        f32x4 bv[2][2];
#pragma unroll
        for (int bj = 0; bj < 2; ++bj)
#pragma unroll
            for (int n = 0; n < 2; ++n) bv[bj][n] = *(const f32x4*)(bd + u.e * D + col0 + bj * HALF + 4 * n);
        const float* gs = lgate + u.e * CAP + u.slot0;
#pragma unroll
        for (int ai = 0; ai < 2; ++ai)
#pragma unroll
            for (int m = 0; m < 4; ++m) { if (ai == 1 && u.nvalid <= HALF) continue; const int lr = lr0 + ai * HALF + m * 16; const float gt = lr < u.nvalid ? gs[lr] : 0.f;
#pragma unroll
                for (int bj = 0; bj < 2; ++bj) *(u32x4*)(Y + (size_t)(u.pm * BM + u.r0 + lr) * D + col0 + bj * HALF) = pack8((acc[ai][bj][m][0] + bv[bj][0]) * gt, (acc[ai][bj][m][1] + bv[bj][1]) * gt); }
    }
};
}


constexpr int ATT_KIMG = 0, ATT_VIMG = 53248, ATT_VP = 840;
constexpr float ATT_THR = 4.0f;
template <int MODE>
__device__ __forceinline__ void att_tile(const LAS unsigned char* kbase, const int (&koff)[4], const LAS unsigned char* vbase, const bf16x8 (&qf)[4], float slope2, float Bq,
                                         float& m, float& l, f32x16& O0, f32x16& O1) {
    f32x16 s;
#pragma unroll
    for (int r = 0; r < 16; ++r) s[r] = 0.f;
#pragma unroll
    for (int ks = 0; ks < 4; ++ks) { const bf16x8 kf = *(const LAS bf16x8*)(kbase + koff[ks]); s = __builtin_amdgcn_mfma_f32_32x32x16_bf16(kf, qf[ks], s, 0, 0, 0); }
    float tmax = -INFINITY;
#pragma unroll
    for (int r = 0; r < 16; ++r) {
        if (MODE == 0) { if (r >= 8) s[r] = -INFINITY; }
        else { const float dl = fabsf(Bq - (float)((r & 3) + 8 * (r >> 2))); float v = s[r] - slope2 * dl; if (MODE == 2) v = dl <= 128.f ? v : -INFINITY; s[r] = v; }
        tmax = fmaxf(tmax, s[r]);
    }
    tmax = fmaxf(tmax, __shfl_xor(tmax, 32));
    if (__any(tmax > m + ATT_THR)) { const float mn = fmaxf(m, tmax); const float al = __builtin_amdgcn_exp2f(m - mn); m = mn; l *= al;
#pragma unroll
        for (int r = 0; r < 16; ++r) { O0[r] *= al; O1[r] *= al; } }
    float ps = 0.f;
#pragma unroll
    for (int r = 0; r < 16; ++r) { s[r] = __builtin_amdgcn_exp2f(s[r] - m); ps += s[r]; }
    l += ps;
#pragma unroll
    for (int s2 = 0; s2 < 2; ++s2) {
        u32x4 pw; pw.x = pg8::cvt_pk_bf16(s[8 * s2 + 0], s[8 * s2 + 1]); pw.y = pg8::cvt_pk_bf16(s[8 * s2 + 2], s[8 * s2 + 3]); pw.z = pg8::cvt_pk_bf16(s[8 * s2 + 4], s[8 * s2 + 5]); pw.w = pg8::cvt_pk_bf16(s[8 * s2 + 6], s[8 * s2 + 7]);
        const bf16x8 pf = __builtin_bit_cast(bf16x8, pw);
        { const u32x2 lo = *(const LAS u32x2*)(vbase + s2 * 32), hi = *(const LAS u32x2*)(vbase + s2 * 32 + 16); const u32x4 vw = {lo.x, lo.y, hi.x, hi.y};
          O0 = __builtin_amdgcn_mfma_f32_32x32x16_bf16(__builtin_bit_cast(bf16x8, vw), pf, O0, 0, 0, 0); }
        { const u32x2 lo = *(const LAS u32x2*)(vbase + 32 * ATT_VP + s2 * 32), hi = *(const LAS u32x2*)(vbase + 32 * ATT_VP + s2 * 32 + 16); const u32x4 vw = {lo.x, lo.y, hi.x, hi.y};
          O1 = __builtin_amdgcn_mfma_f32_32x32x16_bf16(__builtin_bit_cast(bf16x8, vw), pf, O1, 0, 0, 0); }
    }
}
__device__ __forceinline__ void att_fast(Frame& F) {
    LAS unsigned char* Kimg = F.lds + ATT_KIMG; LAS unsigned char* Vimg = F.lds + ATT_VIMG;
    const int tid = F.tid, lane = F.lane, wid = F.wave, q = lane & 31, h = lane >> 5, qt = wid & 3, hsel = wid >> 2;
    int koff[4];
#pragma unroll
    for (int ks = 0; ks < 4; ++ks) koff[ks] = ((2 * ks + h) ^ ((q >> 1) & 7)) << 4;
    for (int item = F.bid; item < NB * 16 * 2; item += F.G) {
        const int hk = item & 1, i = (item >> 1) & 15, b = item >> 5;
        __syncthreads();
        for (int idx = tid; idx < 416 * 8; idx += NTHR) { const int kr = idx >> 3, c = idx & 7; if (kr >= 16 && kr < 32) continue;
            int row; if (kr < 16) row = M_REAL + b * NMETA + kr; else { const int pos = (i - 1) * 128 + kr - 32; if (pos < 0 || pos >= SEQ) continue; row = b * SEQ + pos; }
            const u32x4 v = *(const GAS u32x4*)(F.Kb + (size_t)row * 128 + hk * 64 + 8 * c);
            *(LAS u32x4*)(Kimg + kr * 128 + ((c ^ ((kr >> 1) & 7)) << 4)) = v; }
        for (int idx = tid; idx < 64 * 52; idx += NTHR) { const int d = idx / 52, c = idx % 52; const bf16_t* vrow = F.VT + (size_t)((b * 2 + hk) * 64 + d) * VT_PITCH;
            LAS u32x2* dst; const bf16_t* src;
            if (c < 2) { src = vrow + 8 * c; dst = (LAS u32x2*)(Vimg + d * ATT_VP + 16 * c); }
            else if (c < 4) { dst = (LAS u32x2*)(Vimg + d * ATT_VP + 32 + 16 * (c - 2)); dst[0] = (u32x2){0u, 0u}; dst[1] = (u32x2){0u, 0u}; continue; }
            else { const int cc = c - 4, blk = cc >> 4, w = cc & 15, pos0 = (i - 1 + blk) * 128; if (pos0 < 0 || pos0 >= SEQ) continue; src = vrow + NMETA + pos0 + 8 * w; dst = (LAS u32x2*)(Vimg + d * ATT_VP + (32 + blk * 128 + 8 * w) * 2); }
            const u32x4 v = *(const GAS u32x4*)src; dst[0] = (u32x2){v.x, v.y}; dst[1] = (u32x2){v.z, v.w}; }
        __syncthreads();
#pragma unroll 1
        for (int hp = 0; hp < 2; ++hp) {
            const int head = hk * 4 + hp * 2 + hsel, row = b * SEQ + i * 128 + 32 * qt + q;
            bf16x8 qf[4];
#pragma unroll
            for (int ks = 0; ks < 4; ++ks) qf[ks] = *(const GAS bf16x8*)(F.Qb + (size_t)row * 512 + head * 64 + 16 * ks + 8 * h);
            const float slope2 = exp2f(-(float)(head + 1)) * LOG2E;
            float m = F.sink[head] * LOG2E, l = h == 0 ? 1.f : 0.f;
            f32x16 O0, O1;
#pragma unroll
            for (int r = 0; r < 16; ++r) { O0[r] = 0.f; O1[r] = 0.f; }
            const LAS unsigned char* kb0 = Kimg + q * 128; const LAS unsigned char* vb0 = Vimg + q * ATT_VP + 8 * h;
            att_tile<0>(kb0, koff, vb0, qf, 0.f, 0.f, m, l, O0, O1);
#pragma unroll 1
            for (int kt = qt; kt <= qt + 8; ++kt) { const int blk = kt >> 2; if ((i == 0 && blk == 0) || (i == 15 && blk == 2)) continue;
                const int kr0 = 32 + 32 * kt; const float Bq = (float)(128 + 32 * (qt - kt) + q - 4 * h);
                if (kt == qt || kt == qt + 8) att_tile<2>(kb0 + kr0 * 128, koff, vb0 + kr0 * 2, qf, slope2, Bq, m, l, O0, O1);
                else att_tile<1>(kb0 + kr0 * 128, koff, vb0 + kr0 * 2, qf, slope2, Bq, m, l, O0, O1); }
            l += __shfl_xor(l, 32); const float inv = 1.f / l;
            bf16_t* orow = F.MIX + (size_t)row * D + head * 64 + 4 * h;
#pragma unroll
            for (int g = 0; g < 4; ++g) { *(GAS u32x2*)(orow + 8 * g) = (u32x2){pg8::cvt_pk_bf16(O0[4 * g] * inv, O0[4 * g + 1] * inv), pg8::cvt_pk_bf16(O0[4 * g + 2] * inv, O0[4 * g + 3] * inv)};
                *(GAS u32x2*)(orow + 32 + 8 * g) = (u32x2){pg8::cvt_pk_bf16(O1[4 * g] * inv, O1[4 * g + 1] * inv), pg8::cvt_pk_bf16(O1[4 * g + 2] * inv, O1[4 * g + 3] * inv)}; }
        }
    }
    __syncthreads();
}
__device__ __forceinline__ void conv_fast(Frame& F) {
    const int tid = F.tid, lane = F.lane, wid = F.wave, c2 = tid & 255, th = tid >> 8;
    LAS float* cout = (LAS float*)F.lds;
    float w0[CONV_K], w1[CONV_K];
#pragma unroll
    for (int j = 0; j < CONV_K; ++j) { const f32x2 w = *(const f32x2*)(F.dw_w + j * CONV_W + 2 * c2); w0[j] = w.x; w1[j] = w.y; }
    const f32x2 bias = *(const f32x2*)(F.dw_b + 2 * c2);
    for (int item = F.bid; item < NB * 64; item += F.G) {
        const int b = item >> 6, t0 = (item & 63) * 32;
        unsigned xin[46];
        const int s0 = NMETA + t0 + 16 * th - 15;
#pragma unroll
        for (int jj = 0; jj < 46; ++jj) { const int sq = s0 + jj; xin[jj] = sq < LSEQ ? *(const GAS unsigned*)(F.HC + (size_t)row_of(b, sq) * 512 + 2 * c2) : 0u; }
        __syncthreads();
#pragma unroll
        for (int t = 0; t < 16; ++t) { float a0 = bias.x, a1 = bias.y;
#pragma unroll
            for (int j = 0; j < CONV_K; ++j) { a0 += w0[j] * bflo(xin[t + j]); a1 += w1[j] * bfhi(xin[t + j]); }
            *(LAS f32x2*)(cout + (16 * th + t) * 512 + 2 * c2) = (f32x2){a0, a1}; }
        __syncthreads();
#pragma unroll 1
        for (int tt = 0; tt < 4; ++tt) { const int t = 4 * wid + tt; const LAS f32x4* rp = (const LAS f32x4*)(cout + t * 512 + 8 * lane); const f32x4 x0 = rp[0], x1 = rp[1];
            const float mu = wave_sum((x0[0] + x0[1]) + (x0[2] + x0[3]) + (x1[0] + x1[1]) + (x1[2] + x1[3])) * (1.f / 512.f);
            const f32x4 d0 = x0 - mu, d1 = x1 - mu;
            const float var = wave_sum((d0[0] * d0[0] + d0[1] * d0[1]) + (d0[2] * d0[2] + d0[3] * d0[3]) + (d1[0] * d1[0] + d1[1] * d1[1]) + (d1[2] * d1[2] + d1[3] * d1[3])) * (1.f / 512.f);
            const float rstd = __builtin_amdgcn_rsqf(var + 1e-5f);
            const f32x4 g0 = *(const f32x4*)(F.lng + 8 * lane), g1 = *(const f32x4*)(F.lng + 8 * lane + 4), b0 = *(const f32x4*)(F.lnb + 8 * lane), b1 = *(const f32x4*)(F.lnb + 8 * lane + 4);
            f32x4 y0 = d0 * rstd * g0 + b0, y1 = d1 * rstd * g1 + b1;
#pragma unroll
            for (int e = 0; e < 4; ++e) { y0[e] *= sigmoidf_fast(y0[e]); y1[e] *= sigmoidf_fast(y1[e]); }
            *(GAS u32x4*)(F.MIX + (size_t)(b * SEQ + t0 + t) * D + 512 + 8 * lane) = pg8::pack8(y0, y1); }
    }
    __syncthreads();
}
__device__ __forceinline__ void p4_fast(Frame& F) {
    LAS int* lcnt = (LAS int*)(F.lds + LX_LCNT); LAS int* gbase = (LAS int*)(F.lds + LX_GBASE);
    const int tid = F.tid, lane = F.lane, wid = F.wave, j = lane & 31, h = lane >> 5;
    for (int base = 0; base < M_REAL / 32; base += F.G * NWAVES) {
        const int tile = base + F.bid + F.G * wid; const bool active = tile < M_REAL / 32;
        if (tid < NE) lcnt[tid] = 0;
        __syncthreads();
        int ea = 0, eb = 0, sa = 0, sb = 0, tok = 0; float ga = 0.f, gb = 0.f, rstd = 0.f;
        if (active) {
            tok = tile * 32 + j;
            const bf16_t* xa = F.XN2 + (size_t)tok * D + 8 * h; const bf16_t* wa = F.WrT + (size_t)j * D + 8 * h;
            f32x16 acc;
#pragma unroll
            for (int r = 0; r < 16; ++r) acc[r] = 0.f;
            float ssq = 0.f;
#pragma unroll 8
            for (int ks = 0; ks < 64; ++ks) { const u32x4 xb = *(const GAS u32x4*)(xa + 16 * ks); const bf16x8 wf = *(const GAS bf16x8*)(wa + 16 * ks);
                acc = __builtin_amdgcn_mfma_f32_32x32x16_bf16(wf, __builtin_bit_cast(bf16x8, xb), acc, 0, 0, 0);
                ssq += (bflo(xb.x) * bflo(xb.x) + bfhi(xb.x) * bfhi(xb.x)) + (bflo(xb.y) * bflo(xb.y) + bfhi(xb.y) * bfhi(xb.y)) + (bflo(xb.z) * bflo(xb.z) + bfhi(xb.z) * bfhi(xb.z)) + (bflo(xb.w) * bflo(xb.w) + bfhi(xb.w) * bfhi(xb.w)); }
            ssq += __shfl_xor(ssq, 32);
            rstd = 1.f / sqrtf(ssq * (1.f / D) + 1e-6f);
            float lg[16];
#pragma unroll
            for (int r = 0; r < 16; ++r) lg[r] = acc[r] * rstd + F.rb[(r & 3) + 8 * (r >> 2) + 4 * h];
            float tv[4]; int te[4];
#pragma unroll
            for (int kk = 0; kk < 4; ++kk) { float bv = -INFINITY; int be = 0;
#pragma unroll
                for (int r = 0; r < 16; ++r) { const int er = (r & 3) + 8 * (r >> 2) + 4 * h; if (lg[r] > bv) { bv = lg[r]; be = er; } }
                const float pv = __shfl_xor(bv, 32); const int pe = __shfl_xor(be, 32);
                if (pv > bv || (pv == bv && pe < be)) { bv = pv; be = pe; }
#pragma unroll
                for (int r = 0; r < 16; ++r) { const int er = (r & 3) + 8 * (r >> 2) + 4 * h; if (er == be) lg[r] = -INFINITY; }
                tv[kk] = bv; te[kk] = be; }
            const float p1 = __expf(tv[1] - tv[0]), p2 = __expf(tv[2] - tv[0]), p3 = __expf(tv[3] - tv[0]); const float inv = 1.f / (1.f + p1 + p2 + p3);
            ea = h ? te[2] : te[0]; eb = h ? te[3] : te[1]; ga = (h ? p2 : 1.f) * inv; gb = (h ? p3 : p1) * inv;
            sa = __hip_atomic_fetch_add(lcnt + ea, 1, __ATOMIC_RELAXED, __HIP_MEMORY_SCOPE_WORKGROUP); sb = __hip_atomic_fetch_add(lcnt + eb, 1, __ATOMIC_RELAXED, __HIP_MEMORY_SCOPE_WORKGROUP);
        }
        __syncthreads();
        if (tid < NE) gbase[tid] = (int)__hip_atomic_fetch_add((unsigned*)(F.ctl + CW_CNT + tid), (unsigned)lcnt[tid], RLX_AGENT);
        __syncthreads();
        if (active) {
            sa += gbase[ea]; sb += gbase[eb];
            F.ltok[ea * CAP + sa] = tok; F.lgate[ea * CAP + sa] = ga; F.lrstd[ea * CAP + sa] = rstd; F.where[tok * 4 + 2 * h] = ea * CAP + sa;
            F.ltok[eb * CAP + sb] = tok; F.lgate[eb * CAP + sb] = gb; F.lrstd[eb * CAP + sb] = rstd; F.where[tok * 4 + 2 * h + 1] = eb * CAP + sb;
        }
        __syncthreads();
    }
}

__device__ __forceinline__ void p1_naive(Frame& F) {
    const int gw = F.bid * NWAVES + F.wave, NGW = F.G * NWAVES, lane = F.lane;
    for (int it = gw; it < M_ALL * 20; it += NGW) {
        const int row = it / 20, grp = it % 20;
        const bf16_t* xr = F.XN + (size_t)row * D;
        if (grp < 12) {
            const int col = grp * 64 + lane; float acc = 0.f;
            _Pragma("unroll 4") for (int k = 0; k < D; ++k) acc += bf2f(xr[k]) * F.w_in[(size_t)k * IN_W + col];
            if (grp < 10) {
                const float ssq = wave_sum(acc * acc); const float r = 1.f / sqrtf(ssq * (1.f / 64.f) + 1e-6f);
                if (grp < 8) F.Qb[(size_t)row * 512 + col] = (bf16_t)f2bf(acc * r * F.qg[lane] * QSCALE);
                else F.Kb[(size_t)row * 128 + (col - 512)] = (bf16_t)f2bf(acc * r * F.kg[lane]);
            } else {
                const int hk = grp - 10; int b, kx;
                if (row < M_REAL) { b = row >> 11; kx = NMETA + (row & 2047); } else { b = (row - M_REAL) >> 4; kx = (row - M_REAL) & 15; }
                F.VT[((size_t)(b * 2 + hk) * 64 + lane) * VT_PITCH + kx] = (bf16_t)f2bf(acc);
            }
        } else {
            const int c = (grp - 12) * 64 + lane; float a = 0.f, g = 0.f;
            for (int k = 0; k < D; ++k) { const float xv = bf2f(xr[k]); a += xv * F.w_in[(size_t)k * IN_W + 768 + c]; g += xv * F.w_in[(size_t)k * IN_W + 1280 + c]; }
            F.HC[(size_t)row * 512 + c] = (bf16_t)f2bf(a * sigmoidf_fast(g));
        }
    }
}
__device__ __forceinline__ void att_naive(Frame& F) {
    const int gw = F.bid * NWAVES + F.wave, NGW = F.G * NWAVES, lane = F.lane;
    for (int it = gw; it < M_REAL * NQH; it += NGW) {
        const int row = it >> 3, h = it & 7, hk = h >> 2, b = row >> 11, qp = row & 2047;
        const float q = bf2f(F.Qb[(size_t)row * 512 + h * 64 + lane]);
        const float slope2 = exp2f(-(float)(h + 1)) * LOG2E;
        float m = F.sink[h] * LOG2E, l = 1.f, acc = 0.f;
        const bf16_t* vt = F.VT + ((size_t)(b * 2 + hk) * 64 + lane) * VT_PITCH;
        for (int j = 0; j < NMETA; ++j) {
            const float kv = bf2f(F.Kb[(size_t)(M_REAL + b * NMETA + j) * 128 + hk * 64 + lane]);
            const float s = wave_sum(q * kv);
            const float mn = fmaxf(m, s), al = exp2f(m - mn), p = exp2f(s - mn);
            l = l * al + p; acc = acc * al + p * bf2f(vt[j]); m = mn;
        }
        const int k0 = qp - 128 < 0 ? 0 : qp - 128, k1 = qp + 128 > SEQ - 1 ? SEQ - 1 : qp + 128;
        for (int kp = k0; kp <= k1; ++kp) {
            const float kv = bf2f(F.Kb[(size_t)(b * SEQ + kp) * 128 + hk * 64 + lane]);
            const float dist = (float)(qp > kp ? qp - kp : kp - qp);
            const float s = wave_sum(q * kv) - slope2 * dist;
            const float mn = fmaxf(m, s), al = exp2f(m - mn), p = exp2f(s - mn);
            l = l * al + p; acc = acc * al + p * bf2f(vt[NMETA + kp]); m = mn;
        }
        F.MIX[(size_t)row * D + h * 64 + lane] = (bf16_t)f2bf(acc / l);
    }
}
__device__ __forceinline__ void conv_naive(Frame& F) {
    const int gw = F.bid * NWAVES + F.wave, NGW = F.G * NWAVES, lane = F.lane;
    for (int row = gw; row < M_REAL; row += NGW) {
        const int b = row >> 11, s0 = NMETA + (row & 2047);
        float v[8]; float sum = 0.f;
#pragma unroll
        for (int j = 0; j < 8; ++j) { const int c = lane + 64 * j; float a = F.dw_b[c];
            _Pragma("unroll 1") for (int t = 0; t < CONV_K; ++t) { const int s = s0 - 15 + t; if (s >= 0 && s < LSEQ) a += F.dw_w[t * CONV_W + c] * bf2f(F.HC[(size_t)row_of(b, s) * 512 + c]); }
            v[j] = a; sum += a; }
        const float mu = wave_sum(sum) * (1.f / 512.f); float q = 0.f;
#pragma unroll
        for (int j = 0; j < 8; ++j) { const float d = v[j] - mu; q += d * d; }
        const float rstd = 1.f / sqrtf(wave_sum(q) * (1.f / 512.f) + 1e-5f);
#pragma unroll
        for (int j = 0; j < 8; ++j) { const int c = lane + 64 * j; const float y = (v[j] - mu) * rstd * F.lng[c] + F.lnb[c];
            F.MIX[(size_t)row * D + 512 + c] = (bf16_t)f2bf(y * sigmoidf_fast(y)); }
    }
}
__device__ __forceinline__ void p3_naive(Frame& F) {
    const int gw = F.bid * NWAVES + F.wave, NGW = F.G * NWAVES, lane = F.lane;
    for (int it = gw; it < M_REAL * 16; it += NGW) {
        const int row = it >> 4, col = (it & 15) * 64 + lane; const bf16_t* mr = F.MIX + (size_t)row * D; float acc = 0.f;
        for (int k = 0; k < D; ++k) acc += bf2f(mr[k]) * F.w_out[(size_t)k * D + col];
        const float h2 = F.x[(size_t)row * D + col] + acc;
        F.out[(size_t)row * D + col] = h2; F.XN2[(size_t)row * D + col] = (bf16_t)f2bf(h2);
    }
}
__device__ __forceinline__ void p4_naive(Frame& F) {
    const int gw = F.bid * NWAVES + F.wave, NGW = F.G * NWAVES, lane = F.lane, e = lane & 31;
    for (int t = gw; t < M_REAL; t += NGW) {
        const bf16_t* xr = F.XN2 + (size_t)t * D; float acc = 0.f, ss = 0.f;
        for (int k = 0; k < D; ++k) { const float xv = bf2f(xr[k]); acc += xv * F.n2g[k] * F.wr[k * NE + e]; ss += xv * xv; }
        const float rstd = 1.f / sqrtf(ss * (1.f / D) + 1e-6f);
        float lg = acc * rstd + F.rb[e];
        float tv[4]; int te[4];
#pragma unroll
        for (int kk = 0; kk < 4; ++kk) {
            float bv = lg; int be = e;
#pragma unroll
            for (int o = 1; o < 32; o <<= 1) { const float pv = __shfl_xor(bv, o); const int pe = __shfl_xor(be, o); if (pv > bv || (pv == bv && pe < be)) { bv = pv; be = pe; } }
            tv[kk] = bv; te[kk] = be; if (e == be) lg = -INFINITY;
        }
        float p[4], ps = 0.f;
#pragma unroll
        for (int kk = 0; kk < 4; ++kk) { p[kk] = __expf(tv[kk] - tv[0]); ps += p[kk]; }
        if (lane < 4) {
            const int ee = lane == 0 ? te[0] : lane == 1 ? te[1] : lane == 2 ? te[2] : te[3];
            const float gg = (lane == 0 ? p[0] : lane == 1 ? p[1] : lane == 2 ? p[2] : p[3]) / ps;
            const unsigned slot = __hip_atomic_fetch_add((unsigned*)(F.ctl + CW_CNT + ee), 1u, RLX_AGENT);
            F.ltok[ee * CAP + slot] = t; F.lgate[ee * CAP + slot] = gg; F.lrstd[ee * CAP + slot] = rstd; F.where[t * 4 + lane] = ee * CAP + (int)slot;
        }
    }
}
__device__ __forceinline__ void build_tile_table(Frame& F) {
    LAS int* tb = (LAS int*)(F.lds + LX_TB); LAS int* cn = (LAS int*)(F.lds + LX_CNT);
    __syncthreads();
    if (F.tid == 0) { int acc = 0; for (int e = 0; e < NE; ++e) { int c = (int)__hip_atomic_load(F.ctl + CW_CNT + e, RLX_AGENT); if (c > CAP) c = CAP; if (c < 0) c = 0; cn[e] = c; tb[e] = acc; acc += (c + 255) >> 8; } tb[NE] = acc; }
    __syncthreads();
}
__device__ __forceinline__ int find_expert(const LAS int* tb, int tile) { int e = 0;
#pragma unroll 1
    for (int j = 1; j < NE; ++j) if (tb[j] <= tile) e = j;
    return e; }
__device__ __forceinline__ void p5_naive(Frame& F) {
    build_tile_table(F);
    const LAS int* tb = (const LAS int*)(F.lds + LX_TB); const LAS int* cn = (const LAS int*)(F.lds + LX_CNT);
    const int gw = F.bid * NWAVES + F.wave, NGW = F.G * NWAVES, lane = F.lane, total = tb[NE] * 256;
    for (int it = gw; it < total * 16; it += NGW) {
        const int sr = it >> 4, c = (it & 15) * 64 + lane, e = find_expert(tb, sr >> 8), slot = sr - tb[e] * 256;
        if (slot >= cn[e]) continue;
        const int tok = F.ltok[e * CAP + slot]; const float rstd = F.lrstd[e * CAP + slot];
        const bf16_t* xr = F.XN2 + (size_t)tok * D; const float* W = F.wgu + (size_t)e * D * 2048; float g = 0.f, u = 0.f;
        for (int k = 0; k < D; ++k) { const float xv = bf2f(xr[k]) * F.n2g[k]; g += xv * W[(size_t)k * 2048 + c]; u += xv * W[(size_t)k * 2048 + 1024 + c]; }
        g = g * rstd + F.bgu[e * 2048 + c]; u = u * rstd + F.bgu[e * 2048 + 1024 + c];
        g = fminf(g, 7.f); u = fminf(fmaxf(u, -7.f), 7.f);
        F.ACT[(size_t)sr * D + c] = (bf16_t)f2bf(g * sigmoidf_fast(1.702f * g) * (u + 1.f));
    }
}
__device__ __forceinline__ void p6_naive(Frame& F) {
    build_tile_table(F);
    const LAS int* tb = (const LAS int*)(F.lds + LX_TB); const LAS int* cn = (const LAS int*)(F.lds + LX_CNT);
    const int gw = F.bid * NWAVES + F.wave, NGW = F.G * NWAVES, lane = F.lane, total = tb[NE] * 256;
    for (int it = gw; it < total * 16; it += NGW) {
        const int sr = it >> 4, c = (it & 15) * 64 + lane, e = find_expert(tb, sr >> 8), slot = sr - tb[e] * 256;
        if (slot >= cn[e]) continue;
        const bf16_t* ar = F.ACT + (size_t)sr * D; const float* W = F.wd + (size_t)e * D * D; float acc = 0.f;
        for (int k = 0; k < D; ++k) acc += bf2f(ar[k]) * W[(size_t)k * D + c];
        F.Y[(size_t)sr * D + c] = (bf16_t)f2bf((acc + F.bd[e * D + c]) * F.lgate[e * CAP + slot]);
    }
}
__device__ __forceinline__ void p7_combine(Frame& F) {
    build_tile_table(F);
    const LAS int* tb = (const LAS int*)(F.lds + LX_TB);
    const int gw = F.bid * NWAVES + F.wave, NGW = F.G * NWAVES, lane = F.lane;
    typedef int i32x4 __attribute__((ext_vector_type(4)));
    const GAS i32x4* wh = (const GAS i32x4*)F.where;
    int t0 = gw, t1 = gw + NGW;
    i32x4 w0 = t0 < M_REAL ? wh[t0] : (i32x4){0, 0, 0, 0}, w1 = t1 < M_REAL ? wh[t1] : (i32x4){0, 0, 0, 0};
    while (t0 < M_REAL) {
        const int n0 = t0 + 2 * NGW, n1 = t1 + 2 * NGW;
        const i32x4 nw0 = n0 < M_REAL ? wh[n0] : (i32x4){0, 0, 0, 0}, nw1 = n1 < M_REAL ? wh[n1] : (i32x4){0, 0, 0, 0};
        const bool v1 = t1 < M_REAL; const int tt1 = v1 ? t1 : t0;
        u32x4 y[2][5][2];
#pragma unroll
        for (int u = 0; u < 2; ++u) { const int t = u ? tt1 : t0; const i32x4 w = u ? w1 : w0;
#pragma unroll
            for (int j = 0; j < 2; ++j) y[u][4][j] = *((const GAS u32x4*)(F.XN2 + (size_t)t * D + 512 * j) + lane);
#pragma unroll
            for (int k = 0; k < 4; ++k) { const int e = w[k] / CAP, slot = w[k] - e * CAP; const bf16_t* yr = F.Y + (size_t)(tb[e] * 256 + slot) * D;
#pragma unroll
                for (int j = 0; j < 2; ++j) y[u][k][j] = *((const GAS u32x4*)(yr + 512 * j) + lane); } }
#pragma unroll
        for (int u = 0; u < 2; ++u) { if (u && !v1) break; const int t = u ? tt1 : t0;
#pragma unroll
            for (int j = 0; j < 2; ++j) { f32x4 a0 = {0.f, 0.f, 0.f, 0.f}, a1 = a0;
#pragma unroll
                for (int k = 0; k < 5; ++k) { const u32x4 q = y[u][k][j]; a0 += (f32x4){bflo(q.x), bfhi(q.x), bflo(q.y), bfhi(q.y)}; a1 += (f32x4){bflo(q.z), bfhi(q.z), bflo(q.w), bfhi(q.w)}; }
                GAS f32x4* o = (GAS f32x4*)(F.out + (size_t)t * D + 512 * j) + 2 * lane; o[0] = a0; o[1] = a1; } }
        t0 = n0; t1 = n1; w0 = nw0; w1 = nw1;
    }
}

__global__ void __launch_bounds__(NTHR, 2) mega(Args args) {
    extern __shared__ __attribute__((aligned(16))) unsigned char lds_raw[];
    Frame F;
    F.lds = (LAS unsigned char*)lds_raw;
    F.tid = threadIdx.x; F.lane = F.tid & 63; F.wave = __builtin_amdgcn_readfirstlane(F.tid >> 6); F.G = gridDim.x; F.bid = blockIdx.x;
    F.x = args.in[0]; F.meta = args.in[1]; F.n1g = args.in[2]; F.w_in = args.in[3]; F.qg = args.in[4]; F.kg = args.in[5]; F.sink = args.in[6];
    F.dw_w = args.in[7]; F.dw_b = args.in[8]; F.lng = args.in[9]; F.lnb = args.in[10]; F.w_out = args.in[11]; F.n2g = args.in[12];
    F.wr = args.in[13]; F.rb = args.in[14]; F.wgu = args.in[15]; F.bgu = args.in[16]; F.wd = args.in[17]; F.bd = args.in[18];
    F.out = args.out; F.ws = args.ws; unsigned char* ws = args.ws;
    F.ctl = (gu32*)(ws + WS_CTL);
    F.WinT = (bf16_t*)(ws + WS_WIN_T); F.WoT = (bf16_t*)(ws + WS_WO_T); F.WrT = (bf16_t*)(ws + WS_WR_T); F.WdT = (bf16_t*)(ws + WS_WD_T); F.WguT = (bf16_t*)(ws + WS_WGU_T);
    F.XN = (bf16_t*)(ws + WS_XN); F.Qb = (bf16_t*)(ws + WS_Q); F.Kb = (bf16_t*)(ws + WS_K); F.VT = (bf16_t*)(ws + WS_VT); F.HC = (bf16_t*)(ws + WS_HC);
    F.MIX = (bf16_t*)(ws + WS_MIX); F.XN2 = (bf16_t*)(ws + WS_XN2); F.ACT = (bf16_t*)(ws + WS_ACT); F.Y = (bf16_t*)(ws + WS_Y);
    F.where = (int*)(ws + WS_WHERE); F.ltok = (int*)(ws + WS_LTOK); F.lgate = (float*)(ws + WS_LGATE); F.lrstd = (float*)(ws + WS_LRSTD);
    for (int u = F.tid; u < (LDS_BYTES - RING_BYTES) / 4; u += NTHR) ((LAS unsigned*)(F.lds + RING_BYTES))[u] = 0u;
    __syncthreads();
    const int lo = args.ph_lo, hi = args.ph_hi;
    XcdBarrier bar; bar.bar = (unsigned*)(F.ctl + CW_BAR); bar.x = 0; bar.st = nullptr;
    if (hi - lo > 1) bar = xcd_barrier_post((unsigned*)(F.ctl + CW_BAR), (volatile LAS unsigned*)(F.lds + LX_BAR));
#ifndef PH_MASK
#define PH_MASK 0xFF
#endif
#define IN(k) (((PH_MASK >> (k)) & 1) && lo <= (k) && (k) < hi)
#define SEAM(k) do { if (IN(k) && IN((k) + 1)) xcd_barrier(bar); } while (0)
#ifndef REP_PH
#define REP_PH -1
#endif
#define REPS(k) _Pragma("unroll") for (int rep = 0; rep < ((REP_PH) == (k) ? 2 : 1); ++rep)
#define REPBAR() do { if (rep) xcd_barrier(bar); } while (0)
    if (IN(0)) { REPS(0) { REPBAR(); p0_prologue(F); } } SEAM(0);
    if (IN(1)) { REPS(1) { REPBAR();
#if FAST_P1
        pg8::DenseProb P{F.XN, F.WinT, M_PAD / 256, IN_W / 256, F.G, F.bid}; pg8::EpiIn E{F.Qb, F.Kb, F.VT, F.HC, F.qg, F.kg}; pg8::gemm_phase(F.lds, P, E);
#else
        p1_naive(F);
#endif
    } } SEAM(1);
    if (IN(2)) { REPS(2) { REPBAR();
#if FAST_ATT
        att_fast(F);
#else
        att_naive(F);
#endif
    } REPS(8) { REPBAR();
#if FAST_CONV
        conv_fast(F);
#else
        conv_naive(F);
#endif
    } } SEAM(2);
    if (IN(3)) { REPS(3) { REPBAR();
#if FAST_P3
        pg8::DenseProb P{F.MIX, F.WoT, M_REAL / 256, D / 256, F.G, F.bid}; pg8::EpiOut E{F.x, F.out, F.XN2}; pg8::gemm_phase(F.lds, P, E);
#else
        p3_naive(F);
#endif
    } } SEAM(3);
    if (IN(4)) {
#if FAST_P4
        p4_fast(F);
#else
        p4_naive(F);
#endif
    } SEAM(4);
    if (IN(5)) { REPS(5) { REPBAR();
#if FAST_P5
        build_tile_table(F); pg8::GroupedProb<true> P{F.XN2, F.WguT, F.ltok, (const LAS int*)(F.lds + LX_TB), (const LAS int*)(F.lds + LX_CNT), 8, F.G, F.bid};
        pg8::EpiGU E{F.ACT, F.lrstd, F.bgu}; pg8::gemm_phase(F.lds, P, E);
#else
        p5_naive(F);
#endif
    } } SEAM(5);
    if (IN(6)) { REPS(6) { REPBAR();
#if FAST_P6
        build_tile_table(F); pg8::GroupedProb<false> P{F.ACT, F.WdT, F.ltok, (const LAS int*)(F.lds + LX_TB), (const LAS int*)(F.lds + LX_CNT), 4, F.G, F.bid};
        pg8::EpiDown E{F.Y, F.lgate, F.bd}; pg8::gemm_phase(F.lds, P, E);
#else
        p6_naive(F);
#endif
    } } SEAM(6);
    if (IN(7)) { p7_combine(F); }
#undef IN
#undef SEAM
}

extern "C" void kernel_launch(void* const* d_in, const int* in_sizes, int n_in, void* d_out, int out_size, void* d_ws, size_t ws_size, hipStream_t stream) {
    static int grid = 0;
    if (grid == 0) {
        if (n_in != 19 || in_sizes[0] != M_REAL * D || out_size != M_REAL * D || ws_size < WS_END) {
            fprintf(stderr, "kernel_launch: unexpected shapes/workspace: n_in %d in0 %d out %d ws %zu (need %zu)\n", n_in, n_in > 0 ? in_sizes[0] : -1, out_size, ws_size, (size_t)WS_END); grid = -1; return; }
        int dev = 0, cus = 0, per_cu = 0;
        if (hipGetDevice(&dev) != hipSuccess || hipDeviceGetAttribute(&cus, hipDeviceAttributeMultiprocessorCount, dev) != hipSuccess) { grid = -1; return; }
        if (hipFuncSetAttribute((const void*)mega, hipFuncAttributeMaxDynamicSharedMemorySize, LDS_BYTES) != hipSuccess) { fprintf(stderr, "kernel_launch: hipFuncSetAttribute failed\n"); grid = -1; return; }
        if (hipOccupancyMaxActiveBlocksPerMultiprocessor(&per_cu, (const void*)mega, NTHR, LDS_BYTES) != hipSuccess || per_cu < 1) { fprintf(stderr, "kernel_launch: occupancy query says %d blocks/CU\n", per_cu); (void)hipGetLastError(); grid = -1; return; }
        grid = cus;
    }
    if (grid < 0) return;
    (void)hipMemsetAsync((char*)d_ws + WS_CTL, 0, CTL_ZERO_BYTES, stream);
    Args a{};
    for (int i = 0; i < 19; ++i) a.in[i] = (const float*)d_in[i];
    a.out = (float*)d_out; a.ws = (unsigned char*)d_ws;
#if MK_PER_PHASE
    for (int p = 0; p < 8; ++p) { a.ph_lo = p; a.ph_hi = p + 1; hipLaunchKernelGGL(mega, dim3(grid), dim3(NTHR), LDS_BYTES, stream, a); }
#else
    a.ph_lo = 0; a.ph_hi = 8; hipLaunchKernelGGL(mega, dim3(grid), dim3(NTHR), LDS_BYTES, stream, a);
#endif
}
```

```cpp
#include <hip/hip_runtime.h>
#include <cstdio>
#include <cstdint>

#ifndef MK_PER_PHASE
#define MK_PER_PHASE 0
#endif
#ifndef FAST_P1
#define FAST_P1 1
#endif
#ifndef FAST_ATT
#define FAST_ATT 1
#endif
#ifndef FAST_CONV
#define FAST_CONV 1
#endif
#ifndef FAST_P3
#define FAST_P3 1
#endif
#ifndef FAST_P4
#define FAST_P4 1
#endif
#ifndef FAST_P5
#define FAST_P5 1
#endif
#ifndef FAST_P6
#define FAST_P6 1
#endif

#define GAS __attribute__((address_space(1)))
#define LAS __attribute__((address_space(3)))
typedef unsigned short bf16_t;
typedef short bf16x8 __attribute__((ext_vector_type(8)));
typedef float f32x4 __attribute__((ext_vector_type(4)));
typedef float f32x16 __attribute__((ext_vector_type(16)));
typedef int i32x4 __attribute__((ext_vector_type(4)));
typedef int i32x8 __attribute__((ext_vector_type(8)));
typedef unsigned u32x4 __attribute__((ext_vector_type(4)));
typedef unsigned u32x2 __attribute__((ext_vector_type(2)));
typedef float f32x2 __attribute__((ext_vector_type(2)));
typedef GAS unsigned gu32;
#define RLX_AGENT __ATOMIC_RELAXED, __HIP_MEMORY_SCOPE_AGENT

constexpr int NB = 8, SEQ = 2048, D = 1024, NMETA = 16, LSEQ = NMETA + SEQ;
constexpr int M_REAL = NB * SEQ, M_ALL = NB * LSEQ, M_PAD = 16640;
constexpr int IN_W = 1792, HD = 64, NQH = 8, NKV = 2, CONV_W = 512, CONV_K = 31;
constexpr int NE = 32, CAP = 16384, ACT_ROWS = 4 * M_REAL + NE * 256;
constexpr float LOG2E = 1.4426950408889634f;
constexpr float QSCALE = 0.125f * LOG2E;
constexpr float WSCALE = 32.0f;
constexpr int VT_PITCH = LSEQ;

constexpr size_t MiB = 1u << 20;
constexpr size_t WS_CTL = 0, CTL_ZERO_BYTES = 1 * MiB;
constexpr size_t WS_WIN_T = 2 * MiB;
constexpr size_t WS_WO_T = 6 * MiB;
constexpr size_t WS_WR_T = 8 * MiB;
constexpr size_t WS_RSTD = 9 * MiB;
constexpr size_t WS_WHERE = 9 * MiB + 512 * 1024;
constexpr size_t WS_LTOK = 10 * MiB;
constexpr size_t WS_LGATE = 12 * MiB;
constexpr size_t WS_LRSTD = 14 * MiB;
constexpr size_t WS_WD_T = 16 * MiB;
constexpr size_t WS_WGU_T = 80 * MiB;
constexpr size_t WS_XN = 208 * MiB;
constexpr size_t WS_Q = 241 * MiB;
constexpr size_t WS_K = 258 * MiB;
constexpr size_t WS_VT = 263 * MiB;
constexpr size_t WS_HC = 268 * MiB;
constexpr size_t WS_MIX = 285 * MiB;
constexpr size_t WS_XN2 = 317 * MiB;
constexpr size_t WS_ACT = 349 * MiB;
constexpr size_t WS_Y = 493 * MiB;
constexpr size_t WS_XN2F8 = 637 * MiB;
constexpr size_t WS_END = 653 * MiB;
constexpr int CW_CNT = 64;
constexpr int CW_BAR = 4096;

constexpr int RING_BYTES = 131072;
constexpr int LX_BAR = RING_BYTES;
constexpr int LX_TB = RING_BYTES + 64;
constexpr int LX_CNT = RING_BYTES + 256;
constexpr int LX_LCNT = RING_BYTES + 512;
constexpr int LX_GBASE = RING_BYTES + 768;
constexpr int LDS_BYTES = 147456;

constexpr int NWAVES = 8, NTHR = 512;

__device__ __forceinline__ unsigned f2bf(float f) { unsigned u = __builtin_bit_cast(unsigned, f); return (u + 0x7fffu + ((u >> 16) & 1u)) >> 16; }
__device__ __forceinline__ unsigned pk2(float lo, float hi) { return f2bf(lo) | (f2bf(hi) << 16); }
__device__ __forceinline__ unsigned pk4_fp8(float a, float b, float c, float d) { int w = __builtin_amdgcn_cvt_pk_fp8_f32(a, b, 0, false); w = __builtin_amdgcn_cvt_pk_fp8_f32(c, d, w, true); return (unsigned)w; }
__device__ __forceinline__ float bf2f(unsigned b) { return __builtin_bit_cast(float, b << 16); }
__device__ __forceinline__ float bflo(unsigned w) { return __builtin_bit_cast(float, w << 16); }
__device__ __forceinline__ float bfhi(unsigned w) { return __builtin_bit_cast(float, w & 0xffff0000u); }
__device__ __forceinline__ float wave_sum(float v) {
#pragma unroll
    for (int o = 1; o < 64; o <<= 1) v += __shfl_xor(v, o);
    return v;
}
__device__ __forceinline__ float sigmoidf_fast(float x) { return __builtin_amdgcn_rcpf(1.0f + __builtin_amdgcn_exp2f(-x * LOG2E)); }
__device__ __forceinline__ int row_of(int b, int s) { return s < NMETA ? M_REAL + b * NMETA + s : b * SEQ + (s - NMETA); }

#define XB_TMO      128
#define XB_XCNT(j)  (256  + 64 * (j))
#define XB_XSUB(j)  (1280 + 64 * (j))
#define XB_XGEN(j)  (2304 + 64 * (j))
#define XB_TOP      3328
#define XB_TOPGEN   3392
#define XCD_BAR_WORDS 3456
#define XB_SPIN_CAP (1u << 18)
__device__ __forceinline__ unsigned xb_ld(unsigned* p)              { return __hip_atomic_load(p, __ATOMIC_RELAXED, __HIP_MEMORY_SCOPE_AGENT); }
__device__ __forceinline__ unsigned xb_add(unsigned* p, unsigned v) { return __hip_atomic_fetch_add(p, v, __ATOMIC_RELAXED, __HIP_MEMORY_SCOPE_AGENT); }
__device__ __forceinline__ unsigned xb_xcc_id() { return (unsigned)__builtin_amdgcn_s_getreg((3 << 11) | 20) & 0xFu; }
#define XB_SPIN(cond, bar) do { unsigned _sp = 0; while (cond) { __builtin_amdgcn_s_sleep(1); \
    if ((++_sp & 255u) == 0u) { if (xb_ld(&(bar)[XB_TMO])) break; if (_sp > XB_SPIN_CAP) { atomicAdd(&(bar)[XB_TMO], 1u); break; } } } } while (0)
struct XcdBarrier { unsigned* bar; unsigned x; volatile LAS unsigned* st; };
__device__ __forceinline__ XcdBarrier xcd_barrier_post(unsigned* bar, volatile LAS unsigned* st) {
    XcdBarrier b; b.bar = bar; b.x = xb_xcc_id(); b.st = st;
    if (threadIdx.x == 0) (void)xb_add(&bar[XB_XCNT(b.x)], 1u);
    return b;
}
__device__ __forceinline__ void xcd_barrier_complete(unsigned* bar, unsigned x, unsigned& nloc, unsigned& nx) {
    const unsigned G = gridDim.x * gridDim.y * gridDim.z;
    unsigned sum, cnt, mine, sp = 0u;
    for (;;) {
        sum = 0u; cnt = 0u; mine = 0u;
#pragma unroll
        for (unsigned j = 0; j < 16; ++j) { const unsigned c = xb_ld(&bar[XB_XCNT(j)]); sum += c; cnt += (c > 0u) ? 1u : 0u; mine = (j == x) ? c : mine; }
        if (sum == G) break;
        __builtin_amdgcn_s_sleep(1);
        if ((++sp & 255u) == 0u) { if (xb_ld(&bar[XB_TMO])) break; if (sp > XB_SPIN_CAP) { atomicAdd(&bar[XB_TMO], 1u); break; } }
    }
    nloc = mine > 0u ? mine : 1u; nx = cnt > 0u ? cnt : 1u;
}
__device__ __forceinline__ void xcd_barrier(const XcdBarrier& b) {
    asm volatile("s_waitcnt vmcnt(0)" ::: "memory");
    __syncthreads();
    if (threadIdx.x == 0) {
        unsigned* bar = b.bar;
        __builtin_amdgcn_s_waitcnt(0);
        unsigned nloc = b.st[0], nx = b.st[1];
        if (nloc == 0u) { xcd_barrier_complete(bar, b.x, nloc, nx); b.st[0] = nloc; b.st[1] = nx; }
        const unsigned old = xb_add(&bar[XB_XSUB(b.x)], 1u);
        const unsigned gen = old / nloc;
        if (old + 1u == (gen + 1u) * nloc) {
            __builtin_amdgcn_fence(__ATOMIC_RELEASE, "agent");
            asm volatile("s_waitcnt vmcnt(0)" ::: "memory");
            const unsigned og = xb_add(&bar[XB_TOP], 1u);
            const unsigned tg = og / nx;
            if (og + 1u == (tg + 1u) * nx) xb_add(&bar[XB_TOPGEN], 1u);
            else XB_SPIN(xb_ld(&bar[XB_TOPGEN]) == tg, bar);
            __builtin_amdgcn_fence(__ATOMIC_ACQUIRE, "agent");
            xb_add(&bar[XB_XGEN(b.x)], 1u);
            asm volatile("s_waitcnt vmcnt(0)" ::: "memory");
        } else {
            XB_SPIN(xb_ld(&bar[XB_XGEN(b.x)]) == gen, bar);
            __builtin_amdgcn_fence(__ATOMIC_ACQUIRE, "agent");
            asm volatile("s_waitcnt vmcnt(0)" ::: "memory");
        }
    }
    __syncthreads();
}

struct Args { const float* in[19]; float* out; unsigned char* ws; int ph_lo, ph_hi; };
struct Frame {
    LAS unsigned char* lds;
    int tid, lane, wave, G, bid;
    const float *x, *meta, *n1g, *w_in, *qg, *kg, *sink, *dw_w, *dw_b, *lng, *lnb, *w_out, *n2g, *wr, *rb, *wgu, *bgu, *wd, *bd;
    float* out;
    unsigned char* ws;
    gu32* ctl;
    unsigned char *WguT8, *XN2F8, *WdT8, *ACT8; bf16_t *WinT, *WoT, *WrT, *XN, *Qb, *Kb, *VT, *HC, *MIX, *XN2, *Y;
    int* where; int* ltok; float* lgate; float* lrstd;
};

__device__ __forceinline__ int perm32(int rho) { const int n = rho >> 4, i = rho & 15; return 8 * (i >> 2) + 4 * n + (i & 3); }
__device__ __forceinline__ int lbase_nat(int pg) { return 32 * pg; }
__device__ __forceinline__ int lbase_in(int pg) { const int tile = pg >> 3, bj = (pg >> 2) & 1, wc = pg & 3; return tile <= 2 ? tile * 256 + 64 * wc + 32 * bj : 768 + bj * 512 + (tile - 3) * 128 + 32 * wc; }
__device__ __forceinline__ int lbase_gu(int pg) { const int tile = pg >> 3, bj = (pg >> 2) & 1, wc = pg & 3; return bj * 1024 + tile * 128 + 32 * wc; }
struct P0Item { const float* W; void* WT; const float* g; int N, pg, n0, k0; bool permute; bool f8; };
__device__ __forceinline__ bool p0_decode(const Frame& F, int it, P0Item& I) {
    constexpr int I_IN = 16 * 56, I_O = 16 * 32, I_R = 16, I_GU = NE * 16 * 64, I_D = NE * 16 * 32;
    int r = it;
    if (r < I_IN) { const int pg = r % 56, kb = r / 56; I = P0Item{F.w_in, F.WinT, nullptr, IN_W, pg, lbase_in(pg), 64 * kb, true, false}; return true; } r -= I_IN;
    if (r < I_O) { const int pg = r % 32, kb = r / 32; I = P0Item{F.w_out, F.WoT, nullptr, D, pg, lbase_nat(pg), 64 * kb, true, false}; return true; } r -= I_O;
    if (r < I_R) { I = P0Item{F.wr, F.WrT, F.n2g, NE, 0, 0, 64 * r, false, false}; return true; } r -= I_R;
    if (r < I_GU) { const int e = r / (16 * 64), q = r % (16 * 64), pg = q % 64, kb = q / 64; I = P0Item{F.wgu + (size_t)e * D * 2048, F.WguT8 + (size_t)e * 2048 * D, F.n2g, 2048, pg, lbase_gu(pg), 64 * kb, true, true}; return true; } r -= I_GU;
    if (r < I_D) { const int e = r / (16 * 32), q = r % (16 * 32), pg = q % 32, kb = q / 32; I = P0Item{F.wd + (size_t)e * D * D, F.WdT8 + (size_t)e * D * D, nullptr, D, pg, lbase_nat(pg), 64 * kb, true, true}; return true; }
    return false;
}
__device__ __forceinline__ void p0_load(const P0Item& I, int lane, f32x4 (&v)[8]) {
    const float* p = I.W + (size_t)(I.k0 + (lane >> 3)) * I.N + I.n0 + 4 * (lane & 7);
#pragma unroll
    for (int i = 0; i < 8; ++i) v[i] = __builtin_nontemporal_load((const f32x4*)(p + (size_t)(8 * i) * I.N));
}
__device__ __forceinline__ void p0_store(const P0Item& I, int lane, LAS float* scr, const f32x4 (&v)[8]) {
    LAS float* w = scr + (lane >> 3) * 33 + 4 * (lane & 7);
#pragma unroll
    for (int i = 0; i < 8; ++i) { w[(8 * i) * 33 + 0] = v[i][0]; w[(8 * i) * 33 + 1] = v[i][1]; w[(8 * i) * 33 + 2] = v[i][2]; w[(8 * i) * 33 + 3] = v[i][3]; }
    asm volatile("s_waitcnt lgkmcnt(0)" ::: "memory");
    const int c = lane & 7;
    f32x4 g0 = {1.f, 1.f, 1.f, 1.f}, g1 = g0;
    if (I.g) { g0 = *(const f32x4*)(I.g + I.k0 + 8 * c); g1 = *(const f32x4*)(I.g + I.k0 + 8 * c + 4); }
    if (I.f8) { g0 *= WSCALE; g1 *= WSCALE; }
#pragma unroll
    for (int j = 0; j < 4; ++j) { const int r = (lane >> 3) + 8 * j; const int sc = I.permute ? perm32(r) : r; const LAS float* s = scr + (8 * c) * 33 + sc;
        if (I.f8) { u32x2 o; o.x = pk4_fp8(s[0 * 33] * g0[0], s[1 * 33] * g0[1], s[2 * 33] * g0[2], s[3 * 33] * g0[3]); o.y = pk4_fp8(s[4 * 33] * g1[0], s[5 * 33] * g1[1], s[6 * 33] * g1[2], s[7 * 33] * g1[3]);
            *(GAS u32x2*)((unsigned char*)I.WT + (size_t)(32 * I.pg + r) * D + I.k0 + 8 * c) = o; }
        else { u32x4 o; o.x = pk2(s[0 * 33] * g0[0], s[1 * 33] * g0[1]); o.y = pk2(s[2 * 33] * g0[2], s[3 * 33] * g0[3]); o.z = pk2(s[4 * 33] * g1[0], s[5 * 33] * g1[1]); o.w = pk2(s[6 * 33] * g1[2], s[7 * 33] * g1[3]);
            *(GAS u32x4*)((bf16_t*)I.WT + (size_t)(32 * I.pg + r) * D + I.k0 + 8 * c) = o; } }
    asm volatile("s_waitcnt lgkmcnt(0)" ::: "memory");
}
__device__ __forceinline__ void p0_prologue(Frame& F) {
    LAS float* scr = (LAS float*)(F.lds + F.wave * 16384);
    const int gw = F.bid * NWAVES + F.wave, NGW = F.G * NWAVES, lane = F.lane;
    {
        P0Item cur, nxt; f32x4 va[8], vb[8];
        int it = gw; bool valid = p0_decode(F, it, cur);
        if (valid) p0_load(cur, lane, va);
        while (valid) {
            it += NGW; const bool vn = p0_decode(F, it, nxt);
            if (vn) p0_load(nxt, lane, vb);
            p0_store(cur, lane, scr, va);
            cur = nxt; valid = vn;
#pragma unroll
            for (int i = 0; i < 8; ++i) va[i] = vb[i];
        }
    }
    const GAS f32x4* gr = (const GAS f32x4*)F.n1g + lane;
    for (int m0 = 2 * gw; m0 < M_PAD; m0 += 2 * NGW) {
        f32x4 v[2][4]; float ss[2];
#pragma unroll
        for (int u = 0; u < 2; ++u) { const int m = m0 + u; ss[u] = 0.f;
            if (m < M_ALL) { const float* src = m < M_REAL ? F.x + (size_t)m * D : F.meta + (size_t)((m - M_REAL) & (NMETA - 1)) * D; const GAS f32x4* xr = (const GAS f32x4*)src + lane;
#pragma unroll
                for (int j = 0; j < 4; ++j) v[u][j] = xr[64 * j]; }
            else {
#pragma unroll
                for (int j = 0; j < 4; ++j) v[u][j] = (f32x4){0.f, 0.f, 0.f, 0.f}; } }
#pragma unroll
        for (int u = 0; u < 2; ++u) {
#pragma unroll
            for (int j = 0; j < 4; ++j) ss[u] += (v[u][j].x * v[u][j].x + v[u][j].y * v[u][j].y) + (v[u][j].z * v[u][j].z + v[u][j].w * v[u][j].w);
            const float rstd = 1.f / sqrtf(wave_sum(ss[u]) * (1.f / D) + 1e-6f);
            GAS unsigned long long* o8 = (GAS unsigned long long*)(F.XN + (size_t)(m0 + u) * D) + lane;
#pragma unroll
            for (int j = 0; j < 4; ++j) { const f32x4 g = gr[64 * j]; o8[64 * j] = (unsigned long long)pk2(v[u][j].x * rstd * g.x, v[u][j].y * rstd * g.y) | ((unsigned long long)pk2(v[u][j].z * rstd * g.z, v[u][j].w * rstd * g.w) << 32); }
        }
    }
}

namespace pg8 {
constexpr int BM = 256, BK = 64, HALF = 128, HTB = HALF * BK * 2, STAGE_BYTES = 8 * HTB, NXCD = 8, WGM = 8, KD = 1024;
__device__ __forceinline__ int lds_byte(int r, int c) { const int st = (r >> 4) * 2 + (c >> 5), rr = r & 15, cc = c & 31, ob = rr * 64 + cc * 2; return st * 1024 + (ob ^ (((ob >> 9) & 1) << 5)); }
__device__ __forceinline__ void stage_rc(int b, int& R, int& C) { const int st = b / 1024, sb = b % 1024, swz = sb ^ (((sb >> 9) & 1) << 5); R = (st >> 1) * 16 + swz / 64; C = (st & 1) * 32 + (swz % 64) / 2; }
struct Unit { int pm, pn, e, slot0, nvalid, r0; };
__device__ __forceinline__ unsigned cvt_pk_bf16(float lo, float hi) { unsigned r; asm volatile("v_cvt_pk_bf16_f32 %0, %1, %2" : "=v"(r) : "v"(lo), "v"(hi)); return r; }
__device__ __forceinline__ u32x4 pack8(const f32x4 a, const f32x4 b) { u32x4 w; w.x = cvt_pk_bf16(a[0], a[1]); w.y = cvt_pk_bf16(a[2], a[3]); w.z = cvt_pk_bf16(b[0], b[1]); w.w = cvt_pk_bf16(b[2], b[3]); return w; }

template <bool HALVES>
__device__ __forceinline__ bool tile_order(int i, int G, int c, int nM, int nN, int& pm, int& pn, int& half) {
    const int nwg = nM * nN; long L = (long)i * G + c; half = -1;
    if (HALVES) { const int nfull = (nwg / G) * G, left = nwg - nfull; if (left > 0 && 2 * left <= G && L >= nfull) { const long hidx = L - nfull; if (hidx >= 2 * left) return false; L = nfull + (hidx >> 1); half = (int)(hidx & 1); } }
    if (L >= nwg) return false;
    int wgid = (int)L; { const int q = nwg / NXCD, r = nwg % NXCD, xcd = wgid % NXCD, off = wgid / NXCD; wgid = (xcd < r ? xcd * (q + 1) : r * (q + 1) + (xcd - r) * q) + off; }
    const int nig = WGM * nN, gid = wgid / nig, fm = gid * WGM, gsz = (nM - fm) < WGM ? (nM - fm) : WGM;
    pm = fm + ((wgid % nig) % gsz); pn = (wgid % nig) / gsz; return true;
}
struct DenseProb {
    static constexpr int RB = KD * 2;
    const bf16_t* A; const bf16_t* Bt; int nM, nN, G, c;
    __device__ __forceinline__ bool next(int i, Unit& u) const { u.e = 0; u.slot0 = 0; u.nvalid = 256; u.r0 = 0; int half; return tile_order<false>(i, G, c, nM, nN, u.pm, u.pn, half); }
    __device__ __forceinline__ void addr_load(const Unit&, const int (&)[2], int (&)[4]) const {}
    __device__ __forceinline__ void addr_finish(const Unit& u, const int (&R)[2], const int (&C)[2], const int (&)[4], const char*& a, const char*& b, unsigned (&va0)[2], unsigned (&va1)[2]) const {
        a = (const char*)A + (size_t)u.pm * (BM * RB); b = (const char*)Bt + (size_t)u.pn * (BM * RB);
#pragma unroll
        for (int i = 0; i < 2; ++i) { va0[i] = (unsigned)(R[i] * RB + C[i] * 2); va1[i] = va0[i] + (unsigned)(HALF * RB); }
    }
};
template <bool GATHER, int ES> struct GroupedProb {
    static constexpr int RB = KD * ES;
    const void* A; const void* Bt; const int* ltok; const LAS int* tb; const LAS int* cn; int nN, G, c;
    __device__ __forceinline__ bool next(int i, Unit& u) const {
        const int nM = __builtin_amdgcn_readfirstlane(tb[NE]); int half;
        if (!tile_order<true>(i, G, c, nM, nN, u.pm, u.pn, half)) return false;
        int e = 0;
#pragma unroll 1
        for (int j = 1; j < NE; ++j) if (tb[j] <= u.pm) e = j;
        e = __builtin_amdgcn_readfirstlane(e);
        const int t0 = __builtin_amdgcn_readfirstlane(tb[e]), ce = __builtin_amdgcn_readfirstlane(cn[e]);
        u.e = e; u.r0 = half == 1 ? HALF : 0; u.slot0 = (u.pm - t0) * 256 + u.r0; int rem = ce - u.slot0; const int lim = half >= 0 ? HALF : 256; rem = rem < lim ? rem : lim; u.nvalid = rem < 0 ? 0 : rem; return true;
    }
    __device__ __forceinline__ void addr_load(const Unit& u, const int (&R)[2], int (&raw)[4]) const {
        if (GATHER) { const int* lt = ltok + u.e * CAP + u.slot0;
#pragma unroll
            for (int i = 0; i < 2; ++i) { const int r0 = R[i], r1 = R[i] + HALF; raw[2 * i] = r0 < u.nvalid ? lt[r0] : 0; raw[2 * i + 1] = r1 < u.nvalid ? lt[r1] : 0; } }
    }
    __device__ __forceinline__ void addr_finish(const Unit& u, const int (&R)[2], const int (&C)[2], const int (&raw)[4], const char*& a, const char*& b, unsigned (&va0)[2], unsigned (&va1)[2]) const {
        b = (const char*)Bt + ((size_t)u.e * nN + u.pn) * (BM * RB);
        if (GATHER) { a = (const char*)A;
#pragma unroll
            for (int i = 0; i < 2; ++i) { va0[i] = (unsigned)(raw[2 * i] * RB + C[i] * 2); va1[i] = (unsigned)(raw[2 * i + 1] * RB + C[i] * 2); }
        } else { a = (const char*)A + (size_t)(u.pm * BM + u.r0) * RB;
#pragma unroll
            for (int i = 0; i < 2; ++i) { va0[i] = (unsigned)(R[i] * RB + C[i] * 2); va1[i] = va0[i] + (unsigned)(HALF * RB); }
        }
    }
};

template <int ES  , class Prob, class Epi>
__device__ __forceinline__ void gemm_phase(LAS unsigned char* lds, const Prob& P, const Epi& E) {
    const int tid = threadIdx.x, wid = __builtin_amdgcn_readfirstlane(tid >> 6), lane = tid & 63, wr = wid >> 2, wc = wid & 3, fr = lane & 15, fq = lane >> 4;
    constexpr int RB = KD * ES, nt = RB / (BK * 2);
    int R[2], C[2]; unsigned voffB[2];
#pragma unroll
    for (int i = 0; i < 2; ++i) { stage_rc(tid * 16 + i * 8192, R[i], C[i]); voffB[i] = (unsigned)(R[i] * RB + C[i] * 2); }
    constexpr size_t kstep = (size_t)(BK * 2);
    constexpr size_t hstep = (size_t)HALF * RB;
    const unsigned ldsw = (unsigned)wid * 1024u;
    const int aoff = lds_byte(wr * 64 + fr, fq * 8), boff = lds_byte(wc * 32 + fr, fq * 8);
#define PG8_SA(b, h) (((b) * 2 + (h)) * HTB)
#define PG8_SB(b, h) ((4 + (b) * 2 + (h)) * HTB)
#define PG8_STAGE(bufoff, gbase, voff) do { _Pragma("unroll") for (int _i = 0; _i < 2; ++_i) \
        __builtin_amdgcn_global_load_lds((const unsigned*)((const char*)(gbase) + (voff)[_i]), (LAS unsigned*)(lds + (bufoff) + ldsw + _i * 8192), 16, 0, 0); } while (0)
#define PG8_LDA(dst, b, h) do { _Pragma("unroll") for (int m = 0; m < 4; ++m) { \
        if constexpr (ES == 2) { _Pragma("unroll") for (int k = 0; k < 2; ++k) dst[m][k] = *(const LAS bf16x8*)(lds + PG8_SA(b, h) + aoff + m * 2048 + k * 1024); } \
        else { const i32x4 lo_ = *(const LAS i32x4*)(lds + PG8_SA(b, h) + aoff + m * 2048), hi_ = *(const LAS i32x4*)(lds + PG8_SA(b, h) + aoff + m * 2048 + 1024); dst##8[m] = __builtin_shufflevector(lo_, hi_, 0, 1, 2, 3, 4, 5, 6, 7); } } } while (0)
#define PG8_LDB(dst, b, h) do { _Pragma("unroll") for (int n = 0; n < 2; ++n) { \
        if constexpr (ES == 2) { _Pragma("unroll") for (int k = 0; k < 2; ++k) dst[n][k] = *(const LAS bf16x8*)(lds + PG8_SB(b, h) + boff + n * 2048 + k * 1024); } \
        else { const i32x4 lo_ = *(const LAS i32x4*)(lds + PG8_SB(b, h) + boff + n * 2048), hi_ = *(const LAS i32x4*)(lds + PG8_SB(b, h) + boff + n * 2048 + 1024); dst##8[n] = __builtin_shufflevector(lo_, hi_, 0, 1, 2, 3, 4, 5, 6, 7); } } } while (0)
#define PG8_MMA(ai, bj, At, Bt) do { __builtin_amdgcn_s_setprio(1); _Pragma("unroll") for (int m = 0; m < 4; ++m) _Pragma("unroll") for (int n = 0; n < 2; ++n) { \
        if constexpr (ES == 2) { _Pragma("unroll") for (int k = 0; k < 2; ++k) acc[ai][bj][m][n] = __builtin_amdgcn_mfma_f32_16x16x32_bf16(Bt[n][k], At[m][k], acc[ai][bj][m][n], 0, 0, 0); } \
        else asm volatile("s_nop 1\n\tv_mfma_scale_f32_16x16x128_f8f6f4 %0, %1, %2, %0, %3, %3 op_sel_hi:[0,0,0]" : "+v"(acc[ai][bj][m][n]) : "v"(Bt##8[n]), "v"(At##8[m]), "v"(sc127)); } \
        __builtin_amdgcn_s_setprio(0); } while (0)
#define PG8_WAIT_V(n) asm volatile("s_waitcnt vmcnt(" #n ")" ::: "memory")
#define PG8_WAIT_L(n) asm volatile("s_waitcnt lgkmcnt(" #n ")" ::: "memory")
#define PG8_BAR __builtin_amdgcn_s_barrier()
#define PG8_SCHED __builtin_amdgcn_sched_barrier(0)
    Unit cur, nxt, nn; int ui = 0; int raw[4] = {0, 0, 0, 0};
    if (!P.next(0, cur)) return;
    bool has_next = P.next(1, nxt);
    const char *cA, *cB, *nA, *nB; unsigned va0[2], va1[2], nva0[2], nva1[2];
    P.addr_load(cur, R, raw); P.addr_finish(cur, R, C, raw, cA, cB, va0, va1);
    if (has_next) { P.addr_load(nxt, R, raw); P.addr_finish(nxt, R, C, raw, nA, nB, nva0, nva1); }
    else { nA = cA; nB = cB; nva0[0] = va0[0]; nva0[1] = va0[1]; nva1[0] = va1[0]; nva1[1] = va1[1]; }
    f32x4 acc[2][2][4][2];
#pragma unroll
    for (int a = 0; a < 2; ++a)
#pragma unroll
        for (int b = 0; b < 2; ++b)
#pragma unroll
            for (int m = 0; m < 4; ++m)
#pragma unroll
                for (int n = 0; n < 2; ++n) acc[a][b][m][n] = (f32x4){0.f, 0.f, 0.f, 0.f};
    const int sc127 = 0x7F7F7F7F;
    bf16x8 At[4][2], B0[2][2], B1[2][2]; i32x8 At8[4], B08[2], B18[2];
    PG8_STAGE(PG8_SB(0, 0), cB, voffB); PG8_STAGE(PG8_SB(0, 1), cB + hstep, voffB); PG8_STAGE(PG8_SA(0, 0), cA, va0); PG8_STAGE(PG8_SA(0, 1), cA, va1);
    if (wr == 1) PG8_BAR;
    PG8_WAIT_V(2); PG8_BAR;
    PG8_STAGE(PG8_SB(1, 0), cB + kstep, voffB); PG8_STAGE(PG8_SA(1, 0), cA + kstep, va0); PG8_STAGE(PG8_SB(1, 1), cB + hstep + kstep, voffB);
    PG8_WAIT_V(6); PG8_BAR;
    for (;;) {
        const bool full = cur.nvalid > HALF;
#pragma unroll 1
        for (int t = 0; t < nt; t += 2) {
            const bool last = (t == nt - 2);
            const char* a1 = cA + (size_t)(t + 1) * kstep;
            const char* a2 = last ? nA : cA + (size_t)(t + 2) * kstep; const char* b2 = last ? nB : cB + (size_t)(t + 2) * kstep;
            const char* a3 = a2 + kstep; const char* b3 = b2 + kstep;
            unsigned v2a0[2], v2a1[2];
            v2a0[0] = last ? nva0[0] : va0[0]; v2a0[1] = last ? nva0[1] : va0[1]; v2a1[0] = last ? nva1[0] : va1[0]; v2a1[1] = last ? nva1[1] : va1[1];
            PG8_LDB(B0, 0, 0); PG8_LDB(B1, 0, 1); PG8_SCHED; PG8_LDA(At, 0, 0); PG8_STAGE(PG8_SA(1, 1), a1, va1);
            PG8_WAIT_V(8); PG8_WAIT_L(0); PG8_BAR; PG8_MMA(0, 0, At, B0); PG8_MMA(0, 1, At, B1); PG8_BAR; PG8_SCHED;
            PG8_LDA(At, 0, 1); PG8_STAGE(PG8_SB(0, 0), b2, voffB); PG8_STAGE(PG8_SB(0, 1), b2 + hstep, voffB); PG8_STAGE(PG8_SA(0, 0), a2, v2a0);
            PG8_WAIT_V(8); PG8_WAIT_L(0); PG8_BAR; if (full) { PG8_MMA(1, 0, At, B0); PG8_MMA(1, 1, At, B1); } PG8_BAR; PG8_SCHED;
            PG8_LDB(B0, 1, 0); PG8_LDB(B1, 1, 1); PG8_SCHED; PG8_LDA(At, 1, 0); PG8_STAGE(PG8_SA(0, 1), a2, v2a1);
            PG8_WAIT_V(8); PG8_WAIT_L(0); PG8_BAR; PG8_MMA(0, 0, At, B0); PG8_MMA(0, 1, At, B1); PG8_BAR; PG8_SCHED;
            PG8_LDA(At, 1, 1); PG8_STAGE(PG8_SB(1, 0), b3, voffB); PG8_STAGE(PG8_SB(1, 1), b3 + hstep, voffB); PG8_STAGE(PG8_SA(1, 0), a3, v2a0);
            PG8_WAIT_V(8); PG8_WAIT_L(0); PG8_BAR; if (full) { PG8_MMA(1, 0, At, B0); PG8_MMA(1, 1, At, B1); } PG8_BAR; PG8_SCHED;
        }
        if constexpr (ES == 1) { asm volatile("s_nop 15\n\ts_nop 15" ::: "memory"); __builtin_amdgcn_sched_barrier(0); }
        const bool has_nn = has_next && P.next(ui + 2, nn);
        if (has_nn) P.addr_load(nn, R, raw);
        if (wr == 0) PG8_BAR;
        E(acc, cur, wr, wc, fr, fq);
        if (!has_next) break;
#pragma unroll
        for (int a = 0; a < 2; ++a)
#pragma unroll
            for (int b = 0; b < 2; ++b)
#pragma unroll
                for (int m = 0; m < 4; ++m)
#pragma unroll
                    for (int n = 0; n < 2; ++n) acc[a][b][m][n] = (f32x4){0.f, 0.f, 0.f, 0.f};
        cur = nxt; cA = nA; cB = nB; va0[0] = nva0[0]; va0[1] = nva0[1]; va1[0] = nva1[0]; va1[1] = nva1[1]; ++ui;
        nxt = nn; has_next = has_nn;
        if (has_next) P.addr_finish(nxt, R, C, raw, nA, nB, nva0, nva1);
        if (wr == 1) PG8_BAR;
    }
    PG8_WAIT_V(0);
    PG8_BAR;
#undef PG8_SA
#undef PG8_SB
#undef PG8_STAGE
#undef PG8_LDA
#undef PG8_LDB
#undef PG8_MMA
#undef PG8_WAIT_V
#undef PG8_WAIT_L
#undef PG8_BAR
#undef PG8_SCHED
}

struct EpiOut {
    const float* x; float* out; bf16_t* xn2; unsigned char* xn2f8;
    __device__ __forceinline__ void operator()(const f32x4 (&acc)[2][2][4][2], const Unit& u, int wr, int wc, int fr, int fq) const {
        const int row0 = u.pm * BM + wr * 64 + fr, col0 = u.pn * BM + wc * 32 + 8 * fq;
#pragma unroll
        for (int ai = 0; ai < 2; ++ai)
#pragma unroll
            for (int m = 0; m < 4; ++m) { const size_t off = (size_t)(row0 + ai * HALF + m * 16) * D + col0;
#pragma unroll
                for (int bj = 0; bj < 2; ++bj) { const float* xp = x + off + bj * HALF;
                    const f32x4 h0 = acc[ai][bj][m][0] + *(const f32x4*)xp, h1 = acc[ai][bj][m][1] + *(const f32x4*)(xp + 4);
                    *(u32x4*)(xn2 + off + bj * HALF) = pack8(h0, h1);
                    *(u32x2*)(xn2f8 + off + bj * HALF) = (u32x2){pk4_fp8(h0[0], h0[1], h0[2], h0[3]), pk4_fp8(h1[0], h1[1], h1[2], h1[3])}; }
                asm volatile("" ::: "memory"); }
    }
};
struct EpiIn {
    bf16_t *Qb, *Kb, *VT, *HC; const float *qg, *kg;
    __device__ __forceinline__ void operator()(const f32x4 (&acc)[2][2][4][2], const Unit& u, int wr, int wc, int fr, int fq) const {
        const int rowb = u.pm * BM + wr * 64 + fr;
        if (u.pn <= 2) {
            const bool isv = (u.pn == 2) && (wc >= 2);
            if (!isv) {
                const bool isq = u.pn < 2; const float* g = isq ? qg : kg; const float sc = isq ? QSCALE : 1.f;
                f32x4 gv[2][2];
#pragma unroll
                for (int bj = 0; bj < 2; ++bj)
#pragma unroll
                    for (int n = 0; n < 2; ++n) gv[bj][n] = *(const f32x4*)(g + 32 * bj + 8 * fq + 4 * n) * sc;
                bf16_t* dst = isq ? Qb + (u.pn * 256 + 64 * wc) : Kb + 64 * wc; const int ld = isq ? 512 : 128;
#pragma unroll
                for (int ai = 0; ai < 2; ++ai)
#pragma unroll
                    for (int m = 0; m < 4; ++m) { const int row = rowb + ai * HALF + m * 16; float ss = 0.f;
#pragma unroll
                        for (int bj = 0; bj < 2; ++bj)
#pragma unroll
                            for (int n = 0; n < 2; ++n) { const f32x4 v = acc[ai][bj][m][n]; ss += (v[0] * v[0] + v[1] * v[1]) + (v[2] * v[2] + v[3] * v[3]); }
                        ss += __shfl_xor(ss, 16); ss += __shfl_xor(ss, 32);
                        const float r = __builtin_amdgcn_rsqf(ss * (1.f / 64.f) + 1e-6f);
#pragma unroll
                        for (int bj = 0; bj < 2; ++bj) *(u32x4*)(dst + (size_t)row * ld + 32 * bj + 8 * fq) = pack8(acc[ai][bj][m][0] * r * gv[bj][0], acc[ai][bj][m][1] * r * gv[bj][1]); }
            } else {
                const int hk = wc - 2;
#pragma unroll
                for (int ai = 0; ai < 2; ++ai)
#pragma unroll
                    for (int m = 0; m < 4; ++m) { const int row = rowb + ai * HALF + m * 16;
                        if (row < M_ALL) { int b, kx; if (row < M_REAL) { b = row >> 11; kx = NMETA + (row & 2047); } else { b = (row - M_REAL) >> 4; kx = (row - M_REAL) & 15; }
                            bf16_t* base = VT + (size_t)(b * 2 + hk) * 64 * VT_PITCH + kx;
#pragma unroll
                            for (int bj = 0; bj < 2; ++bj)
#pragma unroll
                                for (int n = 0; n < 2; ++n)
#pragma unroll
                                    for (int e = 0; e < 4; ++e) base[(size_t)(32 * bj + 8 * fq + 4 * n + e) * VT_PITCH] = (bf16_t)f2bf(acc[ai][bj][m][n][e]); } }
            }
        } else {
            const int col = (u.pn - 3) * 128 + 32 * wc + 8 * fq;
#pragma unroll
            for (int ai = 0; ai < 2; ++ai)
#pragma unroll
                for (int m = 0; m < 4; ++m) { const int row = rowb + ai * HALF + m * 16; f32x4 h[2];
#pragma unroll
                    for (int n = 0; n < 2; ++n)
#pragma unroll
                        for (int e = 0; e < 4; ++e) h[n][e] = acc[ai][0][m][n][e] * sigmoidf_fast(acc[ai][1][m][n][e]);
                    *(u32x4*)(HC + (size_t)row * 512 + col) = pack8(h[0], h[1]); }
        }
    }
};
struct EpiGU {
    unsigned char* ACT; const float* lrstd; const float* bgu;
    __device__ __forceinline__ void operator()(const f32x4 (&acc)[2][2][4][2], const Unit& u, int wr, int wc, int fr, int fq) const {
        const int lr0 = wr * 64 + fr, col = u.pn * 128 + 32 * wc + 8 * fq;
        f32x4 bg[2], bu[2];
#pragma unroll
        for (int n = 0; n < 2; ++n) { bg[n] = *(const f32x4*)(bgu + u.e * 2048 + col + 4 * n); bu[n] = *(const f32x4*)(bgu + u.e * 2048 + 1024 + col + 4 * n); }
        const float* rs = lrstd + u.e * CAP + u.slot0;
#pragma unroll
        for (int ai = 0; ai < 2; ++ai)
#pragma unroll
            for (int m = 0; m < 4; ++m) { if (ai == 1 && u.nvalid <= HALF) continue; const int lr = lr0 + ai * HALF + m * 16; const float rstd = lr < u.nvalid ? rs[lr] * (1.f / WSCALE) : 0.f; f32x4 h[2];
#pragma unroll
                for (int n = 0; n < 2; ++n)
#pragma unroll
                    for (int e = 0; e < 4; ++e) { float gt = acc[ai][0][m][n][e] * rstd + bg[n][e], up = acc[ai][1][m][n][e] * rstd + bu[n][e];
                        gt = fminf(gt, 7.f); up = fminf(fmaxf(up, -7.f), 7.f); h[n][e] = gt * sigmoidf_fast(1.702f * gt) * (up + 1.f); }
                *(u32x2*)(ACT + (size_t)(u.pm * BM + u.r0 + lr) * D + col) = (u32x2){pk4_fp8(h[0][0], h[0][1], h[0][2], h[0][3]), pk4_fp8(h[1][0], h[1][1], h[1][2], h[1][3])}; }
    }
};
struct EpiDown {
    bf16_t* Y; const float* lgate; const float* bd;
    __device__ __forceinline__ void operator()(const f32x4 (&acc)[2][2][4][2], const Unit& u, int wr, int wc, int fr, int fq) const {
        const int lr0 = wr * 64 + fr, col0 = u.pn * BM + wc * 32 + 8 * fq;
        f32x4 bv[2][2];
#pragma unroll
        for (int bj = 0; bj < 2; ++bj)
#pragma unroll
            for (int n = 0; n < 2; ++n) bv[bj][n] = *(const f32x4*)(bd + u.e * D + col0 + bj * HALF + 4 * n);
        const float* gs = lgate + u.e * CAP + u.slot0;
#pragma unroll
        for (int ai = 0; ai < 2; ++ai)
#pragma unroll
            for (int m = 0; m < 4; ++m) { if (ai == 1 && u.nvalid <= HALF) continue; const int lr = lr0 + ai * HALF + m * 16; const float gt = lr < u.nvalid ? gs[lr] : 0.f;
#pragma unroll
                for (int bj = 0; bj < 2; ++bj) *(u32x4*)(Y + (size_t)(u.pm * BM + u.r0 + lr) * D + col0 + bj * HALF) = pack8((acc[ai][bj][m][0] * (1.f / WSCALE) + bv[bj][0]) * gt, (acc[ai][bj][m][1] * (1.f / WSCALE) + bv[bj][1]) * gt); }
    }
};
}


constexpr int ATT_KIMG = 0, ATT_VIMG = 53248, ATT_VP = 840;
constexpr float ATT_THR = 4.0f;
template <int MODE>
__device__ __forceinline__ void att_tile(const LAS unsigned char* kbase, const int (&koff)[4], const LAS unsigned char* vbase, const bf16x8 (&qf)[4], float slope2, float Bq,
                                         float& m, float& l, f32x16& O0, f32x16& O1) {
    f32x16 s;
#pragma unroll
    for (int r = 0; r < 16; ++r) s[r] = 0.f;
#pragma unroll
    for (int ks = 0; ks < 4; ++ks) { const bf16x8 kf = *(const LAS bf16x8*)(kbase + koff[ks]); s = __builtin_amdgcn_mfma_f32_32x32x16_bf16(kf, qf[ks], s, 0, 0, 0); }
    float tmax = -INFINITY;
#pragma unroll
    for (int r = 0; r < 16; ++r) {
        if (MODE == 0) { if (r >= 8) s[r] = -INFINITY; }
        else { const float dl = fabsf(Bq - (float)((r & 3) + 8 * (r >> 2))); float v = s[r] - slope2 * dl; if (MODE == 2) v = dl <= 128.f ? v : -INFINITY; s[r] = v; }
        tmax = fmaxf(tmax, s[r]);
    }
    tmax = fmaxf(tmax, __shfl_xor(tmax, 32));
    if (__any(tmax > m + ATT_THR)) { const float mn = fmaxf(m, tmax); const float al = __builtin_amdgcn_exp2f(m - mn); m = mn; l *= al;
#pragma unroll
        for (int r = 0; r < 16; ++r) { O0[r] *= al; O1[r] *= al; } }
    float ps = 0.f;
#pragma unroll
    for (int r = 0; r < 16; ++r) { s[r] = __builtin_amdgcn_exp2f(s[r] - m); ps += s[r]; }
    l += ps;
#pragma unroll
    for (int s2 = 0; s2 < 2; ++s2) {
        u32x4 pw; pw.x = pg8::cvt_pk_bf16(s[8 * s2 + 0], s[8 * s2 + 1]); pw.y = pg8::cvt_pk_bf16(s[8 * s2 + 2], s[8 * s2 + 3]); pw.z = pg8::cvt_pk_bf16(s[8 * s2 + 4], s[8 * s2 + 5]); pw.w = pg8::cvt_pk_bf16(s[8 * s2 + 6], s[8 * s2 + 7]);
        const bf16x8 pf = __builtin_bit_cast(bf16x8, pw);
        { const u32x2 lo = *(const LAS u32x2*)(vbase + s2 * 32), hi = *(const LAS u32x2*)(vbase + s2 * 32 + 16); const u32x4 vw = {lo.x, lo.y, hi.x, hi.y};
          O0 = __builtin_amdgcn_mfma_f32_32x32x16_bf16(__builtin_bit_cast(bf16x8, vw), pf, O0, 0, 0, 0); }
        { const u32x2 lo = *(const LAS u32x2*)(vbase + 32 * ATT_VP + s2 * 32), hi = *(const LAS u32x2*)(vbase + 32 * ATT_VP + s2 * 32 + 16); const u32x4 vw = {lo.x, lo.y, hi.x, hi.y};
          O1 = __builtin_amdgcn_mfma_f32_32x32x16_bf16(__builtin_bit_cast(bf16x8, vw), pf, O1, 0, 0, 0); }
    }
}
__device__ __forceinline__ void att_fast(Frame& F) {
    LAS unsigned char* Kimg = F.lds + ATT_KIMG; LAS unsigned char* Vimg = F.lds + ATT_VIMG;
    const int tid = F.tid, lane = F.lane, wid = F.wave, q = lane & 31, h = lane >> 5, qt = wid & 3, hsel = wid >> 2;
    int koff[4];
#pragma unroll
    for (int ks = 0; ks < 4; ++ks) koff[ks] = ((2 * ks + h) ^ ((q >> 1) & 7)) << 4;
    for (int item = F.bid; item < NB * 16 * 2; item += F.G) {
        const int hk = item & 1, i = (item >> 1) & 15, b = item >> 5;
        __syncthreads();
        for (int idx = tid; idx < 416 * 8; idx += NTHR) { const int kr = idx >> 3, c = idx & 7; if (kr >= 16 && kr < 32) continue;
            int row; if (kr < 16) row = M_REAL + b * NMETA + kr; else { const int pos = (i - 1) * 128 + kr - 32; if (pos < 0 || pos >= SEQ) continue; row = b * SEQ + pos; }
            const u32x4 v = *(const GAS u32x4*)(F.Kb + (size_t)row * 128 + hk * 64 + 8 * c);
            *(LAS u32x4*)(Kimg + kr * 128 + ((c ^ ((kr >> 1) & 7)) << 4)) = v; }
        for (int idx = tid; idx < 64 * 52; idx += NTHR) { const int d = idx / 52, c = idx % 52; const bf16_t* vrow = F.VT + (size_t)((b * 2 + hk) * 64 + d) * VT_PITCH;
            LAS u32x2* dst; const bf16_t* src;
            if (c < 2) { src = vrow + 8 * c; dst = (LAS u32x2*)(Vimg + d * ATT_VP + 16 * c); }
            else if (c < 4) { dst = (LAS u32x2*)(Vimg + d * ATT_VP + 32 + 16 * (c - 2)); dst[0] = (u32x2){0u, 0u}; dst[1] = (u32x2){0u, 0u}; continue; }
            else { const int cc = c - 4, blk = cc >> 4, w = cc & 15, pos0 = (i - 1 + blk) * 128; if (pos0 < 0 || pos0 >= SEQ) continue; src = vrow + NMETA + pos0 + 8 * w; dst = (LAS u32x2*)(Vimg + d * ATT_VP + (32 + blk * 128 + 8 * w) * 2); }
            const u32x4 v = *(const GAS u32x4*)src; dst[0] = (u32x2){v.x, v.y}; dst[1] = (u32x2){v.z, v.w}; }
        __syncthreads();
#pragma unroll 1
        for (int hp = 0; hp < 2; ++hp) {
            const int head = hk * 4 + hp * 2 + hsel, row = b * SEQ + i * 128 + 32 * qt + q;
            bf16x8 qf[4];
#pragma unroll
            for (int ks = 0; ks < 4; ++ks) qf[ks] = *(const GAS bf16x8*)(F.Qb + (size_t)row * 512 + head * 64 + 16 * ks + 8 * h);
            const float slope2 = exp2f(-(float)(head + 1)) * LOG2E;
            float m = F.sink[head] * LOG2E, l = h == 0 ? 1.f : 0.f;
            f32x16 O0, O1;
#pragma unroll
            for (int r = 0; r < 16; ++r) { O0[r] = 0.f; O1[r] = 0.f; }
            const LAS unsigned char* kb0 = Kimg + q * 128; const LAS unsigned char* vb0 = Vimg + q * ATT_VP + 8 * h;
            att_tile<0>(kb0, koff, vb0, qf, 0.f, 0.f, m, l, O0, O1);
#pragma unroll 1
            for (int kt = qt; kt <= qt + 8; ++kt) { const int blk = kt >> 2; if ((i == 0 && blk == 0) || (i == 15 && blk == 2)) continue;
                const int kr0 = 32 + 32 * kt; const float Bq = (float)(128 + 32 * (qt - kt) + q - 4 * h);
                if (kt == qt || kt == qt + 8) att_tile<2>(kb0 + kr0 * 128, koff, vb0 + kr0 * 2, qf, slope2, Bq, m, l, O0, O1);
                else att_tile<1>(kb0 + kr0 * 128, koff, vb0 + kr0 * 2, qf, slope2, Bq, m, l, O0, O1); }
            l += __shfl_xor(l, 32); const float inv = 1.f / l;
            bf16_t* orow = F.MIX + (size_t)row * D + head * 64 + 4 * h;
#pragma unroll
            for (int g = 0; g < 4; ++g) { *(GAS u32x2*)(orow + 8 * g) = (u32x2){pg8::cvt_pk_bf16(O0[4 * g] * inv, O0[4 * g + 1] * inv), pg8::cvt_pk_bf16(O0[4 * g + 2] * inv, O0[4 * g + 3] * inv)};
                *(GAS u32x2*)(orow + 32 + 8 * g) = (u32x2){pg8::cvt_pk_bf16(O1[4 * g] * inv, O1[4 * g + 1] * inv), pg8::cvt_pk_bf16(O1[4 * g + 2] * inv, O1[4 * g + 3] * inv)}; }
        }
    }
    __syncthreads();
}
__device__ __forceinline__ void conv_fast(Frame& F) {
    const int tid = F.tid, lane = F.lane, wid = F.wave, c2 = tid & 255, th = tid >> 8;
    LAS float* cout = (LAS float*)F.lds;
    float w0[CONV_K], w1[CONV_K];
#pragma unroll
    for (int j = 0; j < CONV_K; ++j) { const f32x2 w = *(const f32x2*)(F.dw_w + j * CONV_W + 2 * c2); w0[j] = w.x; w1[j] = w.y; }
    const f32x2 bias = *(const f32x2*)(F.dw_b + 2 * c2);
    for (int item = F.bid; item < NB * 64; item += F.G) {
        const int b = item >> 6, t0 = (item & 63) * 32;
        unsigned xin[46];
        const int s0 = NMETA + t0 + 16 * th - 15;
#pragma unroll
        for (int jj = 0; jj < 46; ++jj) { const int sq = s0 + jj; xin[jj] = sq < LSEQ ? *(const GAS unsigned*)(F.HC + (size_t)row_of(b, sq) * 512 + 2 * c2) : 0u; }
        __syncthreads();
#pragma unroll
        for (int t = 0; t < 16; ++t) { float a0 = bias.x, a1 = bias.y;
#pragma unroll
            for (int j = 0; j < CONV_K; ++j) { a0 += w0[j] * bflo(xin[t + j]); a1 += w1[j] * bfhi(xin[t + j]); }
            *(LAS f32x2*)(cout + (16 * th + t) * 512 + 2 * c2) = (f32x2){a0, a1}; }
        __syncthreads();
#pragma unroll 1
        for (int tt = 0; tt < 4; ++tt) { const int t = 4 * wid + tt; const LAS f32x4* rp = (const LAS f32x4*)(cout + t * 512 + 8 * lane); const f32x4 x0 = rp[0], x1 = rp[1];
            const float mu = wave_sum((x0[0] + x0[1]) + (x0[2] + x0[3]) + (x1[0] + x1[1]) + (x1[2] + x1[3])) * (1.f / 512.f);
            const f32x4 d0 = x0 - mu, d1 = x1 - mu;
            const float var = wave_sum((d0[0] * d0[0] + d0[1] * d0[1]) + (d0[2] * d0[2] + d0[3] * d0[3]) + (d1[0] * d1[0] + d1[1] * d1[1]) + (d1[2] * d1[2] + d1[3] * d1[3])) * (1.f / 512.f);
            const float rstd = __builtin_amdgcn_rsqf(var + 1e-5f);
            const f32x4 g0 = *(const f32x4*)(F.lng + 8 * lane), g1 = *(const f32x4*)(F.lng + 8 * lane + 4), b0 = *(const f32x4*)(F.lnb + 8 * lane), b1 = *(const f32x4*)(F.lnb + 8 * lane + 4);
            f32x4 y0 = d0 * rstd * g0 + b0, y1 = d1 * rstd * g1 + b1;
#pragma unroll
            for (int e = 0; e < 4; ++e) { y0[e] *= sigmoidf_fast(y0[e]); y1[e] *= sigmoidf_fast(y1[e]); }
            *(GAS u32x4*)(F.MIX + (size_t)(b * SEQ + t0 + t) * D + 512 + 8 * lane) = pg8::pack8(y0, y1); }
    }
    __syncthreads();
}
__device__ __forceinline__ void p4_fast(Frame& F) {
    LAS int* lcnt = (LAS int*)(F.lds + LX_LCNT); LAS int* gbase = (LAS int*)(F.lds + LX_GBASE);
    const int tid = F.tid, lane = F.lane, wid = F.wave, j = lane & 31, h = lane >> 5;
    for (int base = 0; base < M_REAL / 32; base += F.G * NWAVES) {
        const int tile = base + F.bid + F.G * wid; const bool active = tile < M_REAL / 32;
        if (tid < NE) lcnt[tid] = 0;
        __syncthreads();
        int ea = 0, eb = 0, sa = 0, sb = 0, tok = 0; float ga = 0.f, gb = 0.f, rstd = 0.f;
        if (active) {
            tok = tile * 32 + j;
            const bf16_t* xa = F.XN2 + (size_t)tok * D + 8 * h; const bf16_t* wa = F.WrT + (size_t)j * D + 8 * h;
            f32x16 acc;
#pragma unroll
            for (int r = 0; r < 16; ++r) acc[r] = 0.f;
            float ssq = 0.f;
#pragma unroll 8
            for (int ks = 0; ks < 64; ++ks) { const u32x4 xb = *(const GAS u32x4*)(xa + 16 * ks); const bf16x8 wf = *(const GAS bf16x8*)(wa + 16 * ks);
                acc = __builtin_amdgcn_mfma_f32_32x32x16_bf16(wf, __builtin_bit_cast(bf16x8, xb), acc, 0, 0, 0);
                ssq += (bflo(xb.x) * bflo(xb.x) + bfhi(xb.x) * bfhi(xb.x)) + (bflo(xb.y) * bflo(xb.y) + bfhi(xb.y) * bfhi(xb.y)) + (bflo(xb.z) * bflo(xb.z) + bfhi(xb.z) * bfhi(xb.z)) + (bflo(xb.w) * bflo(xb.w) + bfhi(xb.w) * bfhi(xb.w)); }
            ssq += __shfl_xor(ssq, 32);
            rstd = 1.f / sqrtf(ssq * (1.f / D) + 1e-6f);
            float lg[16];
#pragma unroll
            for (int r = 0; r < 16; ++r) lg[r] = acc[r] * rstd + F.rb[(r & 3) + 8 * (r >> 2) + 4 * h];
            float tv[4]; int te[4];
#pragma unroll
            for (int kk = 0; kk < 4; ++kk) { float bv = -INFINITY; int be = 0;
#pragma unroll
                for (int r = 0; r < 16; ++r) { const int er = (r & 3) + 8 * (r >> 2) + 4 * h; if (lg[r] > bv) { bv = lg[r]; be = er; } }
                const float pv = __shfl_xor(bv, 32); const int pe = __shfl_xor(be, 32);
                if (pv > bv || (pv == bv && pe < be)) { bv = pv; be = pe; }
#pragma unroll
                for (int r = 0; r < 16; ++r) { const int er = (r & 3) + 8 * (r >> 2) + 4 * h; if (er == be) lg[r] = -INFINITY; }
                tv[kk] = bv; te[kk] = be; }
            const float p1 = __expf(tv[1] - tv[0]), p2 = __expf(tv[2] - tv[0]), p3 = __expf(tv[3] - tv[0]); const float inv = 1.f / (1.f + p1 + p2 + p3);
            ea = h ? te[2] : te[0]; eb = h ? te[3] : te[1]; ga = (h ? p2 : 1.f) * inv; gb = (h ? p3 : p1) * inv;
            sa = __hip_atomic_fetch_add(lcnt + ea, 1, __ATOMIC_RELAXED, __HIP_MEMORY_SCOPE_WORKGROUP); sb = __hip_atomic_fetch_add(lcnt + eb, 1, __ATOMIC_RELAXED, __HIP_MEMORY_SCOPE_WORKGROUP);
        }
        __syncthreads();
        if (tid < NE) gbase[tid] = (int)__hip_atomic_fetch_add((unsigned*)(F.ctl + CW_CNT + tid), (unsigned)lcnt[tid], RLX_AGENT);
        __syncthreads();
        if (active) {
            sa += gbase[ea]; sb += gbase[eb];
            F.ltok[ea * CAP + sa] = tok; F.lgate[ea * CAP + sa] = ga; F.lrstd[ea * CAP + sa] = rstd; F.where[tok * 4 + 2 * h] = ea * CAP + sa;
            F.ltok[eb * CAP + sb] = tok; F.lgate[eb * CAP + sb] = gb; F.lrstd[eb * CAP + sb] = rstd; F.where[tok * 4 + 2 * h + 1] = eb * CAP + sb;
        }
        __syncthreads();
    }
}

__device__ __forceinline__ void p1_naive(Frame& F) {
    const int gw = F.bid * NWAVES + F.wave, NGW = F.G * NWAVES, lane = F.lane;
    for (int it = gw; it < M_ALL * 20; it += NGW) {
        const int row = it / 20, grp = it % 20;
        const bf16_t* xr = F.XN + (size_t)row * D;
        if (grp < 12) {
            const int col = grp * 64 + lane; float acc = 0.f;
            _Pragma("unroll 4") for (int k = 0; k < D; ++k) acc += bf2f(xr[k]) * F.w_in[(size_t)k * IN_W + col];
            if (grp < 10) {
                const float ssq = wave_sum(acc * acc); const float r = 1.f / sqrtf(ssq * (1.f / 64.f) + 1e-6f);
                if (grp < 8) F.Qb[(size_t)row * 512 + col] = (bf16_t)f2bf(acc * r * F.qg[lane] * QSCALE);
                else F.Kb[(size_t)row * 128 + (col - 512)] = (bf16_t)f2bf(acc * r * F.kg[lane]);
            } else {
                const int hk = grp - 10; int b, kx;
                if (row < M_REAL) { b = row >> 11; kx = NMETA + (row & 2047); } else { b = (row - M_REAL) >> 4; kx = (row - M_REAL) & 15; }
                F.VT[((size_t)(b * 2 + hk) * 64 + lane) * VT_PITCH + kx] = (bf16_t)f2bf(acc);
            }
        } else {
            const int c = (grp - 12) * 64 + lane; float a = 0.f, g = 0.f;
            for (int k = 0; k < D; ++k) { const float xv = bf2f(xr[k]); a += xv * F.w_in[(size_t)k * IN_W + 768 + c]; g += xv * F.w_in[(size_t)k * IN_W + 1280 + c]; }
            F.HC[(size_t)row * 512 + c] = (bf16_t)f2bf(a * sigmoidf_fast(g));
        }
    }
}
__device__ __forceinline__ void att_naive(Frame& F) {
    const int gw = F.bid * NWAVES + F.wave, NGW = F.G * NWAVES, lane = F.lane;
    for (int it = gw; it < M_REAL * NQH; it += NGW) {
        const int row = it >> 3, h = it & 7, hk = h >> 2, b = row >> 11, qp = row & 2047;
        const float q = bf2f(F.Qb[(size_t)row * 512 + h * 64 + lane]);
        const float slope2 = exp2f(-(float)(h + 1)) * LOG2E;
        float m = F.sink[h] * LOG2E, l = 1.f, acc = 0.f;
        const bf16_t* vt = F.VT + ((size_t)(b * 2 + hk) * 64 + lane) * VT_PITCH;
        for (int j = 0; j < NMETA; ++j) {
            const float kv = bf2f(F.Kb[(size_t)(M_REAL + b * NMETA + j) * 128 + hk * 64 + lane]);
            const float s = wave_sum(q * kv);
            const float mn = fmaxf(m, s), al = exp2f(m - mn), p = exp2f(s - mn);
            l = l * al + p; acc = acc * al + p * bf2f(vt[j]); m = mn;
        }
        const int k0 = qp - 128 < 0 ? 0 : qp - 128, k1 = qp + 128 > SEQ - 1 ? SEQ - 1 : qp + 128;
        for (int kp = k0; kp <= k1; ++kp) {
            const float kv = bf2f(F.Kb[(size_t)(b * SEQ + kp) * 128 + hk * 64 + lane]);
            const float dist = (float)(qp > kp ? qp - kp : kp - qp);
            const float s = wave_sum(q * kv) - slope2 * dist;
            const float mn = fmaxf(m, s), al = exp2f(m - mn), p = exp2f(s - mn);
            l = l * al + p; acc = acc * al + p * bf2f(vt[NMETA + kp]); m = mn;
        }
        F.MIX[(size_t)row * D + h * 64 + lane] = (bf16_t)f2bf(acc / l);
    }
}
__device__ __forceinline__ void conv_naive(Frame& F) {
    const int gw = F.bid * NWAVES + F.wave, NGW = F.G * NWAVES, lane = F.lane;
    for (int row = gw; row < M_REAL; row += NGW) {
        const int b = row >> 11, s0 = NMETA + (row & 2047);
        float v[8]; float sum = 0.f;
#pragma unroll
        for (int j = 0; j < 8; ++j) { const int c = lane + 64 * j; float a = F.dw_b[c];
            _Pragma("unroll 1") for (int t = 0; t < CONV_K; ++t) { const int s = s0 - 15 + t; if (s >= 0 && s < LSEQ) a += F.dw_w[t * CONV_W + c] * bf2f(F.HC[(size_t)row_of(b, s) * 512 + c]); }
            v[j] = a; sum += a; }
        const float mu = wave_sum(sum) * (1.f / 512.f); float q = 0.f;
#pragma unroll
        for (int j = 0; j < 8; ++j) { const float d = v[j] - mu; q += d * d; }
        const float rstd = 1.f / sqrtf(wave_sum(q) * (1.f / 512.f) + 1e-5f);
#pragma unroll
        for (int j = 0; j < 8; ++j) { const int c = lane + 64 * j; const float y = (v[j] - mu) * rstd * F.lng[c] + F.lnb[c];
            F.MIX[(size_t)row * D + 512 + c] = (bf16_t)f2bf(y * sigmoidf_fast(y)); }
    }
}
__device__ __forceinline__ void p3_naive(Frame& F) {
    const int gw = F.bid * NWAVES + F.wave, NGW = F.G * NWAVES, lane = F.lane;
    for (int it = gw; it < M_REAL * 16; it += NGW) {
        const int row = it >> 4, col = (it & 15) * 64 + lane; const bf16_t* mr = F.MIX + (size_t)row * D; float acc = 0.f;
        for (int k = 0; k < D; ++k) acc += bf2f(mr[k]) * F.w_out[(size_t)k * D + col];
        const float h2 = F.x[(size_t)row * D + col] + acc;
        F.out[(size_t)row * D + col] = h2; F.XN2[(size_t)row * D + col] = (bf16_t)f2bf(h2); F.XN2F8[(size_t)row * D + col] = (unsigned char)(pk4_fp8(h2, 0.f, 0.f, 0.f) & 0xffu);
    }
}
__device__ __forceinline__ void p4_naive(Frame& F) {
    const int gw = F.bid * NWAVES + F.wave, NGW = F.G * NWAVES, lane = F.lane, e = lane & 31;
    for (int t = gw; t < M_REAL; t += NGW) {
        const bf16_t* xr = F.XN2 + (size_t)t * D; float acc = 0.f, ss = 0.f;
        for (int k = 0; k < D; ++k) { const float xv = bf2f(xr[k]); acc += xv * F.n2g[k] * F.wr[k * NE + e]; ss += xv * xv; }
        const float rstd = 1.f / sqrtf(ss * (1.f / D) + 1e-6f);
        float lg = acc * rstd + F.rb[e];
        float tv[4]; int te[4];
#pragma unroll
        for (int kk = 0; kk < 4; ++kk) {
            float bv = lg; int be = e;
#pragma unroll
            for (int o = 1; o < 32; o <<= 1) { const float pv = __shfl_xor(bv, o); const int pe = __shfl_xor(be, o); if (pv > bv || (pv == bv && pe < be)) { bv = pv; be = pe; } }
            tv[kk] = bv; te[kk] = be; if (e == be) lg = -INFINITY;
        }
        float p[4], ps = 0.f;
#pragma unroll
        for (int kk = 0; kk < 4; ++kk) { p[kk] = __expf(tv[kk] - tv[0]); ps += p[kk]; }
        if (lane < 4) {
            const int ee = lane == 0 ? te[0] : lane == 1 ? te[1] : lane == 2 ? te[2] : te[3];
            const float gg = (lane == 0 ? p[0] : lane == 1 ? p[1] : lane == 2 ? p[2] : p[3]) / ps;
            const unsigned slot = __hip_atomic_fetch_add((unsigned*)(F.ctl + CW_CNT + ee), 1u, RLX_AGENT);
            F.ltok[ee * CAP + slot] = t; F.lgate[ee * CAP + slot] = gg; F.lrstd[ee * CAP + slot] = rstd; F.where[t * 4 + lane] = ee * CAP + (int)slot;
        }
    }
}
__device__ __forceinline__ void build_tile_table(Frame& F) {
    LAS int* tb = (LAS int*)(F.lds + LX_TB); LAS int* cn = (LAS int*)(F.lds + LX_CNT);
    __syncthreads();
    if (F.tid == 0) { int acc = 0; for (int e = 0; e < NE; ++e) { int c = (int)__hip_atomic_load(F.ctl + CW_CNT + e, RLX_AGENT); if (c > CAP) c = CAP; if (c < 0) c = 0; cn[e] = c; tb[e] = acc; acc += (c + 255) >> 8; } tb[NE] = acc; }
    __syncthreads();
}
__device__ __forceinline__ int find_expert(const LAS int* tb, int tile) { int e = 0;
#pragma unroll 1
    for (int j = 1; j < NE; ++j) if (tb[j] <= tile) e = j;
    return e; }
__device__ __forceinline__ void p7_combine(Frame& F) {
    build_tile_table(F);
    const LAS int* tb = (const LAS int*)(F.lds + LX_TB);
    const int gw = F.bid * NWAVES + F.wave, NGW = F.G * NWAVES, lane = F.lane;
    typedef int i32x4 __attribute__((ext_vector_type(4)));
    const GAS i32x4* wh = (const GAS i32x4*)F.where;
    int t0 = gw, t1 = gw + NGW;
    i32x4 w0 = t0 < M_REAL ? wh[t0] : (i32x4){0, 0, 0, 0}, w1 = t1 < M_REAL ? wh[t1] : (i32x4){0, 0, 0, 0};
    while (t0 < M_REAL) {
        const int n0 = t0 + 2 * NGW, n1 = t1 + 2 * NGW;
        const i32x4 nw0 = n0 < M_REAL ? wh[n0] : (i32x4){0, 0, 0, 0}, nw1 = n1 < M_REAL ? wh[n1] : (i32x4){0, 0, 0, 0};
        const bool v1 = t1 < M_REAL; const int tt1 = v1 ? t1 : t0;
        u32x4 y[2][5][2];
#pragma unroll
        for (int u = 0; u < 2; ++u) { const int t = u ? tt1 : t0; const i32x4 w = u ? w1 : w0;
#pragma unroll
            for (int j = 0; j < 2; ++j) y[u][4][j] = *((const GAS u32x4*)(F.XN2 + (size_t)t * D + 512 * j) + lane);
#pragma unroll
            for (int k = 0; k < 4; ++k) { const int e = w[k] / CAP, slot = w[k] - e * CAP; const bf16_t* yr = F.Y + (size_t)(tb[e] * 256 + slot) * D;
#pragma unroll
                for (int j = 0; j < 2; ++j) y[u][k][j] = *((const GAS u32x4*)(yr + 512 * j) + lane); } }
#pragma unroll
        for (int u = 0; u < 2; ++u) { if (u && !v1) break; const int t = u ? tt1 : t0;
#pragma unroll
            for (int j = 0; j < 2; ++j) { f32x4 a0 = {0.f, 0.f, 0.f, 0.f}, a1 = a0;
#pragma unroll
                for (int k = 0; k < 5; ++k) { const u32x4 q = y[u][k][j]; a0 += (f32x4){bflo(q.x), bfhi(q.x), bflo(q.y), bfhi(q.y)}; a1 += (f32x4){bflo(q.z), bfhi(q.z), bflo(q.w), bfhi(q.w)}; }
                GAS f32x4* o = (GAS f32x4*)(F.out + (size_t)t * D + 512 * j) + 2 * lane; o[0] = a0; o[1] = a1; } }
        t0 = n0; t1 = n1; w0 = nw0; w1 = nw1;
    }
}

__global__ void __launch_bounds__(NTHR, 2) mega(Args args) {
    extern __shared__ __attribute__((aligned(16))) unsigned char lds_raw[];
    Frame F;
    F.lds = (LAS unsigned char*)lds_raw;
    F.tid = threadIdx.x; F.lane = F.tid & 63; F.wave = __builtin_amdgcn_readfirstlane(F.tid >> 6); F.G = gridDim.x; F.bid = blockIdx.x;
    F.x = args.in[0]; F.meta = args.in[1]; F.n1g = args.in[2]; F.w_in = args.in[3]; F.qg = args.in[4]; F.kg = args.in[5]; F.sink = args.in[6];
    F.dw_w = args.in[7]; F.dw_b = args.in[8]; F.lng = args.in[9]; F.lnb = args.in[10]; F.w_out = args.in[11]; F.n2g = args.in[12];
    F.wr = args.in[13]; F.rb = args.in[14]; F.wgu = args.in[15]; F.bgu = args.in[16]; F.wd = args.in[17]; F.bd = args.in[18];
    F.out = args.out; F.ws = args.ws; unsigned char* ws = args.ws;
    F.ctl = (gu32*)(ws + WS_CTL);
    F.WinT = (bf16_t*)(ws + WS_WIN_T); F.WoT = (bf16_t*)(ws + WS_WO_T); F.WrT = (bf16_t*)(ws + WS_WR_T); F.WdT8 = ws + WS_WD_T; F.WguT8 = ws + WS_WGU_T; F.XN2F8 = ws + WS_XN2F8;
    F.XN = (bf16_t*)(ws + WS_XN); F.Qb = (bf16_t*)(ws + WS_Q); F.Kb = (bf16_t*)(ws + WS_K); F.VT = (bf16_t*)(ws + WS_VT); F.HC = (bf16_t*)(ws + WS_HC);
    F.MIX = (bf16_t*)(ws + WS_MIX); F.XN2 = (bf16_t*)(ws + WS_XN2); F.ACT8 = ws + WS_ACT; F.Y = (bf16_t*)(ws + WS_Y);
    F.where = (int*)(ws + WS_WHERE); F.ltok = (int*)(ws + WS_LTOK); F.lgate = (float*)(ws + WS_LGATE); F.lrstd = (float*)(ws + WS_LRSTD);
    for (int u = F.tid; u < (LDS_BYTES - RING_BYTES) / 4; u += NTHR) ((LAS unsigned*)(F.lds + RING_BYTES))[u] = 0u;
    __syncthreads();
    const int lo = args.ph_lo, hi = args.ph_hi;
    XcdBarrier bar; bar.bar = (unsigned*)(F.ctl + CW_BAR); bar.x = 0; bar.st = nullptr;
    if (hi - lo > 1) bar = xcd_barrier_post((unsigned*)(F.ctl + CW_BAR), (volatile LAS unsigned*)(F.lds + LX_BAR));
#ifndef PH_MASK
#define PH_MASK 0xFF
#endif
#define IN(k) (((PH_MASK >> (k)) & 1) && lo <= (k) && (k) < hi)
#define SEAM(k) do { if (IN(k) && IN((k) + 1)) xcd_barrier(bar); } while (0)
#ifndef REP_PH
#define REP_PH -1
#endif
#define REPS(k) _Pragma("unroll") for (int rep = 0; rep < ((REP_PH) == (k) ? 2 : 1); ++rep)
#define REPBAR() do { if (rep) xcd_barrier(bar); } while (0)
    if (IN(0)) { REPS(0) { REPBAR(); p0_prologue(F); } } SEAM(0);
    if (IN(1)) { REPS(1) { REPBAR();
#if FAST_P1
        pg8::DenseProb P{F.XN, F.WinT, M_PAD / 256, IN_W / 256, F.G, F.bid}; pg8::EpiIn E{F.Qb, F.Kb, F.VT, F.HC, F.qg, F.kg}; pg8::gemm_phase<2>(F.lds, P, E);
#else
        p1_naive(F);
#endif
    } } SEAM(1);
    if (IN(2)) { REPS(2) { REPBAR();
#if FAST_ATT
        att_fast(F);
#else
        att_naive(F);
#endif
    } REPS(8) { REPBAR();
#if FAST_CONV
        conv_fast(F);
#else
        conv_naive(F);
#endif
    } } SEAM(2);
    if (IN(3)) { REPS(3) { REPBAR();
#if FAST_P3
        pg8::DenseProb P{F.MIX, F.WoT, M_REAL / 256, D / 256, F.G, F.bid}; pg8::EpiOut E{F.x, F.out, F.XN2, F.XN2F8}; pg8::gemm_phase<2>(F.lds, P, E);
#else
        p3_naive(F);
#endif
    } } SEAM(3);
    if (IN(4)) {
#if FAST_P4
        p4_fast(F);
#else
        p4_naive(F);
#endif
    } SEAM(4);
    if (IN(5)) { REPS(5) { REPBAR();
        build_tile_table(F); pg8::GroupedProb<true, 1> P{F.XN2F8, F.WguT8, F.ltok, (const LAS int*)(F.lds + LX_TB), (const LAS int*)(F.lds + LX_CNT), 8, F.G, F.bid};
        pg8::EpiGU E{F.ACT8, F.lrstd, F.bgu}; pg8::gemm_phase<1>(F.lds, P, E);
    } } SEAM(5);
    if (IN(6)) { REPS(6) { REPBAR();
        build_tile_table(F); pg8::GroupedProb<false, 1> P{F.ACT8, F.WdT8, F.ltok, (const LAS int*)(F.lds + LX_TB), (const LAS int*)(F.lds + LX_CNT), 4, F.G, F.bid};
        pg8::EpiDown E{F.Y, F.lgate, F.bd}; pg8::gemm_phase<1>(F.lds, P, E);
    } } SEAM(6);
    if (IN(7)) { REPS(7) { REPBAR(); p7_combine(F); } }
#undef IN
#undef SEAM
}

extern "C" void kernel_launch(void* const* d_in, const int* in_sizes, int n_in, void* d_out, int out_size, void* d_ws, size_t ws_size, hipStream_t stream) {
    static int grid = 0;
    if (grid == 0) {
        if (n_in != 19 || in_sizes[0] != M_REAL * D || out_size != M_REAL * D || ws_size < WS_END) {
            fprintf(stderr, "kernel_launch: unexpected shapes/workspace: n_in %d in0 %d out %d ws %zu (need %zu)\n", n_in, n_in > 0 ? in_sizes[0] : -1, out_size, ws_size, (size_t)WS_END); grid = -1; return; }
        int dev = 0, cus = 0, per_cu = 0;
        if (hipGetDevice(&dev) != hipSuccess || hipDeviceGetAttribute(&cus, hipDeviceAttributeMultiprocessorCount, dev) != hipSuccess) { grid = -1; return; }
        if (hipFuncSetAttribute((const void*)mega, hipFuncAttributeMaxDynamicSharedMemorySize, LDS_BYTES) != hipSuccess) { fprintf(stderr, "kernel_launch: hipFuncSetAttribute failed\n"); grid = -1; return; }
        if (hipOccupancyMaxActiveBlocksPerMultiprocessor(&per_cu, (const void*)mega, NTHR, LDS_BYTES) != hipSuccess || per_cu < 1) { fprintf(stderr, "kernel_launch: occupancy query says %d blocks/CU\n", per_cu); (void)hipGetLastError(); grid = -1; return; }
        grid = cus;
    }
    if (grid < 0) return;
    (void)hipMemsetAsync((char*)d_ws + WS_CTL, 0, CTL_ZERO_BYTES, stream);
    Args a{};
    for (int i = 0; i < 19; ++i) a.in[i] = (const float*)d_in[i];
    a.out = (float*)d_out; a.ws = (unsigned char*)d_ws;
#if MK_PER_PHASE
    for (int p = 0; p < 8; ++p) { a.ph_lo = p; a.ph_hi = p + 1; hipLaunchKernelGGL(mega, dim3(grid), dim3(NTHR), LDS_BYTES, stream, a); }
#else
    a.ph_lo = 0; a.ph_hi = 8; hipLaunchKernelGGL(mega, dim3(grid), dim3(NTHR), LDS_BYTES, stream, a);
#endif
}
```

```cpp
#include <hip/hip_runtime.h>
#include <cstdio>
#include <cstdint>

#ifndef MK_PER_PHASE
#define MK_PER_PHASE 0
#endif
#ifndef FAST_P1
#define FAST_P1 1
#endif
#ifndef FAST_ATT
#define FAST_ATT 1
#endif
#ifndef FAST_CONV
#define FAST_CONV 1
#endif
#ifndef FAST_P3
#define FAST_P3 1
#endif
#ifndef FAST_P4
#define FAST_P4 1
#endif
#ifndef FAST_P5
#define FAST_P5 1
#endif
#ifndef FAST_P6
#define FAST_P6 1
#endif

#define GAS __attribute__((address_space(1)))
#define LAS __attribute__((address_space(3)))
typedef unsigned short bf16_t;
typedef short bf16x8 __attribute__((ext_vector_type(8)));
typedef float f32x4 __attribute__((ext_vector_type(4)));
typedef float f32x16 __attribute__((ext_vector_type(16)));
typedef int i32x4 __attribute__((ext_vector_type(4)));
typedef int i32x8 __attribute__((ext_vector_type(8)));
typedef unsigned u32x4 __attribute__((ext_vector_type(4)));
typedef unsigned u32x2 __attribute__((ext_vector_type(2)));
typedef float f32x2 __attribute__((ext_vector_type(2)));
typedef GAS unsigned gu32;
#define RLX_AGENT __ATOMIC_RELAXED, __HIP_MEMORY_SCOPE_AGENT

constexpr int NB = 8, SEQ = 2048, D = 1024, NMETA = 16, LSEQ = NMETA + SEQ;
constexpr int M_REAL = NB * SEQ, M_ALL = NB * LSEQ, M_PAD = 16640;
constexpr int IN_W = 1792, HD = 64, NQH = 8, NKV = 2, CONV_W = 512, CONV_K = 31;
constexpr int NE = 32, CAP = 16384, ACT_ROWS = 4 * M_REAL + NE * 256;
constexpr float LOG2E = 1.4426950408889634f;
constexpr float QSCALE = 0.125f * LOG2E;
constexpr float WSCALE = 32.0f;
constexpr int VT_PITCH = LSEQ;

constexpr size_t MiB = 1u << 20;
constexpr size_t WS_CTL = 0, CTL_ZERO_BYTES = 32768;
constexpr size_t WS_WIN_T = 2 * MiB;
constexpr size_t WS_WO_T = 6 * MiB;
constexpr size_t WS_WR_T = 8 * MiB;
constexpr size_t WS_RSTD = 9 * MiB;
constexpr size_t WS_WHERE = 9 * MiB + 512 * 1024;
constexpr size_t WS_LTOK = 10 * MiB;
constexpr size_t WS_LGATE = 12 * MiB;
constexpr size_t WS_LRSTD = 14 * MiB;
constexpr size_t WS_WD_T = 16 * MiB;
constexpr size_t WS_WGU_T = 80 * MiB;
constexpr size_t WS_XN = 208 * MiB;
constexpr size_t WS_Q = 241 * MiB;
constexpr size_t WS_K = 258 * MiB;
constexpr size_t WS_VT = 263 * MiB;
constexpr size_t WS_HC = 268 * MiB;
constexpr size_t WS_MIX = 285 * MiB;
constexpr size_t WS_XN2 = 317 * MiB;
constexpr size_t WS_ACT = 349 * MiB;
constexpr size_t WS_Y = 493 * MiB;
constexpr size_t WS_XN2F8 = 637 * MiB;
constexpr size_t WS_END = 653 * MiB;
constexpr int CW_CNT = 64;
constexpr int CW_BAR = 4096;

constexpr int RING_BYTES = 131072;
constexpr int LX_BAR = RING_BYTES;
constexpr int LX_TB = RING_BYTES + 64;
constexpr int LX_CNT = RING_BYTES + 256;
constexpr int LX_LCNT = RING_BYTES + 512;
constexpr int LX_GBASE = RING_BYTES + 768;
constexpr int LDS_BYTES = 147456;

constexpr int NWAVES = 8, NTHR = 512;

__device__ __forceinline__ unsigned f2bf(float f) { unsigned u = __builtin_bit_cast(unsigned, f); return (u + 0x7fffu + ((u >> 16) & 1u)) >> 16; }
__device__ __forceinline__ unsigned pk2(float lo, float hi) { return f2bf(lo) | (f2bf(hi) << 16); }
__device__ __forceinline__ unsigned pk4_fp8(float a, float b, float c, float d) { int w = __builtin_amdgcn_cvt_pk_fp8_f32(a, b, 0, false); w = __builtin_amdgcn_cvt_pk_fp8_f32(c, d, w, true); return (unsigned)w; }
__device__ __forceinline__ float bf2f(unsigned b) { return __builtin_bit_cast(float, b << 16); }
__device__ __forceinline__ float bflo(unsigned w) { return __builtin_bit_cast(float, w << 16); }
__device__ __forceinline__ float bfhi(unsigned w) { return __builtin_bit_cast(float, w & 0xffff0000u); }
__device__ __forceinline__ float wave_sum(float v) {
#pragma unroll
    for (int o = 1; o < 64; o <<= 1) v += __shfl_xor(v, o);
    return v;
}
__device__ __forceinline__ float sigmoidf_fast(float x) { return __builtin_amdgcn_rcpf(1.0f + __builtin_amdgcn_exp2f(-x * LOG2E)); }
__device__ __forceinline__ int row_of(int b, int s) { return s < NMETA ? M_REAL + b * NMETA + s : b * SEQ + (s - NMETA); }

#define XB_TMO      128
#define XB_XCNT(j)  (256  + 64 * (j))
#define XB_XSUB(j)  (1280 + 64 * (j))
#define XB_XGEN(j)  (2304 + 64 * (j))
#define XB_TOP      3328
#define XB_TOPGEN   3392
#define XCD_BAR_WORDS 3456
#define XB_SPIN_CAP (1u << 18)
__device__ __forceinline__ unsigned xb_ld(unsigned* p)              { return __hip_atomic_load(p, __ATOMIC_RELAXED, __HIP_MEMORY_SCOPE_AGENT); }
__device__ __forceinline__ unsigned xb_add(unsigned* p, unsigned v) { return __hip_atomic_fetch_add(p, v, __ATOMIC_RELAXED, __HIP_MEMORY_SCOPE_AGENT); }
__device__ __forceinline__ unsigned xb_xcc_id() { return (unsigned)__builtin_amdgcn_s_getreg((3 << 11) | 20) & 0xFu; }
#define XB_SPIN(cond, bar) do { unsigned _sp = 0; while (cond) { __builtin_amdgcn_s_sleep(1); \
    if ((++_sp & 255u) == 0u) { if (xb_ld(&(bar)[XB_TMO])) break; if (_sp > XB_SPIN_CAP) { atomicAdd(&(bar)[XB_TMO], 1u); break; } } } } while (0)
struct XcdBarrier { unsigned* bar; unsigned x; volatile LAS unsigned* st; };
__device__ __forceinline__ XcdBarrier xcd_barrier_post(unsigned* bar, volatile LAS unsigned* st) {
    XcdBarrier b; b.bar = bar; b.x = xb_xcc_id(); b.st = st;
    if (threadIdx.x == 0) (void)xb_add(&bar[XB_XCNT(b.x)], 1u);
    return b;
}
__device__ __forceinline__ void xcd_barrier_complete(unsigned* bar, unsigned x, unsigned& nloc, unsigned& nx) {
    const unsigned G = gridDim.x * gridDim.y * gridDim.z;
    unsigned sum, cnt, mine, sp = 0u;
    for (;;) {
        sum = 0u; cnt = 0u; mine = 0u;
#pragma unroll
        for (unsigned j = 0; j < 16; ++j) { const unsigned c = xb_ld(&bar[XB_XCNT(j)]); sum += c; cnt += (c > 0u) ? 1u : 0u; mine = (j == x) ? c : mine; }
        if (sum == G) break;
        __builtin_amdgcn_s_sleep(1);
        if ((++sp & 255u) == 0u) { if (xb_ld(&bar[XB_TMO])) break; if (sp > XB_SPIN_CAP) { atomicAdd(&bar[XB_TMO], 1u); break; } }
    }
    nloc = mine > 0u ? mine : 1u; nx = cnt > 0u ? cnt : 1u;
}
__device__ __forceinline__ void xcd_barrier(const XcdBarrier& b) {
    asm volatile("s_waitcnt vmcnt(0)" ::: "memory");
    __syncthreads();
    if (threadIdx.x == 0) {
        unsigned* bar = b.bar;
        __builtin_amdgcn_s_waitcnt(0);
        unsigned nloc = b.st[0], nx = b.st[1];
        if (nloc == 0u) { xcd_barrier_complete(bar, b.x, nloc, nx); b.st[0] = nloc; b.st[1] = nx; }
        const unsigned old = xb_add(&bar[XB_XSUB(b.x)], 1u);
        const unsigned gen = old / nloc;
        if (old + 1u == (gen + 1u) * nloc) {
            __builtin_amdgcn_fence(__ATOMIC_RELEASE, "agent");
            asm volatile("s_waitcnt vmcnt(0)" ::: "memory");
            const unsigned og = xb_add(&bar[XB_TOP], 1u);
            const unsigned tg = og / nx;
            if (og + 1u == (tg + 1u) * nx) xb_add(&bar[XB_TOPGEN], 1u);
            else XB_SPIN(xb_ld(&bar[XB_TOPGEN]) == tg, bar);
            __builtin_amdgcn_fence(__ATOMIC_ACQUIRE, "agent");
            xb_add(&bar[XB_XGEN(b.x)], 1u);
            asm volatile("s_waitcnt vmcnt(0)" ::: "memory");
        } else {
            XB_SPIN(xb_ld(&bar[XB_XGEN(b.x)]) == gen, bar);
            __builtin_amdgcn_fence(__ATOMIC_ACQUIRE, "agent");
            asm volatile("s_waitcnt vmcnt(0)" ::: "memory");
        }
    }
    __syncthreads();
}

struct Args { const float* in[19]; float* out; unsigned char* ws; int ph_lo, ph_hi; };
struct Frame {
    LAS unsigned char* lds;
    int tid, lane, wave, G, bid;
    const float *x, *meta, *n1g, *w_in, *qg, *kg, *sink, *dw_w, *dw_b, *lng, *lnb, *w_out, *n2g, *wr, *rb, *wgu, *bgu, *wd, *bd;
    float* out;
    unsigned char* ws;
    gu32* ctl;
    unsigned char *WguT8, *XN2F8, *WdT8, *ACT8; bf16_t *WinT, *WoT, *WrT, *XN, *Qb, *Kb, *VT, *HC, *MIX, *XN2; unsigned char* Y8;
    int* where; int* ltok; float* lgate; float* lrstd;
};

__device__ __forceinline__ int perm32(int rho) { const int n = rho >> 4, i = rho & 15; return 8 * (i >> 2) + 4 * n + (i & 3); }
__device__ __forceinline__ int lbase_nat(int pg) { return 32 * pg; }
__device__ __forceinline__ int lbase_in(int pg) { const int tile = pg >> 3, bj = (pg >> 2) & 1, wc = pg & 3; return tile <= 2 ? tile * 256 + 64 * wc + 32 * bj : 768 + bj * 512 + (tile - 3) * 128 + 32 * wc; }
__device__ __forceinline__ int lbase_gu(int pg) { const int tile = pg >> 3, bj = (pg >> 2) & 1, wc = pg & 3; return bj * 1024 + tile * 128 + 32 * wc; }
struct P0Item { const float* W; void* WT; const float* g; int N, pg, n0, k0; bool permute; bool f8; };
__device__ __forceinline__ bool p0_decode(const Frame& F, int it, P0Item& I) {
    constexpr int I_IN = 16 * 56, I_O = 16 * 32, I_R = 16, I_GU = NE * 16 * 64, I_D = NE * 16 * 32;
    int r = it;
    if (r < I_IN) { const int pg = r % 56, kb = r / 56; I = P0Item{F.w_in, F.WinT, nullptr, IN_W, pg, lbase_in(pg), 64 * kb, true, false}; return true; } r -= I_IN;
    if (r < I_O) { const int pg = r % 32, kb = r / 32; I = P0Item{F.w_out, F.WoT, nullptr, D, pg, lbase_nat(pg), 64 * kb, true, false}; return true; } r -= I_O;
    if (r < I_R) { I = P0Item{F.wr, F.WrT, F.n2g, NE, 0, 0, 64 * r, false, false}; return true; } r -= I_R;
    if (r < I_GU) { const int e = r / (16 * 64), q = r % (16 * 64), pg = q % 64, kb = q / 64; I = P0Item{F.wgu + (size_t)e * D * 2048, F.WguT8 + (size_t)e * 2048 * D, F.n2g, 2048, pg, lbase_gu(pg), 64 * kb, true, true}; return true; } r -= I_GU;
    if (r < I_D) { const int e = r / (16 * 32), q = r % (16 * 32), pg = q % 32, kb = q / 32; I = P0Item{F.wd + (size_t)e * D * D, F.WdT8 + (size_t)e * D * D, nullptr, D, pg, lbase_nat(pg), 64 * kb, true, true}; return true; }
    return false;
}
__device__ __forceinline__ void p0_load(const P0Item& I, int lane, f32x4 (&v)[8]) {
    const float* p = I.W + (size_t)(I.k0 + (lane >> 3)) * I.N + I.n0 + 4 * (lane & 7);
#pragma unroll
    for (int i = 0; i < 8; ++i) v[i] = __builtin_nontemporal_load((const f32x4*)(p + (size_t)(8 * i) * I.N));
}
__device__ __forceinline__ void p0_store(const P0Item& I, int lane, LAS float* scr, const f32x4 (&v)[8]) {
    LAS float* w = scr + (lane >> 3) * 33 + 4 * (lane & 7);
#pragma unroll
    for (int i = 0; i < 8; ++i) { w[(8 * i) * 33 + 0] = v[i][0]; w[(8 * i) * 33 + 1] = v[i][1]; w[(8 * i) * 33 + 2] = v[i][2]; w[(8 * i) * 33 + 3] = v[i][3]; }
    asm volatile("s_waitcnt lgkmcnt(0)" ::: "memory");
    const int c = lane & 7;
    f32x4 g0 = {1.f, 1.f, 1.f, 1.f}, g1 = g0;
    if (I.g) { g0 = *(const f32x4*)(I.g + I.k0 + 8 * c); g1 = *(const f32x4*)(I.g + I.k0 + 8 * c + 4); }
    if (I.f8) { g0 *= WSCALE; g1 *= WSCALE; }
#pragma unroll
    for (int j = 0; j < 4; ++j) { const int r = (lane >> 3) + 8 * j; const int sc = I.permute ? perm32(r) : r; const LAS float* s = scr + (8 * c) * 33 + sc;
        if (I.f8) { u32x2 o; o.x = pk4_fp8(s[0 * 33] * g0[0], s[1 * 33] * g0[1], s[2 * 33] * g0[2], s[3 * 33] * g0[3]); o.y = pk4_fp8(s[4 * 33] * g1[0], s[5 * 33] * g1[1], s[6 * 33] * g1[2], s[7 * 33] * g1[3]);
            *(GAS u32x2*)((unsigned char*)I.WT + (size_t)(32 * I.pg + r) * D + I.k0 + 8 * c) = o; }
        else { u32x4 o; o.x = pk2(s[0 * 33] * g0[0], s[1 * 33] * g0[1]); o.y = pk2(s[2 * 33] * g0[2], s[3 * 33] * g0[3]); o.z = pk2(s[4 * 33] * g1[0], s[5 * 33] * g1[1]); o.w = pk2(s[6 * 33] * g1[2], s[7 * 33] * g1[3]);
            *(GAS u32x4*)((bf16_t*)I.WT + (size_t)(32 * I.pg + r) * D + I.k0 + 8 * c) = o; } }
    asm volatile("s_waitcnt lgkmcnt(0)" ::: "memory");
}
__device__ __forceinline__ void p0_prologue(Frame& F) {
    LAS float* scr = (LAS float*)(F.lds + F.wave * 16384);
    const int gw = F.bid * NWAVES + F.wave, NGW = F.G * NWAVES, lane = F.lane;
    {
        P0Item cur, nxt; f32x4 va[8], vb[8];
        int it = gw; bool valid = p0_decode(F, it, cur);
        if (valid) p0_load(cur, lane, va);
        while (valid) {
            it += NGW; const bool vn = p0_decode(F, it, nxt);
            if (vn) p0_load(nxt, lane, vb);
            p0_store(cur, lane, scr, va);
            cur = nxt; valid = vn;
#pragma unroll
            for (int i = 0; i < 8; ++i) va[i] = vb[i];
        }
    }
    const GAS f32x4* gr = (const GAS f32x4*)F.n1g + lane;
    for (int m0 = 2 * gw; m0 < M_PAD; m0 += 2 * NGW) {
        f32x4 v[2][4]; float ss[2];
#pragma unroll
        for (int u = 0; u < 2; ++u) { const int m = m0 + u; ss[u] = 0.f;
            if (m < M_ALL) { const float* src = m < M_REAL ? F.x + (size_t)m * D : F.meta + (size_t)((m - M_REAL) & (NMETA - 1)) * D; const GAS f32x4* xr = (const GAS f32x4*)src + lane;
#pragma unroll
                for (int j = 0; j < 4; ++j) v[u][j] = xr[64 * j]; }
            else {
#pragma unroll
                for (int j = 0; j < 4; ++j) v[u][j] = (f32x4){0.f, 0.f, 0.f, 0.f}; } }
#pragma unroll
        for (int u = 0; u < 2; ++u) {
#pragma unroll
            for (int j = 0; j < 4; ++j) ss[u] += (v[u][j].x * v[u][j].x + v[u][j].y * v[u][j].y) + (v[u][j].z * v[u][j].z + v[u][j].w * v[u][j].w);
            const float rstd = 1.f / sqrtf(wave_sum(ss[u]) * (1.f / D) + 1e-6f);
            GAS unsigned long long* o8 = (GAS unsigned long long*)(F.XN + (size_t)(m0 + u) * D) + lane;
#pragma unroll
            for (int j = 0; j < 4; ++j) { const f32x4 g = gr[64 * j]; o8[64 * j] = (unsigned long long)pk2(v[u][j].x * rstd * g.x, v[u][j].y * rstd * g.y) | ((unsigned long long)pk2(v[u][j].z * rstd * g.z, v[u][j].w * rstd * g.w) << 32); }
        }
    }
}

namespace pg8 {
constexpr int BM = 256, BK = 64, HALF = 128, HTB = HALF * BK * 2, STAGE_BYTES = 8 * HTB, NXCD = 8, WGM = 8, KD = 1024;
__device__ __forceinline__ int lds_byte(int r, int c) { const int st = (r >> 4) * 2 + (c >> 5), rr = r & 15, cc = c & 31, ob = rr * 64 + cc * 2; return st * 1024 + (ob ^ (((ob >> 9) & 1) << 5)); }
__device__ __forceinline__ void stage_rc(int b, int& R, int& C) { const int st = b / 1024, sb = b % 1024, swz = sb ^ (((sb >> 9) & 1) << 5); R = (st >> 1) * 16 + swz / 64; C = (st & 1) * 32 + (swz % 64) / 2; }
struct Unit { int pm, pn, e, slot0, nvalid, r0; };
__device__ __forceinline__ unsigned cvt_pk_bf16(float lo, float hi) { unsigned r; asm volatile("v_cvt_pk_bf16_f32 %0, %1, %2" : "=v"(r) : "v"(lo), "v"(hi)); return r; }
__device__ __forceinline__ u32x4 pack8(const f32x4 a, const f32x4 b) { u32x4 w; w.x = cvt_pk_bf16(a[0], a[1]); w.y = cvt_pk_bf16(a[2], a[3]); w.z = cvt_pk_bf16(b[0], b[1]); w.w = cvt_pk_bf16(b[2], b[3]); return w; }

template <bool HALVES>
__device__ __forceinline__ bool tile_order(int i, int G, int c, int nM, int nN, int& pm, int& pn, int& half) {
    const int nwg = nM * nN; long L = (long)i * G + c; half = -1;
    if (HALVES) { const int nfull = (nwg / G) * G, left = nwg - nfull; if (left > 0 && 2 * left <= G && L >= nfull) { const long hidx = L - nfull; if (hidx >= 2 * left) return false; L = nfull + (hidx >> 1); half = (int)(hidx & 1); } }
    if (L >= nwg) return false;
    int wgid = (int)L; { const int q = nwg / NXCD, r = nwg % NXCD, xcd = wgid % NXCD, off = wgid / NXCD; wgid = (xcd < r ? xcd * (q + 1) : r * (q + 1) + (xcd - r) * q) + off; }
    const int nig = WGM * nN, gid = wgid / nig, fm = gid * WGM, gsz = (nM - fm) < WGM ? (nM - fm) : WGM;
    pm = fm + ((wgid % nig) % gsz); pn = (wgid % nig) / gsz; return true;
}
struct DenseProb {
    static constexpr int RB = KD * 2;
    const bf16_t* A; const bf16_t* Bt; int nM, nN, G, c;
    __device__ __forceinline__ bool next(int i, Unit& u) const { u.e = 0; u.slot0 = 0; u.nvalid = 256; u.r0 = 0; int half; return tile_order<false>(i, G, c, nM, nN, u.pm, u.pn, half); }
    __device__ __forceinline__ void addr_load(const Unit&, const int (&)[2], int (&)[4]) const {}
    __device__ __forceinline__ void addr_finish(const Unit& u, const int (&R)[2], const int (&C)[2], const int (&)[4], const char*& a, const char*& b, unsigned (&va0)[2], unsigned (&va1)[2]) const {
        a = (const char*)A + (size_t)u.pm * (BM * RB); b = (const char*)Bt + (size_t)u.pn * (BM * RB);
#pragma unroll
        for (int i = 0; i < 2; ++i) { va0[i] = (unsigned)(R[i] * RB + C[i] * 2); va1[i] = va0[i] + (unsigned)(HALF * RB); }
    }
};
template <bool GATHER, int ES> struct GroupedProb {
    static constexpr int RB = KD * ES;
    const void* A; const void* Bt; const int* ltok; const LAS int* tb; const LAS int* cn; int nN, G, c;
    __device__ __forceinline__ bool next(int i, Unit& u) const {
        const int nM = __builtin_amdgcn_readfirstlane(tb[NE]); int half;
        if (!tile_order<true>(i, G, c, nM, nN, u.pm, u.pn, half)) return false;
        int e = 0;
#pragma unroll 1
        for (int j = 1; j < NE; ++j) if (tb[j] <= u.pm) e = j;
        e = __builtin_amdgcn_readfirstlane(e);
        const int t0 = __builtin_amdgcn_readfirstlane(tb[e]), ce = __builtin_amdgcn_readfirstlane(cn[e]);
        u.e = e; u.r0 = half == 1 ? HALF : 0; u.slot0 = (u.pm - t0) * 256 + u.r0; int rem = ce - u.slot0; const int lim = half >= 0 ? HALF : 256; rem = rem < lim ? rem : lim; u.nvalid = rem < 0 ? 0 : rem; return true;
    }
    __device__ __forceinline__ void addr_load(const Unit& u, const int (&R)[2], int (&raw)[4]) const {
        if (GATHER) { const int* lt = ltok + u.e * CAP + u.slot0;
#pragma unroll
            for (int i = 0; i < 2; ++i) { const int r0 = R[i], r1 = R[i] + HALF; raw[2 * i] = r0 < u.nvalid ? lt[r0] : 0; raw[2 * i + 1] = r1 < u.nvalid ? lt[r1] : 0; } }
    }
    __device__ __forceinline__ void addr_finish(const Unit& u, const int (&R)[2], const int (&C)[2], const int (&raw)[4], const char*& a, const char*& b, unsigned (&va0)[2], unsigned (&va1)[2]) const {
        b = (const char*)Bt + ((size_t)u.e * nN + u.pn) * (BM * RB);
        if (GATHER) { a = (const char*)A;
#pragma unroll
            for (int i = 0; i < 2; ++i) { va0[i] = (unsigned)(raw[2 * i] * RB + C[i] * 2); va1[i] = (unsigned)(raw[2 * i + 1] * RB + C[i] * 2); }
        } else { a = (const char*)A + (size_t)(u.pm * BM + u.r0) * RB;
#pragma unroll
            for (int i = 0; i < 2; ++i) { va0[i] = (unsigned)(R[i] * RB + C[i] * 2); va1[i] = va0[i] + (unsigned)(HALF * RB); }
        }
    }
};

template <int ES  , class Prob, class Epi>
__device__ __forceinline__ void gemm_phase(LAS unsigned char* lds, const Prob& P, const Epi& E) {
    const int tid = threadIdx.x, wid = __builtin_amdgcn_readfirstlane(tid >> 6), lane = tid & 63, wr = wid >> 2, wc = wid & 3, fr = lane & 15, fq = lane >> 4;
    constexpr int RB = KD * ES, nt = RB / (BK * 2);
    int R[2], C[2]; unsigned voffB[2];
#pragma unroll
    for (int i = 0; i < 2; ++i) { stage_rc(tid * 16 + i * 8192, R[i], C[i]); voffB[i] = (unsigned)(R[i] * RB + C[i] * 2); }
    constexpr size_t kstep = (size_t)(BK * 2);
    constexpr size_t hstep = (size_t)HALF * RB;
    const unsigned ldsw = (unsigned)wid * 1024u;
    const int aoff = lds_byte(wr * 64 + fr, fq * 8), boff = lds_byte(wc * 32 + fr, fq * 8);
#define PG8_SA(b, h) (((b) * 2 + (h)) * HTB)
#define PG8_SB(b, h) ((4 + (b) * 2 + (h)) * HTB)
#define PG8_STAGE(bufoff, gbase, voff) do { _Pragma("unroll") for (int _i = 0; _i < 2; ++_i) \
        __builtin_amdgcn_global_load_lds((const unsigned*)((const char*)(gbase) + (voff)[_i]), (LAS unsigned*)(lds + (bufoff) + ldsw + _i * 8192), 16, 0, 0); } while (0)
#define PG8_LDA(dst, b, h) do { _Pragma("unroll") for (int m = 0; m < 4; ++m) { \
        if constexpr (ES == 2) { _Pragma("unroll") for (int k = 0; k < 2; ++k) dst[m][k] = *(const LAS bf16x8*)(lds + PG8_SA(b, h) + aoff + m * 2048 + k * 1024); } \
        else { const i32x4 lo_ = *(const LAS i32x4*)(lds + PG8_SA(b, h) + aoff + m * 2048), hi_ = *(const LAS i32x4*)(lds + PG8_SA(b, h) + aoff + m * 2048 + 1024); dst##8[m] = __builtin_shufflevector(lo_, hi_, 0, 1, 2, 3, 4, 5, 6, 7); } } } while (0)
#define PG8_LDB(dst, b, h) do { _Pragma("unroll") for (int n = 0; n < 2; ++n) { \
        if constexpr (ES == 2) { _Pragma("unroll") for (int k = 0; k < 2; ++k) dst[n][k] = *(const LAS bf16x8*)(lds + PG8_SB(b, h) + boff + n * 2048 + k * 1024); } \
        else { const i32x4 lo_ = *(const LAS i32x4*)(lds + PG8_SB(b, h) + boff + n * 2048), hi_ = *(const LAS i32x4*)(lds + PG8_SB(b, h) + boff + n * 2048 + 1024); dst##8[n] = __builtin_shufflevector(lo_, hi_, 0, 1, 2, 3, 4, 5, 6, 7); } } } while (0)
#define PG8_MMA(ai, bj, At, Bt) do { __builtin_amdgcn_s_setprio(1); _Pragma("unroll") for (int m = 0; m < 4; ++m) _Pragma("unroll") for (int n = 0; n < 2; ++n) { \
        if constexpr (ES == 2) { _Pragma("unroll") for (int k = 0; k < 2; ++k) acc[ai][bj][m][n] = __builtin_amdgcn_mfma_f32_16x16x32_bf16(Bt[n][k], At[m][k], acc[ai][bj][m][n], 0, 0, 0); } \
        else asm volatile("s_nop 1\n\tv_mfma_scale_f32_16x16x128_f8f6f4 %0, %1, %2, %0, %3, %3 op_sel_hi:[0,0,0]" : "+v"(acc[ai][bj][m][n]) : "v"(Bt##8[n]), "v"(At##8[m]), "v"(sc127)); } \
        __builtin_amdgcn_s_setprio(0); } while (0)
#define PG8_WAIT_V(n) asm volatile("s_waitcnt vmcnt(" #n ")" ::: "memory")
#define PG8_WAIT_L(n) asm volatile("s_waitcnt lgkmcnt(" #n ")" ::: "memory")
#define PG8_BAR __builtin_amdgcn_s_barrier()
#define PG8_SCHED __builtin_amdgcn_sched_barrier(0)
    Unit cur, nxt, nn; int ui = 0; int raw[4] = {0, 0, 0, 0};
    if (!P.next(0, cur)) return;
    bool has_next = P.next(1, nxt);
    const char *cA, *cB, *nA, *nB; unsigned va0[2], va1[2], nva0[2], nva1[2];
    P.addr_load(cur, R, raw); P.addr_finish(cur, R, C, raw, cA, cB, va0, va1);
    if (has_next) { P.addr_load(nxt, R, raw); P.addr_finish(nxt, R, C, raw, nA, nB, nva0, nva1); }
    else { nA = cA; nB = cB; nva0[0] = va0[0]; nva0[1] = va0[1]; nva1[0] = va1[0]; nva1[1] = va1[1]; }
    f32x4 acc[2][2][4][2];
#pragma unroll
    for (int a = 0; a < 2; ++a)
#pragma unroll
        for (int b = 0; b < 2; ++b)
#pragma unroll
            for (int m = 0; m < 4; ++m)
#pragma unroll
                for (int n = 0; n < 2; ++n) acc[a][b][m][n] = (f32x4){0.f, 0.f, 0.f, 0.f};
    const int sc127 = 0x7F7F7F7F;
    bf16x8 At[4][2], B0[2][2], B1[2][2]; i32x8 At8[4], B08[2], B18[2];
    PG8_STAGE(PG8_SB(0, 0), cB, voffB); PG8_STAGE(PG8_SB(0, 1), cB + hstep, voffB); PG8_STAGE(PG8_SA(0, 0), cA, va0); PG8_STAGE(PG8_SA(0, 1), cA, va1);
    if (wr == 1) PG8_BAR;
    PG8_WAIT_V(2); PG8_BAR;
    PG8_STAGE(PG8_SB(1, 0), cB + kstep, voffB); PG8_STAGE(PG8_SA(1, 0), cA + kstep, va0); PG8_STAGE(PG8_SB(1, 1), cB + hstep + kstep, voffB);
    PG8_WAIT_V(6); PG8_BAR;
    for (;;) {
        const bool full = cur.nvalid > HALF;
#pragma unroll 1
        for (int t = 0; t < nt; t += 2) {
            const bool last = (t == nt - 2);
            const char* a1 = cA + (size_t)(t + 1) * kstep;
            const char* a2 = last ? nA : cA + (size_t)(t + 2) * kstep; const char* b2 = last ? nB : cB + (size_t)(t + 2) * kstep;
            const char* a3 = a2 + kstep; const char* b3 = b2 + kstep;
            unsigned v2a0[2], v2a1[2];
            v2a0[0] = last ? nva0[0] : va0[0]; v2a0[1] = last ? nva0[1] : va0[1]; v2a1[0] = last ? nva1[0] : va1[0]; v2a1[1] = last ? nva1[1] : va1[1];
            PG8_LDB(B0, 0, 0); PG8_LDB(B1, 0, 1); PG8_SCHED; PG8_LDA(At, 0, 0); PG8_STAGE(PG8_SA(1, 1), a1, va1);
            PG8_WAIT_V(8); PG8_WAIT_L(0); PG8_BAR; PG8_MMA(0, 0, At, B0); PG8_MMA(0, 1, At, B1); PG8_BAR; PG8_SCHED;
            PG8_LDA(At, 0, 1); PG8_STAGE(PG8_SB(0, 0), b2, voffB); PG8_STAGE(PG8_SB(0, 1), b2 + hstep, voffB); PG8_STAGE(PG8_SA(0, 0), a2, v2a0);
            PG8_WAIT_V(8); PG8_WAIT_L(0); PG8_BAR; if (full) { PG8_MMA(1, 0, At, B0); PG8_MMA(1, 1, At, B1); } PG8_BAR; PG8_SCHED;
            PG8_LDB(B0, 1, 0); PG8_LDB(B1, 1, 1); PG8_SCHED; PG8_LDA(At, 1, 0); PG8_STAGE(PG8_SA(0, 1), a2, v2a1);
            PG8_WAIT_V(8); PG8_WAIT_L(0); PG8_BAR; PG8_MMA(0, 0, At, B0); PG8_MMA(0, 1, At, B1); PG8_BAR; PG8_SCHED;
            PG8_LDA(At, 1, 1); PG8_STAGE(PG8_SB(1, 0), b3, voffB); PG8_STAGE(PG8_SB(1, 1), b3 + hstep, voffB); PG8_STAGE(PG8_SA(1, 0), a3, v2a0);
            PG8_WAIT_V(8); PG8_WAIT_L(0); PG8_BAR; if (full) { PG8_MMA(1, 0, At, B0); PG8_MMA(1, 1, At, B1); } PG8_BAR; PG8_SCHED;
        }
        if constexpr (ES == 1) { asm volatile("s_nop 15\n\ts_nop 15" ::: "memory"); __builtin_amdgcn_sched_barrier(0); }
        const bool has_nn = has_next && P.next(ui + 2, nn);
        if (has_nn) P.addr_load(nn, R, raw);
        if (wr == 0) PG8_BAR;
        E(acc, cur, wr, wc, fr, fq);
        if (!has_next) break;
#pragma unroll
        for (int a = 0; a < 2; ++a)
#pragma unroll
            for (int b = 0; b < 2; ++b)
#pragma unroll
                for (int m = 0; m < 4; ++m)
#pragma unroll
                    for (int n = 0; n < 2; ++n) acc[a][b][m][n] = (f32x4){0.f, 0.f, 0.f, 0.f};
        cur = nxt; cA = nA; cB = nB; va0[0] = nva0[0]; va0[1] = nva0[1]; va1[0] = nva1[0]; va1[1] = nva1[1]; ++ui;
        nxt = nn; has_next = has_nn;
        if (has_next) P.addr_finish(nxt, R, C, raw, nA, nB, nva0, nva1);
        if (wr == 1) PG8_BAR;
    }
    PG8_WAIT_V(0);
    PG8_BAR;
#undef PG8_SA
#undef PG8_SB
#undef PG8_STAGE
#undef PG8_LDA
#undef PG8_LDB
#undef PG8_MMA
#undef PG8_WAIT_V
#undef PG8_WAIT_L
#undef PG8_BAR
#undef PG8_SCHED
}

struct EpiOut {
    const float* x; float* out; bf16_t* xn2; unsigned char* xn2f8;
    __device__ __forceinline__ void operator()(const f32x4 (&acc)[2][2][4][2], const Unit& u, int wr, int wc, int fr, int fq) const {
        const int row0 = u.pm * BM + wr * 64 + fr, col0 = u.pn * BM + wc * 32 + 8 * fq;
#pragma unroll
        for (int ai = 0; ai < 2; ++ai)
#pragma unroll
            for (int m = 0; m < 4; ++m) { const size_t off = (size_t)(row0 + ai * HALF + m * 16) * D + col0;
#pragma unroll
                for (int bj = 0; bj < 2; ++bj) { const float* xp = x + off + bj * HALF;
                    const f32x4 h0 = acc[ai][bj][m][0] + *(const f32x4*)xp, h1 = acc[ai][bj][m][1] + *(const f32x4*)(xp + 4);
                    *(u32x4*)(xn2 + off + bj * HALF) = pack8(h0, h1);
                    *(u32x2*)(xn2f8 + off + bj * HALF) = (u32x2){pk4_fp8(h0[0], h0[1], h0[2], h0[3]), pk4_fp8(h1[0], h1[1], h1[2], h1[3])}; }
                asm volatile("" ::: "memory"); }
    }
};
struct EpiIn {
    bf16_t *Qb, *Kb, *VT, *HC; const float *qg, *kg;
    __device__ __forceinline__ void operator()(const f32x4 (&acc)[2][2][4][2], const Unit& u, int wr, int wc, int fr, int fq) const {
        const int rowb = u.pm * BM + wr * 64 + fr;
        if (u.pn <= 2) {
            const bool isv = (u.pn == 2) && (wc >= 2);
            if (!isv) {
                const bool isq = u.pn < 2; const float* g = isq ? qg : kg; const float sc = isq ? QSCALE : 1.f;
                f32x4 gv[2][2];
#pragma unroll
                for (int bj = 0; bj < 2; ++bj)
#pragma unroll
                    for (int n = 0; n < 2; ++n) gv[bj][n] = *(const f32x4*)(g + 32 * bj + 8 * fq + 4 * n) * sc;
                bf16_t* dst = isq ? Qb + (u.pn * 256 + 64 * wc) : Kb + 64 * wc; const int ld = isq ? 512 : 128;
#pragma unroll
                for (int ai = 0; ai < 2; ++ai)
#pragma unroll
                    for (int m = 0; m < 4; ++m) { const int row = rowb + ai * HALF + m * 16; float ss = 0.f;
#pragma unroll
                        for (int bj = 0; bj < 2; ++bj)
#pragma unroll
                            for (int n = 0; n < 2; ++n) { const f32x4 v = acc[ai][bj][m][n]; ss += (v[0] * v[0] + v[1] * v[1]) + (v[2] * v[2] + v[3] * v[3]); }
                        ss += __shfl_xor(ss, 16); ss += __shfl_xor(ss, 32);
                        const float r = __builtin_amdgcn_rsqf(ss * (1.f / 64.f) + 1e-6f);
#pragma unroll
                        for (int bj = 0; bj < 2; ++bj) *(u32x4*)(dst + (size_t)row * ld + 32 * bj + 8 * fq) = pack8(acc[ai][bj][m][0] * r * gv[bj][0], acc[ai][bj][m][1] * r * gv[bj][1]); }
            } else {
                const int hk = wc - 2;
#pragma unroll
                for (int ai = 0; ai < 2; ++ai)
#pragma unroll
                    for (int m = 0; m < 4; ++m) { const int row = rowb + ai * HALF + m * 16;
                        if (row < M_ALL) { int b, kx; if (row < M_REAL) { b = row >> 11; kx = NMETA + (row & 2047); } else { b = (row - M_REAL) >> 4; kx = (row - M_REAL) & 15; }
                            bf16_t* base = VT + (size_t)(b * 2 + hk) * 64 * VT_PITCH + kx;
#pragma unroll
                            for (int bj = 0; bj < 2; ++bj)
#pragma unroll
                                for (int n = 0; n < 2; ++n)
#pragma unroll
                                    for (int e = 0; e < 4; ++e) base[(size_t)(32 * bj + 8 * fq + 4 * n + e) * VT_PITCH] = (bf16_t)f2bf(acc[ai][bj][m][n][e]); } }
            }
        } else {
            const int col = (u.pn - 3) * 128 + 32 * wc + 8 * fq;
#pragma unroll
            for (int ai = 0; ai < 2; ++ai)
#pragma unroll
                for (int m = 0; m < 4; ++m) { const int row = rowb + ai * HALF + m * 16; f32x4 h[2];
#pragma unroll
                    for (int n = 0; n < 2; ++n)
#pragma unroll
                        for (int e = 0; e < 4; ++e) h[n][e] = acc[ai][0][m][n][e] * sigmoidf_fast(acc[ai][1][m][n][e]);
                    *(u32x4*)(HC + (size_t)row * 512 + col) = pack8(h[0], h[1]); }
        }
    }
};
struct EpiGU {
    unsigned char* ACT; const float* lrstd; const float* bgu;
    __device__ __forceinline__ void operator()(const f32x4 (&acc)[2][2][4][2], const Unit& u, int wr, int wc, int fr, int fq) const {
        const int lr0 = wr * 64 + fr, col = u.pn * 128 + 32 * wc + 8 * fq;
        f32x4 bg[2], bu[2];
#pragma unroll
        for (int n = 0; n < 2; ++n) { bg[n] = *(const f32x4*)(bgu + u.e * 2048 + col + 4 * n); bu[n] = *(const f32x4*)(bgu + u.e * 2048 + 1024 + col + 4 * n); }
        const float* rs = lrstd + u.e * CAP + u.slot0;
#pragma unroll
        for (int ai = 0; ai < 2; ++ai)
#pragma unroll
            for (int m = 0; m < 4; ++m) { if (ai == 1 && u.nvalid <= HALF) continue; const int lr = lr0 + ai * HALF + m * 16; const float rstd = lr < u.nvalid ? rs[lr] * (1.f / WSCALE) : 0.f; f32x4 h[2];
#pragma unroll
                for (int n = 0; n < 2; ++n)
#pragma unroll
                    for (int e = 0; e < 4; ++e) { float gt = acc[ai][0][m][n][e] * rstd + bg[n][e], up = acc[ai][1][m][n][e] * rstd + bu[n][e];
                        gt = fminf(gt, 7.f); up = fminf(fmaxf(up, -7.f), 7.f); h[n][e] = gt * sigmoidf_fast(1.702f * gt) * (up + 1.f); }
                *(u32x2*)(ACT + (size_t)(u.pm * BM + u.r0 + lr) * D + col) = (u32x2){pk4_fp8(h[0][0], h[0][1], h[0][2], h[0][3]), pk4_fp8(h[1][0], h[1][1], h[1][2], h[1][3])}; }
    }
};
struct EpiDown {
    unsigned char* Y; const float* lgate; const float* bd;
    __device__ __forceinline__ void operator()(const f32x4 (&acc)[2][2][4][2], const Unit& u, int wr, int wc, int fr, int fq) const {
        const int lr0 = wr * 64 + fr, col0 = u.pn * BM + wc * 32 + 8 * fq;
        f32x4 bv[2][2];
#pragma unroll
        for (int bj = 0; bj < 2; ++bj)
#pragma unroll
            for (int n = 0; n < 2; ++n) bv[bj][n] = *(const f32x4*)(bd + u.e * D + col0 + bj * HALF + 4 * n);
        const float* gs = lgate + u.e * CAP + u.slot0;
#pragma unroll
        for (int ai = 0; ai < 2; ++ai)
#pragma unroll
            for (int m = 0; m < 4; ++m) { if (ai == 1 && u.nvalid <= HALF) continue; const int lr = lr0 + ai * HALF + m * 16; const float gt = lr < u.nvalid ? gs[lr] : 0.f;
#pragma unroll
                for (int bj = 0; bj < 2; ++bj) { const f32x4 y0 = (acc[ai][bj][m][0] * (1.f / WSCALE) + bv[bj][0]) * gt, y1 = (acc[ai][bj][m][1] * (1.f / WSCALE) + bv[bj][1]) * gt;
                    *(u32x2*)(Y + (size_t)(u.pm * BM + u.r0 + lr) * D + col0 + bj * HALF) = (u32x2){pk4_fp8(y0[0], y0[1], y0[2], y0[3]), pk4_fp8(y1[0], y1[1], y1[2], y1[3])}; } }
    }
};
}


constexpr int ATT_KIMG = 0, ATT_VIMG = 53248, ATT_VP = 840;
constexpr float ATT_THR = 4.0f;
template <int MODE>
__device__ __forceinline__ void att_tile(const LAS unsigned char* kbase, const int (&koff)[4], const LAS unsigned char* vbase, const bf16x8 (&qf)[4], float slope2, float Bq,
                                         float& m, float& l, f32x16& O0, f32x16& O1) {
    f32x16 s;
#pragma unroll
    for (int r = 0; r < 16; ++r) s[r] = 0.f;
#pragma unroll
    for (int ks = 0; ks < 4; ++ks) { const bf16x8 kf = *(const LAS bf16x8*)(kbase + koff[ks]); s = __builtin_amdgcn_mfma_f32_32x32x16_bf16(kf, qf[ks], s, 0, 0, 0); }
    float tmax = -INFINITY;
#pragma unroll
    for (int r = 0; r < 16; ++r) {
        if (MODE == 0) { if (r >= 8) s[r] = -INFINITY; }
        else { const float dl = fabsf(Bq - (float)((r & 3) + 8 * (r >> 2))); float v = s[r] - slope2 * dl; if (MODE == 2) v = dl <= 128.f ? v : -INFINITY; s[r] = v; }
        tmax = fmaxf(tmax, s[r]);
    }
    tmax = fmaxf(tmax, __shfl_xor(tmax, 32));
    if (__any(tmax > m + ATT_THR)) { const float mn = fmaxf(m, tmax); const float al = __builtin_amdgcn_exp2f(m - mn); m = mn; l *= al;
#pragma unroll
        for (int r = 0; r < 16; ++r) { O0[r] *= al; O1[r] *= al; } }
    float ps = 0.f;
#pragma unroll
    for (int r = 0; r < 16; ++r) { s[r] = __builtin_amdgcn_exp2f(s[r] - m); ps += s[r]; }
    l += ps;
#pragma unroll
    for (int s2 = 0; s2 < 2; ++s2) {
        u32x4 pw; pw.x = pg8::cvt_pk_bf16(s[8 * s2 + 0], s[8 * s2 + 1]); pw.y = pg8::cvt_pk_bf16(s[8 * s2 + 2], s[8 * s2 + 3]); pw.z = pg8::cvt_pk_bf16(s[8 * s2 + 4], s[8 * s2 + 5]); pw.w = pg8::cvt_pk_bf16(s[8 * s2 + 6], s[8 * s2 + 7]);
        const bf16x8 pf = __builtin_bit_cast(bf16x8, pw);
        { const u32x2 lo = *(const LAS u32x2*)(vbase + s2 * 32), hi = *(const LAS u32x2*)(vbase + s2 * 32 + 16); const u32x4 vw = {lo.x, lo.y, hi.x, hi.y};
          O0 = __builtin_amdgcn_mfma_f32_32x32x16_bf16(__builtin_bit_cast(bf16x8, vw), pf, O0, 0, 0, 0); }
        { const u32x2 lo = *(const LAS u32x2*)(vbase + 32 * ATT_VP + s2 * 32), hi = *(const LAS u32x2*)(vbase + 32 * ATT_VP + s2 * 32 + 16); const u32x4 vw = {lo.x, lo.y, hi.x, hi.y};
          O1 = __builtin_amdgcn_mfma_f32_32x32x16_bf16(__builtin_bit_cast(bf16x8, vw), pf, O1, 0, 0, 0); }
    }
}
__device__ __forceinline__ void att_fast(Frame& F) {
    LAS unsigned char* Kimg = F.lds + ATT_KIMG; LAS unsigned char* Vimg = F.lds + ATT_VIMG;
    const int tid = F.tid, lane = F.lane, wid = F.wave, q = lane & 31, h = lane >> 5, qt = wid & 3, hsel = wid >> 2;
    int koff[4];
#pragma unroll
    for (int ks = 0; ks < 4; ++ks) koff[ks] = ((2 * ks + h) ^ ((q >> 1) & 7)) << 4;
    for (int item = F.bid; item < NB * 16 * 2; item += F.G) {
        const int hk = item & 1, i = (item >> 1) & 15, b = item >> 5;
        __syncthreads();
        for (int idx = tid; idx < 416 * 8; idx += NTHR) { const int kr = idx >> 3, c = idx & 7; if (kr >= 16 && kr < 32) continue;
            int row; if (kr < 16) row = M_REAL + b * NMETA + kr; else { const int pos = (i - 1) * 128 + kr - 32; if (pos < 0 || pos >= SEQ) continue; row = b * SEQ + pos; }
            const u32x4 v = *(const GAS u32x4*)(F.Kb + (size_t)row * 128 + hk * 64 + 8 * c);
            *(LAS u32x4*)(Kimg + kr * 128 + ((c ^ ((kr >> 1) & 7)) << 4)) = v; }
        for (int idx = tid; idx < 64 * 52; idx += NTHR) { const int d = idx / 52, c = idx % 52; const bf16_t* vrow = F.VT + (size_t)((b * 2 + hk) * 64 + d) * VT_PITCH;
            LAS u32x2* dst; const bf16_t* src;
            if (c < 2) { src = vrow + 8 * c; dst = (LAS u32x2*)(Vimg + d * ATT_VP + 16 * c); }
            else if (c < 4) { dst = (LAS u32x2*)(Vimg + d * ATT_VP + 32 + 16 * (c - 2)); dst[0] = (u32x2){0u, 0u}; dst[1] = (u32x2){0u, 0u}; continue; }
            else { const int cc = c - 4, blk = cc >> 4, w = cc & 15, pos0 = (i - 1 + blk) * 128; if (pos0 < 0 || pos0 >= SEQ) continue; src = vrow + NMETA + pos0 + 8 * w; dst = (LAS u32x2*)(Vimg + d * ATT_VP + (32 + blk * 128 + 8 * w) * 2); }
            const u32x4 v = *(const GAS u32x4*)src; dst[0] = (u32x2){v.x, v.y}; dst[1] = (u32x2){v.z, v.w}; }
        __syncthreads();
#pragma unroll 1
        for (int hp = 0; hp < 2; ++hp) {
            const int head = hk * 4 + hp * 2 + hsel, row = b * SEQ + i * 128 + 32 * qt + q;
            bf16x8 qf[4];
#pragma unroll
            for (int ks = 0; ks < 4; ++ks) qf[ks] = *(const GAS bf16x8*)(F.Qb + (size_t)row * 512 + head * 64 + 16 * ks + 8 * h);
            const float slope2 = exp2f(-(float)(head + 1)) * LOG2E;
            float m = F.sink[head] * LOG2E, l = h == 0 ? 1.f : 0.f;
            f32x16 O0, O1;
#pragma unroll
            for (int r = 0; r < 16; ++r) { O0[r] = 0.f; O1[r] = 0.f; }
            const LAS unsigned char* kb0 = Kimg + q * 128; const LAS unsigned char* vb0 = Vimg + q * ATT_VP + 8 * h;
            att_tile<0>(kb0, koff, vb0, qf, 0.f, 0.f, m, l, O0, O1);
#pragma unroll 1
            for (int kt = qt; kt <= qt + 8; ++kt) { const int blk = kt >> 2; if ((i == 0 && blk == 0) || (i == 15 && blk == 2)) continue;
                const int kr0 = 32 + 32 * kt; const float Bq = (float)(128 + 32 * (qt - kt) + q - 4 * h);
                if (kt == qt || kt == qt + 8) att_tile<2>(kb0 + kr0 * 128, koff, vb0 + kr0 * 2, qf, slope2, Bq, m, l, O0, O1);
                else att_tile<1>(kb0 + kr0 * 128, koff, vb0 + kr0 * 2, qf, slope2, Bq, m, l, O0, O1); }
            l += __shfl_xor(l, 32); const float inv = 1.f / l;
            bf16_t* orow = F.MIX + (size_t)row * D + head * 64 + 4 * h;
#pragma unroll
            for (int g = 0; g < 4; ++g) { *(GAS u32x2*)(orow + 8 * g) = (u32x2){pg8::cvt_pk_bf16(O0[4 * g] * inv, O0[4 * g + 1] * inv), pg8::cvt_pk_bf16(O0[4 * g + 2] * inv, O0[4 * g + 3] * inv)};
                *(GAS u32x2*)(orow + 32 + 8 * g) = (u32x2){pg8::cvt_pk_bf16(O1[4 * g] * inv, O1[4 * g + 1] * inv), pg8::cvt_pk_bf16(O1[4 * g + 2] * inv, O1[4 * g + 3] * inv)}; }
        }
    }
    __syncthreads();
}
__device__ __forceinline__ void conv_fast(Frame& F) {
    const int tid = F.tid, lane = F.lane, wid = F.wave, c2 = tid & 255, th = tid >> 8;
    LAS float* cout = (LAS float*)F.lds;
    float w0[CONV_K], w1[CONV_K];
#pragma unroll
    for (int j = 0; j < CONV_K; ++j) { const f32x2 w = *(const f32x2*)(F.dw_w + j * CONV_W + 2 * c2); w0[j] = w.x; w1[j] = w.y; }
    const f32x2 bias = *(const f32x2*)(F.dw_b + 2 * c2);
    for (int item = F.bid; item < NB * 64; item += F.G) {
        const int b = item >> 6, t0 = (item & 63) * 32;
        unsigned xin[46];
        const int s0 = NMETA + t0 + 16 * th - 15;
#pragma unroll
        for (int jj = 0; jj < 46; ++jj) { const int sq = s0 + jj; xin[jj] = sq < LSEQ ? *(const GAS unsigned*)(F.HC + (size_t)row_of(b, sq) * 512 + 2 * c2) : 0u; }
        __syncthreads();
#pragma unroll
        for (int t = 0; t < 16; ++t) { float a0 = bias.x, a1 = bias.y;
#pragma unroll
            for (int j = 0; j < CONV_K; ++j) { a0 += w0[j] * bflo(xin[t + j]); a1 += w1[j] * bfhi(xin[t + j]); }
            *(LAS f32x2*)(cout + (16 * th + t) * 512 + 2 * c2) = (f32x2){a0, a1}; }
        __syncthreads();
#pragma unroll 1
        for (int tt = 0; tt < 4; ++tt) { const int t = 4 * wid + tt; const LAS f32x4* rp = (const LAS f32x4*)(cout + t * 512 + 8 * lane); const f32x4 x0 = rp[0], x1 = rp[1];
            const float mu = wave_sum((x0[0] + x0[1]) + (x0[2] + x0[3]) + (x1[0] + x1[1]) + (x1[2] + x1[3])) * (1.f / 512.f);
            const f32x4 d0 = x0 - mu, d1 = x1 - mu;
            const float var = wave_sum((d0[0] * d0[0] + d0[1] * d0[1]) + (d0[2] * d0[2] + d0[3] * d0[3]) + (d1[0] * d1[0] + d1[1] * d1[1]) + (d1[2] * d1[2] + d1[3] * d1[3])) * (1.f / 512.f);
            const float rstd = __builtin_amdgcn_rsqf(var + 1e-5f);
            const f32x4 g0 = *(const f32x4*)(F.lng + 8 * lane), g1 = *(const f32x4*)(F.lng + 8 * lane + 4), b0 = *(const f32x4*)(F.lnb + 8 * lane), b1 = *(const f32x4*)(F.lnb + 8 * lane + 4);
            f32x4 y0 = d0 * rstd * g0 + b0, y1 = d1 * rstd * g1 + b1;
#pragma unroll
            for (int e = 0; e < 4; ++e) { y0[e] *= sigmoidf_fast(y0[e]); y1[e] *= sigmoidf_fast(y1[e]); }
            *(GAS u32x4*)(F.MIX + (size_t)(b * SEQ + t0 + t) * D + 512 + 8 * lane) = pg8::pack8(y0, y1); }
    }
    __syncthreads();
}
__device__ __forceinline__ void p4_fast(Frame& F) {
    LAS int* lcnt = (LAS int*)(F.lds + LX_LCNT); LAS int* gbase = (LAS int*)(F.lds + LX_GBASE);
    const int tid = F.tid, lane = F.lane, wid = F.wave, j = lane & 31, h = lane >> 5;
    for (int base = 0; base < M_REAL / 32; base += F.G * NWAVES) {
        const int tile = base + F.bid + F.G * wid; const bool active = tile < M_REAL / 32;
        if (tid < NE) lcnt[tid] = 0;
        __syncthreads();
        int ea = 0, eb = 0, sa = 0, sb = 0, tok = 0; float ga = 0.f, gb = 0.f, rstd = 0.f;
        if (active) {
            tok = tile * 32 + j;
            const bf16_t* xa = F.XN2 + (size_t)tok * D + 8 * h; const bf16_t* wa = F.WrT + (size_t)j * D + 8 * h;
            f32x16 acc;
#pragma unroll
            for (int r = 0; r < 16; ++r) acc[r] = 0.f;
            float ssq = 0.f;
#pragma unroll 8
            for (int ks = 0; ks < 64; ++ks) { const u32x4 xb = *(const GAS u32x4*)(xa + 16 * ks); const bf16x8 wf = *(const GAS bf16x8*)(wa + 16 * ks);
                acc = __builtin_amdgcn_mfma_f32_32x32x16_bf16(wf, __builtin_bit_cast(bf16x8, xb), acc, 0, 0, 0);
                ssq += (bflo(xb.x) * bflo(xb.x) + bfhi(xb.x) * bfhi(xb.x)) + (bflo(xb.y) * bflo(xb.y) + bfhi(xb.y) * bfhi(xb.y)) + (bflo(xb.z) * bflo(xb.z) + bfhi(xb.z) * bfhi(xb.z)) + (bflo(xb.w) * bflo(xb.w) + bfhi(xb.w) * bfhi(xb.w)); }
            ssq += __shfl_xor(ssq, 32);
            rstd = 1.f / sqrtf(ssq * (1.f / D) + 1e-6f);
            float lg[16];
#pragma unroll
            for (int r = 0; r < 16; ++r) lg[r] = acc[r] * rstd + F.rb[(r & 3) + 8 * (r >> 2) + 4 * h];
            float tv[4]; int te[4];
#pragma unroll
            for (int kk = 0; kk < 4; ++kk) { float bv = -INFINITY; int be = 0;
#pragma unroll
                for (int r = 0; r < 16; ++r) { const int er = (r & 3) + 8 * (r >> 2) + 4 * h; if (lg[r] > bv) { bv = lg[r]; be = er; } }
                const float pv = __shfl_xor(bv, 32); const int pe = __shfl_xor(be, 32);
                if (pv > bv || (pv == bv && pe < be)) { bv = pv; be = pe; }
#pragma unroll
                for (int r = 0; r < 16; ++r) { const int er = (r & 3) + 8 * (r >> 2) + 4 * h; if (er == be) lg[r] = -INFINITY; }
                tv[kk] = bv; te[kk] = be; }
            const float p1 = __expf(tv[1] - tv[0]), p2 = __expf(tv[2] - tv[0]), p3 = __expf(tv[3] - tv[0]); const float inv = 1.f / (1.f + p1 + p2 + p3);
            ea = h ? te[2] : te[0]; eb = h ? te[3] : te[1]; ga = (h ? p2 : 1.f) * inv; gb = (h ? p3 : p1) * inv;
            sa = __hip_atomic_fetch_add(lcnt + ea, 1, __ATOMIC_RELAXED, __HIP_MEMORY_SCOPE_WORKGROUP); sb = __hip_atomic_fetch_add(lcnt + eb, 1, __ATOMIC_RELAXED, __HIP_MEMORY_SCOPE_WORKGROUP);
        }
        __syncthreads();
        if (tid < NE) gbase[tid] = (int)__hip_atomic_fetch_add((unsigned*)(F.ctl + CW_CNT + tid), (unsigned)lcnt[tid], RLX_AGENT);
        __syncthreads();
        if (active) {
            sa += gbase[ea]; sb += gbase[eb];
            F.ltok[ea * CAP + sa] = tok; F.lgate[ea * CAP + sa] = ga; F.lrstd[ea * CAP + sa] = rstd; F.where[tok * 4 + 2 * h] = ea * CAP + sa;
            F.ltok[eb * CAP + sb] = tok; F.lgate[eb * CAP + sb] = gb; F.lrstd[eb * CAP + sb] = rstd; F.where[tok * 4 + 2 * h + 1] = eb * CAP + sb;
        }
        __syncthreads();
    }
}

__device__ __forceinline__ void p1_naive(Frame& F) {
    const int gw = F.bid * NWAVES + F.wave, NGW = F.G * NWAVES, lane = F.lane;
    for (int it = gw; it < M_ALL * 20; it += NGW) {
        const int row = it / 20, grp = it % 20;
        const bf16_t* xr = F.XN + (size_t)row * D;
        if (grp < 12) {
            const int col = grp * 64 + lane; float acc = 0.f;
            _Pragma("unroll 4") for (int k = 0; k < D; ++k) acc += bf2f(xr[k]) * F.w_in[(size_t)k * IN_W + col];
            if (grp < 10) {
                const float ssq = wave_sum(acc * acc); const float r = 1.f / sqrtf(ssq * (1.f / 64.f) + 1e-6f);
                if (grp < 8) F.Qb[(size_t)row * 512 + col] = (bf16_t)f2bf(acc * r * F.qg[lane] * QSCALE);
                else F.Kb[(size_t)row * 128 + (col - 512)] = (bf16_t)f2bf(acc * r * F.kg[lane]);
            } else {
                const int hk = grp - 10; int b, kx;
                if (row < M_REAL) { b = row >> 11; kx = NMETA + (row & 2047); } else { b = (row - M_REAL) >> 4; kx = (row - M_REAL) & 15; }
                F.VT[((size_t)(b * 2 + hk) * 64 + lane) * VT_PITCH + kx] = (bf16_t)f2bf(acc);
            }
        } else {
            const int c = (grp - 12) * 64 + lane; float a = 0.f, g = 0.f;
            for (int k = 0; k < D; ++k) { const float xv = bf2f(xr[k]); a += xv * F.w_in[(size_t)k * IN_W + 768 + c]; g += xv * F.w_in[(size_t)k * IN_W + 1280 + c]; }
            F.HC[(size_t)row * 512 + c] = (bf16_t)f2bf(a * sigmoidf_fast(g));
        }
    }
}
__device__ __forceinline__ void att_naive(Frame& F) {
    const int gw = F.bid * NWAVES + F.wave, NGW = F.G * NWAVES, lane = F.lane;
    for (int it = gw; it < M_REAL * NQH; it += NGW) {
        const int row = it >> 3, h = it & 7, hk = h >> 2, b = row >> 11, qp = row & 2047;
        const float q = bf2f(F.Qb[(size_t)row * 512 + h * 64 + lane]);
        const float slope2 = exp2f(-(float)(h + 1)) * LOG2E;
        float m = F.sink[h] * LOG2E, l = 1.f, acc = 0.f;
        const bf16_t* vt = F.VT + ((size_t)(b * 2 + hk) * 64 + lane) * VT_PITCH;
        for (int j = 0; j < NMETA; ++j) {
            const float kv = bf2f(F.Kb[(size_t)(M_REAL + b * NMETA + j) * 128 + hk * 64 + lane]);
            const float s = wave_sum(q * kv);
            const float mn = fmaxf(m, s), al = exp2f(m - mn), p = exp2f(s - mn);
            l = l * al + p; acc = acc * al + p * bf2f(vt[j]); m = mn;
        }
        const int k0 = qp - 128 < 0 ? 0 : qp - 128, k1 = qp + 128 > SEQ - 1 ? SEQ - 1 : qp + 128;
        for (int kp = k0; kp <= k1; ++kp) {
            const float kv = bf2f(F.Kb[(size_t)(b * SEQ + kp) * 128 + hk * 64 + lane]);
            const float dist = (float)(qp > kp ? qp - kp : kp - qp);
            const float s = wave_sum(q * kv) - slope2 * dist;
            const float mn = fmaxf(m, s), al = exp2f(m - mn), p = exp2f(s - mn);
            l = l * al + p; acc = acc * al + p * bf2f(vt[NMETA + kp]); m = mn;
        }
        F.MIX[(size_t)row * D + h * 64 + lane] = (bf16_t)f2bf(acc / l);
    }
}
__device__ __forceinline__ void conv_naive(Frame& F) {
    const int gw = F.bid * NWAVES + F.wave, NGW = F.G * NWAVES, lane = F.lane;
    for (int row = gw; row < M_REAL; row += NGW) {
        const int b = row >> 11, s0 = NMETA + (row & 2047);
        float v[8]; float sum = 0.f;
#pragma unroll
        for (int j = 0; j < 8; ++j) { const int c = lane + 64 * j; float a = F.dw_b[c];
            _Pragma("unroll 1") for (int t = 0; t < CONV_K; ++t) { const int s = s0 - 15 + t; if (s >= 0 && s < LSEQ) a += F.dw_w[t * CONV_W + c] * bf2f(F.HC[(size_t)row_of(b, s) * 512 + c]); }
            v[j] = a; sum += a; }
        const float mu = wave_sum(sum) * (1.f / 512.f); float q = 0.f;
#pragma unroll
        for (int j = 0; j < 8; ++j) { const float d = v[j] - mu; q += d * d; }
        const float rstd = 1.f / sqrtf(wave_sum(q) * (1.f / 512.f) + 1e-5f);
#pragma unroll
        for (int j = 0; j < 8; ++j) { const int c = lane + 64 * j; const float y = (v[j] - mu) * rstd * F.lng[c] + F.lnb[c];
            F.MIX[(size_t)row * D + 512 + c] = (bf16_t)f2bf(y * sigmoidf_fast(y)); }
    }
}
__device__ __forceinline__ void p3_naive(Frame& F) {
    const int gw = F.bid * NWAVES + F.wave, NGW = F.G * NWAVES, lane = F.lane;
    for (int it = gw; it < M_REAL * 16; it += NGW) {
        const int row = it >> 4, col = (it & 15) * 64 + lane; const bf16_t* mr = F.MIX + (size_t)row * D; float acc = 0.f;
        for (int k = 0; k < D; ++k) acc += bf2f(mr[k]) * F.w_out[(size_t)k * D + col];
        const float h2 = F.x[(size_t)row * D + col] + acc;
        F.out[(size_t)row * D + col] = h2; F.XN2[(size_t)row * D + col] = (bf16_t)f2bf(h2); F.XN2F8[(size_t)row * D + col] = (unsigned char)(pk4_fp8(h2, 0.f, 0.f, 0.f) & 0xffu);
    }
}
__device__ __forceinline__ void p4_naive(Frame& F) {
    const int gw = F.bid * NWAVES + F.wave, NGW = F.G * NWAVES, lane = F.lane, e = lane & 31;
    for (int t = gw; t < M_REAL; t += NGW) {
        const bf16_t* xr = F.XN2 + (size_t)t * D; float acc = 0.f, ss = 0.f;
        for (int k = 0; k < D; ++k) { const float xv = bf2f(xr[k]); acc += xv * F.n2g[k] * F.wr[k * NE + e]; ss += xv * xv; }
        const float rstd = 1.f / sqrtf(ss * (1.f / D) + 1e-6f);
        float lg = acc * rstd + F.rb[e];
        float tv[4]; int te[4];
#pragma unroll
        for (int kk = 0; kk < 4; ++kk) {
            float bv = lg; int be = e;
#pragma unroll
            for (int o = 1; o < 32; o <<= 1) { const float pv = __shfl_xor(bv, o); const int pe = __shfl_xor(be, o); if (pv > bv || (pv == bv && pe < be)) { bv = pv; be = pe; } }
            tv[kk] = bv; te[kk] = be; if (e == be) lg = -INFINITY;
        }
        float p[4], ps = 0.f;
#pragma unroll
        for (int kk = 0; kk < 4; ++kk) { p[kk] = __expf(tv[kk] - tv[0]); ps += p[kk]; }
        if (lane < 4) {
            const int ee = lane == 0 ? te[0] : lane == 1 ? te[1] : lane == 2 ? te[2] : te[3];
            const float gg = (lane == 0 ? p[0] : lane == 1 ? p[1] : lane == 2 ? p[2] : p[3]) / ps;
            const unsigned slot = __hip_atomic_fetch_add((unsigned*)(F.ctl + CW_CNT + ee), 1u, RLX_AGENT);
            F.ltok[ee * CAP + slot] = t; F.lgate[ee * CAP + slot] = gg; F.lrstd[ee * CAP + slot] = rstd; F.where[t * 4 + lane] = ee * CAP + (int)slot;
        }
    }
}
__device__ __forceinline__ void build_tile_table(Frame& F) {
    LAS int* tb = (LAS int*)(F.lds + LX_TB); LAS int* cn = (LAS int*)(F.lds + LX_CNT);
    __syncthreads();
    if (F.tid == 0) { int acc = 0; for (int e = 0; e < NE; ++e) { int c = (int)__hip_atomic_load(F.ctl + CW_CNT + e, RLX_AGENT); if (c > CAP) c = CAP; if (c < 0) c = 0; cn[e] = c; tb[e] = acc; acc += (c + 255) >> 8; } tb[NE] = acc; }
    __syncthreads();
}
__device__ __forceinline__ int find_expert(const LAS int* tb, int tile) { int e = 0;
#pragma unroll 1
    for (int j = 1; j < NE; ++j) if (tb[j] <= tile) e = j;
    return e; }
__device__ __forceinline__ f32x4 fp8x4_to_f32(unsigned w) {
    const f32x2 lo = __builtin_amdgcn_cvt_pk_f32_fp8((int)w, false), hi = __builtin_amdgcn_cvt_pk_f32_fp8((int)w, true); return (f32x4){lo.x, lo.y, hi.x, hi.y}; }
__device__ __forceinline__ void p7_combine(Frame& F) {
    build_tile_table(F);
    const LAS int* tb = (const LAS int*)(F.lds + LX_TB);
    const int gw = F.bid * NWAVES + F.wave, NGW = F.G * NWAVES, lane = F.lane;
    const GAS i32x4* wh = (const GAS i32x4*)F.where;
    int t0 = gw, t1 = gw + NGW;
    i32x4 w0 = t0 < M_REAL ? wh[t0] : (i32x4){0, 0, 0, 0}, w1 = t1 < M_REAL ? wh[t1] : (i32x4){0, 0, 0, 0};
    while (t0 < M_REAL) {
        const int n0 = t0 + 2 * NGW, n1 = t1 + 2 * NGW;
        const i32x4 nw0 = n0 < M_REAL ? wh[n0] : (i32x4){0, 0, 0, 0}, nw1 = n1 < M_REAL ? wh[n1] : (i32x4){0, 0, 0, 0};
        const bool v1 = t1 < M_REAL; const int tt1 = v1 ? t1 : t0;
        u32x4 y[2][4], x[2][2];
#pragma unroll
        for (int u = 0; u < 2; ++u) { const int t = u ? tt1 : t0; const i32x4 w = u ? w1 : w0;
#pragma unroll
            for (int j = 0; j < 2; ++j) x[u][j] = *((const GAS u32x4*)(F.XN2 + (size_t)t * D) + 2 * lane + j);
#pragma unroll
            for (int k = 0; k < 4; ++k) { const int e = w[k] / CAP, slot = w[k] - e * CAP; y[u][k] = *((const GAS u32x4*)(F.Y8 + (size_t)(tb[e] * 256 + slot) * D) + lane); } }
#pragma unroll
        for (int u = 0; u < 2; ++u) { if (u && !v1) break; const int t = u ? tt1 : t0;
            f32x4 a[4] = {(f32x4){0.f, 0.f, 0.f, 0.f}, (f32x4){0.f, 0.f, 0.f, 0.f}, (f32x4){0.f, 0.f, 0.f, 0.f}, (f32x4){0.f, 0.f, 0.f, 0.f}};
#pragma unroll
            for (int k = 0; k < 4; ++k) { a[0] += fp8x4_to_f32(y[u][k].x); a[1] += fp8x4_to_f32(y[u][k].y); a[2] += fp8x4_to_f32(y[u][k].z); a[3] += fp8x4_to_f32(y[u][k].w); }
            a[0] += (f32x4){bflo(x[u][0].x), bfhi(x[u][0].x), bflo(x[u][0].y), bfhi(x[u][0].y)}; a[1] += (f32x4){bflo(x[u][0].z), bfhi(x[u][0].z), bflo(x[u][0].w), bfhi(x[u][0].w)};
            a[2] += (f32x4){bflo(x[u][1].x), bfhi(x[u][1].x), bflo(x[u][1].y), bfhi(x[u][1].y)}; a[3] += (f32x4){bflo(x[u][1].z), bfhi(x[u][1].z), bflo(x[u][1].w), bfhi(x[u][1].w)};
            GAS f32x4* o = (GAS f32x4*)(F.out + (size_t)t * D) + 4 * lane;
#pragma unroll
            for (int j = 0; j < 4; ++j) o[j] = a[j]; }
        t0 = n0; t1 = n1; w0 = nw0; w1 = nw1;
    }
}

__global__ void __launch_bounds__(NTHR, 2) mega(Args args) {
    extern __shared__ __attribute__((aligned(16))) unsigned char lds_raw[];
    Frame F;
    F.lds = (LAS unsigned char*)lds_raw;
    F.tid = threadIdx.x; F.lane = F.tid & 63; F.wave = __builtin_amdgcn_readfirstlane(F.tid >> 6); F.G = gridDim.x; F.bid = blockIdx.x;
    F.x = args.in[0]; F.meta = args.in[1]; F.n1g = args.in[2]; F.w_in = args.in[3]; F.qg = args.in[4]; F.kg = args.in[5]; F.sink = args.in[6];
    F.dw_w = args.in[7]; F.dw_b = args.in[8]; F.lng = args.in[9]; F.lnb = args.in[10]; F.w_out = args.in[11]; F.n2g = args.in[12];
    F.wr = args.in[13]; F.rb = args.in[14]; F.wgu = args.in[15]; F.bgu = args.in[16]; F.wd = args.in[17]; F.bd = args.in[18];
    F.out = args.out; F.ws = args.ws; unsigned char* ws = args.ws;
    F.ctl = (gu32*)(ws + WS_CTL);
    F.WinT = (bf16_t*)(ws + WS_WIN_T); F.WoT = (bf16_t*)(ws + WS_WO_T); F.WrT = (bf16_t*)(ws + WS_WR_T); F.WdT8 = ws + WS_WD_T; F.WguT8 = ws + WS_WGU_T; F.XN2F8 = ws + WS_XN2F8;
    F.XN = (bf16_t*)(ws + WS_XN); F.Qb = (bf16_t*)(ws + WS_Q); F.Kb = (bf16_t*)(ws + WS_K); F.VT = (bf16_t*)(ws + WS_VT); F.HC = (bf16_t*)(ws + WS_HC);
    F.MIX = (bf16_t*)(ws + WS_MIX); F.XN2 = (bf16_t*)(ws + WS_XN2); F.ACT8 = ws + WS_ACT; F.Y8 = ws + WS_Y;
    F.where = (int*)(ws + WS_WHERE); F.ltok = (int*)(ws + WS_LTOK); F.lgate = (float*)(ws + WS_LGATE); F.lrstd = (float*)(ws + WS_LRSTD);
    for (int u = F.tid; u < (LDS_BYTES - RING_BYTES) / 4; u += NTHR) ((LAS unsigned*)(F.lds + RING_BYTES))[u] = 0u;
    __syncthreads();
    const int lo = args.ph_lo, hi = args.ph_hi;
    XcdBarrier bar; bar.bar = (unsigned*)(F.ctl + CW_BAR); bar.x = 0; bar.st = nullptr;
    if (hi - lo > 1) bar = xcd_barrier_post((unsigned*)(F.ctl + CW_BAR), (volatile LAS unsigned*)(F.lds + LX_BAR));
#ifndef PH_MASK
#define PH_MASK 0xFF
#endif
#define IN(k) (((PH_MASK >> (k)) & 1) && lo <= (k) && (k) < hi)
#define SEAM(k) do { if (IN(k) && IN((k) + 1)) xcd_barrier(bar); } while (0)
#ifndef REP_PH
#define REP_PH -1
#endif
#define REPS(k) _Pragma("unroll") for (int rep = 0; rep < ((REP_PH) == (k) ? 2 : 1); ++rep)
#define REPBAR() do { if (rep) xcd_barrier(bar); } while (0)
    if (IN(0)) { REPS(0) { REPBAR(); p0_prologue(F); } } SEAM(0);
    if (IN(1)) { REPS(1) { REPBAR();
#if FAST_P1
        pg8::DenseProb P{F.XN, F.WinT, M_PAD / 256, IN_W / 256, F.G, F.bid}; pg8::EpiIn E{F.Qb, F.Kb, F.VT, F.HC, F.qg, F.kg}; pg8::gemm_phase<2>(F.lds, P, E);
#else
        p1_naive(F);
#endif
    } } SEAM(1);
    if (IN(2)) { REPS(2) { REPBAR();
#if FAST_ATT
        att_fast(F);
#else
        att_naive(F);
#endif
    } REPS(8) { REPBAR();
#if FAST_CONV
        conv_fast(F);
#else
        conv_naive(F);
#endif
    } } SEAM(2);
    if (IN(3)) { REPS(3) { REPBAR();
#if FAST_P3
        pg8::DenseProb P{F.MIX, F.WoT, M_REAL / 256, D / 256, F.G, F.bid}; pg8::EpiOut E{F.x, F.out, F.XN2, F.XN2F8}; pg8::gemm_phase<2>(F.lds, P, E);
#else
        p3_naive(F);
#endif
    } } SEAM(3);
    if (IN(4)) { REPS(4) { if (rep) { xcd_barrier(bar); if (F.bid == 0 && F.tid < NE) __hip_atomic_store(F.ctl + CW_CNT + F.tid, 0u, RLX_AGENT); xcd_barrier(bar); }
#if FAST_P4
        p4_fast(F);
#else
        p4_naive(F);
#endif
    } } SEAM(4);
    if (IN(5)) { REPS(5) { REPBAR();
        build_tile_table(F); pg8::GroupedProb<true, 1> P{F.XN2F8, F.WguT8, F.ltok, (const LAS int*)(F.lds + LX_TB), (const LAS int*)(F.lds + LX_CNT), 8, F.G, F.bid};
        pg8::EpiGU E{F.ACT8, F.lrstd, F.bgu}; pg8::gemm_phase<1>(F.lds, P, E);
    } } SEAM(5);
    if (IN(6)) { REPS(6) { REPBAR();
        build_tile_table(F); pg8::GroupedProb<false, 1> P{F.ACT8, F.WdT8, F.ltok, (const LAS int*)(F.lds + LX_TB), (const LAS int*)(F.lds + LX_CNT), 4, F.G, F.bid};
        pg8::EpiDown E{F.Y8, F.lgate, F.bd}; pg8::gemm_phase<1>(F.lds, P, E);
    } } SEAM(6);
    if (IN(7)) { REPS(7) { REPBAR(); p7_combine(F); } }
#undef IN
#undef SEAM
}

extern "C" void kernel_launch(void* const* d_in, const int* in_sizes, int n_in, void* d_out, int out_size, void* d_ws, size_t ws_size, hipStream_t stream) {
    static int grid = 0;
    if (grid == 0) {
        if (n_in != 19 || in_sizes[0] != M_REAL * D || out_size != M_REAL * D || ws_size < WS_END) {
            fprintf(stderr, "kernel_launch: unexpected shapes/workspace: n_in %d in0 %d out %d ws %zu (need %zu)\n", n_in, n_in > 0 ? in_sizes[0] : -1, out_size, ws_size, (size_t)WS_END); grid = -1; return; }
        int dev = 0, cus = 0, per_cu = 0;
        if (hipGetDevice(&dev) != hipSuccess || hipDeviceGetAttribute(&cus, hipDeviceAttributeMultiprocessorCount, dev) != hipSuccess) { grid = -1; return; }
        if (hipFuncSetAttribute((const void*)mega, hipFuncAttributeMaxDynamicSharedMemorySize, LDS_BYTES) != hipSuccess) { fprintf(stderr, "kernel_launch: hipFuncSetAttribute failed\n"); grid = -1; return; }
        if (hipOccupancyMaxActiveBlocksPerMultiprocessor(&per_cu, (const void*)mega, NTHR, LDS_BYTES) != hipSuccess || per_cu < 1) { fprintf(stderr, "kernel_launch: occupancy query says %d blocks/CU\n", per_cu); (void)hipGetLastError(); grid = -1; return; }
        grid = cus;
    }
    if (grid < 0) return;
    (void)hipMemsetAsync((char*)d_ws + WS_CTL, 0, CTL_ZERO_BYTES, stream);
    Args a{};
    for (int i = 0; i < 19; ++i) a.in[i] = (const float*)d_in[i];
    a.out = (float*)d_out; a.ws = (unsigned char*)d_ws;
#if MK_PER_PHASE
    for (int p = 0; p < 8; ++p) { a.ph_lo = p; a.ph_hi = p + 1; hipLaunchKernelGGL(mega, dim3(grid), dim3(NTHR), LDS_BYTES, stream, a); }
#else
    a.ph_lo = 0; a.ph_hi = 8; hipLaunchKernelGGL(mega, dim3(grid), dim3(NTHR), LDS_BYTES, stream, a);
#endif
}
```

```cpp
#include <hip/hip_runtime.h>
#include <cstdio>
#include <cstdint>

#ifndef MK_PER_PHASE
#define MK_PER_PHASE 0
#endif
#ifndef FAST_P1
#define FAST_P1 1
#endif
#ifndef FAST_ATT
#define FAST_ATT 1
#endif
#ifndef FAST_CONV
#define FAST_CONV 1
#endif
#ifndef FAST_P3
#define FAST_P3 1
#endif
#ifndef FAST_P4
#define FAST_P4 1
#endif
#ifndef FAST_P5
#define FAST_P5 1
#endif
#ifndef FAST_P6
#define FAST_P6 1
#endif

#define GAS __attribute__((address_space(1)))
#define LAS __attribute__((address_space(3)))
typedef unsigned short bf16_t;
typedef short bf16x8 __attribute__((ext_vector_type(8)));
typedef float f32x4 __attribute__((ext_vector_type(4)));
typedef float f32x16 __attribute__((ext_vector_type(16)));
typedef int i32x4 __attribute__((ext_vector_type(4)));
typedef int i32x8 __attribute__((ext_vector_type(8)));
typedef unsigned u32x4 __attribute__((ext_vector_type(4)));
typedef unsigned u32x2 __attribute__((ext_vector_type(2)));
typedef float f32x2 __attribute__((ext_vector_type(2)));
typedef GAS unsigned gu32;
#define RLX_AGENT __ATOMIC_RELAXED, __HIP_MEMORY_SCOPE_AGENT

constexpr int NB = 8, SEQ = 2048, D = 1024, NMETA = 16, LSEQ = NMETA + SEQ;
constexpr int M_REAL = NB * SEQ, M_ALL = NB * LSEQ, M_PAD = 16640;
constexpr int IN_W = 1792, HD = 64, NQH = 8, NKV = 2, CONV_W = 512, CONV_K = 31;
constexpr int NE = 32, CAP = 16384, ACT_ROWS = 4 * M_REAL + NE * 256;
constexpr float LOG2E = 1.4426950408889634f;
constexpr float QSCALE = 0.125f * LOG2E;
constexpr float WSCALE = 32.0f;
constexpr int VT_PITCH = LSEQ;

constexpr size_t MiB = 1u << 20;
constexpr size_t WS_CTL = 0, CTL_ZERO_BYTES = 32768;
constexpr size_t WS_WIN_T = 2 * MiB;
constexpr size_t WS_WO_T = 6 * MiB;
constexpr size_t WS_WR_T = 8 * MiB;
constexpr size_t WS_RSTD = 9 * MiB;
constexpr size_t WS_WHERE = 9 * MiB + 512 * 1024;
constexpr size_t WS_LTOK = 10 * MiB;
constexpr size_t WS_LGATE = 12 * MiB;
constexpr size_t WS_LRSTD = 14 * MiB;
constexpr size_t WS_WD_T = 16 * MiB;
constexpr size_t WS_WGU_T = 80 * MiB;
constexpr size_t WS_XN = 208 * MiB;
constexpr size_t WS_Q = 241 * MiB;
constexpr size_t WS_K = 258 * MiB;
constexpr size_t WS_VT = 263 * MiB;
constexpr size_t WS_HC = 268 * MiB;
constexpr size_t WS_MIX = 285 * MiB;
constexpr size_t WS_XN2 = 317 * MiB;
constexpr size_t WS_ACT = 349 * MiB;
constexpr size_t WS_Y = 493 * MiB;
constexpr size_t WS_XN2F8 = 637 * MiB;
constexpr size_t WS_END = 653 * MiB;
constexpr int CW_CNT = 64;
constexpr int CW_BAR = 4096;

constexpr int RING_BYTES = 131072;
constexpr int LX_BAR = RING_BYTES;
constexpr int LX_TB = RING_BYTES + 64;
constexpr int LX_CNT = RING_BYTES + 256;
constexpr int LX_LCNT = RING_BYTES + 512;
constexpr int LX_GBASE = RING_BYTES + 768;
constexpr int LDS_BYTES = 147456;

constexpr int NWAVES = 8, NTHR = 512;

__device__ __forceinline__ unsigned f2bf(float f) { unsigned u = __builtin_bit_cast(unsigned, f); return (u + 0x7fffu + ((u >> 16) & 1u)) >> 16; }
__device__ __forceinline__ unsigned pk2(float lo, float hi) { return f2bf(lo) | (f2bf(hi) << 16); }
__device__ __forceinline__ unsigned pk4_fp8(float a, float b, float c, float d) { int w = __builtin_amdgcn_cvt_pk_fp8_f32(a, b, 0, false); w = __builtin_amdgcn_cvt_pk_fp8_f32(c, d, w, true); return (unsigned)w; }
__device__ __forceinline__ float bf2f(unsigned b) { return __builtin_bit_cast(float, b << 16); }
__device__ __forceinline__ float bflo(unsigned w) { return __builtin_bit_cast(float, w << 16); }
__device__ __forceinline__ float bfhi(unsigned w) { return __builtin_bit_cast(float, w & 0xffff0000u); }
__device__ __forceinline__ float wave_sum(float v) {
#pragma unroll
    for (int o = 1; o < 64; o <<= 1) v += __shfl_xor(v, o);
    return v;
}
__device__ __forceinline__ float sigmoidf_fast(float x) { return __builtin_amdgcn_rcpf(1.0f + __builtin_amdgcn_exp2f(-x * LOG2E)); }
__device__ __forceinline__ int row_of(int b, int s) { return s < NMETA ? M_REAL + b * NMETA + s : b * SEQ + (s - NMETA); }

#define XB_TMO      128
#define XB_XCNT(j)  (256  + 64 * (j))
#define XB_XSUB(j)  (1280 + 64 * (j))
#define XB_XGEN(j)  (2304 + 64 * (j))
#define XB_TOP      3328
#define XB_TOPGEN   3392
#define XCD_BAR_WORDS 3456
#define XB_SPIN_CAP (1u << 18)
__device__ __forceinline__ unsigned xb_ld(unsigned* p)              { return __hip_atomic_load(p, __ATOMIC_RELAXED, __HIP_MEMORY_SCOPE_AGENT); }
__device__ __forceinline__ unsigned xb_add(unsigned* p, unsigned v) { return __hip_atomic_fetch_add(p, v, __ATOMIC_RELAXED, __HIP_MEMORY_SCOPE_AGENT); }
__device__ __forceinline__ unsigned xb_xcc_id() { return (unsigned)__builtin_amdgcn_s_getreg((3 << 11) | 20) & 0xFu; }
#define XB_SPIN(cond, bar) do { unsigned _sp = 0; while (cond) { __builtin_amdgcn_s_sleep(1); \
    if ((++_sp & 255u) == 0u) { if (xb_ld(&(bar)[XB_TMO])) break; if (_sp > XB_SPIN_CAP) { atomicAdd(&(bar)[XB_TMO], 1u); break; } } } } while (0)
struct XcdBarrier { unsigned* bar; unsigned x; volatile LAS unsigned* st; };
__device__ __forceinline__ XcdBarrier xcd_barrier_post(unsigned* bar, volatile LAS unsigned* st) {
    XcdBarrier b; b.bar = bar; b.x = xb_xcc_id(); b.st = st;
    if (threadIdx.x == 0) (void)xb_add(&bar[XB_XCNT(b.x)], 1u);
    return b;
}
__device__ __forceinline__ void xcd_barrier_complete(unsigned* bar, unsigned x, unsigned& nloc, unsigned& nx) {
    const unsigned G = gridDim.x * gridDim.y * gridDim.z;
    unsigned sum, cnt, mine, sp = 0u;
    for (;;) {
        sum = 0u; cnt = 0u; mine = 0u;
#pragma unroll
        for (unsigned j = 0; j < 16; ++j) { const unsigned c = xb_ld(&bar[XB_XCNT(j)]); sum += c; cnt += (c > 0u) ? 1u : 0u; mine = (j == x) ? c : mine; }
        if (sum == G) break;
        __builtin_amdgcn_s_sleep(1);
        if ((++sp & 255u) == 0u) { if (xb_ld(&bar[XB_TMO])) break; if (sp > XB_SPIN_CAP) { atomicAdd(&bar[XB_TMO], 1u); break; } }
    }
    nloc = mine > 0u ? mine : 1u; nx = cnt > 0u ? cnt : 1u;
}
__device__ __forceinline__ void xcd_barrier(const XcdBarrier& b) {
    asm volatile("s_waitcnt vmcnt(0)" ::: "memory");
    __syncthreads();
    if (threadIdx.x == 0) {
        unsigned* bar = b.bar;
        __builtin_amdgcn_s_waitcnt(0);
        unsigned nloc = b.st[0], nx = b.st[1];
        if (nloc == 0u) { xcd_barrier_complete(bar, b.x, nloc, nx); b.st[0] = nloc; b.st[1] = nx; }
        const unsigned old = xb_add(&bar[XB_XSUB(b.x)], 1u);
        const unsigned gen = old / nloc;
        if (old + 1u == (gen + 1u) * nloc) {
            __builtin_amdgcn_fence(__ATOMIC_RELEASE, "agent");
            asm volatile("s_waitcnt vmcnt(0)" ::: "memory");
            const unsigned og = xb_add(&bar[XB_TOP], 1u);
            const unsigned tg = og / nx;
            if (og + 1u == (tg + 1u) * nx) xb_add(&bar[XB_TOPGEN], 1u);
            else XB_SPIN(xb_ld(&bar[XB_TOPGEN]) == tg, bar);
            __builtin_amdgcn_fence(__ATOMIC_ACQUIRE, "agent");
            xb_add(&bar[XB_XGEN(b.x)], 1u);
            asm volatile("s_waitcnt vmcnt(0)" ::: "memory");
        } else {
            XB_SPIN(xb_ld(&bar[XB_XGEN(b.x)]) == gen, bar);
            __builtin_amdgcn_fence(__ATOMIC_ACQUIRE, "agent");
            asm volatile("s_waitcnt vmcnt(0)" ::: "memory");
        }
    }
    __syncthreads();
}

struct Args { const float* in[19]; float* out; unsigned char* ws; int ph_lo, ph_hi; };
struct Frame {
    LAS unsigned char* lds;
    int tid, lane, wave, G, bid;
    const float *x, *meta, *n1g, *w_in, *qg, *kg, *sink, *dw_w, *dw_b, *lng, *lnb, *w_out, *n2g, *wr, *rb, *wgu, *bgu, *wd, *bd;
    float* out;
    unsigned char* ws;
    gu32* ctl;
    unsigned char *WguT8, *XN2F8, *WdT8, *ACT8; bf16_t *WinT, *WoT, *WrT, *XN, *Qb, *Kb, *VT, *HC, *MIX, *XN2; unsigned char* Y8;
    int* where; int* ltok; float* lgate; float* lrstd;
};

__device__ __forceinline__ int perm32(int rho) { const int n = rho >> 4, i = rho & 15; return 8 * (i >> 2) + 4 * n + (i & 3); }
__device__ __forceinline__ int lbase_nat(int pg) { return 32 * pg; }
__device__ __forceinline__ int lbase_in(int pg) { const int tile = pg >> 3, bj = (pg >> 2) & 1, wc = pg & 3; return tile <= 2 ? tile * 256 + 64 * wc + 32 * bj : 768 + bj * 512 + (tile - 3) * 128 + 32 * wc; }
__device__ __forceinline__ int lbase_gu(int pg) { const int tile = pg >> 3, bj = (pg >> 2) & 1, wc = pg & 3; return bj * 1024 + tile * 128 + 32 * wc; }
struct P0Item { const float* W; void* WT; const float* g; int N, pg, n0, k0; bool permute; bool f8; };
__device__ __forceinline__ bool p0_decode(const Frame& F, int it, P0Item& I) {
    constexpr int I_IN = 16 * 56, I_O = 16 * 32, I_R = 16, I_GU = NE * 16 * 64, I_D = NE * 16 * 32;
    int r = it;
    if (r < I_IN) { const int pg = r % 56, kb = r / 56; I = P0Item{F.w_in, F.WinT, nullptr, IN_W, pg, lbase_in(pg), 64 * kb, true, false}; return true; } r -= I_IN;
    if (r < I_O) { const int pg = r % 32, kb = r / 32; I = P0Item{F.w_out, F.WoT, nullptr, D, pg, lbase_nat(pg), 64 * kb, true, false}; return true; } r -= I_O;
    if (r < I_R) { I = P0Item{F.wr, F.WrT, F.n2g, NE, 0, 0, 64 * r, false, false}; return true; } r -= I_R;
    if (r < I_GU) { const int e = r / (16 * 64), q = r % (16 * 64), pg = q % 64, kb = q / 64; I = P0Item{F.wgu + (size_t)e * D * 2048, F.WguT8 + (size_t)e * 2048 * D, F.n2g, 2048, pg, lbase_gu(pg), 64 * kb, true, true}; return true; } r -= I_GU;
    if (r < I_D) { const int e = r / (16 * 32), q = r % (16 * 32), pg = q % 32, kb = q / 32; I = P0Item{F.wd + (size_t)e * D * D, F.WdT8 + (size_t)e * D * D, nullptr, D, pg, lbase_nat(pg), 64 * kb, true, true}; return true; }
    return false;
}
__device__ __forceinline__ void p0_load(const P0Item& I, int lane, f32x4 (&v)[8]) {
    const float* p = I.W + (size_t)(I.k0 + (lane >> 3)) * I.N + I.n0 + 4 * (lane & 7);
#pragma unroll
    for (int i = 0; i < 8; ++i) v[i] = __builtin_nontemporal_load((const f32x4*)(p + (size_t)(8 * i) * I.N));
}
__device__ __forceinline__ void p0_store(const P0Item& I, int lane, LAS float* scr, const f32x4 (&v)[8]) {
    LAS float* w = scr + (lane >> 3) * 33 + 4 * (lane & 7);
#pragma unroll
    for (int i = 0; i < 8; ++i) { w[(8 * i) * 33 + 0] = v[i][0]; w[(8 * i) * 33 + 1] = v[i][1]; w[(8 * i) * 33 + 2] = v[i][2]; w[(8 * i) * 33 + 3] = v[i][3]; }
    asm volatile("s_waitcnt lgkmcnt(0)" ::: "memory");
    const int c = lane & 7;
    f32x4 g0 = {1.f, 1.f, 1.f, 1.f}, g1 = g0;
    if (I.g) { g0 = *(const f32x4*)(I.g + I.k0 + 8 * c); g1 = *(const f32x4*)(I.g + I.k0 + 8 * c + 4); }
    if (I.f8) { g0 *= WSCALE; g1 *= WSCALE; }
#pragma unroll
    for (int j = 0; j < 4; ++j) { const int r = (lane >> 3) + 8 * j; const int sc = I.permute ? perm32(r) : r; const LAS float* s = scr + (8 * c) * 33 + sc;
        if (I.f8) { u32x2 o; o.x = pk4_fp8(s[0 * 33] * g0[0], s[1 * 33] * g0[1], s[2 * 33] * g0[2], s[3 * 33] * g0[3]); o.y = pk4_fp8(s[4 * 33] * g1[0], s[5 * 33] * g1[1], s[6 * 33] * g1[2], s[7 * 33] * g1[3]);
            *(GAS u32x2*)((unsigned char*)I.WT + (size_t)(32 * I.pg + r) * D + I.k0 + 8 * c) = o; }
        else { u32x4 o; o.x = pk2(s[0 * 33] * g0[0], s[1 * 33] * g0[1]); o.y = pk2(s[2 * 33] * g0[2], s[3 * 33] * g0[3]); o.z = pk2(s[4 * 33] * g1[0], s[5 * 33] * g1[1]); o.w = pk2(s[6 * 33] * g1[2], s[7 * 33] * g1[3]);
            *(GAS u32x4*)((bf16_t*)I.WT + (size_t)(32 * I.pg + r) * D + I.k0 + 8 * c) = o; } }
    asm volatile("s_waitcnt lgkmcnt(0)" ::: "memory");
}
constexpr int P0_NITEMS = 16 * 56 + 16 * 32 + 16 + NE * 16 * 64 + NE * 16 * 32;
constexpr int P1_UNITS = (M_PAD / 256) * (IN_W / 256);
__device__ __forceinline__ int p0_ndef(int G) { return (G == 256) ? 6144 : 0; }
__device__ __forceinline__ void p0_items(Frame& F, int first, int step, int end) {
    LAS float* scr = (LAS float*)(F.lds + F.wave * 16384);
    const int lane = F.lane;
    P0Item cur, nxt; f32x4 va[8], vb[8];
    int it = first; bool valid = it < end && p0_decode(F, it, cur);
    if (valid) p0_load(cur, lane, va);
    while (valid) {
        it += step; const bool vn = it < end && p0_decode(F, it, nxt);
        if (vn) p0_load(nxt, lane, vb);
        p0_store(cur, lane, scr, va);
        cur = nxt; valid = vn;
#pragma unroll
        for (int i = 0; i < 8; ++i) va[i] = vb[i];
    }
}
__device__ __forceinline__ void p0_prologue(Frame& F) {
    const int gw = F.bid * NWAVES + F.wave, NGW = F.G * NWAVES, lane = F.lane;
    p0_items(F, gw, NGW, P0_NITEMS - p0_ndef(F.G));
    const GAS f32x4* gr = (const GAS f32x4*)F.n1g + lane;
    for (int m0 = 2 * gw; m0 < M_PAD; m0 += 2 * NGW) {
        f32x4 v[2][4]; float ss[2];
#pragma unroll
        for (int u = 0; u < 2; ++u) { const int m = m0 + u; ss[u] = 0.f;
            if (m < M_ALL) { const float* src = m < M_REAL ? F.x + (size_t)m * D : F.meta + (size_t)((m - M_REAL) & (NMETA - 1)) * D; const GAS f32x4* xr = (const GAS f32x4*)src + lane;
#pragma unroll
                for (int j = 0; j < 4; ++j) v[u][j] = xr[64 * j]; }
            else {
#pragma unroll
                for (int j = 0; j < 4; ++j) v[u][j] = (f32x4){0.f, 0.f, 0.f, 0.f}; } }
#pragma unroll
        for (int u = 0; u < 2; ++u) {
#pragma unroll
            for (int j = 0; j < 4; ++j) ss[u] += (v[u][j].x * v[u][j].x + v[u][j].y * v[u][j].y) + (v[u][j].z * v[u][j].z + v[u][j].w * v[u][j].w);
            const float rstd = 1.f / sqrtf(wave_sum(ss[u]) * (1.f / D) + 1e-6f);
            GAS unsigned long long* o8 = (GAS unsigned long long*)(F.XN + (size_t)(m0 + u) * D) + lane;
#pragma unroll
            for (int j = 0; j < 4; ++j) { const f32x4 g = gr[64 * j]; o8[64 * j] = (unsigned long long)pk2(v[u][j].x * rstd * g.x, v[u][j].y * rstd * g.y) | ((unsigned long long)pk2(v[u][j].z * rstd * g.z, v[u][j].w * rstd * g.w) << 32); }
        }
    }
}

namespace pg8 {
constexpr int BM = 256, BK = 64, HALF = 128, HTB = HALF * BK * 2, STAGE_BYTES = 8 * HTB, NXCD = 8, WGM = 8, KD = 1024;
__device__ __forceinline__ int lds_byte(int r, int c) { const int st = (r >> 4) * 2 + (c >> 5), rr = r & 15, cc = c & 31, ob = rr * 64 + cc * 2; return st * 1024 + (ob ^ (((ob >> 9) & 1) << 5)); }
__device__ __forceinline__ void stage_rc(int b, int& R, int& C) { const int st = b / 1024, sb = b % 1024, swz = sb ^ (((sb >> 9) & 1) << 5); R = (st >> 1) * 16 + swz / 64; C = (st & 1) * 32 + (swz % 64) / 2; }
struct Unit { int pm, pn, e, slot0, nvalid, r0; };
__device__ __forceinline__ unsigned cvt_pk_bf16(float lo, float hi) { unsigned r; asm volatile("v_cvt_pk_bf16_f32 %0, %1, %2" : "=v"(r) : "v"(lo), "v"(hi)); return r; }
__device__ __forceinline__ u32x4 pack8(const f32x4 a, const f32x4 b) { u32x4 w; w.x = cvt_pk_bf16(a[0], a[1]); w.y = cvt_pk_bf16(a[2], a[3]); w.z = cvt_pk_bf16(b[0], b[1]); w.w = cvt_pk_bf16(b[2], b[3]); return w; }

template <bool HALVES, int nN>
__device__ __forceinline__ bool tile_order(int i, int G, int c, int nM, int& pm, int& pn, int& half) {
    const int nwg = nM * nN; int L = i * G + c; half = -1;
    if (HALVES) { const int nfull = ((G & (G - 1)) == 0) ? (nwg & ~(G - 1)) : (nwg / G) * G, left = nwg - nfull;
        if (left > 0 && 2 * left <= G && L >= nfull) { const int hidx = L - nfull; if (hidx >= 2 * left) return false; L = nfull + (hidx >> 1); half = hidx & 1; } }
    if (L >= nwg) return false;
    int wgid = L; { const int q = nwg >> 3, r = nwg & 7, xcd = wgid & 7, off = wgid >> 3; wgid = (xcd < r ? xcd * (q + 1) : r * (q + 1) + (xcd - r) * q) + off; }
    constexpr int nig = WGM * nN; const int gid = wgid / nig, rem = wgid - gid * nig, fm = gid * WGM, gsz = (nM - fm) < WGM ? (nM - fm) : WGM;
    if (gsz == WGM) { pm = fm + (rem & (WGM - 1)); pn = rem >> 3; } else { pm = fm + rem % gsz; pn = rem / gsz; }
    return true;
}
template <int nN> struct DenseProb {
    static constexpr int RB = KD * 2;
    const bf16_t* A; const bf16_t* Bt; int nM, G, c;
    __device__ __forceinline__ bool next(int i, Unit& u) const { u.e = 0; u.slot0 = 0; u.nvalid = 256; u.r0 = 0; int half; return tile_order<false, nN>(i, G, c, nM, u.pm, u.pn, half); }
    __device__ __forceinline__ void addr_load(const Unit&, const int (&)[2], int (&)[4]) const {}
    __device__ __forceinline__ void addr_finish(const Unit& u, const int (&R)[2], const int (&C)[2], const int (&)[4], const char*& a, const char*& b, unsigned (&va0)[2], unsigned (&va1)[2]) const {
        a = (const char*)A + (size_t)u.pm * (BM * RB); b = (const char*)Bt + (size_t)u.pn * (BM * RB);
#pragma unroll
        for (int i = 0; i < 2; ++i) { va0[i] = (unsigned)(R[i] * RB + C[i] * 2); va1[i] = va0[i] + (unsigned)(HALF * RB); }
    }
};
template <bool GATHER, int ES, int nN> struct GroupedProb {
    static constexpr int RB = KD * ES;
    const void* A; const void* Bt; const int* ltok; const LAS int* tb; const LAS int* cn; int G, c;
    __device__ __forceinline__ bool next(int i, Unit& u) const {
        const int nM = __builtin_amdgcn_readfirstlane(tb[NE]); int half;
        if (!tile_order<true, nN>(i, G, c, nM, u.pm, u.pn, half)) return false;
        int e; { const int j = (int)(threadIdx.x & 31); const unsigned long long hit = __ballot(tb[j] <= u.pm && u.pm < tb[j + 1]);
                 e = __builtin_amdgcn_readfirstlane((int)__builtin_ctzll(hit | (1ull << 63)) & 31); }
        const int t0 = __builtin_amdgcn_readfirstlane(tb[e]), ce = __builtin_amdgcn_readfirstlane(cn[e]);
        u.e = e; u.r0 = half == 1 ? HALF : 0; u.slot0 = (u.pm - t0) * 256 + u.r0; int rem = ce - u.slot0; const int lim = half >= 0 ? HALF : 256; rem = rem < lim ? rem : lim; u.nvalid = rem < 0 ? 0 : rem; return true;
    }
    __device__ __forceinline__ void addr_load(const Unit& u, const int (&R)[2], int (&raw)[4]) const {
        if (GATHER) { const int* lt = ltok + u.e * CAP + u.slot0;
#pragma unroll
            for (int i = 0; i < 2; ++i) { const int r0 = R[i], r1 = R[i] + HALF; raw[2 * i] = r0 < u.nvalid ? lt[r0] : 0; raw[2 * i + 1] = r1 < u.nvalid ? lt[r1] : 0; } }
    }
    __device__ __forceinline__ void addr_finish(const Unit& u, const int (&R)[2], const int (&C)[2], const int (&raw)[4], const char*& a, const char*& b, unsigned (&va0)[2], unsigned (&va1)[2]) const {
        b = (const char*)Bt + ((size_t)u.e * nN + u.pn) * (BM * RB);
        if (GATHER) { a = (const char*)A;
#pragma unroll
            for (int i = 0; i < 2; ++i) { va0[i] = (unsigned)(raw[2 * i] * RB + C[i] * 2); va1[i] = (unsigned)(raw[2 * i + 1] * RB + C[i] * 2); }
        } else { a = (const char*)A + (size_t)(u.pm * BM + u.r0) * RB;
#pragma unroll
            for (int i = 0; i < 2; ++i) { va0[i] = (unsigned)(R[i] * RB + C[i] * 2); va1[i] = va0[i] + (unsigned)(HALF * RB); }
        }
    }
};

template <int ES  , class Prob, class Epi>
__device__ __forceinline__ void gemm_phase(LAS unsigned char* lds, const Prob& P, const Epi& E) {
    const int tid = threadIdx.x, wid = __builtin_amdgcn_readfirstlane(tid >> 6), lane = tid & 63, wr = wid >> 2, wc = wid & 3, fr = lane & 15, fq = lane >> 4;
    constexpr int RB = KD * ES, nt = RB / (BK * 2);
    int R[2], C[2]; unsigned voffB[2];
#pragma unroll
    for (int i = 0; i < 2; ++i) { stage_rc(tid * 16 + i * 8192, R[i], C[i]); voffB[i] = (unsigned)(R[i] * RB + C[i] * 2); }
    constexpr size_t kstep = (size_t)(BK * 2);
    constexpr size_t hstep = (size_t)HALF * RB;
    const unsigned ldsw = (unsigned)wid * 1024u;
    const int aoff = lds_byte(wr * 64 + fr, fq * 8), boff = lds_byte(wc * 32 + fr, fq * 8);
#define PG8_SA(b, h) (((b) * 2 + (h)) * HTB)
#define PG8_SB(b, h) ((4 + (b) * 2 + (h)) * HTB)
#define PG8_STAGE(bufoff, gbase, voff) do { _Pragma("unroll") for (int _i = 0; _i < 2; ++_i) \
        __builtin_amdgcn_global_load_lds((const unsigned*)((const char*)(gbase) + (voff)[_i]), (LAS unsigned*)(lds + (bufoff) + ldsw + _i * 8192), 16, 0, 0); } while (0)
#define PG8_LDA(dst, b, h) do { _Pragma("unroll") for (int m = 0; m < 4; ++m) { \
        if constexpr (ES == 2) { _Pragma("unroll") for (int k = 0; k < 2; ++k) dst[m][k] = *(const LAS bf16x8*)(lds + PG8_SA(b, h) + aoff + m * 2048 + k * 1024); } \
        else { const i32x4 lo_ = *(const LAS i32x4*)(lds + PG8_SA(b, h) + aoff + m * 2048), hi_ = *(const LAS i32x4*)(lds + PG8_SA(b, h) + aoff + m * 2048 + 1024); dst##8[m] = __builtin_shufflevector(lo_, hi_, 0, 1, 2, 3, 4, 5, 6, 7); } } } while (0)
#define PG8_LDB(dst, b, h) do { _Pragma("unroll") for (int n = 0; n < 2; ++n) { \
        if constexpr (ES == 2) { _Pragma("unroll") for (int k = 0; k < 2; ++k) dst[n][k] = *(const LAS bf16x8*)(lds + PG8_SB(b, h) + boff + n * 2048 + k * 1024); } \
        else { const i32x4 lo_ = *(const LAS i32x4*)(lds + PG8_SB(b, h) + boff + n * 2048), hi_ = *(const LAS i32x4*)(lds + PG8_SB(b, h) + boff + n * 2048 + 1024); dst##8[n] = __builtin_shufflevector(lo_, hi_, 0, 1, 2, 3, 4, 5, 6, 7); } } } while (0)
#define PG8_MMA(ai, bj, At, Bt) do { __builtin_amdgcn_s_setprio(1); _Pragma("unroll") for (int m = 0; m < 4; ++m) _Pragma("unroll") for (int n = 0; n < 2; ++n) { \
        if constexpr (ES == 2) { _Pragma("unroll") for (int k = 0; k < 2; ++k) acc[ai][bj][m][n] = __builtin_amdgcn_mfma_f32_16x16x32_bf16(Bt[n][k], At[m][k], acc[ai][bj][m][n], 0, 0, 0); } \
        else asm volatile("s_nop 1\n\tv_mfma_scale_f32_16x16x128_f8f6f4 %0, %1, %2, %0, %3, %3 op_sel_hi:[0,0,0]" : "+v"(acc[ai][bj][m][n]) : "v"(Bt##8[n]), "v"(At##8[m]), "v"(sc127)); } \
        __builtin_amdgcn_s_setprio(0); } while (0)
#define PG8_WAIT_V(n) asm volatile("s_waitcnt vmcnt(" #n ")" ::: "memory")
#define PG8_WAIT_L(n) do { asm volatile("s_waitcnt lgkmcnt(" #n ")" ::: "memory"); __builtin_amdgcn_s_waitcnt(0xC07F); } while (0)
#define PG8_BAR __builtin_amdgcn_s_barrier()
#define PG8_SCHED __builtin_amdgcn_sched_barrier(0)
    Unit cur, nxt, nn; int ui = 0; int raw[4] = {0, 0, 0, 0};
    if (!P.next(0, cur)) return;
    bool has_next = P.next(1, nxt);
    const char *cA, *cB, *nA, *nB; unsigned va0[2], va1[2], nva0[2], nva1[2];
    P.addr_load(cur, R, raw); P.addr_finish(cur, R, C, raw, cA, cB, va0, va1);
    if (has_next) { P.addr_load(nxt, R, raw); P.addr_finish(nxt, R, C, raw, nA, nB, nva0, nva1); }
    else { nA = cA; nB = cB; nva0[0] = va0[0]; nva0[1] = va0[1]; nva1[0] = va1[0]; nva1[1] = va1[1]; }
    f32x4 acc[2][2][4][2];
#pragma unroll
    for (int a = 0; a < 2; ++a)
#pragma unroll
        for (int b = 0; b < 2; ++b)
#pragma unroll
            for (int m = 0; m < 4; ++m)
#pragma unroll
                for (int n = 0; n < 2; ++n) acc[a][b][m][n] = (f32x4){0.f, 0.f, 0.f, 0.f};
    const int sc127 = 0x7F7F7F7F;
    bf16x8 At[4][2], B0[2][2], B1[2][2]; i32x8 At8[4], B08[2], B18[2];
    PG8_STAGE(PG8_SB(0, 0), cB, voffB); PG8_STAGE(PG8_SB(0, 1), cB + hstep, voffB); PG8_STAGE(PG8_SA(0, 0), cA, va0); PG8_STAGE(PG8_SA(0, 1), cA, va1);
    if (wr == 1) PG8_BAR;
    PG8_WAIT_V(2); PG8_BAR;
    PG8_STAGE(PG8_SB(1, 0), cB + kstep, voffB); PG8_STAGE(PG8_SA(1, 0), cA + kstep, va0); PG8_STAGE(PG8_SB(1, 1), cB + hstep + kstep, voffB);
    PG8_WAIT_V(6); PG8_BAR;
    for (;;) {
        const bool full = cur.nvalid > HALF;
#pragma unroll 1
        for (int t = 0; t < nt; t += 2) {
            const bool last = (t == nt - 2);
            const char* a1 = cA + (size_t)(t + 1) * kstep;
            const char* a2 = last ? nA : cA + (size_t)(t + 2) * kstep; const char* b2 = last ? nB : cB + (size_t)(t + 2) * kstep;
            const char* a3 = a2 + kstep; const char* b3 = b2 + kstep;
            unsigned v2a0[2], v2a1[2];
            v2a0[0] = last ? nva0[0] : va0[0]; v2a0[1] = last ? nva0[1] : va0[1]; v2a1[0] = last ? nva1[0] : va1[0]; v2a1[1] = last ? nva1[1] : va1[1];
            PG8_LDB(B0, 0, 0); PG8_LDB(B1, 0, 1); PG8_SCHED; PG8_LDA(At, 0, 0); PG8_STAGE(PG8_SA(1, 1), a1, va1);
            PG8_WAIT_V(8); PG8_WAIT_L(0); PG8_BAR; PG8_MMA(0, 0, At, B0); PG8_MMA(0, 1, At, B1); PG8_BAR; PG8_SCHED;
            PG8_LDA(At, 0, 1); PG8_STAGE(PG8_SB(0, 0), b2, voffB); PG8_STAGE(PG8_SB(0, 1), b2 + hstep, voffB); PG8_STAGE(PG8_SA(0, 0), a2, v2a0);
            PG8_WAIT_V(8); PG8_WAIT_L(0); PG8_BAR; if (full) { PG8_MMA(1, 0, At, B0); PG8_MMA(1, 1, At, B1); } PG8_BAR; PG8_SCHED;
            PG8_LDB(B0, 1, 0); PG8_LDB(B1, 1, 1); PG8_SCHED; PG8_LDA(At, 1, 0); PG8_STAGE(PG8_SA(0, 1), a2, v2a1);
            PG8_WAIT_V(8); PG8_WAIT_L(0); PG8_BAR; PG8_MMA(0, 0, At, B0); PG8_MMA(0, 1, At, B1); PG8_BAR; PG8_SCHED;
            PG8_LDA(At, 1, 1); PG8_STAGE(PG8_SB(1, 0), b3, voffB); PG8_STAGE(PG8_SB(1, 1), b3 + hstep, voffB); PG8_STAGE(PG8_SA(1, 0), a3, v2a0);
            PG8_WAIT_V(8); PG8_WAIT_L(0); PG8_BAR; if (full) { PG8_MMA(1, 0, At, B0); PG8_MMA(1, 1, At, B1); } PG8_BAR; PG8_SCHED;
        }
        if constexpr (ES == 1) { asm volatile("s_nop 15\n\ts_nop 15" ::: "memory"); __builtin_amdgcn_sched_barrier(0); }
        const bool has_nn = has_next && P.next(ui + 2, nn);
        if (has_nn) P.addr_load(nn, R, raw);
        if (wr == 0) PG8_BAR;
        E(acc, cur, wr, wc, fr, fq);
        if (!has_next) break;
#pragma unroll
        for (int a = 0; a < 2; ++a)
#pragma unroll
            for (int b = 0; b < 2; ++b)
#pragma unroll
                for (int m = 0; m < 4; ++m)
#pragma unroll
                    for (int n = 0; n < 2; ++n) acc[a][b][m][n] = (f32x4){0.f, 0.f, 0.f, 0.f};
        cur = nxt; cA = nA; cB = nB; va0[0] = nva0[0]; va0[1] = nva0[1]; va1[0] = nva1[0]; va1[1] = nva1[1]; ++ui;
        nxt = nn; has_next = has_nn;
        if (has_next) P.addr_finish(nxt, R, C, raw, nA, nB, nva0, nva1);
        if (wr == 1) PG8_BAR;
    }
    PG8_WAIT_V(0);
    PG8_BAR;
#undef PG8_SA
#undef PG8_SB
#undef PG8_STAGE
#undef PG8_LDA
#undef PG8_LDB
#undef PG8_MMA
#undef PG8_WAIT_V
#undef PG8_WAIT_L
#undef PG8_BAR
#undef PG8_SCHED
}

struct EpiOut {
    const float* x; float* out; bf16_t* xn2; unsigned char* xn2f8;
    __device__ __forceinline__ void operator()(const f32x4 (&acc)[2][2][4][2], const Unit& u, int wr, int wc, int fr, int fq) const {
        const int row0 = u.pm * BM + wr * 64 + fr, col0 = u.pn * BM + wc * 32 + 8 * fq;
#pragma unroll
        for (int ai = 0; ai < 2; ++ai)
#pragma unroll
            for (int m = 0; m < 4; ++m) { const size_t off = (size_t)(row0 + ai * HALF + m * 16) * D + col0;
#pragma unroll
                for (int bj = 0; bj < 2; ++bj) { const float* xp = x + off + bj * HALF;
                    const f32x4 h0 = acc[ai][bj][m][0] + *(const f32x4*)xp, h1 = acc[ai][bj][m][1] + *(const f32x4*)(xp + 4);
                    *(u32x4*)(xn2 + off + bj * HALF) = pack8(h0, h1);
                    *(u32x2*)(xn2f8 + off + bj * HALF) = (u32x2){pk4_fp8(h0[0], h0[1], h0[2], h0[3]), pk4_fp8(h1[0], h1[1], h1[2], h1[3])}; }
                asm volatile("" ::: "memory"); }
    }
};
struct EpiIn {
    bf16_t *Qb, *Kb, *VT, *HC; const float *qg, *kg;
    __device__ __forceinline__ void operator()(const f32x4 (&acc)[2][2][4][2], const Unit& u, int wr, int wc, int fr, int fq) const {
        const int rowb = u.pm * BM + wr * 64 + fr;
        if (u.pn <= 2) {
            const bool isv = (u.pn == 2) && (wc >= 2);
            if (!isv) {
                const bool isq = u.pn < 2; const float* g = isq ? qg : kg; const float sc = isq ? QSCALE : 1.f;
                f32x4 gv[2][2];
#pragma unroll
                for (int bj = 0; bj < 2; ++bj)
#pragma unroll
                    for (int n = 0; n < 2; ++n) gv[bj][n] = *(const f32x4*)(g + 32 * bj + 8 * fq + 4 * n) * sc;
                bf16_t* dst = isq ? Qb + (u.pn * 256 + 64 * wc) : Kb + 64 * wc; const int ld = isq ? 512 : 128;
#pragma unroll
                for (int ai = 0; ai < 2; ++ai)
#pragma unroll
                    for (int m = 0; m < 4; ++m) { const int row = rowb + ai * HALF + m * 16; float ss = 0.f;
#pragma unroll
                        for (int bj = 0; bj < 2; ++bj)
#pragma unroll
                            for (int n = 0; n < 2; ++n) { const f32x4 v = acc[ai][bj][m][n]; ss += (v[0] * v[0] + v[1] * v[1]) + (v[2] * v[2] + v[3] * v[3]); }
                        ss += __shfl_xor(ss, 16); ss += __shfl_xor(ss, 32);
                        const float r = __builtin_amdgcn_rsqf(ss * (1.f / 64.f) + 1e-6f);
#pragma unroll
                        for (int bj = 0; bj < 2; ++bj) *(u32x4*)(dst + (size_t)row * ld + 32 * bj + 8 * fq) = pack8(acc[ai][bj][m][0] * r * gv[bj][0], acc[ai][bj][m][1] * r * gv[bj][1]); }
            } else {
                const int hk = wc - 2;
#pragma unroll
                for (int ai = 0; ai < 2; ++ai)
#pragma unroll
                    for (int m = 0; m < 4; ++m) { const int row = rowb + ai * HALF + m * 16;
                        if (row < M_ALL) { int b, kx; if (row < M_REAL) { b = row >> 11; kx = NMETA + (row & 2047); } else { b = (row - M_REAL) >> 4; kx = (row - M_REAL) & 15; }
                            bf16_t* base = VT + (size_t)(b * 2 + hk) * 64 * VT_PITCH + kx;
#pragma unroll
                            for (int bj = 0; bj < 2; ++bj)
#pragma unroll
                                for (int n = 0; n < 2; ++n)
#pragma unroll
                                    for (int e = 0; e < 4; ++e) base[(size_t)(32 * bj + 8 * fq + 4 * n + e) * VT_PITCH] = (bf16_t)f2bf(acc[ai][bj][m][n][e]); } }
            }
        } else {
            const int col = (u.pn - 3) * 128 + 32 * wc + 8 * fq;
#pragma unroll
            for (int ai = 0; ai < 2; ++ai)
#pragma unroll
                for (int m = 0; m < 4; ++m) { const int row = rowb + ai * HALF + m * 16; f32x4 h[2];
#pragma unroll
                    for (int n = 0; n < 2; ++n)
#pragma unroll
                        for (int e = 0; e < 4; ++e) h[n][e] = acc[ai][0][m][n][e] * sigmoidf_fast(acc[ai][1][m][n][e]);
                    *(u32x4*)(HC + (size_t)row * 512 + col) = pack8(h[0], h[1]); }
        }
    }
};
struct EpiGU {
    unsigned char* ACT; const float* lrstd; const float* bgu;
    __device__ __forceinline__ void operator()(const f32x4 (&acc)[2][2][4][2], const Unit& u, int wr, int wc, int fr, int fq) const {
        const int lr0 = wr * 64 + fr, col = u.pn * 128 + 32 * wc + 8 * fq;
        f32x2 bg[2][2], bu[2][2];
#pragma unroll
        for (int n = 0; n < 2; ++n) { const f32x4 g4 = *(const f32x4*)(bgu + u.e * 2048 + col + 4 * n), u4 = *(const f32x4*)(bgu + u.e * 2048 + 1024 + col + 4 * n);
            bg[n][0] = (f32x2){g4[0], g4[1]}; bg[n][1] = (f32x2){g4[2], g4[3]}; bu[n][0] = (f32x2){u4[0], u4[1]}; bu[n][1] = (f32x2){u4[2], u4[3]}; }
        const float* rs = lrstd + u.e * CAP + u.slot0;
#pragma unroll
        for (int ai = 0; ai < 2; ++ai) {
            if (ai == 1 && u.nvalid <= HALF) break;
#pragma unroll
            for (int m = 0; m < 4; ++m) { const int lr = lr0 + ai * HALF + m * 16; const float rstd = lr < u.nvalid ? rs[lr] * (1.f / WSCALE) : 0.f; f32x2 h[2][2];
#pragma unroll
                for (int n = 0; n < 2; ++n)
#pragma unroll
                    for (int p = 0; p < 2; ++p) {
                        f32x2 gt = (f32x2){acc[ai][0][m][n][2 * p], acc[ai][0][m][n][2 * p + 1]} * rstd + bg[n][p];
                        f32x2 up = (f32x2){acc[ai][1][m][n][2 * p], acc[ai][1][m][n][2 * p + 1]} * rstd + bu[n][p];
                        gt.x = fminf(gt.x, 7.f); gt.y = fminf(gt.y, 7.f); up.x = __builtin_amdgcn_fmed3f(up.x, -7.f, 7.f); up.y = __builtin_amdgcn_fmed3f(up.y, -7.f, 7.f);
                        const f32x2 z = gt * (-1.702f * LOG2E); f32x2 ex; ex.x = __builtin_amdgcn_exp2f(z.x); ex.y = __builtin_amdgcn_exp2f(z.y);
                        const f32x2 dn = ex + 1.0f; f32x2 rc; rc.x = __builtin_amdgcn_rcpf(dn.x); rc.y = __builtin_amdgcn_rcpf(dn.y);
                        const f32x2 t = gt * rc; h[n][p] = t * up + t; }
                *(u32x2*)(ACT + (size_t)(u.pm * BM + u.r0 + lr) * D + col) = (u32x2){pk4_fp8(h[0][0].x, h[0][0].y, h[0][1].x, h[0][1].y), pk4_fp8(h[1][0].x, h[1][0].y, h[1][1].x, h[1][1].y)}; }
        }
    }
};
struct EpiDown {
    unsigned char* Y; const float* lgate; const float* bd;
    __device__ __forceinline__ void operator()(const f32x4 (&acc)[2][2][4][2], const Unit& u, int wr, int wc, int fr, int fq) const {
        const int lr0 = wr * 64 + fr, col0 = u.pn * BM + wc * 32 + 8 * fq;
        f32x4 bv[2][2];
#pragma unroll
        for (int bj = 0; bj < 2; ++bj)
#pragma unroll
            for (int n = 0; n < 2; ++n) bv[bj][n] = *(const f32x4*)(bd + u.e * D + col0 + bj * HALF + 4 * n);
        const float* gs = lgate + u.e * CAP + u.slot0;
#pragma unroll
        for (int ai = 0; ai < 2; ++ai)
#pragma unroll
            for (int m = 0; m < 4; ++m) { if (ai == 1 && u.nvalid <= HALF) continue; const int lr = lr0 + ai * HALF + m * 16; const float gt = lr < u.nvalid ? gs[lr] : 0.f;
#pragma unroll
                for (int bj = 0; bj < 2; ++bj) { const f32x4 y0 = (acc[ai][bj][m][0] * (1.f / WSCALE) + bv[bj][0]) * gt, y1 = (acc[ai][bj][m][1] * (1.f / WSCALE) + bv[bj][1]) * gt;
                    *(u32x2*)(Y + (size_t)(u.pm * BM + u.r0 + lr) * D + col0 + bj * HALF) = (u32x2){pk4_fp8(y0[0], y0[1], y0[2], y0[3]), pk4_fp8(y1[0], y1[1], y1[2], y1[3])}; } }
    }
};
}


constexpr int ATT_KIMG = 0, ATT_VIMG = 53248, ATT_VP = 840;
constexpr float ATT_THR = 4.0f;
template <int MODE>
__device__ __forceinline__ void att_tile(const LAS unsigned char* kbase, const int (&koff)[4], const LAS unsigned char* vbase, const bf16x8 (&qf)[4], float slope2, float Bq,
                                         float& m, float& l, f32x16& O0, f32x16& O1) {
    f32x16 s;
#pragma unroll
    for (int r = 0; r < 16; ++r) s[r] = 0.f;
#pragma unroll
    for (int ks = 0; ks < 4; ++ks) { const bf16x8 kf = *(const LAS bf16x8*)(kbase + koff[ks]); s = __builtin_amdgcn_mfma_f32_32x32x16_bf16(kf, qf[ks], s, 0, 0, 0); }
    float tmax = -INFINITY;
#pragma unroll
    for (int r = 0; r < 16; ++r) {
        if (MODE == 0) { if (r >= 8) s[r] = -INFINITY; }
        else { const float dl = fabsf(Bq - (float)((r & 3) + 8 * (r >> 2))); float v = s[r] - slope2 * dl; if (MODE == 2) v = dl <= 128.f ? v : -INFINITY; s[r] = v; }
        tmax = fmaxf(tmax, s[r]);
    }
    tmax = fmaxf(tmax, __shfl_xor(tmax, 32));
    if (__any(tmax > m + ATT_THR)) { const float mn = fmaxf(m, tmax); const float al = __builtin_amdgcn_exp2f(m - mn); m = mn; l *= al;
#pragma unroll
        for (int r = 0; r < 16; ++r) { O0[r] *= al; O1[r] *= al; } }
    float ps = 0.f;
#pragma unroll
    for (int r = 0; r < 16; ++r) { s[r] = __builtin_amdgcn_exp2f(s[r] - m); ps += s[r]; }
    l += ps;
#pragma unroll
    for (int s2 = 0; s2 < 2; ++s2) {
        u32x4 pw; pw.x = pg8::cvt_pk_bf16(s[8 * s2 + 0], s[8 * s2 + 1]); pw.y = pg8::cvt_pk_bf16(s[8 * s2 + 2], s[8 * s2 + 3]); pw.z = pg8::cvt_pk_bf16(s[8 * s2 + 4], s[8 * s2 + 5]); pw.w = pg8::cvt_pk_bf16(s[8 * s2 + 6], s[8 * s2 + 7]);
        const bf16x8 pf = __builtin_bit_cast(bf16x8, pw);
        { const u32x2 lo = *(const LAS u32x2*)(vbase + s2 * 32), hi = *(const LAS u32x2*)(vbase + s2 * 32 + 16); const u32x4 vw = {lo.x, lo.y, hi.x, hi.y};
          O0 = __builtin_amdgcn_mfma_f32_32x32x16_bf16(__builtin_bit_cast(bf16x8, vw), pf, O0, 0, 0, 0); }
        { const u32x2 lo = *(const LAS u32x2*)(vbase + 32 * ATT_VP + s2 * 32), hi = *(const LAS u32x2*)(vbase + 32 * ATT_VP + s2 * 32 + 16); const u32x4 vw = {lo.x, lo.y, hi.x, hi.y};
          O1 = __builtin_amdgcn_mfma_f32_32x32x16_bf16(__builtin_bit_cast(bf16x8, vw), pf, O1, 0, 0, 0); }
    }
}
__device__ __forceinline__ void att_fast(Frame& F) {
    LAS unsigned char* Kimg = F.lds + ATT_KIMG; LAS unsigned char* Vimg = F.lds + ATT_VIMG;
    const int tid = F.tid, lane = F.lane, wid = F.wave, q = lane & 31, h = lane >> 5, qt = wid & 3, hsel = wid >> 2;
    int koff[4];
#pragma unroll
    for (int ks = 0; ks < 4; ++ks) koff[ks] = ((2 * ks + h) ^ ((q >> 1) & 7)) << 4;
    for (int item = F.bid; item < NB * 16 * 2; item += F.G) {
        const int hk = item & 1, i = (item >> 1) & 15, b = item >> 5;
        __syncthreads();
        for (int idx = tid; idx < 416 * 8; idx += NTHR) { const int kr = idx >> 3, c = idx & 7; if (kr >= 16 && kr < 32) continue;
            int row; if (kr < 16) row = M_REAL + b * NMETA + kr; else { const int pos = (i - 1) * 128 + kr - 32; if (pos < 0 || pos >= SEQ) continue; row = b * SEQ + pos; }
            const u32x4 v = *(const GAS u32x4*)(F.Kb + (size_t)row * 128 + hk * 64 + 8 * c);
            *(LAS u32x4*)(Kimg + kr * 128 + ((c ^ ((kr >> 1) & 7)) << 4)) = v; }
        for (int idx = tid; idx < 64 * 52; idx += NTHR) { const int d = idx / 52, c = idx % 52; const bf16_t* vrow = F.VT + (size_t)((b * 2 + hk) * 64 + d) * VT_PITCH;
            LAS u32x2* dst; const bf16_t* src;
            if (c < 2) { src = vrow + 8 * c; dst = (LAS u32x2*)(Vimg + d * ATT_VP + 16 * c); }
            else if (c < 4) { dst = (LAS u32x2*)(Vimg + d * ATT_VP + 32 + 16 * (c - 2)); dst[0] = (u32x2){0u, 0u}; dst[1] = (u32x2){0u, 0u}; continue; }
            else { const int cc = c - 4, blk = cc >> 4, w = cc & 15, pos0 = (i - 1 + blk) * 128; if (pos0 < 0 || pos0 >= SEQ) continue; src = vrow + NMETA + pos0 + 8 * w; dst = (LAS u32x2*)(Vimg + d * ATT_VP + (32 + blk * 128 + 8 * w) * 2); }
            const u32x4 v = *(const GAS u32x4*)src; dst[0] = (u32x2){v.x, v.y}; dst[1] = (u32x2){v.z, v.w}; }
        __syncthreads();
#pragma unroll 1
        for (int hp = 0; hp < 2; ++hp) {
            const int head = hk * 4 + hp * 2 + hsel, row = b * SEQ + i * 128 + 32 * qt + q;
            bf16x8 qf[4];
#pragma unroll
            for (int ks = 0; ks < 4; ++ks) qf[ks] = *(const GAS bf16x8*)(F.Qb + (size_t)row * 512 + head * 64 + 16 * ks + 8 * h);
            const float slope2 = exp2f(-(float)(head + 1)) * LOG2E;
            float m = F.sink[head] * LOG2E, l = h == 0 ? 1.f : 0.f;
            f32x16 O0, O1;
#pragma unroll
            for (int r = 0; r < 16; ++r) { O0[r] = 0.f; O1[r] = 0.f; }
            const LAS unsigned char* kb0 = Kimg + q * 128; const LAS unsigned char* vb0 = Vimg + q * ATT_VP + 8 * h;
            att_tile<0>(kb0, koff, vb0, qf, 0.f, 0.f, m, l, O0, O1);
#pragma unroll 1
            for (int kt = qt; kt <= qt + 8; ++kt) { const int blk = kt >> 2; if ((i == 0 && blk == 0) || (i == 15 && blk == 2)) continue;
                const int kr0 = 32 + 32 * kt; const float Bq = (float)(128 + 32 * (qt - kt) + q - 4 * h);
                if (kt == qt || kt == qt + 8) att_tile<2>(kb0 + kr0 * 128, koff, vb0 + kr0 * 2, qf, slope2, Bq, m, l, O0, O1);
                else att_tile<1>(kb0 + kr0 * 128, koff, vb0 + kr0 * 2, qf, slope2, Bq, m, l, O0, O1); }
            l += __shfl_xor(l, 32); const float inv = 1.f / l;
            bf16_t* orow = F.MIX + (size_t)row * D + head * 64 + 4 * h;
#pragma unroll
            for (int g = 0; g < 4; ++g) { *(GAS u32x2*)(orow + 8 * g) = (u32x2){pg8::cvt_pk_bf16(O0[4 * g] * inv, O0[4 * g + 1] * inv), pg8::cvt_pk_bf16(O0[4 * g + 2] * inv, O0[4 * g + 3] * inv)};
                *(GAS u32x2*)(orow + 32 + 8 * g) = (u32x2){pg8::cvt_pk_bf16(O1[4 * g] * inv, O1[4 * g + 1] * inv), pg8::cvt_pk_bf16(O1[4 * g + 2] * inv, O1[4 * g + 3] * inv)}; }
        }
    }
    __syncthreads();
}
__device__ __forceinline__ void conv_fast(Frame& F) {
    const int tid = F.tid, lane = F.lane, wid = F.wave, c2 = tid & 255, th = tid >> 8;
    LAS float* cout = (LAS float*)F.lds;
    float w0[CONV_K], w1[CONV_K];
#pragma unroll
    for (int j = 0; j < CONV_K; ++j) { const f32x2 w = *(const f32x2*)(F.dw_w + j * CONV_W + 2 * c2); w0[j] = w.x; w1[j] = w.y; }
    const f32x2 bias = *(const f32x2*)(F.dw_b + 2 * c2);
    for (int item = F.bid; item < NB * 64; item += F.G) {
        const int b = item >> 6, t0 = (item & 63) * 32;
        unsigned xin[46];
        const int s0 = NMETA + t0 + 16 * th - 15;
#pragma unroll
        for (int jj = 0; jj < 46; ++jj) { const int sq = s0 + jj; xin[jj] = sq < LSEQ ? *(const GAS unsigned*)(F.HC + (size_t)row_of(b, sq) * 512 + 2 * c2) : 0u; }
        __syncthreads();
#pragma unroll
        for (int t = 0; t < 16; ++t) { float a0 = bias.x, a1 = bias.y;
#pragma unroll
            for (int j = 0; j < CONV_K; ++j) { a0 += w0[j] * bflo(xin[t + j]); a1 += w1[j] * bfhi(xin[t + j]); }
            *(LAS f32x2*)(cout + (16 * th + t) * 512 + 2 * c2) = (f32x2){a0, a1}; }
        __syncthreads();
#pragma unroll 1
        for (int tt = 0; tt < 4; ++tt) { const int t = 4 * wid + tt; const LAS f32x4* rp = (const LAS f32x4*)(cout + t * 512 + 8 * lane); const f32x4 x0 = rp[0], x1 = rp[1];
            const float mu = wave_sum((x0[0] + x0[1]) + (x0[2] + x0[3]) + (x1[0] + x1[1]) + (x1[2] + x1[3])) * (1.f / 512.f);
            const f32x4 d0 = x0 - mu, d1 = x1 - mu;
            const float var = wave_sum((d0[0] * d0[0] + d0[1] * d0[1]) + (d0[2] * d0[2] + d0[3] * d0[3]) + (d1[0] * d1[0] + d1[1] * d1[1]) + (d1[2] * d1[2] + d1[3] * d1[3])) * (1.f / 512.f);
            const float rstd = __builtin_amdgcn_rsqf(var + 1e-5f);
            const f32x4 g0 = *(const f32x4*)(F.lng + 8 * lane), g1 = *(const f32x4*)(F.lng + 8 * lane + 4), b0 = *(const f32x4*)(F.lnb + 8 * lane), b1 = *(const f32x4*)(F.lnb + 8 * lane + 4);
            f32x4 y0 = d0 * rstd * g0 + b0, y1 = d1 * rstd * g1 + b1;
#pragma unroll
            for (int e = 0; e < 4; ++e) { y0[e] *= sigmoidf_fast(y0[e]); y1[e] *= sigmoidf_fast(y1[e]); }
            *(GAS u32x4*)(F.MIX + (size_t)(b * SEQ + t0 + t) * D + 512 + 8 * lane) = pg8::pack8(y0, y1); }
    }
    __syncthreads();
}
__device__ __forceinline__ void p4_fast(Frame& F) {
    LAS int* lcnt = (LAS int*)(F.lds + LX_LCNT); LAS int* gbase = (LAS int*)(F.lds + LX_GBASE);
    const int tid = F.tid, lane = F.lane, wid = F.wave, j = lane & 31, h = lane >> 5;
    for (int base = 0; base < M_REAL / 32; base += F.G * NWAVES) {
        const int tile = base + F.bid + F.G * wid; const bool active = tile < M_REAL / 32;
        if (tid < NE) lcnt[tid] = 0;
        __syncthreads();
        int ea = 0, eb = 0, sa = 0, sb = 0, tok = 0; float ga = 0.f, gb = 0.f, rstd = 0.f;
        if (active) {
            tok = tile * 32 + j;
            const bf16_t* xa = F.XN2 + (size_t)tok * D + 8 * h; const bf16_t* wa = F.WrT + (size_t)j * D + 8 * h;
            f32x16 acc;
#pragma unroll
            for (int r = 0; r < 16; ++r) acc[r] = 0.f;
            float ssq = 0.f;
#pragma unroll 8
            for (int ks = 0; ks < 64; ++ks) { const u32x4 xb = *(const GAS u32x4*)(xa + 16 * ks); const bf16x8 wf = *(const GAS bf16x8*)(wa + 16 * ks);
                acc = __builtin_amdgcn_mfma_f32_32x32x16_bf16(wf, __builtin_bit_cast(bf16x8, xb), acc, 0, 0, 0);
                ssq += (bflo(xb.x) * bflo(xb.x) + bfhi(xb.x) * bfhi(xb.x)) + (bflo(xb.y) * bflo(xb.y) + bfhi(xb.y) * bfhi(xb.y)) + (bflo(xb.z) * bflo(xb.z) + bfhi(xb.z) * bfhi(xb.z)) + (bflo(xb.w) * bflo(xb.w) + bfhi(xb.w) * bfhi(xb.w)); }
            ssq += __shfl_xor(ssq, 32);
            rstd = 1.f / sqrtf(ssq * (1.f / D) + 1e-6f);
            float lg[16];
#pragma unroll
            for (int r = 0; r < 16; ++r) lg[r] = acc[r] * rstd + F.rb[(r & 3) + 8 * (r >> 2) + 4 * h];
            float tv[4]; int te[4];
#pragma unroll
            for (int kk = 0; kk < 4; ++kk) { float bv = -INFINITY; int be = 0;
#pragma unroll
                for (int r = 0; r < 16; ++r) { const int er = (r & 3) + 8 * (r >> 2) + 4 * h; if (lg[r] > bv) { bv = lg[r]; be = er; } }
                const float pv = __shfl_xor(bv, 32); const int pe = __shfl_xor(be, 32);
                if (pv > bv || (pv == bv && pe < be)) { bv = pv; be = pe; }
#pragma unroll
                for (int r = 0; r < 16; ++r) { const int er = (r & 3) + 8 * (r >> 2) + 4 * h; if (er == be) lg[r] = -INFINITY; }
                tv[kk] = bv; te[kk] = be; }
            const float p1 = __expf(tv[1] - tv[0]), p2 = __expf(tv[2] - tv[0]), p3 = __expf(tv[3] - tv[0]); const float inv = 1.f / (1.f + p1 + p2 + p3);
            ea = h ? te[2] : te[0]; eb = h ? te[3] : te[1]; ga = (h ? p2 : 1.f) * inv; gb = (h ? p3 : p1) * inv;
            sa = __hip_atomic_fetch_add(lcnt + ea, 1, __ATOMIC_RELAXED, __HIP_MEMORY_SCOPE_WORKGROUP); sb = __hip_atomic_fetch_add(lcnt + eb, 1, __ATOMIC_RELAXED, __HIP_MEMORY_SCOPE_WORKGROUP);
        }
        __syncthreads();
        if (tid < NE) gbase[tid] = (int)__hip_atomic_fetch_add((unsigned*)(F.ctl + CW_CNT + tid), (unsigned)lcnt[tid], RLX_AGENT);
        __syncthreads();
        if (active) {
            sa += gbase[ea]; sb += gbase[eb];
            F.ltok[ea * CAP + sa] = tok; F.lgate[ea * CAP + sa] = ga; F.lrstd[ea * CAP + sa] = rstd; F.where[tok * 4 + 2 * h] = ea * CAP + sa;
            F.ltok[eb * CAP + sb] = tok; F.lgate[eb * CAP + sb] = gb; F.lrstd[eb * CAP + sb] = rstd; F.where[tok * 4 + 2 * h + 1] = eb * CAP + sb;
        }
        __syncthreads();
    }
}

__device__ __forceinline__ void p1_naive(Frame& F) {
    const int gw = F.bid * NWAVES + F.wave, NGW = F.G * NWAVES, lane = F.lane;
    for (int it = gw; it < M_ALL * 20; it += NGW) {
        const int row = it / 20, grp = it % 20;
        const bf16_t* xr = F.XN + (size_t)row * D;
        if (grp < 12) {
            const int col = grp * 64 + lane; float acc = 0.f;
            _Pragma("unroll 4") for (int k = 0; k < D; ++k) acc += bf2f(xr[k]) * F.w_in[(size_t)k * IN_W + col];
            if (grp < 10) {
                const float ssq = wave_sum(acc * acc); const float r = 1.f / sqrtf(ssq * (1.f / 64.f) + 1e-6f);
                if (grp < 8) F.Qb[(size_t)row * 512 + col] = (bf16_t)f2bf(acc * r * F.qg[lane] * QSCALE);
                else F.Kb[(size_t)row * 128 + (col - 512)] = (bf16_t)f2bf(acc * r * F.kg[lane]);
            } else {
                const int hk = grp - 10; int b, kx;
                if (row < M_REAL) { b = row >> 11; kx = NMETA + (row & 2047); } else { b = (row - M_REAL) >> 4; kx = (row - M_REAL) & 15; }
                F.VT[((size_t)(b * 2 + hk) * 64 + lane) * VT_PITCH + kx] = (bf16_t)f2bf(acc);
            }
        } else {
            const int c = (grp - 12) * 64 + lane; float a = 0.f, g = 0.f;
            for (int k = 0; k < D; ++k) { const float xv = bf2f(xr[k]); a += xv * F.w_in[(size_t)k * IN_W + 768 + c]; g += xv * F.w_in[(size_t)k * IN_W + 1280 + c]; }
            F.HC[(size_t)row * 512 + c] = (bf16_t)f2bf(a * sigmoidf_fast(g));
        }
    }
}
__device__ __forceinline__ void att_naive(Frame& F) {
    const int gw = F.bid * NWAVES + F.wave, NGW = F.G * NWAVES, lane = F.lane;
    for (int it = gw; it < M_REAL * NQH; it += NGW) {
        const int row = it >> 3, h = it & 7, hk = h >> 2, b = row >> 11, qp = row & 2047;
        const float q = bf2f(F.Qb[(size_t)row * 512 + h * 64 + lane]);
        const float slope2 = exp2f(-(float)(h + 1)) * LOG2E;
        float m = F.sink[h] * LOG2E, l = 1.f, acc = 0.f;
        const bf16_t* vt = F.VT + ((size_t)(b * 2 + hk) * 64 + lane) * VT_PITCH;
        for (int j = 0; j < NMETA; ++j) {
            const float kv = bf2f(F.Kb[(size_t)(M_REAL + b * NMETA + j) * 128 + hk * 64 + lane]);
            const float s = wave_sum(q * kv);
            const float mn = fmaxf(m, s), al = exp2f(m - mn), p = exp2f(s - mn);
            l = l * al + p; acc = acc * al + p * bf2f(vt[j]); m = mn;
        }
        const int k0 = qp - 128 < 0 ? 0 : qp - 128, k1 = qp + 128 > SEQ - 1 ? SEQ - 1 : qp + 128;
        for (int kp = k0; kp <= k1; ++kp) {
            const float kv = bf2f(F.Kb[(size_t)(b * SEQ + kp) * 128 + hk * 64 + lane]);
            const float dist = (float)(qp > kp ? qp - kp : kp - qp);
            const float s = wave_sum(q * kv) - slope2 * dist;
            const float mn = fmaxf(m, s), al = exp2f(m - mn), p = exp2f(s - mn);
            l = l * al + p; acc = acc * al + p * bf2f(vt[NMETA + kp]); m = mn;
        }
        F.MIX[(size_t)row * D + h * 64 + lane] = (bf16_t)f2bf(acc / l);
    }
}
__device__ __forceinline__ void conv_naive(Frame& F) {
    const int gw = F.bid * NWAVES + F.wave, NGW = F.G * NWAVES, lane = F.lane;
    for (int row = gw; row < M_REAL; row += NGW) {
        const int b = row >> 11, s0 = NMETA + (row & 2047);
        float v[8]; float sum = 0.f;
#pragma unroll
        for (int j = 0; j < 8; ++j) { const int c = lane + 64 * j; float a = F.dw_b[c];
            _Pragma("unroll 1") for (int t = 0; t < CONV_K; ++t) { const int s = s0 - 15 + t; if (s >= 0 && s < LSEQ) a += F.dw_w[t * CONV_W + c] * bf2f(F.HC[(size_t)row_of(b, s) * 512 + c]); }
            v[j] = a; sum += a; }
        const float mu = wave_sum(sum) * (1.f / 512.f); float q = 0.f;
#pragma unroll
        for (int j = 0; j < 8; ++j) { const float d = v[j] - mu; q += d * d; }
        const float rstd = 1.f / sqrtf(wave_sum(q) * (1.f / 512.f) + 1e-5f);
#pragma unroll
        for (int j = 0; j < 8; ++j) { const int c = lane + 64 * j; const float y = (v[j] - mu) * rstd * F.lng[c] + F.lnb[c];
            F.MIX[(size_t)row * D + 512 + c] = (bf16_t)f2bf(y * sigmoidf_fast(y)); }
    }
}
__device__ __forceinline__ void p3_naive(Frame& F) {
    const int gw = F.bid * NWAVES + F.wave, NGW = F.G * NWAVES, lane = F.lane;
    for (int it = gw; it < M_REAL * 16; it += NGW) {
        const int row = it >> 4, col = (it & 15) * 64 + lane; const bf16_t* mr = F.MIX + (size_t)row * D; float acc = 0.f;
        for (int k = 0; k < D; ++k) acc += bf2f(mr[k]) * F.w_out[(size_t)k * D + col];
        const float h2 = F.x[(size_t)row * D + col] + acc;
        F.out[(size_t)row * D + col] = h2; F.XN2[(size_t)row * D + col] = (bf16_t)f2bf(h2); F.XN2F8[(size_t)row * D + col] = (unsigned char)(pk4_fp8(h2, 0.f, 0.f, 0.f) & 0xffu);
    }
}
__device__ __forceinline__ void p4_naive(Frame& F) {
    const int gw = F.bid * NWAVES + F.wave, NGW = F.G * NWAVES, lane = F.lane, e = lane & 31;
    for (int t = gw; t < M_REAL; t += NGW) {
        const bf16_t* xr = F.XN2 + (size_t)t * D; float acc = 0.f, ss = 0.f;
        for (int k = 0; k < D; ++k) { const float xv = bf2f(xr[k]); acc += xv * F.n2g[k] * F.wr[k * NE + e]; ss += xv * xv; }
        const float rstd = 1.f / sqrtf(ss * (1.f / D) + 1e-6f);
        float lg = acc * rstd + F.rb[e];
        float tv[4]; int te[4];
#pragma unroll
        for (int kk = 0; kk < 4; ++kk) {
            float bv = lg; int be = e;
#pragma unroll
            for (int o = 1; o < 32; o <<= 1) { const float pv = __shfl_xor(bv, o); const int pe = __shfl_xor(be, o); if (pv > bv || (pv == bv && pe < be)) { bv = pv; be = pe; } }
            tv[kk] = bv; te[kk] = be; if (e == be) lg = -INFINITY;
        }
        float p[4], ps = 0.f;
#pragma unroll
        for (int kk = 0; kk < 4; ++kk) { p[kk] = __expf(tv[kk] - tv[0]); ps += p[kk]; }
        if (lane < 4) {
            const int ee = lane == 0 ? te[0] : lane == 1 ? te[1] : lane == 2 ? te[2] : te[3];
            const float gg = (lane == 0 ? p[0] : lane == 1 ? p[1] : lane == 2 ? p[2] : p[3]) / ps;
            const unsigned slot = __hip_atomic_fetch_add((unsigned*)(F.ctl + CW_CNT + ee), 1u, RLX_AGENT);
            F.ltok[ee * CAP + slot] = t; F.lgate[ee * CAP + slot] = gg; F.lrstd[ee * CAP + slot] = rstd; F.where[t * 4 + lane] = ee * CAP + (int)slot;
        }
    }
}
__device__ __forceinline__ void build_tile_table(Frame& F) {
    LAS int* tb = (LAS int*)(F.lds + LX_TB); LAS int* cn = (LAS int*)(F.lds + LX_CNT);
    __syncthreads();
    if (F.tid == 0) { int acc = 0; for (int e = 0; e < NE; ++e) { int c = (int)__hip_atomic_load(F.ctl + CW_CNT + e, RLX_AGENT); if (c > CAP) c = CAP; if (c < 0) c = 0; cn[e] = c; tb[e] = acc; acc += (c + 255) >> 8; } tb[NE] = acc; }
    __syncthreads();
}
__device__ __forceinline__ int find_expert(const LAS int* tb, int tile) { int e = 0;
#pragma unroll 1
    for (int j = 1; j < NE; ++j) if (tb[j] <= tile) e = j;
    return e; }
__device__ __forceinline__ f32x4 fp8x4_to_f32(unsigned w) {
    const f32x2 lo = __builtin_amdgcn_cvt_pk_f32_fp8((int)w, false), hi = __builtin_amdgcn_cvt_pk_f32_fp8((int)w, true); return (f32x4){lo.x, lo.y, hi.x, hi.y}; }
__device__ __forceinline__ void p7_combine(Frame& F) {
    build_tile_table(F);
    const LAS int* tb = (const LAS int*)(F.lds + LX_TB);
    const int gw = F.bid * NWAVES + F.wave, NGW = F.G * NWAVES, lane = F.lane;
    const GAS i32x4* wh = (const GAS i32x4*)F.where;
    int t0 = gw, t1 = gw + NGW;
    i32x4 w0 = t0 < M_REAL ? wh[t0] : (i32x4){0, 0, 0, 0}, w1 = t1 < M_REAL ? wh[t1] : (i32x4){0, 0, 0, 0};
    while (t0 < M_REAL) {
        const int n0 = t0 + 2 * NGW, n1 = t1 + 2 * NGW;
        const i32x4 nw0 = n0 < M_REAL ? wh[n0] : (i32x4){0, 0, 0, 0}, nw1 = n1 < M_REAL ? wh[n1] : (i32x4){0, 0, 0, 0};
        const bool v1 = t1 < M_REAL; const int tt1 = v1 ? t1 : t0;
        u32x4 y[2][4], x[2][2];
#pragma unroll
        for (int u = 0; u < 2; ++u) { const int t = u ? tt1 : t0; const i32x4 w = u ? w1 : w0;
#pragma unroll
            for (int j = 0; j < 2; ++j) x[u][j] = *((const GAS u32x4*)(F.XN2 + (size_t)t * D) + 2 * lane + j);
#pragma unroll
            for (int k = 0; k < 4; ++k) { const int e = w[k] / CAP, slot = w[k] - e * CAP; y[u][k] = *((const GAS u32x4*)(F.Y8 + (size_t)(tb[e] * 256 + slot) * D) + lane); } }
#pragma unroll
        for (int u = 0; u < 2; ++u) { if (u && !v1) break; const int t = u ? tt1 : t0;
            f32x4 a[4] = {(f32x4){0.f, 0.f, 0.f, 0.f}, (f32x4){0.f, 0.f, 0.f, 0.f}, (f32x4){0.f, 0.f, 0.f, 0.f}, (f32x4){0.f, 0.f, 0.f, 0.f}};
#pragma unroll
            for (int k = 0; k < 4; ++k) { a[0] += fp8x4_to_f32(y[u][k].x); a[1] += fp8x4_to_f32(y[u][k].y); a[2] += fp8x4_to_f32(y[u][k].z); a[3] += fp8x4_to_f32(y[u][k].w); }
            a[0] += (f32x4){bflo(x[u][0].x), bfhi(x[u][0].x), bflo(x[u][0].y), bfhi(x[u][0].y)}; a[1] += (f32x4){bflo(x[u][0].z), bfhi(x[u][0].z), bflo(x[u][0].w), bfhi(x[u][0].w)};
            a[2] += (f32x4){bflo(x[u][1].x), bfhi(x[u][1].x), bflo(x[u][1].y), bfhi(x[u][1].y)}; a[3] += (f32x4){bflo(x[u][1].z), bfhi(x[u][1].z), bflo(x[u][1].w), bfhi(x[u][1].w)};
            GAS f32x4* o = (GAS f32x4*)(F.out + (size_t)t * D) + 4 * lane;
#pragma unroll
            for (int j = 0; j < 4; ++j) o[j] = a[j]; }
        t0 = n0; t1 = n1; w0 = nw0; w1 = nw1;
    }
}

__global__ void __launch_bounds__(NTHR, 2) mega(Args args) {
    extern __shared__ __attribute__((aligned(16))) unsigned char lds_raw[];
    Frame F;
    F.lds = (LAS unsigned char*)lds_raw;
    F.tid = threadIdx.x; F.lane = F.tid & 63; F.wave = __builtin_amdgcn_readfirstlane(F.tid >> 6); F.G = gridDim.x; F.bid = blockIdx.x;
    F.x = args.in[0]; F.meta = args.in[1]; F.n1g = args.in[2]; F.w_in = args.in[3]; F.qg = args.in[4]; F.kg = args.in[5]; F.sink = args.in[6];
    F.dw_w = args.in[7]; F.dw_b = args.in[8]; F.lng = args.in[9]; F.lnb = args.in[10]; F.w_out = args.in[11]; F.n2g = args.in[12];
    F.wr = args.in[13]; F.rb = args.in[14]; F.wgu = args.in[15]; F.bgu = args.in[16]; F.wd = args.in[17]; F.bd = args.in[18];
    F.out = args.out; F.ws = args.ws; unsigned char* ws = args.ws;
    F.ctl = (gu32*)(ws + WS_CTL);
    F.WinT = (bf16_t*)(ws + WS_WIN_T); F.WoT = (bf16_t*)(ws + WS_WO_T); F.WrT = (bf16_t*)(ws + WS_WR_T); F.WdT8 = ws + WS_WD_T; F.WguT8 = ws + WS_WGU_T; F.XN2F8 = ws + WS_XN2F8;
    F.XN = (bf16_t*)(ws + WS_XN); F.Qb = (bf16_t*)(ws + WS_Q); F.Kb = (bf16_t*)(ws + WS_K); F.VT = (bf16_t*)(ws + WS_VT); F.HC = (bf16_t*)(ws + WS_HC);
    F.MIX = (bf16_t*)(ws + WS_MIX); F.XN2 = (bf16_t*)(ws + WS_XN2); F.ACT8 = ws + WS_ACT; F.Y8 = ws + WS_Y;
    F.where = (int*)(ws + WS_WHERE); F.ltok = (int*)(ws + WS_LTOK); F.lgate = (float*)(ws + WS_LGATE); F.lrstd = (float*)(ws + WS_LRSTD);
    for (int u = F.tid; u < (LDS_BYTES - RING_BYTES) / 4; u += NTHR) ((LAS unsigned*)(F.lds + RING_BYTES))[u] = 0u;
    __syncthreads();
    const int lo = args.ph_lo, hi = args.ph_hi;
    XcdBarrier bar; bar.bar = (unsigned*)(F.ctl + CW_BAR); bar.x = 0; bar.st = nullptr;
    if (hi - lo > 1) bar = xcd_barrier_post((unsigned*)(F.ctl + CW_BAR), (volatile LAS unsigned*)(F.lds + LX_BAR));
#ifndef PH_MASK
#define PH_MASK 0xFF
#endif
#define IN(k) (((PH_MASK >> (k)) & 1) && lo <= (k) && (k) < hi)
#define SEAM(k) do { if (IN(k) && IN((k) + 1)) xcd_barrier(bar); } while (0)
#ifndef REP_PH
#define REP_PH -1
#endif
#define REPS(k) _Pragma("unroll") for (int rep = 0; rep < ((REP_PH) == (k) ? 2 : 1); ++rep)
#define REPBAR() do { if (rep) xcd_barrier(bar); } while (0)
    if (IN(0)) { REPS(0) { REPBAR(); p0_prologue(F); } } SEAM(0);
    if (IN(1)) { REPS(1) { REPBAR();
#if FAST_P1
        pg8::DenseProb<IN_W / 256> P{F.XN, F.WinT, M_PAD / 256, F.G, F.bid}; pg8::EpiIn E{F.Qb, F.Kb, F.VT, F.HC, F.qg, F.kg}; pg8::gemm_phase<2>(F.lds, P, E);
        { const int nd = p0_ndef(F.G), first_idle = P1_UNITS - F.G;
          if (nd > 0 && F.bid >= first_idle) { __syncthreads(); p0_items(F, P0_NITEMS - nd + (F.bid - first_idle) * NWAVES + F.wave, (F.G - first_idle) * NWAVES, P0_NITEMS); } }
#else
        p1_naive(F);
#endif
    } } SEAM(1);
    if (IN(2)) { REPS(2) { REPBAR();
#if FAST_ATT
        att_fast(F);
#else
        att_naive(F);
#endif
    } REPS(8) { REPBAR();
#if FAST_CONV
        conv_fast(F);
#else
        conv_naive(F);
#endif
    } } SEAM(2);
    if (IN(3)) { REPS(3) { REPBAR();
#if FAST_P3
        pg8::DenseProb<D / 256> P{F.MIX, F.WoT, M_REAL / 256, F.G, F.bid}; pg8::EpiOut E{F.x, F.out, F.XN2, F.XN2F8}; pg8::gemm_phase<2>(F.lds, P, E);
#else
        p3_naive(F);
#endif
    } } SEAM(3);
    if (IN(4)) { REPS(4) { if (rep) { xcd_barrier(bar); if (F.bid == 0 && F.tid < NE) __hip_atomic_store(F.ctl + CW_CNT + F.tid, 0u, RLX_AGENT); xcd_barrier(bar); }
#if FAST_P4
        p4_fast(F);
#else
        p4_naive(F);
#endif
    } } SEAM(4);
    if (IN(5)) { REPS(5) { REPBAR();
        build_tile_table(F); pg8::GroupedProb<true, 1, 8> P{F.XN2F8, F.WguT8, F.ltok, (const LAS int*)(F.lds + LX_TB), (const LAS int*)(F.lds + LX_CNT), F.G, F.bid};
        pg8::EpiGU E{F.ACT8, F.lrstd, F.bgu}; pg8::gemm_phase<1>(F.lds, P, E);
    } } SEAM(5);
    if (IN(6)) { REPS(6) { REPBAR();
        build_tile_table(F); pg8::GroupedProb<false, 1, 4> P{F.ACT8, F.WdT8, F.ltok, (const LAS int*)(F.lds + LX_TB), (const LAS int*)(F.lds + LX_CNT), F.G, F.bid};
        pg8::EpiDown E{F.Y8, F.lgate, F.bd}; pg8::gemm_phase<1>(F.lds, P, E);
    } } SEAM(6);
    if (IN(7)) { REPS(7) { REPBAR(); p7_combine(F); } }
#undef IN
#undef SEAM
}

extern "C" void kernel_launch(void* const* d_in, const int* in_sizes, int n_in, void* d_out, int out_size, void* d_ws, size_t ws_size, hipStream_t stream) {
    static int grid = 0;
    if (grid == 0) {
        if (n_in != 19 || in_sizes[0] != M_REAL * D || out_size != M_REAL * D || ws_size < WS_END) {
            fprintf(stderr, "kernel_launch: unexpected shapes/workspace: n_in %d in0 %d out %d ws %zu (need %zu)\n", n_in, n_in > 0 ? in_sizes[0] : -1, out_size, ws_size, (size_t)WS_END); grid = -1; return; }
        int dev = 0, cus = 0, per_cu = 0;
        if (hipGetDevice(&dev) != hipSuccess || hipDeviceGetAttribute(&cus, hipDeviceAttributeMultiprocessorCount, dev) != hipSuccess) { grid = -1; return; }
        if (hipFuncSetAttribute((const void*)mega, hipFuncAttributeMaxDynamicSharedMemorySize, LDS_BYTES) != hipSuccess) { fprintf(stderr, "kernel_launch: hipFuncSetAttribute failed\n"); grid = -1; return; }
        if (hipOccupancyMaxActiveBlocksPerMultiprocessor(&per_cu, (const void*)mega, NTHR, LDS_BYTES) != hipSuccess || per_cu < 1) { fprintf(stderr, "kernel_launch: occupancy query says %d blocks/CU\n", per_cu); (void)hipGetLastError(); grid = -1; return; }
        grid = cus;
    }
    if (grid < 0) return;
    (void)hipMemsetAsync((char*)d_ws + WS_CTL, 0, CTL_ZERO_BYTES, stream);
    Args a{};
    for (int i = 0; i < 19; ++i) a.in[i] = (const float*)d_in[i];
    a.out = (float*)d_out; a.ws = (unsigned char*)d_ws;
#if MK_PER_PHASE
    for (int p = 0; p < 8; ++p) { a.ph_lo = p; a.ph_hi = p + 1; hipLaunchKernelGGL(mega, dim3(grid), dim3(NTHR), LDS_BYTES, stream, a); }
#else
    a.ph_lo = 0; a.ph_hi = 8; hipLaunchKernelGGL(mega, dim3(grid), dim3(NTHR), LDS_BYTES, stream, a);
#endif
}
```

```cpp
#include <hip/hip_runtime.h>
#include <cstdio>
#include <cstdint>

#ifndef MK_PER_PHASE
#define MK_PER_PHASE 0
#endif
#ifndef PROBE_PH
#define PROBE_PH -1
#endif
#ifndef PROBE_SCALE
#define PROBE_SCALE 2e-5
#endif
#ifndef FAST_P1
#define FAST_P1 1
#endif
#ifndef FAST_ATT
#define FAST_ATT 1
#endif
#ifndef FAST_CONV
#define FAST_CONV 1
#endif
#ifndef FAST_P3
#define FAST_P3 1
#endif
#ifndef FAST_P4
#define FAST_P4 1
#endif
#ifndef FAST_P5
#define FAST_P5 1
#endif
#ifndef FAST_P6
#define FAST_P6 1
#endif

#define GAS __attribute__((address_space(1)))
#define LAS __attribute__((address_space(3)))
typedef unsigned short bf16_t;
typedef short bf16x8 __attribute__((ext_vector_type(8)));
typedef float f32x4 __attribute__((ext_vector_type(4)));
typedef float f32x16 __attribute__((ext_vector_type(16)));
typedef int i32x4 __attribute__((ext_vector_type(4)));
typedef int i32x8 __attribute__((ext_vector_type(8)));
typedef unsigned u32x4 __attribute__((ext_vector_type(4)));
typedef unsigned u32x2 __attribute__((ext_vector_type(2)));
typedef float f32x2 __attribute__((ext_vector_type(2)));
typedef GAS unsigned gu32;
#define RLX_AGENT __ATOMIC_RELAXED, __HIP_MEMORY_SCOPE_AGENT

constexpr int NB = 8, SEQ = 2048, D = 1024, NMETA = 16, LSEQ = NMETA + SEQ;
constexpr int M_REAL = NB * SEQ, M_ALL = NB * LSEQ, M_PAD = 16640;
constexpr int IN_W = 1792, HD = 64, NQH = 8, NKV = 2, CONV_W = 512, CONV_K = 31;
constexpr int NE = 32, CAP = 16384, ACT_ROWS = 4 * M_REAL + NE * 256;
constexpr float LOG2E = 1.4426950408889634f;
constexpr float QSCALE = 0.125f * LOG2E;
constexpr float WSCALE = 32.0f;
constexpr int VT_PITCH = LSEQ + 64;

constexpr size_t MiB = 1u << 20;
constexpr size_t WS_CTL = 0, CTL_ZERO_BYTES = 32768;
constexpr size_t WS_WIN_T = 2 * MiB;
constexpr size_t WS_WO_T = 6 * MiB;
constexpr size_t WS_WR_T = 8 * MiB;
constexpr size_t WS_RSTD = 9 * MiB;
constexpr size_t WS_WHERE = 9 * MiB + 512 * 1024;
constexpr size_t WS_LTOK = 10 * MiB;
constexpr size_t WS_LGATE = 12 * MiB;
constexpr size_t WS_LRSTD = 14 * MiB;
constexpr size_t WS_WD_T = 16 * MiB;
constexpr size_t WS_WGU_T = 80 * MiB;
constexpr size_t WS_XN = 208 * MiB;
constexpr size_t WS_Q = 241 * MiB;
constexpr size_t WS_K = 258 * MiB;
constexpr size_t WS_VT = 263 * MiB;
constexpr size_t WS_HC = 268 * MiB;
constexpr size_t WS_MIX = 285 * MiB;
constexpr size_t WS_XN2 = 317 * MiB;
constexpr size_t WS_ACT = 349 * MiB;
constexpr size_t WS_Y = 493 * MiB;
constexpr size_t WS_XN2F8 = 637 * MiB;
constexpr size_t WS_END = 653 * MiB;
constexpr int CW_CNT = 64;
constexpr int CW_BAR = 4096;

constexpr int RING_BYTES = 131072;
constexpr int LX_BAR = RING_BYTES;
constexpr int LX_TB = RING_BYTES + 64;
constexpr int LX_CNT = RING_BYTES + 256;
constexpr int LX_LCNT = RING_BYTES + 512;
constexpr int LX_GBASE = RING_BYTES + 768;
constexpr int LX_HB = RING_BYTES + 1280;
constexpr int LX_LB = RING_BYTES + 1536;
constexpr int LDS_BYTES = 147456;

constexpr int NWAVES = 8, NTHR = 512;

__device__ __forceinline__ unsigned f2bf(float f) { unsigned u = __builtin_bit_cast(unsigned, f); return (u + 0x7fffu + ((u >> 16) & 1u)) >> 16; }
__device__ __forceinline__ unsigned pk2(float lo, float hi) { return f2bf(lo) | (f2bf(hi) << 16); }
__device__ __forceinline__ unsigned pk4_fp8(float a, float b, float c, float d) { int w = __builtin_amdgcn_cvt_pk_fp8_f32(a, b, 0, false); w = __builtin_amdgcn_cvt_pk_fp8_f32(c, d, w, true); return (unsigned)w; }
__device__ __forceinline__ float bf2f(unsigned b) { return __builtin_bit_cast(float, b << 16); }
__device__ __forceinline__ float bflo(unsigned w) { return __builtin_bit_cast(float, w << 16); }
__device__ __forceinline__ float bfhi(unsigned w) { return __builtin_bit_cast(float, w & 0xffff0000u); }
__device__ __forceinline__ float wave_sum(float v) {
#pragma unroll
    for (int o = 1; o < 64; o <<= 1) v += __shfl_xor(v, o);
    return v;
}
__device__ __forceinline__ float sigmoidf_fast(float x) { return __builtin_amdgcn_rcpf(1.0f + __builtin_amdgcn_exp2f(-x * LOG2E)); }
__device__ __forceinline__ int row_of(int b, int s) { return s < NMETA ? M_REAL + b * NMETA + s : b * SEQ + (s - NMETA); }

#define XB_TMO      128
#define XB_XCNT(j)  (256  + 64 * (j))
#define XB_XSUB(j)  (1280 + 64 * (j))
#define XB_XGEN(j)  (2304 + 64 * (j))
#define XB_TOP      3328
#define XB_TOPGEN   3392
#define XCD_BAR_WORDS 3456
#define XB_SPIN_CAP (1u << 18)
__device__ __forceinline__ unsigned xb_ld(unsigned* p)              { return __hip_atomic_load(p, __ATOMIC_RELAXED, __HIP_MEMORY_SCOPE_AGENT); }
__device__ __forceinline__ unsigned xb_add(unsigned* p, unsigned v) { return __hip_atomic_fetch_add(p, v, __ATOMIC_RELAXED, __HIP_MEMORY_SCOPE_AGENT); }
__device__ __forceinline__ unsigned xb_xcc_id() { return (unsigned)__builtin_amdgcn_s_getreg((3 << 11) | 20) & 0xFu; }
#define XB_SPIN(cond, bar) do { unsigned _sp = 0; while (cond) { __builtin_amdgcn_s_sleep(1); \
    if ((++_sp & 255u) == 0u) { if (xb_ld(&(bar)[XB_TMO])) break; if (_sp > XB_SPIN_CAP) { atomicAdd(&(bar)[XB_TMO], 1u); break; } } } } while (0)
struct XcdBarrier { unsigned* bar; unsigned x; volatile LAS unsigned* st; };
__device__ __forceinline__ XcdBarrier xcd_barrier_post(unsigned* bar, volatile LAS unsigned* st) {
    XcdBarrier b; b.bar = bar; b.x = xb_xcc_id(); b.st = st;
    if (threadIdx.x == 0) (void)xb_add(&bar[XB_XCNT(b.x)], 1u);
    return b;
}
__device__ __forceinline__ void xcd_barrier_complete(unsigned* bar, unsigned x, unsigned& nloc, unsigned& nx) {
    const unsigned G = gridDim.x * gridDim.y * gridDim.z;
    unsigned sum, cnt, mine, sp = 0u;
    for (;;) {
        sum = 0u; cnt = 0u; mine = 0u;
#pragma unroll
        for (unsigned j = 0; j < 16; ++j) { const unsigned c = xb_ld(&bar[XB_XCNT(j)]); sum += c; cnt += (c > 0u) ? 1u : 0u; mine = (j == x) ? c : mine; }
        if (sum == G) break;
        __builtin_amdgcn_s_sleep(1);
        if ((++sp & 255u) == 0u) { if (xb_ld(&bar[XB_TMO])) break; if (sp > XB_SPIN_CAP) { atomicAdd(&bar[XB_TMO], 1u); break; } }
    }
    nloc = mine > 0u ? mine : 1u; nx = cnt > 0u ? cnt : 1u;
}
__device__ __forceinline__ void xcd_barrier(const XcdBarrier& b) {
    asm volatile("s_waitcnt vmcnt(0)" ::: "memory");
    __syncthreads();
    if (threadIdx.x == 0) {
        unsigned* bar = b.bar;
        __builtin_amdgcn_s_waitcnt(0);
        unsigned nloc = b.st[0], nx = b.st[1];
        if (nloc == 0u) { xcd_barrier_complete(bar, b.x, nloc, nx); b.st[0] = nloc; b.st[1] = nx; }
        const unsigned old = xb_add(&bar[XB_XSUB(b.x)], 1u);
        const unsigned gen = old / nloc;
        if (old + 1u == (gen + 1u) * nloc) {
            __builtin_amdgcn_fence(__ATOMIC_RELEASE, "agent");
            asm volatile("s_waitcnt vmcnt(0)" ::: "memory");
            const unsigned og = xb_add(&bar[XB_TOP], 1u);
            const unsigned tg = og / nx;
            if (og + 1u == (tg + 1u) * nx) xb_add(&bar[XB_TOPGEN], 1u);
            else XB_SPIN(xb_ld(&bar[XB_TOPGEN]) == tg, bar);
            __builtin_amdgcn_fence(__ATOMIC_ACQUIRE, "agent");
            xb_add(&bar[XB_XGEN(b.x)], 1u);
            asm volatile("s_waitcnt vmcnt(0)" ::: "memory");
        } else {
            XB_SPIN(xb_ld(&bar[XB_XGEN(b.x)]) == gen, bar);
            __builtin_amdgcn_fence(__ATOMIC_ACQUIRE, "agent");
            asm volatile("s_waitcnt vmcnt(0)" ::: "memory");
        }
    }
    __syncthreads();
}

struct Args { const float* in[19]; float* out; unsigned char* ws; int ph_lo, ph_hi; };
struct Frame {
    LAS unsigned char* lds;
    int tid, lane, wave, G, bid;
    const float *x, *meta, *n1g, *w_in, *qg, *kg, *sink, *dw_w, *dw_b, *lng, *lnb, *w_out, *n2g, *wr, *rb, *wgu, *bgu, *wd, *bd;
    float* out;
    unsigned char* ws;
    gu32* ctl;
    unsigned char *WguT8, *XN2F8, *WdT8, *ACT8; bf16_t *WinT, *WoT, *WrT, *XN, *Qb, *Kb, *VT, *HC, *MIX, *XN2; unsigned char* Y8;
    int* where; int* ltok; float* lgate; float* lrstd;
};

__device__ __forceinline__ int perm32(int rho) { const int n = rho >> 4, i = rho & 15; return 8 * (i >> 2) + 4 * n + (i & 3); }
__device__ __forceinline__ int lbase_nat(int pg) { return 32 * pg; }
__device__ __forceinline__ int lbase_in(int pg) { const int tile = pg >> 3, bj = (pg >> 2) & 1, wc = pg & 3; return tile <= 2 ? tile * 256 + 64 * wc + 32 * bj : 768 + bj * 512 + (tile - 3) * 128 + 32 * wc; }
__device__ __forceinline__ int lbase_gu(int pg) { const int tile = pg >> 3, bj = (pg >> 2) & 1, wc = pg & 3; return bj * 1024 + tile * 128 + 32 * wc; }
struct P0Item { const float* W; void* WT; const float* g; int N, pg, n0, k0; bool permute; bool f8; };
__device__ __forceinline__ bool p0_decode(const Frame& F, int it, P0Item& I) {
    constexpr int I_IN = 16 * 56, I_O = 16 * 32, I_R = 16, I_GU = NE * 16 * 64, I_D = NE * 16 * 32;
    int r = it;
    if (r < I_IN) { const int pg = r % 56, kb = r / 56; I = P0Item{F.w_in, F.WinT, nullptr, IN_W, pg, lbase_in(pg), 64 * kb, true, false}; return true; } r -= I_IN;
    if (r < I_O) { const int pg = r % 32, kb = r / 32; I = P0Item{F.w_out, F.WoT, nullptr, D, pg, lbase_nat(pg), 64 * kb, true, false}; return true; } r -= I_O;
    if (r < I_R) { I = P0Item{F.wr, F.WrT, F.n2g, NE, 0, 0, 64 * r, false, false}; return true; } r -= I_R;
    if (r < I_GU) { const int e = r / (16 * 64), q = r % (16 * 64), pg = q % 64, kb = q / 64; I = P0Item{F.wgu + (size_t)e * D * 2048, F.WguT8 + (size_t)e * 2048 * D, F.n2g, 2048, pg, lbase_gu(pg), 64 * kb, true, true}; return true; } r -= I_GU;
    if (r < I_D) { const int e = r / (16 * 32), q = r % (16 * 32), pg = q % 32, kb = q / 32; I = P0Item{F.wd + (size_t)e * D * D, F.WdT8 + (size_t)e * D * D, nullptr, D, pg, lbase_nat(pg), 64 * kb, true, true}; return true; }
    return false;
}
__device__ __forceinline__ void p0_load(const P0Item& I, int lane, f32x4 (&v)[8]) {
    const float* p = I.W + (size_t)(I.k0 + (lane >> 3)) * I.N + I.n0 + 4 * (lane & 7);
#pragma unroll
    for (int i = 0; i < 8; ++i) v[i] = __builtin_nontemporal_load((const f32x4*)(p + (size_t)(8 * i) * I.N));
}
__device__ __forceinline__ void p0_store(const P0Item& I, int lane, LAS float* scr, const f32x4 (&v)[8]) {
    LAS float* w = scr + (lane >> 3) * 33 + 4 * (lane & 7);
#pragma unroll
    for (int i = 0; i < 8; ++i) { w[(8 * i) * 33 + 0] = v[i][0]; w[(8 * i) * 33 + 1] = v[i][1]; w[(8 * i) * 33 + 2] = v[i][2]; w[(8 * i) * 33 + 3] = v[i][3]; }
    asm volatile("s_waitcnt lgkmcnt(0)" ::: "memory");
    const int c = lane & 7;
    f32x4 g0 = {1.f, 1.f, 1.f, 1.f}, g1 = g0;
    if (I.g) { g0 = *(const f32x4*)(I.g + I.k0 + 8 * c); g1 = *(const f32x4*)(I.g + I.k0 + 8 * c + 4); }
    if (I.f8) { g0 *= WSCALE; g1 *= WSCALE; }
#pragma unroll
    for (int j = 0; j < 4; ++j) { const int r = (lane >> 3) + 8 * j; const int sc = I.permute ? perm32(r) : r; const LAS float* s = scr + (8 * c) * 33 + sc;
        if (I.f8) { u32x2 o; o.x = pk4_fp8(s[0 * 33] * g0[0], s[1 * 33] * g0[1], s[2 * 33] * g0[2], s[3 * 33] * g0[3]); o.y = pk4_fp8(s[4 * 33] * g1[0], s[5 * 33] * g1[1], s[6 * 33] * g1[2], s[7 * 33] * g1[3]);
            *(GAS u32x2*)((unsigned char*)I.WT + (size_t)(32 * I.pg + r) * D + I.k0 + 8 * c) = o; }
        else { u32x4 o; o.x = pk2(s[0 * 33] * g0[0], s[1 * 33] * g0[1]); o.y = pk2(s[2 * 33] * g0[2], s[3 * 33] * g0[3]); o.z = pk2(s[4 * 33] * g1[0], s[5 * 33] * g1[1]); o.w = pk2(s[6 * 33] * g1[2], s[7 * 33] * g1[3]);
            *(GAS u32x4*)((bf16_t*)I.WT + (size_t)(32 * I.pg + r) * D + I.k0 + 8 * c) = o; } }
    asm volatile("s_waitcnt lgkmcnt(0)" ::: "memory");
}
constexpr int P0_NITEMS = 16 * 56 + 16 * 32 + 16 + NE * 16 * 64 + NE * 16 * 32, P0_NMOE0 = 16 * 56 + 16 * 32 + 16;
constexpr int P1_UNITS = (M_PAD / 256) * (IN_W / 256);
__device__ __forceinline__ int p0_ndef(int G) { return 0; }
__device__ __forceinline__ void p0_items(Frame& F, int first, int step, int end) {
    LAS float* scr = (LAS float*)(F.lds + F.wave * 16384);
    const int lane = F.lane;
    P0Item cur, nxt; f32x4 va[8], vb[8];
    int it = first; bool valid = it < end && p0_decode(F, it, cur);
    if (valid) p0_load(cur, lane, va);
    while (valid) {
        it += step; const bool vn = it < end && p0_decode(F, it, nxt);
        if (vn) p0_load(nxt, lane, vb);
        p0_store(cur, lane, scr, va);
        cur = nxt; valid = vn;
#pragma unroll
        for (int i = 0; i < 8; ++i) va[i] = vb[i];
    }
}
__device__ __forceinline__ void p0_prologue(Frame& F) {
    const int gw = F.bid * NWAVES + F.wave, NGW = F.G * NWAVES, lane = F.lane;
    p0_items(F, gw, NGW, P0_NMOE0);
    const GAS f32x4* gr = (const GAS f32x4*)F.n1g + lane;
    for (int m0 = 2 * gw; m0 < M_PAD; m0 += 2 * NGW) {
        f32x4 v[2][4]; float ss[2];
#pragma unroll
        for (int u = 0; u < 2; ++u) { const int m = m0 + u; ss[u] = 0.f;
            if (m < M_ALL) { const float* src = m < M_REAL ? F.x + (size_t)m * D : F.meta + (size_t)((m - M_REAL) & (NMETA - 1)) * D; const GAS f32x4* xr = (const GAS f32x4*)src + lane;
#pragma unroll
                for (int j = 0; j < 4; ++j) v[u][j] = xr[64 * j]; }
            else {
#pragma unroll
                for (int j = 0; j < 4; ++j) v[u][j] = (f32x4){0.f, 0.f, 0.f, 0.f}; } }
#pragma unroll
        for (int u = 0; u < 2; ++u) {
#pragma unroll
            for (int j = 0; j < 4; ++j) ss[u] += (v[u][j].x * v[u][j].x + v[u][j].y * v[u][j].y) + (v[u][j].z * v[u][j].z + v[u][j].w * v[u][j].w);
            const float rstd = 1.f / sqrtf(wave_sum(ss[u]) * (1.f / D) + 1e-6f);
            GAS unsigned long long* o8 = (GAS unsigned long long*)(F.XN + (size_t)(m0 + u) * D) + lane;
#pragma unroll
            for (int j = 0; j < 4; ++j) { const f32x4 g = gr[64 * j]; o8[64 * j] = (unsigned long long)pk2(v[u][j].x * rstd * g.x, v[u][j].y * rstd * g.y) | ((unsigned long long)pk2(v[u][j].z * rstd * g.z, v[u][j].w * rstd * g.w) << 32); }
        }
    }
}

namespace pg8 {
constexpr int BM = 256, BK = 64, HALF = 128, HTB = HALF * BK * 2, STAGE_BYTES = 8 * HTB, NXCD = 8, WGM = 8, KD = 1024;
__device__ __forceinline__ int lds_byte(int r, int c) { const int st = (r >> 4) * 2 + (c >> 5), rr = r & 15, cc = c & 31, ob = rr * 64 + cc * 2; return st * 1024 + (ob ^ (((ob >> 9) & 1) << 5)); }
__device__ __forceinline__ void stage_rc(int b, int& R, int& C) { const int st = b / 1024, sb = b % 1024, swz = sb ^ (((sb >> 9) & 1) << 5); R = (st >> 1) * 16 + swz / 64; C = (st & 1) * 32 + (swz % 64) / 2; }
struct Unit { int pm, pn, e, slot0, nvalid, r0; };
__device__ __forceinline__ unsigned cvt_pk_bf16(float lo, float hi) { unsigned r; asm volatile("v_cvt_pk_bf16_f32 %0, %1, %2" : "=v"(r) : "v"(lo), "v"(hi)); return r; }
__device__ __forceinline__ u32x4 pack8(const f32x4 a, const f32x4 b) { u32x4 w; w.x = cvt_pk_bf16(a[0], a[1]); w.y = cvt_pk_bf16(a[2], a[3]); w.z = cvt_pk_bf16(b[0], b[1]); w.w = cvt_pk_bf16(b[2], b[3]); return w; }

template <bool HALVES, int nN>
__device__ __forceinline__ bool tile_order(int i, int G, int c, int nM, int& pm, int& pn, int& half) {
    const int nwg = nM * nN; int L = i * G + c; half = -1;
    if (HALVES) { const int nfull = ((G & (G - 1)) == 0) ? (nwg & ~(G - 1)) : (nwg / G) * G, left = nwg - nfull;
        if (left > 0 && 2 * left <= G && L >= nfull) { const int hidx = L - nfull; if (hidx >= 2 * left) return false; L = nfull + (hidx >> 1); half = hidx & 1; } }
    if (L >= nwg) return false;
    int wgid = L; { const int q = nwg >> 3, r = nwg & 7, xcd = wgid & 7, off = wgid >> 3; wgid = (xcd < r ? xcd * (q + 1) : r * (q + 1) + (xcd - r) * q) + off; }
    constexpr int nig = WGM * nN; const int gid = wgid / nig, rem = wgid - gid * nig, fm = gid * WGM, gsz = (nM - fm) < WGM ? (nM - fm) : WGM;
    if (gsz == WGM) { pm = fm + (rem & (WGM - 1)); pn = rem >> 3; } else { pm = fm + rem % gsz; pn = rem / gsz; }
    return true;
}
template <int nN> struct DenseProb {
    static constexpr int RB = KD * 2;
    const bf16_t* A; const bf16_t* Bt; int nM, G, c;
    __device__ __forceinline__ bool next(int i, Unit& u) const { u.e = 0; u.slot0 = 0; u.nvalid = 256; u.r0 = 0; int half; return tile_order<false, nN>(i, G, c, nM, u.pm, u.pn, half); }
    __device__ __forceinline__ void addr_load(const Unit&, const int (&)[2], int (&)[4]) const {}
    __device__ __forceinline__ void addr_finish(const Unit& u, const int (&R)[2], const int (&C)[2], const int (&)[4], const char*& a, const char*& b, unsigned (&va0)[2], unsigned (&va1)[2]) const {
        a = (const char*)A + (size_t)u.pm * (BM * RB); b = (const char*)Bt + (size_t)u.pn * (BM * RB);
#pragma unroll
        for (int i = 0; i < 2; ++i) { va0[i] = (unsigned)(R[i] * RB + C[i] * 2); va1[i] = va0[i] + (unsigned)(HALF * RB); }
    }
};
template <bool GATHER, int ES, int nN> struct GroupedProb {
    static constexpr int RB = KD * ES;
    const void* A; const void* Bt; const int* ltok; const LAS int* tb; const LAS int* cn; int G, c;
    __device__ __forceinline__ bool next(int i, Unit& u) const {
        const LAS int* hb = tb + (LX_HB - LX_TB) / 4; const LAS int* lb = tb + (LX_LB - LX_TB) / 4;
        const int H = __builtin_amdgcn_readfirstlane(hb[NE]), Lt = __builtin_amdgcn_readfirstlane(lb[NE]), HU = H * nN, LU = Lt * nN;
        const int L = i * G + c, nfull = ((G & (G - 1)) == 0) ? (HU & ~(G - 1)) : (HU / G) * G, r = HU - nfull;
        const bool tail_half = r > 0 && 2 * r + LU <= G;
        int half = -1, idx; bool light = false;
        if (L < nfull) idx = L;
        else { const int Lp = L - nfull;
            if (tail_half) { if (Lp < 2 * r) { idx = nfull + (Lp >> 1); half = Lp & 1; } else { light = true; idx = Lp - 2 * r; } }
            else { if (Lp < r) idx = nfull + Lp; else { light = true; idx = Lp - r; } } }
        const int j = (int)(threadIdx.x & 31); int e;
        if (light) { if (idx >= LU) return false; const int le = idx / nN; u.pn = idx % nN;
            const unsigned long long hit = __ballot(lb[j] == le && lb[j + 1] == le + 1); e = __builtin_amdgcn_readfirstlane((int)__builtin_ctzll(hit | (1ull << 63)) & 31);
            u.pm = __builtin_amdgcn_readfirstlane(tb[e + 1]) - 1;
        } else { int wgid = idx; { const int q = HU >> 3, rr = HU & 7, xcd = wgid & 7, off = wgid >> 3; wgid = (xcd < rr ? xcd * (q + 1) : rr * (q + 1) + (xcd - rr) * q) + off; }
            constexpr int nig = WGM * nN; const int gid = wgid / nig, rem = wgid - gid * nig, fm = gid * WGM, gsz = (H - fm) < WGM ? (H - fm) : WGM; int ht;
            if (gsz == WGM) { ht = fm + (rem & (WGM - 1)); u.pn = rem >> 3; } else { ht = fm + rem % gsz; u.pn = rem / gsz; }
            const unsigned long long hit = __ballot(hb[j] <= ht && ht < hb[j + 1]); e = __builtin_amdgcn_readfirstlane((int)__builtin_ctzll(hit | (1ull << 63)) & 31);
            u.pm = __builtin_amdgcn_readfirstlane(tb[e]) + (ht - __builtin_amdgcn_readfirstlane(hb[e])); }
        const int t0 = __builtin_amdgcn_readfirstlane(tb[e]), ce = __builtin_amdgcn_readfirstlane(cn[e]);
        u.e = e; u.r0 = half == 1 ? HALF : 0; u.slot0 = (u.pm - t0) * 256 + u.r0; int rem2 = ce - u.slot0; const int lim = half >= 0 ? HALF : 256; rem2 = rem2 < lim ? rem2 : lim; u.nvalid = rem2 < 0 ? 0 : rem2; return true;
    }
    __device__ __forceinline__ void addr_load(const Unit& u, const int (&R)[2], int (&raw)[4]) const {
        if (GATHER) { const int* lt = ltok + u.e * CAP + u.slot0;
#pragma unroll
            for (int i = 0; i < 2; ++i) { const int r0 = R[i], r1 = R[i] + HALF; raw[2 * i] = r0 < u.nvalid ? lt[r0] : 0; raw[2 * i + 1] = r1 < u.nvalid ? lt[r1] : 0; } }
    }
    __device__ __forceinline__ void addr_finish(const Unit& u, const int (&R)[2], const int (&C)[2], const int (&raw)[4], const char*& a, const char*& b, unsigned (&va0)[2], unsigned (&va1)[2]) const {
        b = (const char*)Bt + ((size_t)u.e * nN + u.pn) * (BM * RB);
        if (GATHER) { a = (const char*)A;
#pragma unroll
            for (int i = 0; i < 2; ++i) { va0[i] = (unsigned)(raw[2 * i] * RB + C[i] * 2); va1[i] = (unsigned)(raw[2 * i + 1] * RB + C[i] * 2); }
        } else { a = (const char*)A + (size_t)(u.pm * BM + u.r0) * RB;
#pragma unroll
            for (int i = 0; i < 2; ++i) { va0[i] = (unsigned)(R[i] * RB + C[i] * 2); va1[i] = va0[i] + (unsigned)(HALF * RB); }
        }
    }
};

template <int ES  , class Prob, class Epi>
__device__ __forceinline__ void gemm_phase(LAS unsigned char* lds, const Prob& P, const Epi& E) {
    const int tid = threadIdx.x, wid = __builtin_amdgcn_readfirstlane(tid >> 6), lane = tid & 63, wr = wid >> 2, wc = wid & 3, fr = lane & 15, fq = lane >> 4;
    constexpr int RB = KD * ES, nt = RB / (BK * 2);
    int R[2], C[2]; unsigned voffB[2];
#pragma unroll
    for (int i = 0; i < 2; ++i) { stage_rc(tid * 16 + i * 8192, R[i], C[i]); voffB[i] = (unsigned)(R[i] * RB + C[i] * 2); }
    constexpr size_t kstep = (size_t)(BK * 2);
    constexpr size_t hstep = (size_t)HALF * RB;
    const unsigned ldsw = (unsigned)wid * 1024u;
    const int aoff = lds_byte(wr * 64 + fr, fq * 8), boff = lds_byte(wc * 32 + fr, fq * 8);
#define PG8_SA(b, h) (((b) * 2 + (h)) * HTB)
#define PG8_SB(b, h) ((4 + (b) * 2 + (h)) * HTB)
#define PG8_STAGE(bufoff, gbase, voff) do { _Pragma("unroll") for (int _i = 0; _i < 2; ++_i) \
        __builtin_amdgcn_global_load_lds((const unsigned*)((const char*)(gbase) + (voff)[_i]), (LAS unsigned*)(lds + (bufoff) + ldsw + _i * 8192), 16, 0, 0); } while (0)
#define PG8_LDA(dst, b, h) do { _Pragma("unroll") for (int m = 0; m < 4; ++m) { \
        if constexpr (ES == 2) { _Pragma("unroll") for (int k = 0; k < 2; ++k) dst[m][k] = *(const LAS bf16x8*)(lds + PG8_SA(b, h) + aoff + m * 2048 + k * 1024); } \
        else { const i32x4 lo_ = *(const LAS i32x4*)(lds + PG8_SA(b, h) + aoff + m * 2048), hi_ = *(const LAS i32x4*)(lds + PG8_SA(b, h) + aoff + m * 2048 + 1024); dst##8[m] = __builtin_shufflevector(lo_, hi_, 0, 1, 2, 3, 4, 5, 6, 7); } } } while (0)
#define PG8_LDB(dst, b, h) do { _Pragma("unroll") for (int n = 0; n < 2; ++n) { \
        if constexpr (ES == 2) { _Pragma("unroll") for (int k = 0; k < 2; ++k) dst[n][k] = *(const LAS bf16x8*)(lds + PG8_SB(b, h) + boff + n * 2048 + k * 1024); } \
        else { const i32x4 lo_ = *(const LAS i32x4*)(lds + PG8_SB(b, h) + boff + n * 2048), hi_ = *(const LAS i32x4*)(lds + PG8_SB(b, h) + boff + n * 2048 + 1024); dst##8[n] = __builtin_shufflevector(lo_, hi_, 0, 1, 2, 3, 4, 5, 6, 7); } } } while (0)
#define PG8_MMA(ai, bj, At, Bt) do { __builtin_amdgcn_s_setprio(1); _Pragma("unroll") for (int m = 0; m < 4; ++m) _Pragma("unroll") for (int n = 0; n < 2; ++n) { \
        if constexpr (ES == 2) { _Pragma("unroll") for (int k = 0; k < 2; ++k) acc[ai][bj][m][n] = __builtin_amdgcn_mfma_f32_16x16x32_bf16(Bt[n][k], At[m][k], acc[ai][bj][m][n], 0, 0, 0); } \
        else asm volatile("s_nop 1\n\tv_mfma_scale_f32_16x16x128_f8f6f4 %0, %1, %2, %0, %3, %3 op_sel_hi:[0,0,0]" : "+v"(acc[ai][bj][m][n]) : "v"(Bt##8[n]), "v"(At##8[m]), "v"(sc127)); } \
        __builtin_amdgcn_s_setprio(0); } while (0)
#define PG8_WAIT_V(n) asm volatile("s_waitcnt vmcnt(" #n ")" ::: "memory")
#define PG8_WAIT_L(n) do { asm volatile("s_waitcnt lgkmcnt(" #n ")" ::: "memory"); __builtin_amdgcn_s_waitcnt(0xC07F); } while (0)
#define PG8_BAR __builtin_amdgcn_s_barrier()
#define PG8_SCHED __builtin_amdgcn_sched_barrier(0)
    Unit cur, nxt, nn; int ui = 0; int raw[4] = {0, 0, 0, 0};
    if (!P.next(0, cur)) return;
    bool has_next = P.next(1, nxt);
    const char *cA, *cB, *nA, *nB; unsigned va0[2], va1[2], nva0[2], nva1[2];
    P.addr_load(cur, R, raw); P.addr_finish(cur, R, C, raw, cA, cB, va0, va1);
    if (has_next) { P.addr_load(nxt, R, raw); P.addr_finish(nxt, R, C, raw, nA, nB, nva0, nva1); }
    else { nA = cA; nB = cB; nva0[0] = va0[0]; nva0[1] = va0[1]; nva1[0] = va1[0]; nva1[1] = va1[1]; }
    f32x4 acc[2][2][4][2];
#pragma unroll
    for (int a = 0; a < 2; ++a)
#pragma unroll
        for (int b = 0; b < 2; ++b)
#pragma unroll
            for (int m = 0; m < 4; ++m)
#pragma unroll
                for (int n = 0; n < 2; ++n) acc[a][b][m][n] = (f32x4){0.f, 0.f, 0.f, 0.f};
    const int sc127 = 0x7F7F7F7F;
    bf16x8 At[4][2], B0[2][2], B1[2][2]; i32x8 At8[4], B08[2], B18[2];
    PG8_STAGE(PG8_SB(0, 0), cB, voffB); PG8_STAGE(PG8_SB(0, 1), cB + hstep, voffB); PG8_STAGE(PG8_SA(0, 0), cA, va0); PG8_STAGE(PG8_SA(0, 1), cA, va1);
    if (wr == 1) PG8_BAR;
    PG8_WAIT_V(2); PG8_BAR;
    PG8_STAGE(PG8_SB(1, 0), cB + kstep, voffB); PG8_STAGE(PG8_SA(1, 0), cA + kstep, va0); PG8_STAGE(PG8_SB(1, 1), cB + hstep + kstep, voffB);
    PG8_WAIT_V(6); PG8_BAR;
    for (;;) {
        const bool full = cur.nvalid > HALF;
#pragma unroll 1
        for (int t = 0; t < nt; t += 2) {
            const bool last = (t == nt - 2);
            const char* a1 = cA + (size_t)(t + 1) * kstep;
            const char* a2 = last ? nA : cA + (size_t)(t + 2) * kstep; const char* b2 = last ? nB : cB + (size_t)(t + 2) * kstep;
            const char* a3 = a2 + kstep; const char* b3 = b2 + kstep;
            unsigned v2a0[2], v2a1[2];
            v2a0[0] = last ? nva0[0] : va0[0]; v2a0[1] = last ? nva0[1] : va0[1]; v2a1[0] = last ? nva1[0] : va1[0]; v2a1[1] = last ? nva1[1] : va1[1];
            PG8_LDB(B0, 0, 0); PG8_LDB(B1, 0, 1); PG8_SCHED; PG8_LDA(At, 0, 0); PG8_STAGE(PG8_SA(1, 1), a1, va1);
            PG8_WAIT_V(8); PG8_WAIT_L(0); PG8_BAR; PG8_MMA(0, 0, At, B0); PG8_MMA(0, 1, At, B1); PG8_BAR; PG8_SCHED;
            PG8_LDA(At, 0, 1); PG8_STAGE(PG8_SB(0, 0), b2, voffB); PG8_STAGE(PG8_SB(0, 1), b2 + hstep, voffB); PG8_STAGE(PG8_SA(0, 0), a2, v2a0);
            PG8_WAIT_V(8); PG8_WAIT_L(0); PG8_BAR; if (full) { PG8_MMA(1, 0, At, B0); PG8_MMA(1, 1, At, B1); } PG8_BAR; PG8_SCHED;
            PG8_LDB(B0, 1, 0); PG8_LDB(B1, 1, 1); PG8_SCHED; PG8_LDA(At, 1, 0); PG8_STAGE(PG8_SA(0, 1), a2, v2a1);
            PG8_WAIT_V(8); PG8_WAIT_L(0); PG8_BAR; PG8_MMA(0, 0, At, B0); PG8_MMA(0, 1, At, B1); PG8_BAR; PG8_SCHED;
            PG8_LDA(At, 1, 1); PG8_STAGE(PG8_SB(1, 0), b3, voffB); PG8_STAGE(PG8_SB(1, 1), b3 + hstep, voffB); PG8_STAGE(PG8_SA(1, 0), a3, v2a0);
            PG8_WAIT_V(8); PG8_WAIT_L(0); PG8_BAR; if (full) { PG8_MMA(1, 0, At, B0); PG8_MMA(1, 1, At, B1); } PG8_BAR; PG8_SCHED;
        }
        if constexpr (ES == 1) { asm volatile("s_nop 15\n\ts_nop 15" ::: "memory"); __builtin_amdgcn_sched_barrier(0); }
        const bool has_nn = has_next && P.next(ui + 2, nn);
        if (has_nn) P.addr_load(nn, R, raw);
        if (wr == 0) PG8_BAR;
        E(acc, cur, wr, wc, fr, fq);
        if (!has_next) break;
#pragma unroll
        for (int a = 0; a < 2; ++a)
#pragma unroll
            for (int b = 0; b < 2; ++b)
#pragma unroll
                for (int m = 0; m < 4; ++m)
#pragma unroll
                    for (int n = 0; n < 2; ++n) acc[a][b][m][n] = (f32x4){0.f, 0.f, 0.f, 0.f};
        cur = nxt; cA = nA; cB = nB; va0[0] = nva0[0]; va0[1] = nva0[1]; va1[0] = nva1[0]; va1[1] = nva1[1]; ++ui;
        nxt = nn; has_next = has_nn;
        if (has_next) P.addr_finish(nxt, R, C, raw, nA, nB, nva0, nva1);
        if (wr == 1) PG8_BAR;
    }
    PG8_WAIT_V(0);
    PG8_BAR;
#undef PG8_SA
#undef PG8_SB
#undef PG8_STAGE
#undef PG8_LDA
#undef PG8_LDB
#undef PG8_MMA
#undef PG8_WAIT_V
#undef PG8_WAIT_L
#undef PG8_BAR
#undef PG8_SCHED
}

struct EpiOut {
    const float* x; float* out; bf16_t* xn2; unsigned char* xn2f8;
    __device__ __forceinline__ void operator()(const f32x4 (&acc)[2][2][4][2], const Unit& u, int wr, int wc, int fr, int fq) const {
        const int row0 = u.pm * BM + wr * 64 + fr, col0 = u.pn * BM + wc * 32 + 8 * fq;
#pragma unroll
        for (int ai = 0; ai < 2; ++ai)
#pragma unroll
            for (int m = 0; m < 4; ++m) { const size_t off = (size_t)(row0 + ai * HALF + m * 16) * D + col0;
#pragma unroll
                for (int bj = 0; bj < 2; ++bj) { const float* xp = x + off + bj * HALF;
                    const f32x4 h0 = acc[ai][bj][m][0] + *(const f32x4*)xp, h1 = acc[ai][bj][m][1] + *(const f32x4*)(xp + 4);
                    *(u32x4*)(xn2 + off + bj * HALF) = pack8(h0, h1);
                    *(u32x2*)(xn2f8 + off + bj * HALF) = (u32x2){pk4_fp8(h0[0], h0[1], h0[2], h0[3]), pk4_fp8(h1[0], h1[1], h1[2], h1[3])}; }
                asm volatile("" ::: "memory"); }
    }
};
struct EpiIn {
    bf16_t *Qb, *Kb, *VT, *HC; const float *qg, *kg;
    __device__ __forceinline__ void operator()(const f32x4 (&acc)[2][2][4][2], const Unit& u, int wr, int wc, int fr, int fq) const {
        const int rowb = u.pm * BM + wr * 64 + fr;
        if (u.pn <= 2) {
            const bool isv = (u.pn == 2) && (wc >= 2);
            if (!isv) {
                const bool isq = u.pn < 2; const float* g = isq ? qg : kg; const float sc = isq ? QSCALE : 1.f;
                f32x4 gv[2][2];
#pragma unroll
                for (int bj = 0; bj < 2; ++bj)
#pragma unroll
                    for (int n = 0; n < 2; ++n) gv[bj][n] = *(const f32x4*)(g + 32 * bj + 8 * fq + 4 * n) * sc;
                bf16_t* dst = isq ? Qb + (u.pn * 256 + 64 * wc) : Kb + 64 * wc; const int ld = isq ? 512 : 128;
#pragma unroll
                for (int ai = 0; ai < 2; ++ai)
#pragma unroll
                    for (int m = 0; m < 4; ++m) { const int row = rowb + ai * HALF + m * 16; float ss = 0.f;
#pragma unroll
                        for (int bj = 0; bj < 2; ++bj)
#pragma unroll
                            for (int n = 0; n < 2; ++n) { const f32x4 v = acc[ai][bj][m][n]; ss += (v[0] * v[0] + v[1] * v[1]) + (v[2] * v[2] + v[3] * v[3]); }
                        ss += __shfl_xor(ss, 16); ss += __shfl_xor(ss, 32);
                        const float r = __builtin_amdgcn_rsqf(ss * (1.f / 64.f) + 1e-6f);
#pragma unroll
                        for (int bj = 0; bj < 2; ++bj) *(u32x4*)(dst + (size_t)row * ld + 32 * bj + 8 * fq) = pack8(acc[ai][bj][m][0] * r * gv[bj][0], acc[ai][bj][m][1] * r * gv[bj][1]); }
            } else {
                const int hk = wc - 2;
#pragma unroll
                for (int ai = 0; ai < 2; ++ai)
#pragma unroll
                    for (int m = 0; m < 4; ++m) { const int row = rowb + ai * HALF + m * 16;
                        if (row < M_ALL) { int b, kx; if (row < M_REAL) { b = row >> 11; kx = NMETA + (row & 2047); } else { b = (row - M_REAL) >> 4; kx = (row - M_REAL) & 15; }
                            bf16_t* base = VT + (size_t)(b * 2 + hk) * 64 * VT_PITCH + kx;
#pragma unroll
                            for (int bj = 0; bj < 2; ++bj)
#pragma unroll
                                for (int n = 0; n < 2; ++n)
#pragma unroll
                                    for (int e = 0; e < 4; ++e) base[(size_t)(32 * bj + 8 * fq + 4 * n + e) * VT_PITCH] = (bf16_t)f2bf(acc[ai][bj][m][n][e]); } }
            }
        } else {
            const int col = (u.pn - 3) * 128 + 32 * wc + 8 * fq;
#pragma unroll
            for (int ai = 0; ai < 2; ++ai)
#pragma unroll
                for (int m = 0; m < 4; ++m) { const int row = rowb + ai * HALF + m * 16; f32x4 h[2];
#pragma unroll
                    for (int n = 0; n < 2; ++n)
#pragma unroll
                        for (int e = 0; e < 4; ++e) h[n][e] = acc[ai][0][m][n][e] * sigmoidf_fast(acc[ai][1][m][n][e]);
                    *(u32x4*)(HC + (size_t)row * 512 + col) = pack8(h[0], h[1]); }
        }
    }
};
struct EpiGU {
    unsigned char* ACT; const float* lrstd; const float* bgu;
    __device__ __forceinline__ void operator()(const f32x4 (&acc)[2][2][4][2], const Unit& u, int wr, int wc, int fr, int fq) const {
        const int lr0 = wr * 64 + fr, col = u.pn * 128 + 32 * wc + 8 * fq;
        f32x2 bg[2][2], bu[2][2];
#pragma unroll
        for (int n = 0; n < 2; ++n) { const f32x4 g4 = *(const f32x4*)(bgu + u.e * 2048 + col + 4 * n), u4 = *(const f32x4*)(bgu + u.e * 2048 + 1024 + col + 4 * n);
            bg[n][0] = (f32x2){g4[0], g4[1]}; bg[n][1] = (f32x2){g4[2], g4[3]}; bu[n][0] = (f32x2){u4[0], u4[1]}; bu[n][1] = (f32x2){u4[2], u4[3]}; }
        const float* rs = lrstd + u.e * CAP + u.slot0;
#pragma unroll
        for (int ai = 0; ai < 2; ++ai) {
            if (ai == 1 && u.nvalid <= HALF) break;
#pragma unroll
            for (int m = 0; m < 4; ++m) { const int lr = lr0 + ai * HALF + m * 16; const float rstd = lr < u.nvalid ? rs[lr] * (1.f / WSCALE) : 0.f; f32x2 h[2][2];
#pragma unroll
                for (int n = 0; n < 2; ++n)
#pragma unroll
                    for (int p = 0; p < 2; ++p) {
                        f32x2 gt = (f32x2){acc[ai][0][m][n][2 * p], acc[ai][0][m][n][2 * p + 1]} * rstd + bg[n][p];
                        f32x2 up = (f32x2){acc[ai][1][m][n][2 * p], acc[ai][1][m][n][2 * p + 1]} * rstd + bu[n][p];
                        gt.x = fminf(gt.x, 7.f); gt.y = fminf(gt.y, 7.f); up.x = __builtin_amdgcn_fmed3f(up.x, -7.f, 7.f); up.y = __builtin_amdgcn_fmed3f(up.y, -7.f, 7.f);
                        const f32x2 z = gt * (-1.702f * LOG2E); f32x2 ex; ex.x = __builtin_amdgcn_exp2f(z.x); ex.y = __builtin_amdgcn_exp2f(z.y);
                        const f32x2 dn = ex + 1.0f; f32x2 rc; rc.x = __builtin_amdgcn_rcpf(dn.x); rc.y = __builtin_amdgcn_rcpf(dn.y);
                        const f32x2 t = gt * rc; h[n][p] = t * up + t; }
                *(u32x2*)(ACT + (size_t)(u.pm * BM + u.r0 + lr) * D + col) = (u32x2){pk4_fp8(h[0][0].x, h[0][0].y, h[0][1].x, h[0][1].y), pk4_fp8(h[1][0].x, h[1][0].y, h[1][1].x, h[1][1].y)}; }
        }
    }
};
struct EpiDown {
    unsigned char* Y; const float* lgate; const float* bd;
    __device__ __forceinline__ void operator()(const f32x4 (&acc)[2][2][4][2], const Unit& u, int wr, int wc, int fr, int fq) const {
        const int lr0 = wr * 64 + fr, col0 = u.pn * BM + wc * 32 + 8 * fq;
        f32x4 bv[2][2];
#pragma unroll
        for (int bj = 0; bj < 2; ++bj)
#pragma unroll
            for (int n = 0; n < 2; ++n) bv[bj][n] = *(const f32x4*)(bd + u.e * D + col0 + bj * HALF + 4 * n);
        const float* gs = lgate + u.e * CAP + u.slot0;
#pragma unroll
        for (int ai = 0; ai < 2; ++ai)
#pragma unroll
            for (int m = 0; m < 4; ++m) { if (ai == 1 && u.nvalid <= HALF) continue; const int lr = lr0 + ai * HALF + m * 16; const float gt = lr < u.nvalid ? gs[lr] : 0.f;
#pragma unroll
                for (int bj = 0; bj < 2; ++bj) { const f32x4 y0 = (acc[ai][bj][m][0] * (1.f / WSCALE) + bv[bj][0]) * gt, y1 = (acc[ai][bj][m][1] * (1.f / WSCALE) + bv[bj][1]) * gt;
                    *(u32x2*)(Y + (size_t)(u.pm * BM + u.r0 + lr) * D + col0 + bj * HALF) = (u32x2){pk4_fp8(y0[0], y0[1], y0[2], y0[3]), pk4_fp8(y1[0], y1[1], y1[2], y1[3])}; } }
    }
};
}


constexpr int ATT_KIMG = 0, ATT_VIMG = 53248, ATT_VP = 840;
constexpr float ATT_THR = 4.0f;
struct AttHead { float m, l, slope2; f32x16 O0, O1; };
template <int MODE>
__device__ __forceinline__ void att_softmax(f32x16& s, AttHead& H, float Bq, float lim, bf16x8 (&pf)[2]) {
    float tmax = -INFINITY;
#pragma unroll
    for (int r = 0; r < 16; ++r) {
        if (MODE == 0) { if (r >= 8) s[r] = -INFINITY; }
        else { const float dl = fabsf(Bq - (float)((r & 3) + 8 * (r >> 2))); const float v = s[r] - H.slope2 * dl; s[r] = dl <= lim ? v : -INFINITY; }
        tmax = fmaxf(tmax, s[r]);
    }
    tmax = fmaxf(tmax, __shfl_xor(tmax, 32));
    if (__any(tmax > H.m + ATT_THR)) { const float mn = fmaxf(H.m, tmax); const float al = __builtin_amdgcn_exp2f(H.m - mn); H.m = mn; H.l *= al;
#pragma unroll
        for (int r = 0; r < 16; ++r) { H.O0[r] *= al; H.O1[r] *= al; } }
    float ps = 0.f;
#pragma unroll
    for (int r = 0; r < 16; ++r) { s[r] = __builtin_amdgcn_exp2f(s[r] - H.m); ps += s[r]; }
    H.l += ps;
#pragma unroll
    for (int s2 = 0; s2 < 2; ++s2) { u32x4 pw; pw.x = pg8::cvt_pk_bf16(s[8 * s2 + 0], s[8 * s2 + 1]); pw.y = pg8::cvt_pk_bf16(s[8 * s2 + 2], s[8 * s2 + 3]); pw.z = pg8::cvt_pk_bf16(s[8 * s2 + 4], s[8 * s2 + 5]); pw.w = pg8::cvt_pk_bf16(s[8 * s2 + 6], s[8 * s2 + 7]);
        pf[s2] = __builtin_bit_cast(bf16x8, pw); }
}
template <int MODE>
__device__ __forceinline__ void att_tile2(const LAS unsigned char* kbase, const int (&koff)[4], const LAS unsigned char* vbase, const bf16x8 (&qa)[4], const bf16x8 (&qb)[4], float Bq, float lim, AttHead& A, AttHead& B) {
    f32x16 sa, sb;
#pragma unroll
    for (int r = 0; r < 16; ++r) { sa[r] = 0.f; sb[r] = 0.f; }
#pragma unroll
    for (int ks = 0; ks < 4; ++ks) { const bf16x8 kf = *(const LAS bf16x8*)(kbase + koff[ks]);
        sa = __builtin_amdgcn_mfma_f32_32x32x16_bf16(kf, qa[ks], sa, 0, 0, 0); sb = __builtin_amdgcn_mfma_f32_32x32x16_bf16(kf, qb[ks], sb, 0, 0, 0); }
    bf16x8 pa[2], pb[2];
    att_softmax<MODE>(sa, A, Bq, lim, pa);
    att_softmax<MODE>(sb, B, Bq, lim, pb);
#pragma unroll
    for (int s2 = 0; s2 < 2; ++s2) {
        { const u32x2 lo = *(const LAS u32x2*)(vbase + s2 * 32), hi = *(const LAS u32x2*)(vbase + s2 * 32 + 16); const bf16x8 vf = __builtin_bit_cast(bf16x8, (u32x4){lo.x, lo.y, hi.x, hi.y});
          A.O0 = __builtin_amdgcn_mfma_f32_32x32x16_bf16(vf, pa[s2], A.O0, 0, 0, 0); B.O0 = __builtin_amdgcn_mfma_f32_32x32x16_bf16(vf, pb[s2], B.O0, 0, 0, 0); }
        { const u32x2 lo = *(const LAS u32x2*)(vbase + 32 * ATT_VP + s2 * 32), hi = *(const LAS u32x2*)(vbase + 32 * ATT_VP + s2 * 32 + 16); const bf16x8 vf = __builtin_bit_cast(bf16x8, (u32x4){lo.x, lo.y, hi.x, hi.y});
          A.O1 = __builtin_amdgcn_mfma_f32_32x32x16_bf16(vf, pa[s2], A.O1, 0, 0, 0); B.O1 = __builtin_amdgcn_mfma_f32_32x32x16_bf16(vf, pb[s2], B.O1, 0, 0, 0); }
    }
}
__device__ __forceinline__ void att_fast(Frame& F) {
    LAS unsigned char* Kimg = F.lds + ATT_KIMG; LAS unsigned char* Vimg = F.lds + ATT_VIMG;
    const int tid = F.tid, lane = F.lane, wid = F.wave, q = lane & 31, h = lane >> 5, qt = wid & 3, hsel = wid >> 2;
    int koff[4];
#pragma unroll
    for (int ks = 0; ks < 4; ++ks) koff[ks] = ((2 * ks + h) ^ ((q >> 1) & 7)) << 4;
    const int vb = (F.G & 7) == 0 ? (F.bid & 7) * (F.G >> 3) + (F.bid >> 3) : F.bid;
    for (int item = vb; item < NB * 16 * 2; item += F.G) {
        const int hk = item & 1, i = (item >> 1) & 15, b = item >> 5;
        const int row = b * SEQ + i * 128 + 32 * qt + q;
        bf16x8 qf[2][4];
#pragma unroll
        for (int hp = 0; hp < 2; ++hp)
#pragma unroll
            for (int ks = 0; ks < 4; ++ks) qf[hp][ks] = *(const GAS bf16x8*)(F.Qb + (size_t)row * 512 + (hk * 4 + hp * 2 + hsel) * 64 + 16 * ks + 8 * h);
        __syncthreads();
        {
            const int c8 = tid & 7, r64 = tid >> 3; u32x4 kv[7], vv[7];
            const bf16_t* vrow = F.VT + (size_t)((b * 2 + hk) * 64 + r64) * VT_PITCH;
#pragma unroll
            for (int it = 0; it < 7; ++it) { const int kr = r64 + 64 * it; int pos = (i - 1) * 128 + kr - 32; pos = pos < 0 ? 0 : (pos >= SEQ ? SEQ - 1 : pos);
                const int row = kr < 16 ? M_REAL + b * NMETA + kr : b * SEQ + pos;
                kv[it] = *(const GAS u32x4*)(F.Kb + (size_t)row * 128 + hk * 64 + 8 * c8); }
#pragma unroll
            for (int it = 0; it < 7; ++it) { const int c = c8 + 8 * it, cc = c - 4, blk = cc >> 4, w = cc & 15, pos0 = (i - 1 + blk) * 128; const bool inr = c >= 4 && c < 52 && pos0 >= 0 && pos0 < SEQ;
                const bf16_t* src = inr ? vrow + NMETA + pos0 + 8 * w : vrow + 8 * (c & 1);
                vv[it] = *(const GAS u32x4*)src; }
#pragma unroll
            for (int it = 0; it < 7; ++it) { const int kr = r64 + 64 * it; if (kr < 416) *(LAS u32x4*)(Kimg + kr * 128 + ((c8 ^ ((kr >> 1) & 7)) << 4)) = kv[it]; }
#pragma unroll
            for (int it = 0; it < 7; ++it) { const int c = c8 + 8 * it; if (c < 52) { const int cc = c - 4; const int koffs = c < 4 ? 8 * c : 32 + 8 * cc;
                    u32x4 v = vv[it]; if (c >= 2 && c < 4) v = (u32x4){0u, 0u, 0u, 0u};
                    LAS u32x2* dst = (LAS u32x2*)(Vimg + r64 * ATT_VP + koffs * 2); dst[0] = (u32x2){v.x, v.y}; dst[1] = (u32x2){v.z, v.w}; } }
        }
        __syncthreads();
        if (PROBE_PH >= 0 && F.bid == 100 && F.tid == 0) ((volatile LAS unsigned*)(F.lds + RING_BYTES + 1024))[11] = (unsigned)__builtin_amdgcn_s_memrealtime();
        {
            AttHead H[2];
#pragma unroll
            for (int hp = 0; hp < 2; ++hp) { const int head = hk * 4 + hp * 2 + hsel; H[hp].slope2 = exp2f(-(float)(head + 1)) * LOG2E; H[hp].m = F.sink[head] * LOG2E; H[hp].l = h == 0 ? 1.f : 0.f;
#pragma unroll
                for (int r = 0; r < 16; ++r) { H[hp].O0[r] = 0.f; H[hp].O1[r] = 0.f; } }
            const LAS unsigned char* kb0 = Kimg + q * 128; const LAS unsigned char* vb0 = Vimg + q * ATT_VP + 8 * h;
            att_tile2<0>(kb0, koff, vb0, qf[0], qf[1], 0.f, 0.f, H[0], H[1]);
#pragma unroll 1
            for (int kt = qt; kt <= qt + 8; ++kt) { const int blk = kt >> 2; if ((i == 0 && blk == 0) || (i == 15 && blk == 2)) continue;
                const int kr0 = 32 + 32 * kt; const float Bq = (float)(128 + 32 * (qt - kt) + q - 4 * h);
                att_tile2<1>(kb0 + kr0 * 128, koff, vb0 + kr0 * 2, qf[0], qf[1], Bq, (kt == qt || kt == qt + 8) ? 128.f : 1e30f, H[0], H[1]); }
#pragma unroll
            for (int hp = 0; hp < 2; ++hp) { const int head = hk * 4 + hp * 2 + hsel; float l = H[hp].l; l += __shfl_xor(l, 32); const float inv = 1.f / l;
                bf16_t* orow = F.MIX + (size_t)row * D + head * 64 + 4 * h;
#pragma unroll
                for (int g = 0; g < 4; ++g) { *(GAS u32x2*)(orow + 8 * g) = (u32x2){pg8::cvt_pk_bf16(H[hp].O0[4 * g] * inv, H[hp].O0[4 * g + 1] * inv), pg8::cvt_pk_bf16(H[hp].O0[4 * g + 2] * inv, H[hp].O0[4 * g + 3] * inv)};
                    *(GAS u32x2*)(orow + 32 + 8 * g) = (u32x2){pg8::cvt_pk_bf16(H[hp].O1[4 * g] * inv, H[hp].O1[4 * g + 1] * inv), pg8::cvt_pk_bf16(H[hp].O1[4 * g + 2] * inv, H[hp].O1[4 * g + 3] * inv)}; } }
        }
    }
    __syncthreads();
}
__device__ __forceinline__ void conv_fast(Frame& F) {
    const int tid = F.tid, lane = F.lane, wid = F.wave, c2 = tid & 255, th = tid >> 8;
    LAS float* cout = (LAS float*)F.lds;
    float w0[CONV_K], w1[CONV_K];
#pragma unroll
    for (int j = 0; j < CONV_K; ++j) { const f32x2 w = *(const f32x2*)(F.dw_w + j * CONV_W + 2 * c2); w0[j] = w.x; w1[j] = w.y; }
    const f32x2 bias = *(const f32x2*)(F.dw_b + 2 * c2);
    const f32x4 g0 = *(const f32x4*)(F.lng + 8 * lane), g1 = *(const f32x4*)(F.lng + 8 * lane + 4), b0 = *(const f32x4*)(F.lnb + 8 * lane), b1 = *(const f32x4*)(F.lnb + 8 * lane + 4);
    const int vb = (F.G & 7) == 0 ? (F.bid & 7) * (F.G >> 3) + (F.bid >> 3) : F.bid;
    for (int item = vb; item < NB * 32; item += F.G) {
        const int b = item >> 5, t0 = (item & 31) * 64;
        unsigned xin[62];
        const int s0 = NMETA + t0 + 32 * th - 15;
#pragma unroll
        for (int jj = 0; jj < 62; ++jj) { const int sq = s0 + jj; xin[jj] = sq < LSEQ ? *(const GAS unsigned*)(F.HC + (size_t)row_of(b, sq) * 512 + 2 * c2) : 0u; }
        __syncthreads();
#pragma unroll
        for (int t = 0; t < 32; ++t) { float a0 = bias.x, a1 = bias.y;
#pragma unroll
            for (int j = 0; j < CONV_K; ++j) { a0 += w0[j] * bflo(xin[t + j]); a1 += w1[j] * bfhi(xin[t + j]); }
            *(LAS f32x2*)(cout + (32 * th + t) * 512 + 2 * c2) = (f32x2){a0, a1}; }
        __syncthreads();
#pragma unroll 1
        for (int hb = 0; hb < 2; ++hb) {
            f32x4 x0[4], x1[4]; float sm[4], sq[4];
#pragma unroll
            for (int tt = 0; tt < 4; ++tt) { const LAS f32x4* rp = (const LAS f32x4*)(cout + (8 * wid + 4 * hb + tt) * 512 + 8 * lane); x0[tt] = rp[0]; x1[tt] = rp[1];
                sm[tt] = (x0[tt][0] + x0[tt][1]) + (x0[tt][2] + x0[tt][3]) + (x1[tt][0] + x1[tt][1]) + (x1[tt][2] + x1[tt][3]);
                sq[tt] = (x0[tt][0] * x0[tt][0] + x0[tt][1] * x0[tt][1]) + (x0[tt][2] * x0[tt][2] + x0[tt][3] * x0[tt][3]) + (x1[tt][0] * x1[tt][0] + x1[tt][1] * x1[tt][1]) + (x1[tt][2] * x1[tt][2] + x1[tt][3] * x1[tt][3]); }
#pragma unroll
            for (int o = 1; o < 64; o <<= 1)
#pragma unroll
                for (int tt = 0; tt < 4; ++tt) { sm[tt] += __shfl_xor(sm[tt], o); sq[tt] += __shfl_xor(sq[tt], o); }
#pragma unroll
            for (int tt = 0; tt < 4; ++tt) { const float mu = sm[tt] * (1.f / 512.f); const float var = fmaxf(sq[tt] * (1.f / 512.f) - mu * mu, 0.f); const float rstd = __builtin_amdgcn_rsqf(var + 1e-5f);
                f32x4 y0 = (x0[tt] - mu) * rstd * g0 + b0, y1 = (x1[tt] - mu) * rstd * g1 + b1;
#pragma unroll
                for (int e = 0; e < 4; ++e) { y0[e] *= sigmoidf_fast(y0[e]); y1[e] *= sigmoidf_fast(y1[e]); }
                *(GAS u32x4*)(F.MIX + (size_t)(b * SEQ + t0 + 8 * wid + 4 * hb + tt) * D + 512 + 8 * lane) = pg8::pack8(y0, y1); }
        }
    }
    __syncthreads();
}
__device__ __forceinline__ void p4_fast(Frame& F) {
    LAS int* lcnt = (LAS int*)(F.lds + LX_LCNT); LAS int* gbase = (LAS int*)(F.lds + LX_GBASE); LAS float* part = (LAS float*)F.lds;
    const int tid = F.tid, lane = F.lane, wid = F.wave, j = lane & 31, h = lane >> 5, grp = wid >> 2, sub = wid & 3;
    for (int base = 0; base < M_REAL / 32; base += F.G * 2) {
        const int tile = base + F.bid + F.G * grp; const bool active = tile < M_REAL / 32;
        if (tid < NE) lcnt[tid] = 0;
        int tok = 0;
        if (active) {
            tok = tile * 32 + j;
            const bf16_t* xa = F.XN2 + (size_t)tok * D + 256 * sub + 8 * h; const bf16_t* wa = F.WrT + (size_t)j * D + 256 * sub + 8 * h;
            f32x16 acc;
#pragma unroll
            for (int r = 0; r < 16; ++r) acc[r] = 0.f;
            float ssq = 0.f;
#pragma unroll
            for (int ks = 0; ks < 16; ++ks) { const u32x4 xb = *(const GAS u32x4*)(xa + 16 * ks); const bf16x8 wf = *(const GAS bf16x8*)(wa + 16 * ks);
                acc = __builtin_amdgcn_mfma_f32_32x32x16_bf16(wf, __builtin_bit_cast(bf16x8, xb), acc, 0, 0, 0);
                ssq += (bflo(xb.x) * bflo(xb.x) + bfhi(xb.x) * bfhi(xb.x)) + (bflo(xb.y) * bflo(xb.y) + bfhi(xb.y) * bfhi(xb.y)) + (bflo(xb.z) * bflo(xb.z) + bfhi(xb.z) * bfhi(xb.z)) + (bflo(xb.w) * bflo(xb.w) + bfhi(xb.w) * bfhi(xb.w)); }
            LAS float* p = part + (size_t)((grp * 4 + sub) * 17) * 64 + lane;
#pragma unroll
            for (int r = 0; r < 16; ++r) p[r * 64] = acc[r];
            p[16 * 64] = ssq;
        }
        __syncthreads();
        int ea = 0, eb = 0, sa = 0, sb = 0; float ga = 0.f, gb = 0.f, rstd = 0.f;
        const bool fin = active && sub == 0;
        if (fin) {
            float lg[16]; float ssq = 0.f;
#pragma unroll
            for (int r = 0; r < 16; ++r) lg[r] = 0.f;
#pragma unroll
            for (int q = 0; q < 4; ++q) { const LAS float* p = part + (size_t)((grp * 4 + q) * 17) * 64 + lane;
#pragma unroll
                for (int r = 0; r < 16; ++r) lg[r] += p[r * 64];
                ssq += p[16 * 64]; }
            ssq += __shfl_xor(ssq, 32);
            rstd = 1.f / sqrtf(ssq * (1.f / D) + 1e-6f);
#pragma unroll
            for (int r = 0; r < 16; ++r) lg[r] = lg[r] * rstd + F.rb[(r & 3) + 8 * (r >> 2) + 4 * h];
            float tv[4]; int te[4];
#pragma unroll
            for (int kk = 0; kk < 4; ++kk) { float bv = -INFINITY; int be = 0;
#pragma unroll
                for (int r = 0; r < 16; ++r) { const int er = (r & 3) + 8 * (r >> 2) + 4 * h; if (lg[r] > bv) { bv = lg[r]; be = er; } }
                const float pv = __shfl_xor(bv, 32); const int pe = __shfl_xor(be, 32);
                if (pv > bv || (pv == bv && pe < be)) { bv = pv; be = pe; }
#pragma unroll
                for (int r = 0; r < 16; ++r) { const int er = (r & 3) + 8 * (r >> 2) + 4 * h; if (er == be) lg[r] = -INFINITY; }
                tv[kk] = bv; te[kk] = be; }
            const float p1 = __expf(tv[1] - tv[0]), p2 = __expf(tv[2] - tv[0]), p3 = __expf(tv[3] - tv[0]); const float inv = 1.f / (1.f + p1 + p2 + p3);
            ea = h ? te[2] : te[0]; eb = h ? te[3] : te[1]; ga = (h ? p2 : 1.f) * inv; gb = (h ? p3 : p1) * inv;
            sa = __hip_atomic_fetch_add(lcnt + ea, 1, __ATOMIC_RELAXED, __HIP_MEMORY_SCOPE_WORKGROUP); sb = __hip_atomic_fetch_add(lcnt + eb, 1, __ATOMIC_RELAXED, __HIP_MEMORY_SCOPE_WORKGROUP);
        }
        __syncthreads();
        if (tid < NE) gbase[tid] = (int)__hip_atomic_fetch_add((unsigned*)(F.ctl + CW_CNT + tid), (unsigned)lcnt[tid], RLX_AGENT);
        __syncthreads();
        if (fin) {
            sa += gbase[ea]; sb += gbase[eb];
            F.ltok[ea * CAP + sa] = tok; F.lgate[ea * CAP + sa] = ga; F.lrstd[ea * CAP + sa] = rstd; F.where[tok * 4 + 2 * h] = ea * CAP + sa;
            F.ltok[eb * CAP + sb] = tok; F.lgate[eb * CAP + sb] = gb; F.lrstd[eb * CAP + sb] = rstd; F.where[tok * 4 + 2 * h + 1] = eb * CAP + sb;
        }
        __syncthreads();
    }
}

__device__ __forceinline__ void p1_naive(Frame& F) {
    const int gw = F.bid * NWAVES + F.wave, NGW = F.G * NWAVES, lane = F.lane;
    for (int it = gw; it < M_ALL * 20; it += NGW) {
        const int row = it / 20, grp = it % 20;
        const bf16_t* xr = F.XN + (size_t)row * D;
        if (grp < 12) {
            const int col = grp * 64 + lane; float acc = 0.f;
            _Pragma("unroll 4") for (int k = 0; k < D; ++k) acc += bf2f(xr[k]) * F.w_in[(size_t)k * IN_W + col];
            if (grp < 10) {
                const float ssq = wave_sum(acc * acc); const float r = 1.f / sqrtf(ssq * (1.f / 64.f) + 1e-6f);
                if (grp < 8) F.Qb[(size_t)row * 512 + col] = (bf16_t)f2bf(acc * r * F.qg[lane] * QSCALE);
                else F.Kb[(size_t)row * 128 + (col - 512)] = (bf16_t)f2bf(acc * r * F.kg[lane]);
            } else {
                const int hk = grp - 10; int b, kx;
                if (row < M_REAL) { b = row >> 11; kx = NMETA + (row & 2047); } else { b = (row - M_REAL) >> 4; kx = (row - M_REAL) & 15; }
                F.VT[((size_t)(b * 2 + hk) * 64 + lane) * VT_PITCH + kx] = (bf16_t)f2bf(acc);
            }
        } else {
            const int c = (grp - 12) * 64 + lane; float a = 0.f, g = 0.f;
            for (int k = 0; k < D; ++k) { const float xv = bf2f(xr[k]); a += xv * F.w_in[(size_t)k * IN_W + 768 + c]; g += xv * F.w_in[(size_t)k * IN_W + 1280 + c]; }
            F.HC[(size_t)row * 512 + c] = (bf16_t)f2bf(a * sigmoidf_fast(g));
        }
    }
}
__device__ __forceinline__ void att_naive(Frame& F) {
    const int gw = F.bid * NWAVES + F.wave, NGW = F.G * NWAVES, lane = F.lane;
    for (int it = gw; it < M_REAL * NQH; it += NGW) {
        const int row = it >> 3, h = it & 7, hk = h >> 2, b = row >> 11, qp = row & 2047;
        const float q = bf2f(F.Qb[(size_t)row * 512 + h * 64 + lane]);
        const float slope2 = exp2f(-(float)(h + 1)) * LOG2E;
        float m = F.sink[h] * LOG2E, l = 1.f, acc = 0.f;
        const bf16_t* vt = F.VT + ((size_t)(b * 2 + hk) * 64 + lane) * VT_PITCH;
        for (int j = 0; j < NMETA; ++j) {
            const float kv = bf2f(F.Kb[(size_t)(M_REAL + b * NMETA + j) * 128 + hk * 64 + lane]);
            const float s = wave_sum(q * kv);
            const float mn = fmaxf(m, s), al = exp2f(m - mn), p = exp2f(s - mn);
            l = l * al + p; acc = acc * al + p * bf2f(vt[j]); m = mn;
        }
        const int k0 = qp - 128 < 0 ? 0 : qp - 128, k1 = qp + 128 > SEQ - 1 ? SEQ - 1 : qp + 128;
        for (int kp = k0; kp <= k1; ++kp) {
            const float kv = bf2f(F.Kb[(size_t)(b * SEQ + kp) * 128 + hk * 64 + lane]);
            const float dist = (float)(qp > kp ? qp - kp : kp - qp);
            const float s = wave_sum(q * kv) - slope2 * dist;
            const float mn = fmaxf(m, s), al = exp2f(m - mn), p = exp2f(s - mn);
            l = l * al + p; acc = acc * al + p * bf2f(vt[NMETA + kp]); m = mn;
        }
        F.MIX[(size_t)row * D + h * 64 + lane] = (bf16_t)f2bf(acc / l);
    }
}
__device__ __forceinline__ void conv_naive(Frame& F) {
    const int gw = F.bid * NWAVES + F.wave, NGW = F.G * NWAVES, lane = F.lane;
    for (int row = gw; row < M_REAL; row += NGW) {
        const int b = row >> 11, s0 = NMETA + (row & 2047);
        float v[8]; float sum = 0.f;
#pragma unroll
        for (int j = 0; j < 8; ++j) { const int c = lane + 64 * j; float a = F.dw_b[c];
            _Pragma("unroll 1") for (int t = 0; t < CONV_K; ++t) { const int s = s0 - 15 + t; if (s >= 0 && s < LSEQ) a += F.dw_w[t * CONV_W + c] * bf2f(F.HC[(size_t)row_of(b, s) * 512 + c]); }
            v[j] = a; sum += a; }
        const float mu = wave_sum(sum) * (1.f / 512.f); float q = 0.f;
#pragma unroll
        for (int j = 0; j < 8; ++j) { const float d = v[j] - mu; q += d * d; }
        const float rstd = 1.f / sqrtf(wave_sum(q) * (1.f / 512.f) + 1e-5f);
#pragma unroll
        for (int j = 0; j < 8; ++j) { const int c = lane + 64 * j; const float y = (v[j] - mu) * rstd * F.lng[c] + F.lnb[c];
            F.MIX[(size_t)row * D + 512 + c] = (bf16_t)f2bf(y * sigmoidf_fast(y)); }
    }
}
__device__ __forceinline__ void p3_naive(Frame& F) {
    const int gw = F.bid * NWAVES + F.wave, NGW = F.G * NWAVES, lane = F.lane;
    for (int it = gw; it < M_REAL * 16; it += NGW) {
        const int row = it >> 4, col = (it & 15) * 64 + lane; const bf16_t* mr = F.MIX + (size_t)row * D; float acc = 0.f;
        for (int k = 0; k < D; ++k) acc += bf2f(mr[k]) * F.w_out[(size_t)k * D + col];
        const float h2 = F.x[(size_t)row * D + col] + acc;
        F.out[(size_t)row * D + col] = h2; F.XN2[(size_t)row * D + col] = (bf16_t)f2bf(h2); F.XN2F8[(size_t)row * D + col] = (unsigned char)(pk4_fp8(h2, 0.f, 0.f, 0.f) & 0xffu);
    }
}
__device__ __forceinline__ void p4_naive(Frame& F) {
    const int gw = F.bid * NWAVES + F.wave, NGW = F.G * NWAVES, lane = F.lane, e = lane & 31;
    for (int t = gw; t < M_REAL; t += NGW) {
        const bf16_t* xr = F.XN2 + (size_t)t * D; float acc = 0.f, ss = 0.f;
        for (int k = 0; k < D; ++k) { const float xv = bf2f(xr[k]); acc += xv * F.n2g[k] * F.wr[k * NE + e]; ss += xv * xv; }
        const float rstd = 1.f / sqrtf(ss * (1.f / D) + 1e-6f);
        float lg = acc * rstd + F.rb[e];
        float tv[4]; int te[4];
#pragma unroll
        for (int kk = 0; kk < 4; ++kk) {
            float bv = lg; int be = e;
#pragma unroll
            for (int o = 1; o < 32; o <<= 1) { const float pv = __shfl_xor(bv, o); const int pe = __shfl_xor(be, o); if (pv > bv || (pv == bv && pe < be)) { bv = pv; be = pe; } }
            tv[kk] = bv; te[kk] = be; if (e == be) lg = -INFINITY;
        }
        float p[4], ps = 0.f;
#pragma unroll
        for (int kk = 0; kk < 4; ++kk) { p[kk] = __expf(tv[kk] - tv[0]); ps += p[kk]; }
        if (lane < 4) {
            const int ee = lane == 0 ? te[0] : lane == 1 ? te[1] : lane == 2 ? te[2] : te[3];
            const float gg = (lane == 0 ? p[0] : lane == 1 ? p[1] : lane == 2 ? p[2] : p[3]) / ps;
            const unsigned slot = __hip_atomic_fetch_add((unsigned*)(F.ctl + CW_CNT + ee), 1u, RLX_AGENT);
            F.ltok[ee * CAP + slot] = t; F.lgate[ee * CAP + slot] = gg; F.lrstd[ee * CAP + slot] = rstd; F.where[t * 4 + lane] = ee * CAP + (int)slot;
        }
    }
}
__device__ __forceinline__ void build_tile_table(Frame& F) {
    LAS int* tb = (LAS int*)(F.lds + LX_TB); LAS int* cn = (LAS int*)(F.lds + LX_CNT); LAS int* hb = (LAS int*)(F.lds + LX_HB); LAS int* lb = (LAS int*)(F.lds + LX_LB);
    __syncthreads();
    if (F.tid == 0) { int acc = 0, ah = 0, al = 0; for (int e = 0; e < NE; ++e) { int c = (int)__hip_atomic_load(F.ctl + CW_CNT + e, RLX_AGENT); if (c > CAP) c = CAP; if (c < 0) c = 0;
            const int t = (c + 255) >> 8, rem = c & 255, light = (rem != 0 && rem <= 128) ? 1 : 0; cn[e] = c; tb[e] = acc; hb[e] = ah; lb[e] = al; acc += t; ah += t - light; al += light; }
        tb[NE] = acc; hb[NE] = ah; lb[NE] = al; }
    __syncthreads();
}
__device__ __forceinline__ int find_expert(const LAS int* tb, int tile) { int e = 0;
#pragma unroll 1
    for (int j = 1; j < NE; ++j) if (tb[j] <= tile) e = j;
    return e; }
__device__ __forceinline__ f32x4 fp8x4_to_f32(unsigned w) {
    const f32x2 lo = __builtin_amdgcn_cvt_pk_f32_fp8((int)w, false), hi = __builtin_amdgcn_cvt_pk_f32_fp8((int)w, true); return (f32x4){lo.x, lo.y, hi.x, hi.y}; }
__device__ __forceinline__ void p7_combine(Frame& F) {
    build_tile_table(F);
    const LAS int* tb = (const LAS int*)(F.lds + LX_TB);
    const int gw = F.bid * NWAVES + F.wave, NGW = F.G * NWAVES, lane = F.lane;
    const float pscale = PROBE_PH >= 0 ? 1.f + __builtin_bit_cast(float, __hip_atomic_load((unsigned*)(F.ctl + 32), RLX_AGENT)) : 1.f;
    const GAS i32x4* wh = (const GAS i32x4*)F.where;
    int t0 = gw, t1 = gw + NGW;
    i32x4 w0 = t0 < M_REAL ? wh[t0] : (i32x4){0, 0, 0, 0}, w1 = t1 < M_REAL ? wh[t1] : (i32x4){0, 0, 0, 0};
    while (t0 < M_REAL) {
        const int n0 = t0 + 2 * NGW, n1 = t1 + 2 * NGW;
        const i32x4 nw0 = n0 < M_REAL ? wh[n0] : (i32x4){0, 0, 0, 0}, nw1 = n1 < M_REAL ? wh[n1] : (i32x4){0, 0, 0, 0};
        const bool v1 = t1 < M_REAL; const int tt1 = v1 ? t1 : t0;
        u32x4 y[2][4], x[2][2];
#pragma unroll
        for (int u = 0; u < 2; ++u) { const int t = u ? tt1 : t0; const i32x4 w = u ? w1 : w0;
#pragma unroll
            for (int j = 0; j < 2; ++j) x[u][j] = *((const GAS u32x4*)(F.XN2 + (size_t)t * D) + 2 * lane + j);
#pragma unroll
            for (int k = 0; k < 4; ++k) { const int e = w[k] / CAP, slot = w[k] - e * CAP; y[u][k] = *((const GAS u32x4*)(F.Y8 + (size_t)(tb[e] * 256 + slot) * D) + lane); } }
#pragma unroll
        for (int u = 0; u < 2; ++u) { if (u && !v1) break; const int t = u ? tt1 : t0;
            f32x4 a[4] = {(f32x4){0.f, 0.f, 0.f, 0.f}, (f32x4){0.f, 0.f, 0.f, 0.f}, (f32x4){0.f, 0.f, 0.f, 0.f}, (f32x4){0.f, 0.f, 0.f, 0.f}};
#pragma unroll
            for (int k = 0; k < 4; ++k) { a[0] += fp8x4_to_f32(y[u][k].x); a[1] += fp8x4_to_f32(y[u][k].y); a[2] += fp8x4_to_f32(y[u][k].z); a[3] += fp8x4_to_f32(y[u][k].w); }
            a[0] += (f32x4){bflo(x[u][0].x), bfhi(x[u][0].x), bflo(x[u][0].y), bfhi(x[u][0].y)}; a[1] += (f32x4){bflo(x[u][0].z), bfhi(x[u][0].z), bflo(x[u][0].w), bfhi(x[u][0].w)};
            a[2] += (f32x4){bflo(x[u][1].x), bfhi(x[u][1].x), bflo(x[u][1].y), bfhi(x[u][1].y)}; a[3] += (f32x4){bflo(x[u][1].z), bfhi(x[u][1].z), bflo(x[u][1].w), bfhi(x[u][1].w)};
            GAS f32x4* o = (GAS f32x4*)(F.out + (size_t)t * D) + 4 * lane;
#pragma unroll
            for (int j = 0; j < 4; ++j) o[j] = PROBE_PH >= 0 ? a[j] * pscale : a[j]; }
        t0 = n0; t1 = n1; w0 = nw0; w1 = nw1;
    }
}

__global__ void __launch_bounds__(NTHR, 2) mega(Args args) {
    extern __shared__ __attribute__((aligned(16))) unsigned char lds_raw[];
    Frame F;
    F.lds = (LAS unsigned char*)lds_raw;
    F.tid = threadIdx.x; F.lane = F.tid & 63; F.wave = __builtin_amdgcn_readfirstlane(F.tid >> 6); F.G = gridDim.x; F.bid = blockIdx.x;
    F.x = args.in[0]; F.meta = args.in[1]; F.n1g = args.in[2]; F.w_in = args.in[3]; F.qg = args.in[4]; F.kg = args.in[5]; F.sink = args.in[6];
    F.dw_w = args.in[7]; F.dw_b = args.in[8]; F.lng = args.in[9]; F.lnb = args.in[10]; F.w_out = args.in[11]; F.n2g = args.in[12];
    F.wr = args.in[13]; F.rb = args.in[14]; F.wgu = args.in[15]; F.bgu = args.in[16]; F.wd = args.in[17]; F.bd = args.in[18];
    F.out = args.out; F.ws = args.ws; unsigned char* ws = args.ws;
    F.ctl = (gu32*)(ws + WS_CTL);
    F.WinT = (bf16_t*)(ws + WS_WIN_T); F.WoT = (bf16_t*)(ws + WS_WO_T); F.WrT = (bf16_t*)(ws + WS_WR_T); F.WdT8 = ws + WS_WD_T; F.WguT8 = ws + WS_WGU_T; F.XN2F8 = ws + WS_XN2F8;
    F.XN = (bf16_t*)(ws + WS_XN); F.Qb = (bf16_t*)(ws + WS_Q); F.Kb = (bf16_t*)(ws + WS_K); F.VT = (bf16_t*)(ws + WS_VT); F.HC = (bf16_t*)(ws + WS_HC);
    F.MIX = (bf16_t*)(ws + WS_MIX); F.XN2 = (bf16_t*)(ws + WS_XN2); F.ACT8 = ws + WS_ACT; F.Y8 = ws + WS_Y;
    F.where = (int*)(ws + WS_WHERE); F.ltok = (int*)(ws + WS_LTOK); F.lgate = (float*)(ws + WS_LGATE); F.lrstd = (float*)(ws + WS_LRSTD);
    for (int u = F.tid; u < (LDS_BYTES - RING_BYTES) / 4; u += NTHR) ((LAS unsigned*)(F.lds + RING_BYTES))[u] = 0u;
    __syncthreads();
    const int lo = args.ph_lo, hi = args.ph_hi;
    XcdBarrier bar; bar.bar = (unsigned*)(F.ctl + CW_BAR); bar.x = 0; bar.st = nullptr;
    if (hi - lo > 1) bar = xcd_barrier_post((unsigned*)(F.ctl + CW_BAR), (volatile LAS unsigned*)(F.lds + LX_BAR));
#ifndef PH_MASK
#define PH_MASK 0xFF
#endif
#define IN(k) (((PH_MASK >> (k)) & 1) && lo <= (k) && (k) < hi)
#define STAMP(k) do { if (PROBE_PH >= 0 && F.bid == 100 && F.tid == 0) ((volatile LAS unsigned*)(F.lds + RING_BYTES + 1024))[k] = (unsigned)__builtin_amdgcn_s_memrealtime(); } while (0)
#define SEAM(k) do { if (IN(k) && IN((k) + 1)) xcd_barrier(bar); STAMP((k) + 1); } while (0)
#ifndef REP_PH
#define REP_PH -1
#endif
#define REPS(k) _Pragma("unroll") for (int rep = 0; rep < ((REP_PH) == (k) ? 2 : 1); ++rep)
#define REPBAR() do { if (rep) xcd_barrier(bar); } while (0)
    STAMP(0);
    if (IN(0)) { REPS(0) { REPBAR(); p0_prologue(F); } } SEAM(0);
    if (IN(1)) { REPS(1) { REPBAR();
#if FAST_P1
        pg8::DenseProb<IN_W / 256> P{F.XN, F.WinT, M_PAD / 256, F.G, F.bid}; pg8::EpiIn E{F.Qb, F.Kb, F.VT, F.HC, F.qg, F.kg}; pg8::gemm_phase<2>(F.lds, P, E);
        { const int nd = p0_ndef(F.G), first_idle = P1_UNITS - F.G;
          if (nd > 0 && F.bid >= first_idle) { __syncthreads(); p0_items(F, P0_NITEMS - nd + (F.bid - first_idle) * NWAVES + F.wave, (F.G - first_idle) * NWAVES, P0_NITEMS); } }
#else
        p1_naive(F);
#endif
    } } SEAM(1);
    if (IN(2)) { REPS(2) { REPBAR();
#if FAST_ATT
        att_fast(F);
#else
        att_naive(F);
#endif
    } STAMP(9); REPS(8) { REPBAR();
#if FAST_CONV
        conv_fast(F);
#else
        conv_naive(F);
#endif
    } } SEAM(2);
    if (IN(3)) { REPS(3) { REPBAR();
#if FAST_P3
        pg8::DenseProb<D / 256> P{F.MIX, F.WoT, M_REAL / 256, F.G, F.bid}; pg8::EpiOut E{F.x, F.out, F.XN2, F.XN2F8}; pg8::gemm_phase<2>(F.lds, P, E);
#else
        p3_naive(F);
#endif
    } } SEAM(3);
    if (IN(4)) { REPS(4) { if (rep) { xcd_barrier(bar); if (F.bid == 0 && F.tid < NE) __hip_atomic_store(F.ctl + CW_CNT + F.tid, 0u, RLX_AGENT); xcd_barrier(bar); }
#if FAST_P4
        p4_fast(F);
#else
        p4_naive(F);
#endif
        __syncthreads(); p0_items(F, P0_NMOE0 + F.bid * NWAVES + F.wave, F.G * NWAVES, P0_NITEMS - p0_ndef(F.G));
    } } SEAM(4);
    if (IN(5)) { REPS(5) { REPBAR();
        build_tile_table(F); pg8::GroupedProb<true, 1, 8> P{F.XN2F8, F.WguT8, F.ltok, (const LAS int*)(F.lds + LX_TB), (const LAS int*)(F.lds + LX_CNT), F.G, F.bid};
        pg8::EpiGU E{F.ACT8, F.lrstd, F.bgu}; pg8::gemm_phase<1>(F.lds, P, E);
    } } SEAM(5);
    if (IN(6)) { REPS(6) { REPBAR();
        build_tile_table(F); pg8::GroupedProb<false, 1, 4> P{F.ACT8, F.WdT8, F.ltok, (const LAS int*)(F.lds + LX_TB), (const LAS int*)(F.lds + LX_CNT), F.G, F.bid};
        pg8::EpiDown E{F.Y8, F.lgate, F.bd}; pg8::gemm_phase<1>(F.lds, P, E);
    } } SEAM(6);
    if (PROBE_PH >= 0 && hi - lo > 1) {
        if (F.bid == 100 && F.tid == 0) { volatile LAS unsigned* ts = (volatile LAS unsigned*)(F.lds + RING_BYTES + 1024); const unsigned dt = PROBE_PH == 11 ? ts[11] - ts[2] : PROBE_PH == 12 ? ts[9] - ts[11] : PROBE_PH == 9 ? ts[9] - ts[2] : PROBE_PH == 10 ? ts[3] - ts[9] : ts[PROBE_PH + 1] - ts[PROBE_PH];
            const float eps = sqrtf((float)dt * 0.01f * (float)(PROBE_SCALE)); __hip_atomic_store((unsigned*)(F.ctl + 32), __builtin_bit_cast(unsigned, eps), RLX_AGENT); }
        xcd_barrier(bar);
    }
    if (IN(7)) { REPS(7) { REPBAR(); p7_combine(F); } }
#undef IN
#undef SEAM
}

extern "C" void kernel_launch(void* const* d_in, const int* in_sizes, int n_in, void* d_out, int out_size, void* d_ws, size_t ws_size, hipStream_t stream) {
    static int grid = 0;
    if (grid == 0) {
        if (n_in != 19 || in_sizes[0] != M_REAL * D || out_size != M_REAL * D || ws_size < WS_END) {
            fprintf(stderr, "kernel_launch: unexpected shapes/workspace: n_in %d in0 %d out %d ws %zu (need %zu)\n", n_in, n_in > 0 ? in_sizes[0] : -1, out_size, ws_size, (size_t)WS_END); grid = -1; return; }
        int dev = 0, cus = 0, per_cu = 0;
        if (hipGetDevice(&dev) != hipSuccess || hipDeviceGetAttribute(&cus, hipDeviceAttributeMultiprocessorCount, dev) != hipSuccess) { grid = -1; return; }
        if (hipFuncSetAttribute((const void*)mega, hipFuncAttributeMaxDynamicSharedMemorySize, LDS_BYTES) != hipSuccess) { fprintf(stderr, "kernel_launch: hipFuncSetAttribute failed\n"); grid = -1; return; }
        if (hipOccupancyMaxActiveBlocksPerMultiprocessor(&per_cu, (const void*)mega, NTHR, LDS_BYTES) != hipSuccess || per_cu < 1) { fprintf(stderr, "kernel_launch: occupancy query says %d blocks/CU\n", per_cu); (void)hipGetLastError(); grid = -1; return; }
        grid = cus;
    }
    if (grid < 0) return;
    (void)hipMemsetAsync((char*)d_ws + WS_CTL, 0, CTL_ZERO_BYTES, stream);
    Args a{};
    for (int i = 0; i < 19; ++i) a.in[i] = (const float*)d_in[i];
    a.out = (float*)d_out; a.ws = (unsigned char*)d_ws;
#if MK_PER_PHASE
    for (int p = 0; p < 8; ++p) { a.ph_lo = p; a.ph_hi = p + 1; hipLaunchKernelGGL(mega, dim3(grid), dim3(NTHR), LDS_BYTES, stream, a); }
#else
    a.ph_lo = 0; a.ph_hi = 8; hipLaunchKernelGGL(mega, dim3(grid), dim3(NTHR), LDS_BYTES, stream, a);
#endif
}
```

```cpp
#include <hip/hip_runtime.h>
#include <cstdio>
#include <cstdint>

#ifndef MK_PER_PHASE
#define MK_PER_PHASE 0
#endif
#ifndef PROBE_PH
#define PROBE_PH -1
#endif
#ifndef PROBE_SCALE
#define PROBE_SCALE 2e-5
#endif
#ifndef FAST_P1
#define FAST_P1 1
#endif
#ifndef FAST_ATT
#define FAST_ATT 1
#endif
#ifndef FAST_CONV
#define FAST_CONV 1
#endif
#ifndef FAST_P3
#define FAST_P3 1
#endif
#ifndef FAST_P4
#define FAST_P4 1
#endif
#ifndef FAST_P5
#define FAST_P5 1
#endif
#ifndef FAST_P6
#define FAST_P6 1
#endif

#define GAS __attribute__((address_space(1)))
#define LAS __attribute__((address_space(3)))
typedef unsigned short bf16_t;
typedef short bf16x8 __attribute__((ext_vector_type(8)));
typedef float f32x4 __attribute__((ext_vector_type(4)));
typedef float f32x16 __attribute__((ext_vector_type(16)));
typedef int i32x4 __attribute__((ext_vector_type(4)));
typedef int i32x8 __attribute__((ext_vector_type(8)));
typedef unsigned u32x4 __attribute__((ext_vector_type(4)));
typedef unsigned u32x2 __attribute__((ext_vector_type(2)));
typedef float f32x2 __attribute__((ext_vector_type(2)));
typedef GAS unsigned gu32;
#define RLX_AGENT __ATOMIC_RELAXED, __HIP_MEMORY_SCOPE_AGENT

constexpr int NB = 8, SEQ = 2048, D = 1024, NMETA = 16, LSEQ = NMETA + SEQ;
constexpr int M_REAL = NB * SEQ, M_ALL = NB * LSEQ, M_PAD = 16640;
constexpr int IN_W = 1792, HD = 64, NQH = 8, NKV = 2, CONV_W = 512, CONV_K = 31;
constexpr int NE = 32, CAP = 16384, ACT_ROWS = 4 * M_REAL + NE * 256;
constexpr float LOG2E = 1.4426950408889634f;
constexpr float QSCALE = 0.125f * LOG2E;
constexpr float WSCALE = 32.0f;
constexpr int VT_PITCH = LSEQ + 64;

constexpr size_t MiB = 1u << 20;
constexpr size_t WS_CTL = 0, CTL_ZERO_BYTES = 32768;
constexpr size_t WS_WIN_T = 2 * MiB;
constexpr size_t WS_WO_T = 6 * MiB;
constexpr size_t WS_WR_T = 8 * MiB;
constexpr size_t WS_RSTD = 9 * MiB;
constexpr size_t WS_WHERE = 9 * MiB + 512 * 1024;
constexpr size_t WS_LTOK = 10 * MiB;
constexpr size_t WS_LGATE = 12 * MiB;
constexpr size_t WS_LRSTD = 14 * MiB;
constexpr size_t WS_WD_T = 16 * MiB;
constexpr size_t WS_WGU_T = 80 * MiB;
constexpr size_t WS_XN = 208 * MiB;
constexpr size_t WS_Q = 241 * MiB;
constexpr size_t WS_K = 258 * MiB;
constexpr size_t WS_VT = 263 * MiB;
constexpr size_t WS_HC = 268 * MiB;
constexpr size_t WS_MIX = 285 * MiB;
constexpr size_t WS_XN2 = 317 * MiB;
constexpr size_t WS_ACT = 349 * MiB;
constexpr size_t WS_Y = 493 * MiB;
constexpr size_t WS_XN2F8 = 637 * MiB;
constexpr size_t WS_END = 653 * MiB;
constexpr int CW_CNT = 64;
constexpr int CW_BAR = 4096;

constexpr int RING_BYTES = 131072;
constexpr int LX_BAR = RING_BYTES;
constexpr int LX_TB = RING_BYTES + 64;
constexpr int LX_CNT = RING_BYTES + 256;
constexpr int LX_LCNT = RING_BYTES + 512;
constexpr int LX_GBASE = RING_BYTES + 768;
constexpr int LX_HB = RING_BYTES + 1280;
constexpr int LX_LB = RING_BYTES + 1536;
constexpr int LDS_BYTES = 147456;

constexpr int NWAVES = 8, NTHR = 512;

__device__ __forceinline__ unsigned f2bf(float f) { unsigned u = __builtin_bit_cast(unsigned, f); return (u + 0x7fffu + ((u >> 16) & 1u)) >> 16; }
__device__ __forceinline__ unsigned pk2(float lo, float hi) { return f2bf(lo) | (f2bf(hi) << 16); }
__device__ __forceinline__ unsigned pk4_fp8(float a, float b, float c, float d) { int w = __builtin_amdgcn_cvt_pk_fp8_f32(a, b, 0, false); w = __builtin_amdgcn_cvt_pk_fp8_f32(c, d, w, true); return (unsigned)w; }
__device__ __forceinline__ float bf2f(unsigned b) { return __builtin_bit_cast(float, b << 16); }
__device__ __forceinline__ float bflo(unsigned w) { return __builtin_bit_cast(float, w << 16); }
__device__ __forceinline__ float bfhi(unsigned w) { return __builtin_bit_cast(float, w & 0xffff0000u); }
__device__ __forceinline__ float wave_sum(float v) {
#pragma unroll
    for (int o = 1; o < 64; o <<= 1) v += __shfl_xor(v, o);
    return v;
}
__device__ __forceinline__ float sigmoidf_fast(float x) { return __builtin_amdgcn_rcpf(1.0f + __builtin_amdgcn_exp2f(-x * LOG2E)); }
__device__ __forceinline__ int row_of(int b, int s) { return s < NMETA ? M_REAL + b * NMETA + s : b * SEQ + (s - NMETA); }

#define XB_TMO      128
#define XB_XCNT(j)  (256  + 64 * (j))
#define XB_XSUB(j)  (1280 + 64 * (j))
#define XB_XGEN(j)  (2304 + 64 * (j))
#define XB_TOP      3328
#define XB_TOPGEN   3392
#define XCD_BAR_WORDS 3456
#define XB_SPIN_CAP (1u << 18)
__device__ __forceinline__ unsigned xb_ld(unsigned* p)              { return __hip_atomic_load(p, __ATOMIC_RELAXED, __HIP_MEMORY_SCOPE_AGENT); }
__device__ __forceinline__ unsigned xb_add(unsigned* p, unsigned v) { return __hip_atomic_fetch_add(p, v, __ATOMIC_RELAXED, __HIP_MEMORY_SCOPE_AGENT); }
__device__ __forceinline__ unsigned xb_xcc_id() { return (unsigned)__builtin_amdgcn_s_getreg((3 << 11) | 20) & 0xFu; }
#define XB_SPIN(cond, bar) do { unsigned _sp = 0; while (cond) { __builtin_amdgcn_s_sleep(1); \
    if ((++_sp & 255u) == 0u) { if (xb_ld(&(bar)[XB_TMO])) break; if (_sp > XB_SPIN_CAP) { atomicAdd(&(bar)[XB_TMO], 1u); break; } } } } while (0)
struct XcdBarrier { unsigned* bar; unsigned x; volatile LAS unsigned* st; };
__device__ __forceinline__ XcdBarrier xcd_barrier_post(unsigned* bar, volatile LAS unsigned* st) {
    XcdBarrier b; b.bar = bar; b.x = xb_xcc_id(); b.st = st;
    if (threadIdx.x == 0) (void)xb_add(&bar[XB_XCNT(b.x)], 1u);
    return b;
}
__device__ __forceinline__ void xcd_barrier_complete(unsigned* bar, unsigned x, unsigned& nloc, unsigned& nx) {
    const unsigned G = gridDim.x * gridDim.y * gridDim.z;
    unsigned sum, cnt, mine, sp = 0u;
    for (;;) {
        sum = 0u; cnt = 0u; mine = 0u;
#pragma unroll
        for (unsigned j = 0; j < 16; ++j) { const unsigned c = xb_ld(&bar[XB_XCNT(j)]); sum += c; cnt += (c > 0u) ? 1u : 0u; mine = (j == x) ? c : mine; }
        if (sum == G) break;
        __builtin_amdgcn_s_sleep(1);
        if ((++sp & 255u) == 0u) { if (xb_ld(&bar[XB_TMO])) break; if (sp > XB_SPIN_CAP) { atomicAdd(&bar[XB_TMO], 1u); break; } }
    }
    nloc = mine > 0u ? mine : 1u; nx = cnt > 0u ? cnt : 1u;
}
__device__ __forceinline__ void xcd_barrier(const XcdBarrier& b) {
    asm volatile("s_waitcnt vmcnt(0)" ::: "memory");
    __syncthreads();
    if (threadIdx.x == 0) {
        unsigned* bar = b.bar;
        __builtin_amdgcn_s_waitcnt(0);
        unsigned nloc = b.st[0], nx = b.st[1];
        if (nloc == 0u) { xcd_barrier_complete(bar, b.x, nloc, nx); b.st[0] = nloc; b.st[1] = nx; }
        const unsigned old = xb_add(&bar[XB_XSUB(b.x)], 1u);
        const unsigned gen = old / nloc;
        if (old + 1u == (gen + 1u) * nloc) {
            __builtin_amdgcn_fence(__ATOMIC_RELEASE, "agent");
            asm volatile("s_waitcnt vmcnt(0)" ::: "memory");
            const unsigned og = xb_add(&bar[XB_TOP], 1u);
            const unsigned tg = og / nx;
            if (og + 1u == (tg + 1u) * nx) xb_add(&bar[XB_TOPGEN], 1u);
            else XB_SPIN(xb_ld(&bar[XB_TOPGEN]) == tg, bar);
            __builtin_amdgcn_fence(__ATOMIC_ACQUIRE, "agent");
            xb_add(&bar[XB_XGEN(b.x)], 1u);
            asm volatile("s_waitcnt vmcnt(0)" ::: "memory");
        } else {
            XB_SPIN(xb_ld(&bar[XB_XGEN(b.x)]) == gen, bar);
            __builtin_amdgcn_fence(__ATOMIC_ACQUIRE, "agent");
            asm volatile("s_waitcnt vmcnt(0)" ::: "memory");
        }
    }
    __syncthreads();
}

struct Args { const float* in[19]; float* out; unsigned char* ws; int ph_lo, ph_hi; };
struct Frame {
    LAS unsigned char* lds;
    int tid, lane, wave, G, bid;
    const float *x, *meta, *n1g, *w_in, *qg, *kg, *sink, *dw_w, *dw_b, *lng, *lnb, *w_out, *n2g, *wr, *rb, *wgu, *bgu, *wd, *bd;
    float* out;
    unsigned char* ws;
    gu32* ctl;
    unsigned char *WguT8, *XN2F8, *WdT8, *ACT8; bf16_t *WinT, *WoT, *WrT, *XN, *Qb, *Kb, *VT, *HC, *MIX, *XN2; unsigned char* Y8;
    int* where; int* ltok; float* lgate; float* lrstd;
};

__device__ __forceinline__ int perm32(int rho) { const int n = rho >> 4, i = rho & 15; return 8 * (i >> 2) + 4 * n + (i & 3); }
__device__ __forceinline__ int lbase_nat(int pg) { return 32 * pg; }
__device__ __forceinline__ int lbase_in(int pg) { const int tile = pg >> 3, bj = (pg >> 2) & 1, wc = pg & 3; return tile <= 2 ? tile * 256 + 64 * wc + 32 * bj : 768 + bj * 512 + (tile - 3) * 128 + 32 * wc; }
__device__ __forceinline__ int lbase_gu(int pg) { const int tile = pg >> 3, bj = (pg >> 2) & 1, wc = pg & 3; return bj * 1024 + tile * 128 + 32 * wc; }
struct P0Item { const float* W; void* WT; const float* g; int N, pg, n0, k0; bool permute; bool f8; };
__device__ __forceinline__ bool p0_decode(const Frame& F, int it, P0Item& I) {
    constexpr int I_IN = 16 * 56, I_O = 16 * 32, I_R = 16, I_GU = NE * 16 * 64, I_D = NE * 16 * 32;
    int r = it;
    if (r < I_IN) { const int pg = r % 56, kb = r / 56; I = P0Item{F.w_in, F.WinT, nullptr, IN_W, pg, lbase_in(pg), 64 * kb, true, false}; return true; } r -= I_IN;
    if (r < I_O) { const int pg = r % 32, kb = r / 32; I = P0Item{F.w_out, F.WoT, nullptr, D, pg, lbase_nat(pg), 64 * kb, true, false}; return true; } r -= I_O;
    if (r < I_R) { I = P0Item{F.wr, F.WrT, F.n2g, NE, 0, 0, 64 * r, false, false}; return true; } r -= I_R;
    if (r < I_GU) { const int e = r / (16 * 64), q = r % (16 * 64), pg = q % 64, kb = q / 64; I = P0Item{F.wgu + (size_t)e * D * 2048, F.WguT8 + (size_t)e * 2048 * D, F.n2g, 2048, pg, lbase_gu(pg), 64 * kb, true, true}; return true; } r -= I_GU;
    if (r < I_D) { const int e = r / (16 * 32), q = r % (16 * 32), pg = q % 32, kb = q / 32; I = P0Item{F.wd + (size_t)e * D * D, F.WdT8 + (size_t)e * D * D, nullptr, D, pg, lbase_nat(pg), 64 * kb, true, true}; return true; }
    return false;
}
__device__ __forceinline__ void p0_load(const P0Item& I, int lane, f32x4 (&v)[8]) {
    const float* p = I.W + (size_t)(I.k0 + (lane >> 3)) * I.N + I.n0 + 4 * (lane & 7);
#pragma unroll
    for (int i = 0; i < 8; ++i) v[i] = __builtin_nontemporal_load((const f32x4*)(p + (size_t)(8 * i) * I.N));
}
__device__ __forceinline__ void p0_store(const P0Item& I, int lane, LAS float* scr, const f32x4 (&v)[8]) {
    LAS float* w = scr + (lane >> 3) * 33 + 4 * (lane & 7);
#pragma unroll
    for (int i = 0; i < 8; ++i) { w[(8 * i) * 33 + 0] = v[i][0]; w[(8 * i) * 33 + 1] = v[i][1]; w[(8 * i) * 33 + 2] = v[i][2]; w[(8 * i) * 33 + 3] = v[i][3]; }
    asm volatile("s_waitcnt lgkmcnt(0)" ::: "memory");
    const int c = lane & 7;
    f32x4 g0 = {1.f, 1.f, 1.f, 1.f}, g1 = g0;
    if (I.g) { g0 = *(const f32x4*)(I.g + I.k0 + 8 * c); g1 = *(const f32x4*)(I.g + I.k0 + 8 * c + 4); }
    if (I.f8) { g0 *= WSCALE; g1 *= WSCALE; }
#pragma unroll
    for (int j = 0; j < 4; ++j) { const int r = (lane >> 3) + 8 * j; const int sc = I.permute ? perm32(r) : r; const LAS float* s = scr + (8 * c) * 33 + sc;
        if (I.f8) { u32x2 o; o.x = pk4_fp8(s[0 * 33] * g0[0], s[1 * 33] * g0[1], s[2 * 33] * g0[2], s[3 * 33] * g0[3]); o.y = pk4_fp8(s[4 * 33] * g1[0], s[5 * 33] * g1[1], s[6 * 33] * g1[2], s[7 * 33] * g1[3]);
            *(GAS u32x2*)((unsigned char*)I.WT + (size_t)(32 * I.pg + r) * D + I.k0 + 8 * c) = o; }
        else { u32x4 o; o.x = pk2(s[0 * 33] * g0[0], s[1 * 33] * g0[1]); o.y = pk2(s[2 * 33] * g0[2], s[3 * 33] * g0[3]); o.z = pk2(s[4 * 33] * g1[0], s[5 * 33] * g1[1]); o.w = pk2(s[6 * 33] * g1[2], s[7 * 33] * g1[3]);
            *(GAS u32x4*)((bf16_t*)I.WT + (size_t)(32 * I.pg + r) * D + I.k0 + 8 * c) = o; } }
    asm volatile("s_waitcnt lgkmcnt(0)" ::: "memory");
}
constexpr int P0_NITEMS = 16 * 56 + 16 * 32 + 16 + NE * 16 * 64 + NE * 16 * 32, P0_NMOE0 = 16 * 56 + 16 * 32 + 16;
constexpr int P3_CONV_ITEMS = 12288;
constexpr int P1_UNITS = (M_PAD / 256) * (IN_W / 256);
__device__ __forceinline__ int p0_ndef(int G) { return 0; }
__device__ __forceinline__ void p0_items(Frame& F, int first, int step, int end) {
    LAS float* scr = (LAS float*)(F.lds + F.wave * 16384);
    const int lane = F.lane;
    P0Item c0, c1, c2; f32x4 va[8], vb[8], vc[8];
    int it = first; bool v0 = it < end && p0_decode(F, it, c0);
    if (v0) p0_load(c0, lane, va);
    it += step; bool v1 = v0 && it < end && p0_decode(F, it, c1);
    if (v1) p0_load(c1, lane, vb);
    while (v0) {
        it += step; const bool v2 = v1 && it < end && p0_decode(F, it, c2);
        if (v2) p0_load(c2, lane, vc);
        p0_store(c0, lane, scr, va);
        c0 = c1; c1 = c2; v0 = v1; v1 = v2;
#pragma unroll
        for (int i = 0; i < 8; ++i) { va[i] = vb[i]; vb[i] = vc[i]; }
    }
}
__device__ __forceinline__ void p0_prologue(Frame& F) {
    const int gw = F.bid * NWAVES + F.wave, NGW = F.G * NWAVES, lane = F.lane;
    p0_items(F, gw, NGW, P0_NMOE0);
    const GAS f32x4* gr = (const GAS f32x4*)F.n1g + lane;
    for (int m0 = 2 * gw; m0 < M_PAD; m0 += 2 * NGW) {
        f32x4 v[2][4]; float ss[2];
#pragma unroll
        for (int u = 0; u < 2; ++u) { const int m = m0 + u; ss[u] = 0.f;
            if (m < M_ALL) { const float* src = m < M_REAL ? F.x + (size_t)m * D : F.meta + (size_t)((m - M_REAL) & (NMETA - 1)) * D; const GAS f32x4* xr = (const GAS f32x4*)src + lane;
#pragma unroll
                for (int j = 0; j < 4; ++j) v[u][j] = xr[64 * j]; }
            else {
#pragma unroll
                for (int j = 0; j < 4; ++j) v[u][j] = (f32x4){0.f, 0.f, 0.f, 0.f}; } }
#pragma unroll
        for (int u = 0; u < 2; ++u) {
#pragma unroll
            for (int j = 0; j < 4; ++j) ss[u] += (v[u][j].x * v[u][j].x + v[u][j].y * v[u][j].y) + (v[u][j].z * v[u][j].z + v[u][j].w * v[u][j].w);
            const float rstd = 1.f / sqrtf(wave_sum(ss[u]) * (1.f / D) + 1e-6f);
            GAS unsigned long long* o8 = (GAS unsigned long long*)(F.XN + (size_t)(m0 + u) * D) + lane;
#pragma unroll
            for (int j = 0; j < 4; ++j) { const f32x4 g = gr[64 * j]; o8[64 * j] = (unsigned long long)pk2(v[u][j].x * rstd * g.x, v[u][j].y * rstd * g.y) | ((unsigned long long)pk2(v[u][j].z * rstd * g.z, v[u][j].w * rstd * g.w) << 32); }
        }
    }
}

namespace pg8 {
constexpr int BM = 256, BK = 64, HALF = 128, HTB = HALF * BK * 2, STAGE_BYTES = 8 * HTB, NXCD = 8, WGM = 8, KD = 1024;
__device__ __forceinline__ int lds_byte(int r, int c) { const int st = (r >> 4) * 2 + (c >> 5), rr = r & 15, cc = c & 31, ob = rr * 64 + cc * 2; return st * 1024 + (ob ^ (((ob >> 9) & 1) << 5)); }
__device__ __forceinline__ void stage_rc(int b, int& R, int& C) { const int st = b / 1024, sb = b % 1024, swz = sb ^ (((sb >> 9) & 1) << 5); R = (st >> 1) * 16 + swz / 64; C = (st & 1) * 32 + (swz % 64) / 2; }
struct Unit { int pm, pn, e, slot0, nvalid, r0; };
__device__ __forceinline__ unsigned cvt_pk_bf16(float lo, float hi) { unsigned r; asm volatile("v_cvt_pk_bf16_f32 %0, %1, %2" : "=v"(r) : "v"(lo), "v"(hi)); return r; }
__device__ __forceinline__ u32x4 pack8(const f32x4 a, const f32x4 b) { u32x4 w; w.x = cvt_pk_bf16(a[0], a[1]); w.y = cvt_pk_bf16(a[2], a[3]); w.z = cvt_pk_bf16(b[0], b[1]); w.w = cvt_pk_bf16(b[2], b[3]); return w; }

template <bool HALVES, int nN>
__device__ __forceinline__ bool tile_order(int i, int G, int c, int nM, int& pm, int& pn, int& half) {
    const int nwg = nM * nN; int L = i * G + c; half = -1;
    if (HALVES) { const int nfull = ((G & (G - 1)) == 0) ? (nwg & ~(G - 1)) : (nwg / G) * G, left = nwg - nfull;
        if (left > 0 && 2 * left <= G && L >= nfull) { const int hidx = L - nfull; if (hidx >= 2 * left) return false; L = nfull + (hidx >> 1); half = hidx & 1; } }
    if (L >= nwg) return false;
    int wgid = L; { const int q = nwg >> 3, r = nwg & 7, xcd = wgid & 7, off = wgid >> 3; wgid = (xcd < r ? xcd * (q + 1) : r * (q + 1) + (xcd - r) * q) + off; }
    constexpr int nig = WGM * nN; const int gid = wgid / nig, rem = wgid - gid * nig, fm = gid * WGM, gsz = (nM - fm) < WGM ? (nM - fm) : WGM;
    if (gsz == WGM) { pm = fm + (rem & (WGM - 1)); pn = rem >> 3; } else { pm = fm + rem % gsz; pn = rem / gsz; }
    return true;
}
template <int nN> struct DenseProb {
    static constexpr int RB = KD * 2;
    const bf16_t* A; const bf16_t* Bt; int nM, G, c;
    __device__ __forceinline__ bool next(int i, Unit& u) const { u.e = 0; u.slot0 = 0; u.nvalid = 256; u.r0 = 0; int half; return tile_order<false, nN>(i, G, c, nM, u.pm, u.pn, half); }
    __device__ __forceinline__ void addr_load(const Unit&, const int (&)[2], int (&)[4]) const {}
    __device__ __forceinline__ void addr_finish(const Unit& u, const int (&R)[2], const int (&C)[2], const int (&)[4], const char*& a, const char*& b, unsigned (&va0)[2], unsigned (&va1)[2]) const {
        a = (const char*)A + (size_t)u.pm * (BM * RB); b = (const char*)Bt + (size_t)u.pn * (BM * RB);
#pragma unroll
        for (int i = 0; i < 2; ++i) { va0[i] = (unsigned)(R[i] * RB + C[i] * 2); va1[i] = va0[i] + (unsigned)(HALF * RB); }
    }
};
template <bool GATHER, int ES, int nN> struct GroupedProb {
    static constexpr int RB = KD * ES;
    const void* A; const void* Bt; const int* ltok; const LAS int* tb; const LAS int* cn; int G, c;
    __device__ __forceinline__ bool next(int i, Unit& u) const {
        const LAS int* hb = tb + (LX_HB - LX_TB) / 4; const LAS int* lb = tb + (LX_LB - LX_TB) / 4;
        const int H = __builtin_amdgcn_readfirstlane(hb[NE]), Lt = __builtin_amdgcn_readfirstlane(lb[NE]), HU = H * nN, LU = Lt * nN;
        const int L = i * G + c, nfull = ((G & (G - 1)) == 0) ? (HU & ~(G - 1)) : (HU / G) * G, r = HU - nfull;
        const bool tail_half = r > 0 && 2 * r + LU <= G;
        int half = -1, idx; bool light = false;
        if (L < nfull) idx = L;
        else { const int Lp = L - nfull;
            if (tail_half) { if (Lp < 2 * r) { idx = nfull + (Lp >> 1); half = Lp & 1; } else { light = true; idx = Lp - 2 * r; } }
            else { if (Lp < r) idx = nfull + Lp; else { light = true; idx = Lp - r; } } }
        const int j = (int)(threadIdx.x & 31); int e;
        if (light) { if (idx >= LU) return false; const int le = idx / nN; u.pn = idx % nN;
            const unsigned long long hit = __ballot(lb[j] == le && lb[j + 1] == le + 1); e = __builtin_amdgcn_readfirstlane((int)__builtin_ctzll(hit | (1ull << 63)) & 31);
            u.pm = __builtin_amdgcn_readfirstlane(tb[e + 1]) - 1;
        } else { int wgid = idx; { const int q = HU >> 3, rr = HU & 7, xcd = wgid & 7, off = wgid >> 3; wgid = (xcd < rr ? xcd * (q + 1) : rr * (q + 1) + (xcd - rr) * q) + off; }
            constexpr int nig = WGM * nN; const int gid = wgid / nig, rem = wgid - gid * nig, fm = gid * WGM, gsz = (H - fm) < WGM ? (H - fm) : WGM; int ht;
            if (gsz == WGM) { ht = fm + (rem & (WGM - 1)); u.pn = rem >> 3; } else { ht = fm + rem % gsz; u.pn = rem / gsz; }
            const unsigned long long hit = __ballot(hb[j] <= ht && ht < hb[j + 1]); e = __builtin_amdgcn_readfirstlane((int)__builtin_ctzll(hit | (1ull << 63)) & 31);
            u.pm = __builtin_amdgcn_readfirstlane(tb[e]) + (ht - __builtin_amdgcn_readfirstlane(hb[e])); }
        const int t0 = __builtin_amdgcn_readfirstlane(tb[e]), ce = __builtin_amdgcn_readfirstlane(cn[e]);
        u.e = e; u.r0 = half == 1 ? HALF : 0; u.slot0 = (u.pm - t0) * 256 + u.r0; int rem2 = ce - u.slot0; const int lim = half >= 0 ? HALF : 256; rem2 = rem2 < lim ? rem2 : lim; u.nvalid = rem2 < 0 ? 0 : rem2; return true;
    }
    __device__ __forceinline__ void addr_load(const Unit& u, const int (&R)[2], int (&raw)[4]) const {
        if (GATHER) { const int* lt = ltok + u.e * CAP + u.slot0;
#pragma unroll
            for (int i = 0; i < 2; ++i) { const int r0 = R[i], r1 = R[i] + HALF; raw[2 * i] = r0 < u.nvalid ? lt[r0] : 0; raw[2 * i + 1] = r1 < u.nvalid ? lt[r1] : 0; } }
    }
    __device__ __forceinline__ void addr_finish(const Unit& u, const int (&R)[2], const int (&C)[2], const int (&raw)[4], const char*& a, const char*& b, unsigned (&va0)[2], unsigned (&va1)[2]) const {
        b = (const char*)Bt + ((size_t)u.e * nN + u.pn) * (BM * RB);
        if (GATHER) { a = (const char*)A;
#pragma unroll
            for (int i = 0; i < 2; ++i) { va0[i] = (unsigned)(raw[2 * i] * RB + C[i] * 2); va1[i] = (unsigned)(raw[2 * i + 1] * RB + C[i] * 2); }
        } else { a = (const char*)A + (size_t)(u.pm * BM + u.r0) * RB;
#pragma unroll
            for (int i = 0; i < 2; ++i) { va0[i] = (unsigned)(R[i] * RB + C[i] * 2); va1[i] = va0[i] + (unsigned)(HALF * RB); }
        }
    }
};

template <int ES  , class Prob, class Epi>
__device__ __forceinline__ void gemm_phase(LAS unsigned char* lds, const Prob& P, const Epi& E) {
    const int tid = threadIdx.x, wid = __builtin_amdgcn_readfirstlane(tid >> 6), lane = tid & 63, wr = wid >> 2, wc = wid & 3, fr = lane & 15, fq = lane >> 4;
    constexpr int RB = KD * ES, nt = RB / (BK * 2);
    int R[2], C[2]; unsigned voffB[2];
#pragma unroll
    for (int i = 0; i < 2; ++i) { stage_rc(tid * 16 + i * 8192, R[i], C[i]); voffB[i] = (unsigned)(R[i] * RB + C[i] * 2); }
    constexpr size_t kstep = (size_t)(BK * 2);
    constexpr size_t hstep = (size_t)HALF * RB;
    const unsigned ldsw = (unsigned)wid * 1024u;
    const int aoff = lds_byte(wr * 64 + fr, fq * 8), boff = lds_byte(wc * 32 + fr, fq * 8);
#define PG8_SA(b, h) (((b) * 2 + (h)) * HTB)
#define PG8_SB(b, h) ((4 + (b) * 2 + (h)) * HTB)
#define PG8_STAGE(bufoff, gbase, voff) do { _Pragma("unroll") for (int _i = 0; _i < 2; ++_i) \
        __builtin_amdgcn_global_load_lds((const unsigned*)((const char*)(gbase) + (voff)[_i]), (LAS unsigned*)(lds + (bufoff) + ldsw + _i * 8192), 16, 0, 0); } while (0)
#define PG8_LDA(dst, b, h) do { _Pragma("unroll") for (int m = 0; m < 4; ++m) { \
        if constexpr (ES == 2) { _Pragma("unroll") for (int k = 0; k < 2; ++k) dst[m][k] = *(const LAS bf16x8*)(lds + PG8_SA(b, h) + aoff + m * 2048 + k * 1024); } \
        else { const i32x4 lo_ = *(const LAS i32x4*)(lds + PG8_SA(b, h) + aoff + m * 2048), hi_ = *(const LAS i32x4*)(lds + PG8_SA(b, h) + aoff + m * 2048 + 1024); dst##8[m] = __builtin_shufflevector(lo_, hi_, 0, 1, 2, 3, 4, 5, 6, 7); } } } while (0)
#define PG8_LDB(dst, b, h) do { _Pragma("unroll") for (int n = 0; n < 2; ++n) { \
        if constexpr (ES == 2) { _Pragma("unroll") for (int k = 0; k < 2; ++k) dst[n][k] = *(const LAS bf16x8*)(lds + PG8_SB(b, h) + boff + n * 2048 + k * 1024); } \
        else { const i32x4 lo_ = *(const LAS i32x4*)(lds + PG8_SB(b, h) + boff + n * 2048), hi_ = *(const LAS i32x4*)(lds + PG8_SB(b, h) + boff + n * 2048 + 1024); dst##8[n] = __builtin_shufflevector(lo_, hi_, 0, 1, 2, 3, 4, 5, 6, 7); } } } while (0)
#define PG8_MMA(ai, bj, At, Bt) do { __builtin_amdgcn_s_setprio(1); _Pragma("unroll") for (int m = 0; m < 4; ++m) _Pragma("unroll") for (int n = 0; n < 2; ++n) { \
        if constexpr (ES == 2) { _Pragma("unroll") for (int k = 0; k < 2; ++k) acc[ai][bj][m][n] = __builtin_amdgcn_mfma_f32_16x16x32_bf16(Bt[n][k], At[m][k], acc[ai][bj][m][n], 0, 0, 0); } \
        else asm volatile("s_nop 1\n\tv_mfma_scale_f32_16x16x128_f8f6f4 %0, %1, %2, %0, %3, %3 op_sel_hi:[0,0,0]" : "+v"(acc[ai][bj][m][n]) : "v"(Bt##8[n]), "v"(At##8[m]), "v"(sc127)); } \
        __builtin_amdgcn_s_setprio(0); } while (0)
#define PG8_WAIT_V(n) asm volatile("s_waitcnt vmcnt(" #n ")" ::: "memory")
#define PG8_WAIT_L(n) do { asm volatile("s_waitcnt lgkmcnt(" #n ")" ::: "memory"); __builtin_amdgcn_s_waitcnt(0xC07F); } while (0)
#define PG8_BAR __builtin_amdgcn_s_barrier()
#define PG8_SCHED __builtin_amdgcn_sched_barrier(0)
    Unit cur, nxt, nn; int ui = 0; int raw[4] = {0, 0, 0, 0};
    if (!P.next(0, cur)) return;
    bool has_next = P.next(1, nxt);
    const char *cA, *cB, *nA, *nB; unsigned va0[2], va1[2], nva0[2], nva1[2];
    P.addr_load(cur, R, raw); P.addr_finish(cur, R, C, raw, cA, cB, va0, va1);
    if (has_next) { P.addr_load(nxt, R, raw); P.addr_finish(nxt, R, C, raw, nA, nB, nva0, nva1); }
    else { nA = cA; nB = cB; nva0[0] = va0[0]; nva0[1] = va0[1]; nva1[0] = va1[0]; nva1[1] = va1[1]; }
    f32x4 acc[2][2][4][2];
#pragma unroll
    for (int a = 0; a < 2; ++a)
#pragma unroll
        for (int b = 0; b < 2; ++b)
#pragma unroll
            for (int m = 0; m < 4; ++m)
#pragma unroll
                for (int n = 0; n < 2; ++n) acc[a][b][m][n] = (f32x4){0.f, 0.f, 0.f, 0.f};
    const int sc127 = 0x7F7F7F7F;
    bf16x8 At[4][2], B0[2][2], B1[2][2]; i32x8 At8[4], B08[2], B18[2];
    PG8_STAGE(PG8_SB(0, 0), cB, voffB); PG8_STAGE(PG8_SB(0, 1), cB + hstep, voffB); PG8_STAGE(PG8_SA(0, 0), cA, va0); PG8_STAGE(PG8_SA(0, 1), cA, va1);
    if (wr == 1) PG8_BAR;
    PG8_WAIT_V(2); PG8_BAR;
    PG8_STAGE(PG8_SB(1, 0), cB + kstep, voffB); PG8_STAGE(PG8_SA(1, 0), cA + kstep, va0); PG8_STAGE(PG8_SB(1, 1), cB + hstep + kstep, voffB);
    PG8_WAIT_V(6); PG8_BAR;
    for (;;) {
        const bool full = cur.nvalid > HALF;
#pragma unroll 1
        for (int t = 0; t < nt; t += 2) {
            const bool last = (t == nt - 2);
            const char* a1 = cA + (size_t)(t + 1) * kstep;
            const char* a2 = last ? nA : cA + (size_t)(t + 2) * kstep; const char* b2 = last ? nB : cB + (size_t)(t + 2) * kstep;
            const char* a3 = a2 + kstep; const char* b3 = b2 + kstep;
            unsigned v2a0[2], v2a1[2];
            v2a0[0] = last ? nva0[0] : va0[0]; v2a0[1] = last ? nva0[1] : va0[1]; v2a1[0] = last ? nva1[0] : va1[0]; v2a1[1] = last ? nva1[1] : va1[1];
            PG8_LDB(B0, 0, 0); PG8_LDB(B1, 0, 1); PG8_SCHED; PG8_LDA(At, 0, 0); PG8_STAGE(PG8_SA(1, 1), a1, va1);
            PG8_WAIT_V(8); PG8_WAIT_L(0); PG8_BAR; PG8_MMA(0, 0, At, B0); PG8_MMA(0, 1, At, B1); PG8_BAR; PG8_SCHED;
            PG8_LDA(At, 0, 1); PG8_STAGE(PG8_SB(0, 0), b2, voffB); PG8_STAGE(PG8_SB(0, 1), b2 + hstep, voffB); PG8_STAGE(PG8_SA(0, 0), a2, v2a0);
            PG8_WAIT_V(8); PG8_WAIT_L(0); PG8_BAR; if (full) { PG8_MMA(1, 0, At, B0); PG8_MMA(1, 1, At, B1); } PG8_BAR; PG8_SCHED;
            PG8_LDB(B0, 1, 0); PG8_LDB(B1, 1, 1); PG8_SCHED; PG8_LDA(At, 1, 0); PG8_STAGE(PG8_SA(0, 1), a2, v2a1);
            PG8_WAIT_V(8); PG8_WAIT_L(0); PG8_BAR; PG8_MMA(0, 0, At, B0); PG8_MMA(0, 1, At, B1); PG8_BAR; PG8_SCHED;
            PG8_LDA(At, 1, 1); PG8_STAGE(PG8_SB(1, 0), b3, voffB); PG8_STAGE(PG8_SB(1, 1), b3 + hstep, voffB); PG8_STAGE(PG8_SA(1, 0), a3, v2a0);
            PG8_WAIT_V(8); PG8_WAIT_L(0); PG8_BAR; if (full) { PG8_MMA(1, 0, At, B0); PG8_MMA(1, 1, At, B1); } PG8_BAR; PG8_SCHED;
        }
        if constexpr (ES == 1) { asm volatile("s_nop 15\n\ts_nop 15" ::: "memory"); __builtin_amdgcn_sched_barrier(0); }
        const bool has_nn = has_next && P.next(ui + 2, nn);
        if (has_nn) P.addr_load(nn, R, raw);
        if (wr == 0) PG8_BAR;
        E(acc, cur, wr, wc, fr, fq);
        if (!has_next) break;
#pragma unroll
        for (int a = 0; a < 2; ++a)
#pragma unroll
            for (int b = 0; b < 2; ++b)
#pragma unroll
                for (int m = 0; m < 4; ++m)
#pragma unroll
                    for (int n = 0; n < 2; ++n) acc[a][b][m][n] = (f32x4){0.f, 0.f, 0.f, 0.f};
        cur = nxt; cA = nA; cB = nB; va0[0] = nva0[0]; va0[1] = nva0[1]; va1[0] = nva1[0]; va1[1] = nva1[1]; ++ui;
        nxt = nn; has_next = has_nn;
        if (has_next) P.addr_finish(nxt, R, C, raw, nA, nB, nva0, nva1);
        if (wr == 1) PG8_BAR;
    }
    PG8_WAIT_V(0);
    PG8_BAR;
#undef PG8_SA
#undef PG8_SB
#undef PG8_STAGE
#undef PG8_LDA
#undef PG8_LDB
#undef PG8_MMA
#undef PG8_WAIT_V
#undef PG8_WAIT_L
#undef PG8_BAR
#undef PG8_SCHED
}

struct EpiOut {
    const float* x; float* out; bf16_t* xn2; unsigned char* xn2f8;
    __device__ __forceinline__ void operator()(const f32x4 (&acc)[2][2][4][2], const Unit& u, int wr, int wc, int fr, int fq) const {
        const int row0 = u.pm * BM + wr * 64 + fr, col0 = u.pn * BM + wc * 32 + 8 * fq;
#pragma unroll
        for (int ai = 0; ai < 2; ++ai)
#pragma unroll
            for (int m = 0; m < 4; ++m) { const size_t off = (size_t)(row0 + ai * HALF + m * 16) * D + col0;
#pragma unroll
                for (int bj = 0; bj < 2; ++bj) { const float* xp = x + off + bj * HALF;
                    const f32x4 h0 = acc[ai][bj][m][0] + *(const f32x4*)xp, h1 = acc[ai][bj][m][1] + *(const f32x4*)(xp + 4);
                    *(u32x4*)(xn2 + off + bj * HALF) = pack8(h0, h1);
                    *(u32x2*)(xn2f8 + off + bj * HALF) = (u32x2){pk4_fp8(h0[0], h0[1], h0[2], h0[3]), pk4_fp8(h1[0], h1[1], h1[2], h1[3])}; }
                asm volatile("" ::: "memory"); }
    }
};
struct EpiIn {
    bf16_t *Qb, *Kb, *VT, *HC; const float *qg, *kg;
    __device__ __forceinline__ void operator()(const f32x4 (&acc)[2][2][4][2], const Unit& u, int wr, int wc, int fr, int fq) const {
        const int rowb = u.pm * BM + wr * 64 + fr;
        if (u.pn <= 2) {
            const bool isv = (u.pn == 2) && (wc >= 2);
            if (!isv) {
                const bool isq = u.pn < 2; const float* g = isq ? qg : kg; const float sc = isq ? QSCALE : 1.f;
                f32x4 gv[2][2];
#pragma unroll
                for (int bj = 0; bj < 2; ++bj)
#pragma unroll
                    for (int n = 0; n < 2; ++n) gv[bj][n] = *(const f32x4*)(g + 32 * bj + 8 * fq + 4 * n) * sc;
                bf16_t* dst = isq ? Qb + (u.pn * 256 + 64 * wc) : Kb + 64 * wc; const int ld = isq ? 512 : 128;
#pragma unroll
                for (int ai = 0; ai < 2; ++ai)
#pragma unroll
                    for (int m = 0; m < 4; ++m) { const int row = rowb + ai * HALF + m * 16; float ss = 0.f;
#pragma unroll
                        for (int bj = 0; bj < 2; ++bj)
#pragma unroll
                            for (int n = 0; n < 2; ++n) { const f32x4 v = acc[ai][bj][m][n]; ss += (v[0] * v[0] + v[1] * v[1]) + (v[2] * v[2] + v[3] * v[3]); }
                        ss += __shfl_xor(ss, 16); ss += __shfl_xor(ss, 32);
                        const float r = __builtin_amdgcn_rsqf(ss * (1.f / 64.f) + 1e-6f);
#pragma unroll
                        for (int bj = 0; bj < 2; ++bj) *(u32x4*)(dst + (size_t)row * ld + 32 * bj + 8 * fq) = pack8(acc[ai][bj][m][0] * r * gv[bj][0], acc[ai][bj][m][1] * r * gv[bj][1]); }
            } else {
                const int hk = wc - 2;
#pragma unroll
                for (int ai = 0; ai < 2; ++ai)
#pragma unroll
                    for (int m = 0; m < 4; ++m) { const int row = rowb + ai * HALF + m * 16;
                        if (row < M_ALL) { int b, kx; if (row < M_REAL) { b = row >> 11; kx = NMETA + (row & 2047); } else { b = (row - M_REAL) >> 4; kx = (row - M_REAL) & 15; }
                            bf16_t* base = VT + (size_t)(b * 2 + hk) * 64 * VT_PITCH + kx;
#pragma unroll
                            for (int bj = 0; bj < 2; ++bj)
#pragma unroll
                                for (int n = 0; n < 2; ++n)
#pragma unroll
                                    for (int e = 0; e < 4; ++e) base[(size_t)(32 * bj + 8 * fq + 4 * n + e) * VT_PITCH] = (bf16_t)f2bf(acc[ai][bj][m][n][e]); } }
            }
        } else {
            const int col = (u.pn - 3) * 128 + 32 * wc + 8 * fq;
#pragma unroll
            for (int ai = 0; ai < 2; ++ai)
#pragma unroll
                for (int m = 0; m < 4; ++m) { const int row = rowb + ai * HALF + m * 16; f32x4 h[2];
#pragma unroll
                    for (int n = 0; n < 2; ++n)
#pragma unroll
                        for (int e = 0; e < 4; ++e) h[n][e] = acc[ai][0][m][n][e] * sigmoidf_fast(acc[ai][1][m][n][e]);
                    *(u32x4*)(HC + (size_t)row * 512 + col) = pack8(h[0], h[1]); }
        }
    }
};
struct EpiGU {
    unsigned char* ACT; const float* lrstd; const float* bgu;
    __device__ __forceinline__ void operator()(const f32x4 (&acc)[2][2][4][2], const Unit& u, int wr, int wc, int fr, int fq) const {
        const int lr0 = wr * 64 + fr, col = u.pn * 128 + 32 * wc + 8 * fq;
        f32x2 bg[2][2], bu[2][2];
#pragma unroll
        for (int n = 0; n < 2; ++n) { const f32x4 g4 = *(const f32x4*)(bgu + u.e * 2048 + col + 4 * n), u4 = *(const f32x4*)(bgu + u.e * 2048 + 1024 + col + 4 * n);
            bg[n][0] = (f32x2){g4[0], g4[1]}; bg[n][1] = (f32x2){g4[2], g4[3]}; bu[n][0] = (f32x2){u4[0], u4[1]}; bu[n][1] = (f32x2){u4[2], u4[3]}; }
        const float* rs = lrstd + u.e * CAP + u.slot0;
#pragma unroll
        for (int ai = 0; ai < 2; ++ai) {
            if (ai == 1 && u.nvalid <= HALF) break;
#pragma unroll
            for (int m = 0; m < 4; ++m) { const int lr = lr0 + ai * HALF + m * 16; const float rstd = lr < u.nvalid ? rs[lr] * (1.f / WSCALE) : 0.f; f32x2 h[2][2];
#pragma unroll
                for (int n = 0; n < 2; ++n)
#pragma unroll
                    for (int p = 0; p < 2; ++p) {
                        f32x2 gt = (f32x2){acc[ai][0][m][n][2 * p], acc[ai][0][m][n][2 * p + 1]} * rstd + bg[n][p];
                        f32x2 up = (f32x2){acc[ai][1][m][n][2 * p], acc[ai][1][m][n][2 * p + 1]} * rstd + bu[n][p];
                        gt.x = fminf(gt.x, 7.f); gt.y = fminf(gt.y, 7.f); up.x = __builtin_amdgcn_fmed3f(up.x, -7.f, 7.f); up.y = __builtin_amdgcn_fmed3f(up.y, -7.f, 7.f);
                        const f32x2 z = gt * (-1.702f * LOG2E); f32x2 ex; ex.x = __builtin_amdgcn_exp2f(z.x); ex.y = __builtin_amdgcn_exp2f(z.y);
                        const f32x2 dn = ex + 1.0f; f32x2 rc; rc.x = __builtin_amdgcn_rcpf(dn.x); rc.y = __builtin_amdgcn_rcpf(dn.y);
                        const f32x2 t = gt * rc; h[n][p] = t * up + t; }
                *(u32x2*)(ACT + (size_t)(u.pm * BM + u.r0 + lr) * D + col) = (u32x2){pk4_fp8(h[0][0].x, h[0][0].y, h[0][1].x, h[0][1].y), pk4_fp8(h[1][0].x, h[1][0].y, h[1][1].x, h[1][1].y)}; }
        }
    }
};
struct EpiDown {
    unsigned char* Y; const float* lgate; const float* bd;
    __device__ __forceinline__ void operator()(const f32x4 (&acc)[2][2][4][2], const Unit& u, int wr, int wc, int fr, int fq) const {
        const int lr0 = wr * 64 + fr, col0 = u.pn * BM + wc * 32 + 8 * fq;
        f32x4 bv[2][2];
#pragma unroll
        for (int bj = 0; bj < 2; ++bj)
#pragma unroll
            for (int n = 0; n < 2; ++n) bv[bj][n] = *(const f32x4*)(bd + u.e * D + col0 + bj * HALF + 4 * n);
        const float* gs = lgate + u.e * CAP + u.slot0;
#pragma unroll
        for (int ai = 0; ai < 2; ++ai)
#pragma unroll
            for (int m = 0; m < 4; ++m) { if (ai == 1 && u.nvalid <= HALF) continue; const int lr = lr0 + ai * HALF + m * 16; const float gt = lr < u.nvalid ? gs[lr] : 0.f;
#pragma unroll
                for (int bj = 0; bj < 2; ++bj) { const f32x4 y0 = (acc[ai][bj][m][0] * (1.f / WSCALE) + bv[bj][0]) * gt, y1 = (acc[ai][bj][m][1] * (1.f / WSCALE) + bv[bj][1]) * gt;
                    *(u32x2*)(Y + (size_t)(u.pm * BM + u.r0 + lr) * D + col0 + bj * HALF) = (u32x2){pk4_fp8(y0[0], y0[1], y0[2], y0[3]), pk4_fp8(y1[0], y1[1], y1[2], y1[3])}; } }
    }
};
}


constexpr int ATT_KIMG = 0, ATT_VIMG = 53248, ATT_VP = 840;
constexpr float ATT_THR = 4.0f;
struct AttHead { float m, l, slope2; f32x16 O0, O1; };
template <int MODE>
__device__ __forceinline__ void att_softmax(f32x16& s, AttHead& H, float Bq, float lim, bf16x8 (&pf)[2]) {
    float tmax = -INFINITY;
#pragma unroll
    for (int r = 0; r < 16; ++r) {
        if (MODE == 0) { if (r >= 8) s[r] = -INFINITY; }
        else { const float dl = fabsf(Bq - (float)((r & 3) + 8 * (r >> 2))); const float v = s[r] - H.slope2 * dl; s[r] = dl <= lim ? v : -INFINITY; }
        tmax = fmaxf(tmax, s[r]);
    }
    tmax = fmaxf(tmax, __shfl_xor(tmax, 32));
    if (__any(tmax > H.m + ATT_THR)) { const float mn = fmaxf(H.m, tmax); const float al = __builtin_amdgcn_exp2f(H.m - mn); H.m = mn; H.l *= al;
#pragma unroll
        for (int r = 0; r < 16; ++r) { H.O0[r] *= al; H.O1[r] *= al; } }
    float ps = 0.f;
#pragma unroll
    for (int r = 0; r < 16; ++r) { s[r] = __builtin_amdgcn_exp2f(s[r] - H.m); ps += s[r]; }
    H.l += ps;
#pragma unroll
    for (int s2 = 0; s2 < 2; ++s2) { u32x4 pw; pw.x = pg8::cvt_pk_bf16(s[8 * s2 + 0], s[8 * s2 + 1]); pw.y = pg8::cvt_pk_bf16(s[8 * s2 + 2], s[8 * s2 + 3]); pw.z = pg8::cvt_pk_bf16(s[8 * s2 + 4], s[8 * s2 + 5]); pw.w = pg8::cvt_pk_bf16(s[8 * s2 + 6], s[8 * s2 + 7]);
        pf[s2] = __builtin_bit_cast(bf16x8, pw); }
}
template <int MODE>
__device__ __forceinline__ void att_tile2(const LAS unsigned char* kbase, const int (&koff)[4], const LAS unsigned char* vbase, const bf16x8 (&qa)[4], const bf16x8 (&qb)[4], float Bq, float lim, AttHead& A, AttHead& B) {
    f32x16 sa, sb;
#pragma unroll
    for (int r = 0; r < 16; ++r) { sa[r] = 0.f; sb[r] = 0.f; }
#pragma unroll
    for (int ks = 0; ks < 4; ++ks) { const bf16x8 kf = *(const LAS bf16x8*)(kbase + koff[ks]);
        sa = __builtin_amdgcn_mfma_f32_32x32x16_bf16(kf, qa[ks], sa, 0, 0, 0); sb = __builtin_amdgcn_mfma_f32_32x32x16_bf16(kf, qb[ks], sb, 0, 0, 0); }
    bf16x8 pa[2], pb[2];
    att_softmax<MODE>(sa, A, Bq, lim, pa);
    att_softmax<MODE>(sb, B, Bq, lim, pb);
#pragma unroll
    for (int s2 = 0; s2 < 2; ++s2) {
        { const u32x2 lo = *(const LAS u32x2*)(vbase + s2 * 32), hi = *(const LAS u32x2*)(vbase + s2 * 32 + 16); const bf16x8 vf = __builtin_bit_cast(bf16x8, (u32x4){lo.x, lo.y, hi.x, hi.y});
          A.O0 = __builtin_amdgcn_mfma_f32_32x32x16_bf16(vf, pa[s2], A.O0, 0, 0, 0); B.O0 = __builtin_amdgcn_mfma_f32_32x32x16_bf16(vf, pb[s2], B.O0, 0, 0, 0); }
        { const u32x2 lo = *(const LAS u32x2*)(vbase + 32 * ATT_VP + s2 * 32), hi = *(const LAS u32x2*)(vbase + 32 * ATT_VP + s2 * 32 + 16); const bf16x8 vf = __builtin_bit_cast(bf16x8, (u32x4){lo.x, lo.y, hi.x, hi.y});
          A.O1 = __builtin_amdgcn_mfma_f32_32x32x16_bf16(vf, pa[s2], A.O1, 0, 0, 0); B.O1 = __builtin_amdgcn_mfma_f32_32x32x16_bf16(vf, pb[s2], B.O1, 0, 0, 0); }
    }
}
__device__ __forceinline__ void att_fast(Frame& F) {
    LAS unsigned char* Kimg = F.lds + ATT_KIMG; LAS unsigned char* Vimg = F.lds + ATT_VIMG;
    const int tid = F.tid, lane = F.lane, wid = F.wave, q = lane & 31, h = lane >> 5, qt = wid & 3, hsel = wid >> 2;
    int koff[4];
#pragma unroll
    for (int ks = 0; ks < 4; ++ks) koff[ks] = ((2 * ks + h) ^ ((q >> 1) & 7)) << 4;
    const int vb = (F.G & 7) == 0 ? (F.bid & 7) * (F.G >> 3) + (F.bid >> 3) : F.bid;
    for (int item = vb; item < NB * 16 * 2; item += F.G) {
        const int hk = item & 1, i = (item >> 1) & 15, b = item >> 5;
        const int row = b * SEQ + i * 128 + 32 * qt + q;
        bf16x8 qf[2][4];
#pragma unroll
        for (int hp = 0; hp < 2; ++hp)
#pragma unroll
            for (int ks = 0; ks < 4; ++ks) qf[hp][ks] = *(const GAS bf16x8*)(F.Qb + (size_t)row * 512 + (hk * 4 + hp * 2 + hsel) * 64 + 16 * ks + 8 * h);
        __syncthreads();
        {
            const int c8 = tid & 7, r64 = tid >> 3; u32x4 kv[7], vv[7];
            const bf16_t* vrow = F.VT + (size_t)((b * 2 + hk) * 64 + r64) * VT_PITCH;
#pragma unroll
            for (int it = 0; it < 7; ++it) { const int kr = r64 + 64 * it; int pos = (i - 1) * 128 + kr - 32; pos = pos < 0 ? 0 : (pos >= SEQ ? SEQ - 1 : pos);
                const int row = kr < 16 ? M_REAL + b * NMETA + kr : b * SEQ + pos;
                kv[it] = *(const GAS u32x4*)(F.Kb + (size_t)row * 128 + hk * 64 + 8 * c8); }
#pragma unroll
            for (int it = 0; it < 7; ++it) { const int c = c8 + 8 * it, cc = c - 4, blk = cc >> 4, w = cc & 15, pos0 = (i - 1 + blk) * 128; const bool inr = c >= 4 && c < 52 && pos0 >= 0 && pos0 < SEQ;
                const bf16_t* src = inr ? vrow + NMETA + pos0 + 8 * w : vrow + 8 * (c & 1);
                vv[it] = *(const GAS u32x4*)src; }
#pragma unroll
            for (int it = 0; it < 7; ++it) { const int kr = r64 + 64 * it; if (kr < 416) *(LAS u32x4*)(Kimg + kr * 128 + ((c8 ^ ((kr >> 1) & 7)) << 4)) = kv[it]; }
#pragma unroll
            for (int it = 0; it < 7; ++it) { const int c = c8 + 8 * it; if (c < 52) { const int cc = c - 4; const int koffs = c < 4 ? 8 * c : 32 + 8 * cc;
                    u32x4 v = vv[it]; if (c >= 2 && c < 4) v = (u32x4){0u, 0u, 0u, 0u};
                    LAS u32x2* dst = (LAS u32x2*)(Vimg + r64 * ATT_VP + koffs * 2); dst[0] = (u32x2){v.x, v.y}; dst[1] = (u32x2){v.z, v.w}; } }
        }
        __syncthreads();
        if (PROBE_PH >= 0 && F.bid == 100 && F.tid == 0) ((volatile LAS unsigned*)(F.lds + RING_BYTES + 1024))[11] = (unsigned)__builtin_amdgcn_s_memrealtime();
        {
            AttHead H[2];
#pragma unroll
            for (int hp = 0; hp < 2; ++hp) { const int head = hk * 4 + hp * 2 + hsel; H[hp].slope2 = exp2f(-(float)(head + 1)) * LOG2E; H[hp].m = F.sink[head] * LOG2E; H[hp].l = h == 0 ? 1.f : 0.f;
#pragma unroll
                for (int r = 0; r < 16; ++r) { H[hp].O0[r] = 0.f; H[hp].O1[r] = 0.f; } }
            const LAS unsigned char* kb0 = Kimg + q * 128; const LAS unsigned char* vb0 = Vimg + q * ATT_VP + 8 * h;
            att_tile2<0>(kb0, koff, vb0, qf[0], qf[1], 0.f, 0.f, H[0], H[1]);
#pragma unroll 1
            for (int kt = qt; kt <= qt + 8; ++kt) { const int blk = kt >> 2; if ((i == 0 && blk == 0) || (i == 15 && blk == 2)) continue;
                const int kr0 = 32 + 32 * kt; const float Bq = (float)(128 + 32 * (qt - kt) + q - 4 * h);
                att_tile2<1>(kb0 + kr0 * 128, koff, vb0 + kr0 * 2, qf[0], qf[1], Bq, (kt == qt || kt == qt + 8) ? 128.f : 1e30f, H[0], H[1]); }
#pragma unroll
            for (int hp = 0; hp < 2; ++hp) { const int head = hk * 4 + hp * 2 + hsel; float l = H[hp].l; l += __shfl_xor(l, 32); const float inv = 1.f / l;
                bf16_t* orow = F.MIX + (size_t)row * D + head * 64 + 4 * h;
#pragma unroll
                for (int g = 0; g < 4; ++g) { *(GAS u32x2*)(orow + 8 * g) = (u32x2){pg8::cvt_pk_bf16(H[hp].O0[4 * g] * inv, H[hp].O0[4 * g + 1] * inv), pg8::cvt_pk_bf16(H[hp].O0[4 * g + 2] * inv, H[hp].O0[4 * g + 3] * inv)};
                    *(GAS u32x2*)(orow + 32 + 8 * g) = (u32x2){pg8::cvt_pk_bf16(H[hp].O1[4 * g] * inv, H[hp].O1[4 * g + 1] * inv), pg8::cvt_pk_bf16(H[hp].O1[4 * g + 2] * inv, H[hp].O1[4 * g + 3] * inv)}; } }
        }
    }
    __syncthreads();
}
__device__ __forceinline__ void conv_fast(Frame& F) {
    const int tid = F.tid, lane = F.lane, wid = F.wave, c2 = tid & 255, th = tid >> 8;
    LAS float* cout = (LAS float*)F.lds;
    float w0[CONV_K], w1[CONV_K];
#pragma unroll
    for (int j = 0; j < CONV_K; ++j) { const f32x2 w = *(const f32x2*)(F.dw_w + j * CONV_W + 2 * c2); w0[j] = w.x; w1[j] = w.y; }
    const f32x2 bias = *(const f32x2*)(F.dw_b + 2 * c2);
    const f32x4 g0 = *(const f32x4*)(F.lng + 8 * lane), g1 = *(const f32x4*)(F.lng + 8 * lane + 4), b0 = *(const f32x4*)(F.lnb + 8 * lane), b1 = *(const f32x4*)(F.lnb + 8 * lane + 4);
    const int vb = (F.G & 7) == 0 ? (F.bid & 7) * (F.G >> 3) + (F.bid >> 3) : F.bid;
    for (int item = vb; item < NB * 32; item += F.G) {
        const int b = item >> 5, t0 = (item & 31) * 64;
        unsigned xin[62];
        const int s0 = NMETA + t0 + 32 * th - 15;
#pragma unroll
        for (int jj = 0; jj < 62; ++jj) { const int sq = s0 + jj; xin[jj] = sq < LSEQ ? *(const GAS unsigned*)(F.HC + (size_t)row_of(b, sq) * 512 + 2 * c2) : 0u; }
        __syncthreads();
#pragma unroll
        for (int t = 0; t < 32; ++t) { float a0 = bias.x, a1 = bias.y;
#pragma unroll
            for (int j = 0; j < CONV_K; ++j) { a0 += w0[j] * bflo(xin[t + j]); a1 += w1[j] * bfhi(xin[t + j]); }
            *(LAS f32x2*)(cout + (32 * th + t) * 512 + 2 * c2) = (f32x2){a0, a1}; }
        __syncthreads();
#pragma unroll 1
        for (int hb = 0; hb < 2; ++hb) {
            f32x4 x0[4], x1[4]; float sm[4], sq[4];
#pragma unroll
            for (int tt = 0; tt < 4; ++tt) { const LAS f32x4* rp = (const LAS f32x4*)(cout + (8 * wid + 4 * hb + tt) * 512 + 8 * lane); x0[tt] = rp[0]; x1[tt] = rp[1];
                sm[tt] = (x0[tt][0] + x0[tt][1]) + (x0[tt][2] + x0[tt][3]) + (x1[tt][0] + x1[tt][1]) + (x1[tt][2] + x1[tt][3]);
                sq[tt] = (x0[tt][0] * x0[tt][0] + x0[tt][1] * x0[tt][1]) + (x0[tt][2] * x0[tt][2] + x0[tt][3] * x0[tt][3]) + (x1[tt][0] * x1[tt][0] + x1[tt][1] * x1[tt][1]) + (x1[tt][2] * x1[tt][2] + x1[tt][3] * x1[tt][3]); }
#pragma unroll
            for (int o = 1; o < 64; o <<= 1)
#pragma unroll
                for (int tt = 0; tt < 4; ++tt) { sm[tt] += __shfl_xor(sm[tt], o); sq[tt] += __shfl_xor(sq[tt], o); }
#pragma unroll
            for (int tt = 0; tt < 4; ++tt) { const float mu = sm[tt] * (1.f / 512.f); const float var = fmaxf(sq[tt] * (1.f / 512.f) - mu * mu, 0.f); const float rstd = __builtin_amdgcn_rsqf(var + 1e-5f);
                f32x4 y0 = (x0[tt] - mu) * rstd * g0 + b0, y1 = (x1[tt] - mu) * rstd * g1 + b1;
#pragma unroll
                for (int e = 0; e < 4; ++e) { y0[e] *= sigmoidf_fast(y0[e]); y1[e] *= sigmoidf_fast(y1[e]); }
                *(GAS u32x4*)(F.MIX + (size_t)(b * SEQ + t0 + 8 * wid + 4 * hb + tt) * D + 512 + 8 * lane) = pg8::pack8(y0, y1); }
        }
    }
    __syncthreads();
}
__device__ __forceinline__ void p4_fast(Frame& F) {
    LAS int* lcnt = (LAS int*)(F.lds + LX_LCNT); LAS int* gbase = (LAS int*)(F.lds + LX_GBASE); LAS float* part = (LAS float*)F.lds;
    const int tid = F.tid, lane = F.lane, wid = F.wave, j = lane & 31, h = lane >> 5, grp = wid >> 2, sub = wid & 3;
    for (int base = 0; base < M_REAL / 32; base += F.G * 2) {
        const int tile = base + F.bid + F.G * grp; const bool active = tile < M_REAL / 32;
        if (tid < NE) lcnt[tid] = 0;
        int tok = 0;
        if (active) {
            tok = tile * 32 + j;
            const bf16_t* xa = F.XN2 + (size_t)tok * D + 256 * sub + 8 * h; const bf16_t* wa = F.WrT + (size_t)j * D + 256 * sub + 8 * h;
            f32x16 acc;
#pragma unroll
            for (int r = 0; r < 16; ++r) acc[r] = 0.f;
            float ssq = 0.f;
#pragma unroll
            for (int ks = 0; ks < 16; ++ks) { const u32x4 xb = *(const GAS u32x4*)(xa + 16 * ks); const bf16x8 wf = *(const GAS bf16x8*)(wa + 16 * ks);
                acc = __builtin_amdgcn_mfma_f32_32x32x16_bf16(wf, __builtin_bit_cast(bf16x8, xb), acc, 0, 0, 0);
                ssq += (bflo(xb.x) * bflo(xb.x) + bfhi(xb.x) * bfhi(xb.x)) + (bflo(xb.y) * bflo(xb.y) + bfhi(xb.y) * bfhi(xb.y)) + (bflo(xb.z) * bflo(xb.z) + bfhi(xb.z) * bfhi(xb.z)) + (bflo(xb.w) * bflo(xb.w) + bfhi(xb.w) * bfhi(xb.w)); }
            LAS float* p = part + (size_t)((grp * 4 + sub) * 17) * 64 + lane;
#pragma unroll
            for (int r = 0; r < 16; ++r) p[r * 64] = acc[r];
            p[16 * 64] = ssq;
        }
        __syncthreads();
        int ea = 0, eb = 0, sa = 0, sb = 0; float ga = 0.f, gb = 0.f, rstd = 0.f;
        const bool fin = active && sub == 0;
        if (fin) {
            float lg[16]; float ssq = 0.f;
#pragma unroll
            for (int r = 0; r < 16; ++r) lg[r] = 0.f;
#pragma unroll
            for (int q = 0; q < 4; ++q) { const LAS float* p = part + (size_t)((grp * 4 + q) * 17) * 64 + lane;
#pragma unroll
                for (int r = 0; r < 16; ++r) lg[r] += p[r * 64];
                ssq += p[16 * 64]; }
            ssq += __shfl_xor(ssq, 32);
            rstd = 1.f / sqrtf(ssq * (1.f / D) + 1e-6f);
#pragma unroll
            for (int r = 0; r < 16; ++r) lg[r] = lg[r] * rstd + F.rb[(r & 3) + 8 * (r >> 2) + 4 * h];
            float tv[4]; int te[4];
#pragma unroll
            for (int kk = 0; kk < 4; ++kk) { float bv = -INFINITY; int be = 0;
#pragma unroll
                for (int r = 0; r < 16; ++r) { const int er = (r & 3) + 8 * (r >> 2) + 4 * h; if (lg[r] > bv) { bv = lg[r]; be = er; } }
                const float pv = __shfl_xor(bv, 32); const int pe = __shfl_xor(be, 32);
                if (pv > bv || (pv == bv && pe < be)) { bv = pv; be = pe; }
#pragma unroll
                for (int r = 0; r < 16; ++r) { const int er = (r & 3) + 8 * (r >> 2) + 4 * h; if (er == be) lg[r] = -INFINITY; }
                tv[kk] = bv; te[kk] = be; }
            const float p1 = __expf(tv[1] - tv[0]), p2 = __expf(tv[2] - tv[0]), p3 = __expf(tv[3] - tv[0]); const float inv = 1.f / (1.f + p1 + p2 + p3);
            ea = h ? te[2] : te[0]; eb = h ? te[3] : te[1]; ga = (h ? p2 : 1.f) * inv; gb = (h ? p3 : p1) * inv;
            sa = __hip_atomic_fetch_add(lcnt + ea, 1, __ATOMIC_RELAXED, __HIP_MEMORY_SCOPE_WORKGROUP); sb = __hip_atomic_fetch_add(lcnt + eb, 1, __ATOMIC_RELAXED, __HIP_MEMORY_SCOPE_WORKGROUP);
        }
        __syncthreads();
        if (tid < NE) gbase[tid] = (int)__hip_atomic_fetch_add((unsigned*)(F.ctl + CW_CNT + tid), (unsigned)lcnt[tid], RLX_AGENT);
        __syncthreads();
        if (fin) {
            sa += gbase[ea]; sb += gbase[eb];
            F.ltok[ea * CAP + sa] = tok; F.lgate[ea * CAP + sa] = ga; F.lrstd[ea * CAP + sa] = rstd; F.where[tok * 4 + 2 * h] = ea * CAP + sa;
            F.ltok[eb * CAP + sb] = tok; F.lgate[eb * CAP + sb] = gb; F.lrstd[eb * CAP + sb] = rstd; F.where[tok * 4 + 2 * h + 1] = eb * CAP + sb;
        }
        __syncthreads();
    }
}

__device__ __forceinline__ void p1_naive(Frame& F) {
    const int gw = F.bid * NWAVES + F.wave, NGW = F.G * NWAVES, lane = F.lane;
    for (int it = gw; it < M_ALL * 20; it += NGW) {
        const int row = it / 20, grp = it % 20;
        const bf16_t* xr = F.XN + (size_t)row * D;
        if (grp < 12) {
            const int col = grp * 64 + lane; float acc = 0.f;
            _Pragma("unroll 4") for (int k = 0; k < D; ++k) acc += bf2f(xr[k]) * F.w_in[(size_t)k * IN_W + col];
            if (grp < 10) {
                const float ssq = wave_sum(acc * acc); const float r = 1.f / sqrtf(ssq * (1.f / 64.f) + 1e-6f);
                if (grp < 8) F.Qb[(size_t)row * 512 + col] = (bf16_t)f2bf(acc * r * F.qg[lane] * QSCALE);
                else F.Kb[(size_t)row * 128 + (col - 512)] = (bf16_t)f2bf(acc * r * F.kg[lane]);
            } else {
                const int hk = grp - 10; int b, kx;
                if (row < M_REAL) { b = row >> 11; kx = NMETA + (row & 2047); } else { b = (row - M_REAL) >> 4; kx = (row - M_REAL) & 15; }
                F.VT[((size_t)(b * 2 + hk) * 64 + lane) * VT_PITCH + kx] = (bf16_t)f2bf(acc);
            }
        } else {
            const int c = (grp - 12) * 64 + lane; float a = 0.f, g = 0.f;
            for (int k = 0; k < D; ++k) { const float xv = bf2f(xr[k]); a += xv * F.w_in[(size_t)k * IN_W + 768 + c]; g += xv * F.w_in[(size_t)k * IN_W + 1280 + c]; }
            F.HC[(size_t)row * 512 + c] = (bf16_t)f2bf(a * sigmoidf_fast(g));
        }
    }
}
__device__ __forceinline__ void att_naive(Frame& F) {
    const int gw = F.bid * NWAVES + F.wave, NGW = F.G * NWAVES, lane = F.lane;
    for (int it = gw; it < M_REAL * NQH; it += NGW) {
        const int row = it >> 3, h = it & 7, hk = h >> 2, b = row >> 11, qp = row & 2047;
        const float q = bf2f(F.Qb[(size_t)row * 512 + h * 64 + lane]);
        const float slope2 = exp2f(-(float)(h + 1)) * LOG2E;
        float m = F.sink[h] * LOG2E, l = 1.f, acc = 0.f;
        const bf16_t* vt = F.VT + ((size_t)(b * 2 + hk) * 64 + lane) * VT_PITCH;
        for (int j = 0; j < NMETA; ++j) {
            const float kv = bf2f(F.Kb[(size_t)(M_REAL + b * NMETA + j) * 128 + hk * 64 + lane]);
            const float s = wave_sum(q * kv);
            const float mn = fmaxf(m, s), al = exp2f(m - mn), p = exp2f(s - mn);
            l = l * al + p; acc = acc * al + p * bf2f(vt[j]); m = mn;
        }
        const int k0 = qp - 128 < 0 ? 0 : qp - 128, k1 = qp + 128 > SEQ - 1 ? SEQ - 1 : qp + 128;
        for (int kp = k0; kp <= k1; ++kp) {
            const float kv = bf2f(F.Kb[(size_t)(b * SEQ + kp) * 128 + hk * 64 + lane]);
            const float dist = (float)(qp > kp ? qp - kp : kp - qp);
            const float s = wave_sum(q * kv) - slope2 * dist;
            const float mn = fmaxf(m, s), al = exp2f(m - mn), p = exp2f(s - mn);
            l = l * al + p; acc = acc * al + p * bf2f(vt[NMETA + kp]); m = mn;
        }
        F.MIX[(size_t)row * D + h * 64 + lane] = (bf16_t)f2bf(acc / l);
    }
}
__device__ __forceinline__ void conv_naive(Frame& F) {
    const int gw = F.bid * NWAVES + F.wave, NGW = F.G * NWAVES, lane = F.lane;
    for (int row = gw; row < M_REAL; row += NGW) {
        const int b = row >> 11, s0 = NMETA + (row & 2047);
        float v[8]; float sum = 0.f;
#pragma unroll
        for (int j = 0; j < 8; ++j) { const int c = lane + 64 * j; float a = F.dw_b[c];
            _Pragma("unroll 1") for (int t = 0; t < CONV_K; ++t) { const int s = s0 - 15 + t; if (s >= 0 && s < LSEQ) a += F.dw_w[t * CONV_W + c] * bf2f(F.HC[(size_t)row_of(b, s) * 512 + c]); }
            v[j] = a; sum += a; }
        const float mu = wave_sum(sum) * (1.f / 512.f); float q = 0.f;
#pragma unroll
        for (int j = 0; j < 8; ++j) { const float d = v[j] - mu; q += d * d; }
        const float rstd = 1.f / sqrtf(wave_sum(q) * (1.f / 512.f) + 1e-5f);
#pragma unroll
        for (int j = 0; j < 8; ++j) { const int c = lane + 64 * j; const float y = (v[j] - mu) * rstd * F.lng[c] + F.lnb[c];
            F.MIX[(size_t)row * D + 512 + c] = (bf16_t)f2bf(y * sigmoidf_fast(y)); }
    }
}
__device__ __forceinline__ void p3_naive(Frame& F) {
    const int gw = F.bid * NWAVES + F.wave, NGW = F.G * NWAVES, lane = F.lane;
    for (int it = gw; it < M_REAL * 16; it += NGW) {
        const int row = it >> 4, col = (it & 15) * 64 + lane; const bf16_t* mr = F.MIX + (size_t)row * D; float acc = 0.f;
        for (int k = 0; k < D; ++k) acc += bf2f(mr[k]) * F.w_out[(size_t)k * D + col];
        const float h2 = F.x[(size_t)row * D + col] + acc;
        F.out[(size_t)row * D + col] = h2; F.XN2[(size_t)row * D + col] = (bf16_t)f2bf(h2); F.XN2F8[(size_t)row * D + col] = (unsigned char)(pk4_fp8(h2, 0.f, 0.f, 0.f) & 0xffu);
    }
}
__device__ __forceinline__ void p4_naive(Frame& F) {
    const int gw = F.bid * NWAVES + F.wave, NGW = F.G * NWAVES, lane = F.lane, e = lane & 31;
    for (int t = gw; t < M_REAL; t += NGW) {
        const bf16_t* xr = F.XN2 + (size_t)t * D; float acc = 0.f, ss = 0.f;
        for (int k = 0; k < D; ++k) { const float xv = bf2f(xr[k]); acc += xv * F.n2g[k] * F.wr[k * NE + e]; ss += xv * xv; }
        const float rstd = 1.f / sqrtf(ss * (1.f / D) + 1e-6f);
        float lg = acc * rstd + F.rb[e];
        float tv[4]; int te[4];
#pragma unroll
        for (int kk = 0; kk < 4; ++kk) {
            float bv = lg; int be = e;
#pragma unroll
            for (int o = 1; o < 32; o <<= 1) { const float pv = __shfl_xor(bv, o); const int pe = __shfl_xor(be, o); if (pv > bv || (pv == bv && pe < be)) { bv = pv; be = pe; } }
            tv[kk] = bv; te[kk] = be; if (e == be) lg = -INFINITY;
        }
        float p[4], ps = 0.f;
#pragma unroll
        for (int kk = 0; kk < 4; ++kk) { p[kk] = __expf(tv[kk] - tv[0]); ps += p[kk]; }
        if (lane < 4) {
            const int ee = lane == 0 ? te[0] : lane == 1 ? te[1] : lane == 2 ? te[2] : te[3];
            const float gg = (lane == 0 ? p[0] : lane == 1 ? p[1] : lane == 2 ? p[2] : p[3]) / ps;
            const unsigned slot = __hip_atomic_fetch_add((unsigned*)(F.ctl + CW_CNT + ee), 1u, RLX_AGENT);
            F.ltok[ee * CAP + slot] = t; F.lgate[ee * CAP + slot] = gg; F.lrstd[ee * CAP + slot] = rstd; F.where[t * 4 + lane] = ee * CAP + (int)slot;
        }
    }
}
__device__ __forceinline__ void build_tile_table(Frame& F) {
    LAS int* tb = (LAS int*)(F.lds + LX_TB); LAS int* cn = (LAS int*)(F.lds + LX_CNT); LAS int* hb = (LAS int*)(F.lds + LX_HB); LAS int* lb = (LAS int*)(F.lds + LX_LB);
    __syncthreads();
    if (F.tid == 0) { int acc = 0, ah = 0, al = 0; for (int e = 0; e < NE; ++e) { int c = (int)__hip_atomic_load(F.ctl + CW_CNT + e, RLX_AGENT); if (c > CAP) c = CAP; if (c < 0) c = 0;
            const int t = (c + 255) >> 8, rem = c & 255, light = (rem != 0 && rem <= 128) ? 1 : 0; cn[e] = c; tb[e] = acc; hb[e] = ah; lb[e] = al; acc += t; ah += t - light; al += light; }
        tb[NE] = acc; hb[NE] = ah; lb[NE] = al; }
    __syncthreads();
}
__device__ __forceinline__ int find_expert(const LAS int* tb, int tile) { int e = 0;
#pragma unroll 1
    for (int j = 1; j < NE; ++j) if (tb[j] <= tile) e = j;
    return e; }
__device__ __forceinline__ f32x4 fp8x4_to_f32(unsigned w) {
    const f32x2 lo = __builtin_amdgcn_cvt_pk_f32_fp8((int)w, false), hi = __builtin_amdgcn_cvt_pk_f32_fp8((int)w, true); return (f32x4){lo.x, lo.y, hi.x, hi.y}; }
__device__ __forceinline__ void p7_combine(Frame& F) {
    build_tile_table(F);
    const LAS int* tb = (const LAS int*)(F.lds + LX_TB);
    const int gw = F.bid * NWAVES + F.wave, NGW = F.G * NWAVES, lane = F.lane;
    const float pscale = PROBE_PH >= 0 ? 1.f + __builtin_bit_cast(float, __hip_atomic_load((unsigned*)(F.ctl + 32), RLX_AGENT)) : 1.f;
    const GAS i32x4* wh = (const GAS i32x4*)F.where;
    int t0 = gw, t1 = gw + NGW;
    i32x4 w0 = t0 < M_REAL ? wh[t0] : (i32x4){0, 0, 0, 0}, w1 = t1 < M_REAL ? wh[t1] : (i32x4){0, 0, 0, 0};
    while (t0 < M_REAL) {
        const int n0 = t0 + 2 * NGW, n1 = t1 + 2 * NGW;
        const i32x4 nw0 = n0 < M_REAL ? wh[n0] : (i32x4){0, 0, 0, 0}, nw1 = n1 < M_REAL ? wh[n1] : (i32x4){0, 0, 0, 0};
        const bool v1 = t1 < M_REAL; const int tt1 = v1 ? t1 : t0;
        u32x4 y[2][4], x[2][2];
#pragma unroll
        for (int u = 0; u < 2; ++u) { const int t = u ? tt1 : t0; const i32x4 w = u ? w1 : w0;
#pragma unroll
            for (int j = 0; j < 2; ++j) x[u][j] = *((const GAS u32x4*)(F.XN2 + (size_t)t * D) + 2 * lane + j);
#pragma unroll
            for (int k = 0; k < 4; ++k) { const int e = w[k] / CAP, slot = w[k] - e * CAP; y[u][k] = *((const GAS u32x4*)(F.Y8 + (size_t)(tb[e] * 256 + slot) * D) + lane); } }
#pragma unroll
        for (int u = 0; u < 2; ++u) { if (u && !v1) break; const int t = u ? tt1 : t0;
            f32x4 a[4] = {(f32x4){0.f, 0.f, 0.f, 0.f}, (f32x4){0.f, 0.f, 0.f, 0.f}, (f32x4){0.f, 0.f, 0.f, 0.f}, (f32x4){0.f, 0.f, 0.f, 0.f}};
#pragma unroll
            for (int k = 0; k < 4; ++k) { a[0] += fp8x4_to_f32(y[u][k].x); a[1] += fp8x4_to_f32(y[u][k].y); a[2] += fp8x4_to_f32(y[u][k].z); a[3] += fp8x4_to_f32(y[u][k].w); }
            a[0] += (f32x4){bflo(x[u][0].x), bfhi(x[u][0].x), bflo(x[u][0].y), bfhi(x[u][0].y)}; a[1] += (f32x4){bflo(x[u][0].z), bfhi(x[u][0].z), bflo(x[u][0].w), bfhi(x[u][0].w)};
            a[2] += (f32x4){bflo(x[u][1].x), bfhi(x[u][1].x), bflo(x[u][1].y), bfhi(x[u][1].y)}; a[3] += (f32x4){bflo(x[u][1].z), bfhi(x[u][1].z), bflo(x[u][1].w), bfhi(x[u][1].w)};
            GAS f32x4* o = (GAS f32x4*)(F.out + (size_t)t * D) + 4 * lane;
#pragma unroll
            for (int j = 0; j < 4; ++j) o[j] = PROBE_PH >= 0 ? a[j] * pscale : a[j]; }
        t0 = n0; t1 = n1; w0 = nw0; w1 = nw1;
    }
}

__global__ void __launch_bounds__(NTHR, 2) mega(Args args) {
    extern __shared__ __attribute__((aligned(16))) unsigned char lds_raw[];
    Frame F;
    F.lds = (LAS unsigned char*)lds_raw;
    F.tid = threadIdx.x; F.lane = F.tid & 63; F.wave = __builtin_amdgcn_readfirstlane(F.tid >> 6); F.G = gridDim.x; F.bid = blockIdx.x;
    F.x = args.in[0]; F.meta = args.in[1]; F.n1g = args.in[2]; F.w_in = args.in[3]; F.qg = args.in[4]; F.kg = args.in[5]; F.sink = args.in[6];
    F.dw_w = args.in[7]; F.dw_b = args.in[8]; F.lng = args.in[9]; F.lnb = args.in[10]; F.w_out = args.in[11]; F.n2g = args.in[12];
    F.wr = args.in[13]; F.rb = args.in[14]; F.wgu = args.in[15]; F.bgu = args.in[16]; F.wd = args.in[17]; F.bd = args.in[18];
    F.out = args.out; F.ws = args.ws; unsigned char* ws = args.ws;
    F.ctl = (gu32*)(ws + WS_CTL);
    F.WinT = (bf16_t*)(ws + WS_WIN_T); F.WoT = (bf16_t*)(ws + WS_WO_T); F.WrT = (bf16_t*)(ws + WS_WR_T); F.WdT8 = ws + WS_WD_T; F.WguT8 = ws + WS_WGU_T; F.XN2F8 = ws + WS_XN2F8;
    F.XN = (bf16_t*)(ws + WS_XN); F.Qb = (bf16_t*)(ws + WS_Q); F.Kb = (bf16_t*)(ws + WS_K); F.VT = (bf16_t*)(ws + WS_VT); F.HC = (bf16_t*)(ws + WS_HC);
    F.MIX = (bf16_t*)(ws + WS_MIX); F.XN2 = (bf16_t*)(ws + WS_XN2); F.ACT8 = ws + WS_ACT; F.Y8 = ws + WS_Y;
    F.where = (int*)(ws + WS_WHERE); F.ltok = (int*)(ws + WS_LTOK); F.lgate = (float*)(ws + WS_LGATE); F.lrstd = (float*)(ws + WS_LRSTD);
    for (int u = F.tid; u < (LDS_BYTES - RING_BYTES) / 4; u += NTHR) ((LAS unsigned*)(F.lds + RING_BYTES))[u] = 0u;
    __syncthreads();
    const int lo = args.ph_lo, hi = args.ph_hi;
    XcdBarrier bar; bar.bar = (unsigned*)(F.ctl + CW_BAR); bar.x = 0; bar.st = nullptr;
    if (hi - lo > 1) bar = xcd_barrier_post((unsigned*)(F.ctl + CW_BAR), (volatile LAS unsigned*)(F.lds + LX_BAR));
#ifndef PH_MASK
#define PH_MASK 0xFF
#endif
#define IN(k) (((PH_MASK >> (k)) & 1) && lo <= (k) && (k) < hi)
#define STAMP(k) do { if (PROBE_PH >= 0 && F.bid == 100 && F.tid == 0) ((volatile LAS unsigned*)(F.lds + RING_BYTES + 1024))[k] = (unsigned)__builtin_amdgcn_s_memrealtime(); } while (0)
#define SEAM(k) do { if (IN(k) && IN((k) + 1)) xcd_barrier(bar); STAMP((k) + 1); } while (0)
#ifndef REP_PH
#define REP_PH -1
#endif
#define REPS(k) _Pragma("unroll") for (int rep = 0; rep < ((REP_PH) == (k) ? 2 : 1); ++rep)
#define REPBAR() do { if (rep) xcd_barrier(bar); } while (0)
    STAMP(0);
    if (IN(0)) { REPS(0) { REPBAR(); p0_prologue(F); } } SEAM(0);
    if (IN(1)) { REPS(1) { REPBAR();
#if FAST_P1
        pg8::DenseProb<IN_W / 256> P{F.XN, F.WinT, M_PAD / 256, F.G, F.bid}; pg8::EpiIn E{F.Qb, F.Kb, F.VT, F.HC, F.qg, F.kg}; pg8::gemm_phase<2>(F.lds, P, E);
        { const int nd = p0_ndef(F.G), first_idle = P1_UNITS - F.G;
          if (nd > 0 && F.bid >= first_idle) { __syncthreads(); p0_items(F, P0_NITEMS - nd + (F.bid - first_idle) * NWAVES + F.wave, (F.G - first_idle) * NWAVES, P0_NITEMS); } }
#else
        p1_naive(F);
#endif
    } } SEAM(1);
    if (IN(2)) { REPS(2) { REPBAR();
#if FAST_ATT
        att_fast(F);
#else
        att_naive(F);
#endif
    } STAMP(9); REPS(8) { REPBAR();
#if FAST_CONV
        conv_fast(F);
#else
        conv_naive(F);
#endif
    } } SEAM(2);
    if (IN(3)) { REPS(3) { REPBAR();
#if FAST_P3
        const int np3 = (F.G & 1) == 0 ? P3_CONV_ITEMS : 0, hw = (F.G >> 1) * NWAVES, hrank = (F.bid >> 1) * NWAVES + F.wave;
        if (np3 && (F.bid & 1)) { p0_items(F, P0_NITEMS - np3 + hrank, hw, P0_NITEMS - np3 / 2); __syncthreads(); }
        pg8::DenseProb<D / 256> P{F.MIX, F.WoT, M_REAL / 256, F.G, F.bid}; pg8::EpiOut E{F.x, F.out, F.XN2, F.XN2F8}; pg8::gemm_phase<2>(F.lds, P, E);
        if (np3 && !(F.bid & 1)) { __syncthreads(); p0_items(F, P0_NITEMS - np3 / 2 + hrank, hw, P0_NITEMS); }
#else
        p3_naive(F);
#endif
    } } SEAM(3);
    if (IN(4)) { REPS(4) { if (rep) { xcd_barrier(bar); if (F.bid == 0 && F.tid < NE) __hip_atomic_store(F.ctl + CW_CNT + F.tid, 0u, RLX_AGENT); xcd_barrier(bar); }
#if FAST_P4
        p4_fast(F);
#else
        p4_naive(F);
#endif
        __syncthreads(); p0_items(F, P0_NMOE0 + F.bid * NWAVES + F.wave, F.G * NWAVES, P0_NITEMS - ((F.G & 1) == 0 ? P3_CONV_ITEMS : 0));
    } } SEAM(4);
    if (IN(5)) { REPS(5) { REPBAR();
        build_tile_table(F); pg8::GroupedProb<true, 1, 8> P{F.XN2F8, F.WguT8, F.ltok, (const LAS int*)(F.lds + LX_TB), (const LAS int*)(F.lds + LX_CNT), F.G, F.bid};
        pg8::EpiGU E{F.ACT8, F.lrstd, F.bgu}; pg8::gemm_phase<1>(F.lds, P, E);
    } } SEAM(5);
    if (IN(6)) { REPS(6) { REPBAR();
        build_tile_table(F); pg8::GroupedProb<false, 1, 4> P{F.ACT8, F.WdT8, F.ltok, (const LAS int*)(F.lds + LX_TB), (const LAS int*)(F.lds + LX_CNT), F.G, F.bid};
        pg8::EpiDown E{F.Y8, F.lgate, F.bd}; pg8::gemm_phase<1>(F.lds, P, E);
    } } SEAM(6);
    if (PROBE_PH >= 0 && hi - lo > 1) {
        if (F.bid == 100 && F.tid == 0) { volatile LAS unsigned* ts = (volatile LAS unsigned*)(F.lds + RING_BYTES + 1024); const unsigned dt = PROBE_PH == 11 ? ts[11] - ts[2] : PROBE_PH == 12 ? ts[9] - ts[11] : PROBE_PH == 9 ? ts[9] - ts[2] : PROBE_PH == 10 ? ts[3] - ts[9] : ts[PROBE_PH + 1] - ts[PROBE_PH];
            const float eps = sqrtf((float)dt * 0.01f * (float)(PROBE_SCALE)); __hip_atomic_store((unsigned*)(F.ctl + 32), __builtin_bit_cast(unsigned, eps), RLX_AGENT); }
        xcd_barrier(bar);
    }
    if (IN(7)) { REPS(7) { REPBAR(); p7_combine(F); } }
#undef IN
#undef SEAM
}

extern "C" void kernel_launch(void* const* d_in, const int* in_sizes, int n_in, void* d_out, int out_size, void* d_ws, size_t ws_size, hipStream_t stream) {
    static int grid = 0;
    if (grid == 0) {
        if (n_in != 19 || in_sizes[0] != M_REAL * D || out_size != M_REAL * D || ws_size < WS_END) {
            fprintf(stderr, "kernel_launch: unexpected shapes/workspace: n_in %d in0 %d out %d ws %zu (need %zu)\n", n_in, n_in > 0 ? in_sizes[0] : -1, out_size, ws_size, (size_t)WS_END); grid = -1; return; }
        int dev = 0, cus = 0, per_cu = 0;
        if (hipGetDevice(&dev) != hipSuccess || hipDeviceGetAttribute(&cus, hipDeviceAttributeMultiprocessorCount, dev) != hipSuccess) { grid = -1; return; }
        if (hipFuncSetAttribute((const void*)mega, hipFuncAttributeMaxDynamicSharedMemorySize, LDS_BYTES) != hipSuccess) { fprintf(stderr, "kernel_launch: hipFuncSetAttribute failed\n"); grid = -1; return; }
        if (hipOccupancyMaxActiveBlocksPerMultiprocessor(&per_cu, (const void*)mega, NTHR, LDS_BYTES) != hipSuccess || per_cu < 1) { fprintf(stderr, "kernel_launch: occupancy query says %d blocks/CU\n", per_cu); (void)hipGetLastError(); grid = -1; return; }
        grid = cus;
    }
    if (grid < 0) return;
    (void)hipMemsetAsync((char*)d_ws + WS_CTL, 0, CTL_ZERO_BYTES, stream);
    Args a{};
    for (int i = 0; i < 19; ++i) a.in[i] = (const float*)d_in[i];
    a.out = (float*)d_out; a.ws = (unsigned char*)d_ws;
#if MK_PER_PHASE
    for (int p = 0; p < 8; ++p) { a.ph_lo = p; a.ph_hi = p + 1; hipLaunchKernelGGL(mega, dim3(grid), dim3(NTHR), LDS_BYTES, stream, a); }
#else
    a.ph_lo = 0; a.ph_hi = 8; hipLaunchKernelGGL(mega, dim3(grid), dim3(NTHR), LDS_BYTES, stream, a);
#endif
}
```

```cpp
#include <hip/hip_runtime.h>
#include <cstdio>
#include <cstdint>

#ifndef MK_PER_PHASE
#define MK_PER_PHASE 0
#endif
#ifndef PROBE_PH
#define PROBE_PH -1
#endif
#ifndef PROBE_SCALE
#define PROBE_SCALE 2e-5
#endif
#ifndef FAST_P1
#define FAST_P1 1
#endif
#ifndef FAST_ATT
#define FAST_ATT 1
#endif
#ifndef FAST_CONV
#define FAST_CONV 1
#endif
#ifndef FAST_P3
#define FAST_P3 1
#endif
#ifndef FAST_P4
#define FAST_P4 1
#endif
#ifndef FAST_P5
#define FAST_P5 1
#endif
#ifndef FAST_P6
#define FAST_P6 1
#endif

#define GAS __attribute__((address_space(1)))
#define LAS __attribute__((address_space(3)))
typedef unsigned short bf16_t;
typedef short bf16x8 __attribute__((ext_vector_type(8)));
typedef float f32x4 __attribute__((ext_vector_type(4)));
typedef float f32x16 __attribute__((ext_vector_type(16)));
typedef int i32x4 __attribute__((ext_vector_type(4)));
typedef int i32x8 __attribute__((ext_vector_type(8)));
typedef unsigned u32x4 __attribute__((ext_vector_type(4)));
typedef unsigned u32x2 __attribute__((ext_vector_type(2)));
typedef float f32x2 __attribute__((ext_vector_type(2)));
typedef GAS unsigned gu32;
#define RLX_AGENT __ATOMIC_RELAXED, __HIP_MEMORY_SCOPE_AGENT

constexpr int NB = 8, SEQ = 2048, D = 1024, NMETA = 16, LSEQ = NMETA + SEQ;
constexpr int M_REAL = NB * SEQ, M_ALL = NB * LSEQ, M_PAD = 16640;
constexpr int IN_W = 1792, HD = 64, NQH = 8, NKV = 2, CONV_W = 512, CONV_K = 31;
constexpr int NE = 32, CAP = 16384, ACT_ROWS = 4 * M_REAL + NE * 256;
constexpr float LOG2E = 1.4426950408889634f;
constexpr float QSCALE = 0.125f * LOG2E;
constexpr float WSCALE = 32.0f;
constexpr int VT_PITCH = LSEQ + 64;

constexpr size_t MiB = 1u << 20;
constexpr size_t WS_CTL = 0, CTL_ZERO_BYTES = 32768;
constexpr size_t WS_WIN_T = 2 * MiB;
constexpr size_t WS_WO_T = 6 * MiB;
constexpr size_t WS_WR_T = 8 * MiB;
constexpr size_t WS_RSTD = 9 * MiB;
constexpr size_t WS_WHERE = 9 * MiB + 512 * 1024;
constexpr size_t WS_LTOK = 10 * MiB;
constexpr size_t WS_LGATE = 12 * MiB;
constexpr size_t WS_LRSTD = 14 * MiB;
constexpr size_t WS_WD_T = 16 * MiB;
constexpr size_t WS_WGU_T = 80 * MiB;
constexpr size_t WS_XN = 208 * MiB;
constexpr size_t WS_Q = 241 * MiB;
constexpr size_t WS_K = 258 * MiB;
constexpr size_t WS_VT = 263 * MiB;
constexpr size_t WS_HC = 268 * MiB;
constexpr size_t WS_MIX = 285 * MiB;
constexpr size_t WS_XN2 = 317 * MiB;
constexpr size_t WS_ACT = 349 * MiB;
constexpr size_t WS_Y = 493 * MiB;
constexpr size_t WS_XN2F8 = 637 * MiB;
constexpr size_t WS_END = 653 * MiB;
constexpr int CW_CNT = 64;
constexpr int CW_BAR = 4096;

constexpr int RING_BYTES = 131072;
constexpr int LX_BAR = RING_BYTES;
constexpr int LX_TB = RING_BYTES + 64;
constexpr int LX_CNT = RING_BYTES + 256;
constexpr int LX_LCNT = RING_BYTES + 512;
constexpr int LX_GBASE = RING_BYTES + 768;
constexpr int LX_HB = RING_BYTES + 1280;
constexpr int LX_LB = RING_BYTES + 1536;
constexpr int LDS_BYTES = 147456;

constexpr int NWAVES = 8, NTHR = 512;

__device__ __forceinline__ unsigned f2bf(float f) { unsigned u = __builtin_bit_cast(unsigned, f); return (u + 0x7fffu + ((u >> 16) & 1u)) >> 16; }
__device__ __forceinline__ unsigned pk2(float lo, float hi) { return f2bf(lo) | (f2bf(hi) << 16); }
__device__ __forceinline__ unsigned pk4_fp8(float a, float b, float c, float d) { int w = __builtin_amdgcn_cvt_pk_fp8_f32(a, b, 0, false); w = __builtin_amdgcn_cvt_pk_fp8_f32(c, d, w, true); return (unsigned)w; }
__device__ __forceinline__ float bf2f(unsigned b) { return __builtin_bit_cast(float, b << 16); }
__device__ __forceinline__ float bflo(unsigned w) { return __builtin_bit_cast(float, w << 16); }
__device__ __forceinline__ float bfhi(unsigned w) { return __builtin_bit_cast(float, w & 0xffff0000u); }
__device__ __forceinline__ float wave_sum(float v) {
#pragma unroll
    for (int o = 1; o < 64; o <<= 1) v += __shfl_xor(v, o);
    return v;
}
__device__ __forceinline__ float sigmoidf_fast(float x) { return __builtin_amdgcn_rcpf(1.0f + __builtin_amdgcn_exp2f(-x * LOG2E)); }
__device__ __forceinline__ int row_of(int b, int s) { return s < NMETA ? M_REAL + b * NMETA + s : b * SEQ + (s - NMETA); }

#define XB_TMO      128
#define XB_XCNT(j)  (256  + 64 * (j))
#define XB_XSUB(j)  (1280 + 64 * (j))
#define XB_XGEN(j)  (2304 + 64 * (j))
#define XB_TOP      3328
#define XB_TOPGEN   3392
#define XCD_BAR_WORDS 3456
#define XB_SPIN_CAP (1u << 18)
__device__ __forceinline__ unsigned xb_ld(unsigned* p)              { return __hip_atomic_load(p, __ATOMIC_RELAXED, __HIP_MEMORY_SCOPE_AGENT); }
__device__ __forceinline__ unsigned xb_add(unsigned* p, unsigned v) { return __hip_atomic_fetch_add(p, v, __ATOMIC_RELAXED, __HIP_MEMORY_SCOPE_AGENT); }
__device__ __forceinline__ unsigned xb_xcc_id() { return (unsigned)__builtin_amdgcn_s_getreg((3 << 11) | 20) & 0xFu; }
#define XB_SPIN(cond, bar) do { unsigned _sp = 0; while (cond) { __builtin_amdgcn_s_sleep(1); \
    if ((++_sp & 255u) == 0u) { if (xb_ld(&(bar)[XB_TMO])) break; if (_sp > XB_SPIN_CAP) { atomicAdd(&(bar)[XB_TMO], 1u); break; } } } } while (0)
struct XcdBarrier { unsigned* bar; unsigned x; volatile LAS unsigned* st; };
__device__ __forceinline__ XcdBarrier xcd_barrier_post(unsigned* bar, volatile LAS unsigned* st) {
    XcdBarrier b; b.bar = bar; b.x = xb_xcc_id(); b.st = st;
    if (threadIdx.x == 0) (void)xb_add(&bar[XB_XCNT(b.x)], 1u);
    return b;
}
__device__ __forceinline__ void xcd_barrier_complete(unsigned* bar, unsigned x, unsigned& nloc, unsigned& nx) {
    const unsigned G = gridDim.x * gridDim.y * gridDim.z;
    unsigned sum, cnt, mine, sp = 0u;
    for (;;) {
        sum = 0u; cnt = 0u; mine = 0u;
#pragma unroll
        for (unsigned j = 0; j < 16; ++j) { const unsigned c = xb_ld(&bar[XB_XCNT(j)]); sum += c; cnt += (c > 0u) ? 1u : 0u; mine = (j == x) ? c : mine; }
        if (sum == G) break;
        __builtin_amdgcn_s_sleep(1);
        if ((++sp & 255u) == 0u) { if (xb_ld(&bar[XB_TMO])) break; if (sp > XB_SPIN_CAP) { atomicAdd(&bar[XB_TMO], 1u); break; } }
    }
    nloc = mine > 0u ? mine : 1u; nx = cnt > 0u ? cnt : 1u;
}
__device__ __forceinline__ void xcd_barrier(const XcdBarrier& b) {
    asm volatile("s_waitcnt vmcnt(0)" ::: "memory");
    __syncthreads();
    if (threadIdx.x == 0) {
        unsigned* bar = b.bar;
        __builtin_amdgcn_s_waitcnt(0);
        unsigned nloc = b.st[0], nx = b.st[1];
        if (nloc == 0u) { xcd_barrier_complete(bar, b.x, nloc, nx); b.st[0] = nloc; b.st[1] = nx; }
        const unsigned old = xb_add(&bar[XB_XSUB(b.x)], 1u);
        const unsigned gen = old / nloc;
        if (old + 1u == (gen + 1u) * nloc) {
            __builtin_amdgcn_fence(__ATOMIC_RELEASE, "agent");
            asm volatile("s_waitcnt vmcnt(0)" ::: "memory");
            const unsigned og = xb_add(&bar[XB_TOP], 1u);
            const unsigned tg = og / nx;
            if (og + 1u == (tg + 1u) * nx) xb_add(&bar[XB_TOPGEN], 1u);
            else XB_SPIN(xb_ld(&bar[XB_TOPGEN]) == tg, bar);
            __builtin_amdgcn_fence(__ATOMIC_ACQUIRE, "agent");
            xb_add(&bar[XB_XGEN(b.x)], 1u);
            asm volatile("s_waitcnt vmcnt(0)" ::: "memory");
        } else {
            XB_SPIN(xb_ld(&bar[XB_XGEN(b.x)]) == gen, bar);
            __builtin_amdgcn_fence(__ATOMIC_ACQUIRE, "agent");
            asm volatile("s_waitcnt vmcnt(0)" ::: "memory");
        }
    }
    __syncthreads();
}

struct Args { const float* in[19]; float* out; unsigned char* ws; int ph_lo, ph_hi; };
struct Frame {
    LAS unsigned char* lds;
    int tid, lane, wave, G, bid;
    const float *x, *meta, *n1g, *w_in, *qg, *kg, *sink, *dw_w, *dw_b, *lng, *lnb, *w_out, *n2g, *wr, *rb, *wgu, *bgu, *wd, *bd;
    float* out;
    unsigned char* ws;
    gu32* ctl;
    unsigned char *WguT8, *XN2F8, *WdT8, *ACT8; bf16_t *WinT, *WoT, *WrT, *XN, *Qb, *Kb, *VT, *HC, *MIX, *XN2; unsigned char* Y8;
    int* where; int* ltok; float* lgate; float* lrstd;
};

__device__ __forceinline__ int perm32(int rho) { const int n = rho >> 4, i = rho & 15; return 8 * (i >> 2) + 4 * n + (i & 3); }
__device__ __forceinline__ int lbase_nat(int pg) { return 32 * pg; }
__device__ __forceinline__ int lbase_in(int pg) { const int tile = pg >> 3, bj = (pg >> 2) & 1, wc = pg & 3; return tile <= 2 ? tile * 256 + 64 * wc + 32 * bj : 768 + bj * 512 + (tile - 3) * 128 + 32 * wc; }
__device__ __forceinline__ int lbase_gu(int pg) { const int tile = pg >> 3, bj = (pg >> 2) & 1, wc = pg & 3; return bj * 1024 + tile * 128 + 32 * wc; }
struct P0Item { const float* W; void* WT; const float* g; int N, pg, n0, k0; bool permute; bool f8; };
__device__ __forceinline__ bool p0_decode(const Frame& F, int it, P0Item& I) {
    constexpr int I_IN = 16 * 56, I_O = 16 * 32, I_R = 16, I_GU = NE * 16 * 64, I_D = NE * 16 * 32;
    int r = it;
    if (r < I_IN) { const int pg = r % 56, kb = r / 56; I = P0Item{F.w_in, F.WinT, nullptr, IN_W, pg, lbase_in(pg), 64 * kb, true, false}; return true; } r -= I_IN;
    if (r < I_O) { const int pg = r % 32, kb = r / 32; I = P0Item{F.w_out, F.WoT, nullptr, D, pg, lbase_nat(pg), 64 * kb, true, false}; return true; } r -= I_O;
    if (r < I_R) { I = P0Item{F.wr, F.WrT, F.n2g, NE, 0, 0, 64 * r, false, false}; return true; } r -= I_R;
    if (r < I_GU) { const int e = r / (16 * 64), q = r % (16 * 64), pg = q % 64, kb = q / 64; I = P0Item{F.wgu + (size_t)e * D * 2048, F.WguT8 + (size_t)e * 2048 * D, F.n2g, 2048, pg, lbase_gu(pg), 64 * kb, true, true}; return true; } r -= I_GU;
    if (r < I_D) { const int e = r / (16 * 32), q = r % (16 * 32), pg = q % 32, kb = q / 32; I = P0Item{F.wd + (size_t)e * D * D, F.WdT8 + (size_t)e * D * D, nullptr, D, pg, lbase_nat(pg), 64 * kb, true, true}; return true; }
    return false;
}
__device__ __forceinline__ void p0_load(const P0Item& I, int lane, f32x4 (&v)[8]) {
    const float* p = I.W + (size_t)(I.k0 + (lane >> 3)) * I.N + I.n0 + 4 * (lane & 7);
#pragma unroll
    for (int i = 0; i < 8; ++i) v[i] = __builtin_nontemporal_load((const f32x4*)(p + (size_t)(8 * i) * I.N));
}
__device__ __forceinline__ void p0_store(const P0Item& I, int lane, LAS float* scr, const f32x4 (&v)[8]) {
    LAS float* w = scr + (lane >> 3) * 33 + 4 * (lane & 7);
#pragma unroll
    for (int i = 0; i < 8; ++i) { w[(8 * i) * 33 + 0] = v[i][0]; w[(8 * i) * 33 + 1] = v[i][1]; w[(8 * i) * 33 + 2] = v[i][2]; w[(8 * i) * 33 + 3] = v[i][3]; }
    asm volatile("s_waitcnt lgkmcnt(0)" ::: "memory");
    const int c = lane & 7;
    f32x4 g0 = {1.f, 1.f, 1.f, 1.f}, g1 = g0;
    if (I.g) { g0 = *(const f32x4*)(I.g + I.k0 + 8 * c); g1 = *(const f32x4*)(I.g + I.k0 + 8 * c + 4); }
    if (I.f8) { g0 *= WSCALE; g1 *= WSCALE; }
#pragma unroll
    for (int j = 0; j < 4; ++j) { const int r = (lane >> 3) + 8 * j; const int sc = I.permute ? perm32(r) : r; const LAS float* s = scr + (8 * c) * 33 + sc;
        if (I.f8) { u32x2 o; o.x = pk4_fp8(s[0 * 33] * g0[0], s[1 * 33] * g0[1], s[2 * 33] * g0[2], s[3 * 33] * g0[3]); o.y = pk4_fp8(s[4 * 33] * g1[0], s[5 * 33] * g1[1], s[6 * 33] * g1[2], s[7 * 33] * g1[3]);
            *(GAS u32x2*)((unsigned char*)I.WT + (size_t)(32 * I.pg + r) * D + I.k0 + 8 * c) = o; }
        else { u32x4 o; o.x = pk2(s[0 * 33] * g0[0], s[1 * 33] * g0[1]); o.y = pk2(s[2 * 33] * g0[2], s[3 * 33] * g0[3]); o.z = pk2(s[4 * 33] * g1[0], s[5 * 33] * g1[1]); o.w = pk2(s[6 * 33] * g1[2], s[7 * 33] * g1[3]);
            *(GAS u32x4*)((bf16_t*)I.WT + (size_t)(32 * I.pg + r) * D + I.k0 + 8 * c) = o; } }
    asm volatile("s_waitcnt lgkmcnt(0)" ::: "memory");
}
constexpr int P0_NITEMS = 16 * 56 + 16 * 32 + 16 + NE * 16 * 64 + NE * 16 * 32, P0_NMOE0 = 16 * 56 + 16 * 32 + 16;
constexpr int P4_PRE = 8;
constexpr int P3_CONV_ITEMS = 12288;
constexpr int P1_UNITS = (M_PAD / 256) * (IN_W / 256);
__device__ __forceinline__ int p0_ndef(int G) { return 0; }
__device__ __forceinline__ void p0_items(Frame& F, int first, int step, int end) {
    LAS float* scr = (LAS float*)(F.lds + F.wave * 16384);
    const int lane = F.lane;
    P0Item c0, c1, c2; f32x4 va[8], vb[8], vc[8];
    int it = first; bool v0 = it < end && p0_decode(F, it, c0);
    if (v0) p0_load(c0, lane, va);
    it += step; bool v1 = v0 && it < end && p0_decode(F, it, c1);
    if (v1) p0_load(c1, lane, vb);
    while (v0) {
        it += step; const bool v2 = v1 && it < end && p0_decode(F, it, c2);
        if (v2) p0_load(c2, lane, vc);
        p0_store(c0, lane, scr, va);
        c0 = c1; c1 = c2; v0 = v1; v1 = v2;
#pragma unroll
        for (int i = 0; i < 8; ++i) { va[i] = vb[i]; vb[i] = vc[i]; }
    }
}
__device__ __forceinline__ void p0_prologue(Frame& F) {
    const int gw = F.bid * NWAVES + F.wave, NGW = F.G * NWAVES, lane = F.lane;
    p0_items(F, gw, NGW, P0_NMOE0);
    const GAS f32x4* gr = (const GAS f32x4*)F.n1g + lane;
    for (int m0 = 2 * gw; m0 < M_PAD; m0 += 2 * NGW) {
        f32x4 v[2][4]; float ss[2];
#pragma unroll
        for (int u = 0; u < 2; ++u) { const int m = m0 + u; ss[u] = 0.f;
            if (m < M_ALL) { const float* src = m < M_REAL ? F.x + (size_t)m * D : F.meta + (size_t)((m - M_REAL) & (NMETA - 1)) * D; const GAS f32x4* xr = (const GAS f32x4*)src + lane;
#pragma unroll
                for (int j = 0; j < 4; ++j) v[u][j] = xr[64 * j]; }
            else {
#pragma unroll
                for (int j = 0; j < 4; ++j) v[u][j] = (f32x4){0.f, 0.f, 0.f, 0.f}; } }
#pragma unroll
        for (int u = 0; u < 2; ++u) {
#pragma unroll
            for (int j = 0; j < 4; ++j) ss[u] += (v[u][j].x * v[u][j].x + v[u][j].y * v[u][j].y) + (v[u][j].z * v[u][j].z + v[u][j].w * v[u][j].w);
            const float rstd = 1.f / sqrtf(wave_sum(ss[u]) * (1.f / D) + 1e-6f);
            GAS unsigned long long* o8 = (GAS unsigned long long*)(F.XN + (size_t)(m0 + u) * D) + lane;
#pragma unroll
            for (int j = 0; j < 4; ++j) { const f32x4 g = gr[64 * j]; o8[64 * j] = (unsigned long long)pk2(v[u][j].x * rstd * g.x, v[u][j].y * rstd * g.y) | ((unsigned long long)pk2(v[u][j].z * rstd * g.z, v[u][j].w * rstd * g.w) << 32); }
        }
    }
}

namespace pg8 {
constexpr int BM = 256, BK = 64, HALF = 128, HTB = HALF * BK * 2, STAGE_BYTES = 8 * HTB, NXCD = 8, WGM = 8, KD = 1024;
__device__ __forceinline__ int lds_byte(int r, int c) { const int st = (r >> 4) * 2 + (c >> 5), rr = r & 15, cc = c & 31, ob = rr * 64 + cc * 2; return st * 1024 + (ob ^ (((ob >> 9) & 1) << 5)); }
__device__ __forceinline__ void stage_rc(int b, int& R, int& C) { const int st = b / 1024, sb = b % 1024, swz = sb ^ (((sb >> 9) & 1) << 5); R = (st >> 1) * 16 + swz / 64; C = (st & 1) * 32 + (swz % 64) / 2; }
struct Unit { int pm, pn, e, slot0, nvalid, r0; };
__device__ __forceinline__ unsigned cvt_pk_bf16(float lo, float hi) { unsigned r; asm volatile("v_cvt_pk_bf16_f32 %0, %1, %2" : "=v"(r) : "v"(lo), "v"(hi)); return r; }
__device__ __forceinline__ u32x4 pack8(const f32x4 a, const f32x4 b) { u32x4 w; w.x = cvt_pk_bf16(a[0], a[1]); w.y = cvt_pk_bf16(a[2], a[3]); w.z = cvt_pk_bf16(b[0], b[1]); w.w = cvt_pk_bf16(b[2], b[3]); return w; }

template <bool HALVES, int nN>
__device__ __forceinline__ bool tile_order(int i, int G, int c, int nM, int& pm, int& pn, int& half) {
    const int nwg = nM * nN; int L = i * G + c; half = -1;
    if (HALVES) { const int nfull = ((G & (G - 1)) == 0) ? (nwg & ~(G - 1)) : (nwg / G) * G, left = nwg - nfull;
        if (left > 0 && 2 * left <= G && L >= nfull) { const int hidx = L - nfull; if (hidx >= 2 * left) return false; L = nfull + (hidx >> 1); half = hidx & 1; } }
    if (L >= nwg) return false;
    int wgid = L; { const int q = nwg >> 3, r = nwg & 7, xcd = wgid & 7, off = wgid >> 3; wgid = (xcd < r ? xcd * (q + 1) : r * (q + 1) + (xcd - r) * q) + off; }
    constexpr int nig = WGM * nN; const int gid = wgid / nig, rem = wgid - gid * nig, fm = gid * WGM, gsz = (nM - fm) < WGM ? (nM - fm) : WGM;
    if (gsz == WGM) { pm = fm + (rem & (WGM - 1)); pn = rem >> 3; } else { pm = fm + rem % gsz; pn = rem / gsz; }
    return true;
}
template <int nN> struct DenseProb {
    static constexpr int RB = KD * 2;
    const bf16_t* A; const bf16_t* Bt; int nM, G, c;
    __device__ __forceinline__ bool next(int i, Unit& u) const { u.e = 0; u.slot0 = 0; u.nvalid = 256; u.r0 = 0; int half; return tile_order<false, nN>(i, G, c, nM, u.pm, u.pn, half); }
    __device__ __forceinline__ void addr_load(const Unit&, const int (&)[2], int (&)[4]) const {}
    __device__ __forceinline__ void addr_finish(const Unit& u, const int (&R)[2], const int (&C)[2], const int (&)[4], const char*& a, const char*& b, unsigned (&va0)[2], unsigned (&va1)[2]) const {
        a = (const char*)A + (size_t)u.pm * (BM * RB); b = (const char*)Bt + (size_t)u.pn * (BM * RB);
#pragma unroll
        for (int i = 0; i < 2; ++i) { va0[i] = (unsigned)(R[i] * RB + C[i] * 2); va1[i] = va0[i] + (unsigned)(HALF * RB); }
    }
};
template <bool GATHER, int ES, int nN> struct GroupedProb {
    static constexpr int RB = KD * ES;
    const void* A; const void* Bt; const int* ltok; const LAS int* tb; const LAS int* cn; int G, c;
    __device__ __forceinline__ bool next(int i, Unit& u) const {
        const LAS int* hb = tb + (LX_HB - LX_TB) / 4; const LAS int* lb = tb + (LX_LB - LX_TB) / 4;
        const int H = __builtin_amdgcn_readfirstlane(hb[NE]), Lt = __builtin_amdgcn_readfirstlane(lb[NE]), HU = H * nN, LU = Lt * nN;
        const int L = i * G + c, nfull = ((G & (G - 1)) == 0) ? (HU & ~(G - 1)) : (HU / G) * G, r = HU - nfull;
        const bool tail_half = r > 0 && 2 * r + LU <= G;
        int half = -1, idx; bool light = false;
        if (L < nfull) idx = L;
        else { const int Lp = L - nfull;
            if (tail_half) { if (Lp < 2 * r) { idx = nfull + (Lp >> 1); half = Lp & 1; } else { light = true; idx = Lp - 2 * r; } }
            else { if (Lp < r) idx = nfull + Lp; else { light = true; idx = Lp - r; } } }
        const int j = (int)(threadIdx.x & 31); int e;
        if (light) { if (idx >= LU) return false; const int le = idx / nN; u.pn = idx % nN;
            const unsigned long long hit = __ballot(lb[j] == le && lb[j + 1] == le + 1); e = __builtin_amdgcn_readfirstlane((int)__builtin_ctzll(hit | (1ull << 63)) & 31);
            u.pm = __builtin_amdgcn_readfirstlane(tb[e + 1]) - 1;
        } else { int wgid = idx; { const int q = HU >> 3, rr = HU & 7, xcd = wgid & 7, off = wgid >> 3; wgid = (xcd < rr ? xcd * (q + 1) : rr * (q + 1) + (xcd - rr) * q) + off; }
            constexpr int nig = WGM * nN; const int gid = wgid / nig, rem = wgid - gid * nig, fm = gid * WGM, gsz = (H - fm) < WGM ? (H - fm) : WGM; int ht;
            if (gsz == WGM) { ht = fm + (rem & (WGM - 1)); u.pn = rem >> 3; } else { ht = fm + rem % gsz; u.pn = rem / gsz; }
            const unsigned long long hit = __ballot(hb[j] <= ht && ht < hb[j + 1]); e = __builtin_amdgcn_readfirstlane((int)__builtin_ctzll(hit | (1ull << 63)) & 31);
            u.pm = __builtin_amdgcn_readfirstlane(tb[e]) + (ht - __builtin_amdgcn_readfirstlane(hb[e])); }
        const int t0 = __builtin_amdgcn_readfirstlane(tb[e]), ce = __builtin_amdgcn_readfirstlane(cn[e]);
        u.e = e; u.r0 = half == 1 ? HALF : 0; u.slot0 = (u.pm - t0) * 256 + u.r0; int rem2 = ce - u.slot0; const int lim = half >= 0 ? HALF : 256; rem2 = rem2 < lim ? rem2 : lim; u.nvalid = rem2 < 0 ? 0 : rem2; return true;
    }
    __device__ __forceinline__ void addr_load(const Unit& u, const int (&R)[2], int (&raw)[4]) const {
        if (GATHER) { const int* lt = ltok + u.e * CAP + u.slot0;
#pragma unroll
            for (int i = 0; i < 2; ++i) { const int r0 = R[i], r1 = R[i] + HALF; raw[2 * i] = r0 < u.nvalid ? lt[r0] : 0; raw[2 * i + 1] = r1 < u.nvalid ? lt[r1] : 0; } }
    }
    __device__ __forceinline__ void addr_finish(const Unit& u, const int (&R)[2], const int (&C)[2], const int (&raw)[4], const char*& a, const char*& b, unsigned (&va0)[2], unsigned (&va1)[2]) const {
        b = (const char*)Bt + ((size_t)u.e * nN + u.pn) * (BM * RB);
        if (GATHER) { a = (const char*)A;
#pragma unroll
            for (int i = 0; i < 2; ++i) { va0[i] = (unsigned)(raw[2 * i] * RB + C[i] * 2); va1[i] = (unsigned)(raw[2 * i + 1] * RB + C[i] * 2); }
        } else { a = (const char*)A + (size_t)(u.pm * BM + u.r0) * RB;
#pragma unroll
            for (int i = 0; i < 2; ++i) { va0[i] = (unsigned)(R[i] * RB + C[i] * 2); va1[i] = va0[i] + (unsigned)(HALF * RB); }
        }
    }
};

template <int ES  , class Prob, class Epi>
__device__ __forceinline__ void gemm_phase(LAS unsigned char* lds, const Prob& P, const Epi& E) {
    const int tid = threadIdx.x, wid = __builtin_amdgcn_readfirstlane(tid >> 6), lane = tid & 63, wr = wid >> 2, wc = wid & 3, fr = lane & 15, fq = lane >> 4;
    constexpr int RB = KD * ES, nt = RB / (BK * 2);
    int R[2], C[2]; unsigned voffB[2];
#pragma unroll
    for (int i = 0; i < 2; ++i) { stage_rc(tid * 16 + i * 8192, R[i], C[i]); voffB[i] = (unsigned)(R[i] * RB + C[i] * 2); }
    constexpr size_t kstep = (size_t)(BK * 2);
    constexpr size_t hstep = (size_t)HALF * RB;
    const unsigned ldsw = (unsigned)wid * 1024u;
    const int aoff = lds_byte(wr * 64 + fr, fq * 8), boff = lds_byte(wc * 32 + fr, fq * 8);
#define PG8_SA(b, h) (((b) * 2 + (h)) * HTB)
#define PG8_SB(b, h) ((4 + (b) * 2 + (h)) * HTB)
#define PG8_STAGE(bufoff, gbase, voff) do { _Pragma("unroll") for (int _i = 0; _i < 2; ++_i) \
        __builtin_amdgcn_global_load_lds((const unsigned*)((const char*)(gbase) + (voff)[_i]), (LAS unsigned*)(lds + (bufoff) + ldsw + _i * 8192), 16, 0, 0); } while (0)
#define PG8_LDA(dst, b, h) do { _Pragma("unroll") for (int m = 0; m < 4; ++m) { \
        if constexpr (ES == 2) { _Pragma("unroll") for (int k = 0; k < 2; ++k) dst[m][k] = *(const LAS bf16x8*)(lds + PG8_SA(b, h) + aoff + m * 2048 + k * 1024); } \
        else { const i32x4 lo_ = *(const LAS i32x4*)(lds + PG8_SA(b, h) + aoff + m * 2048), hi_ = *(const LAS i32x4*)(lds + PG8_SA(b, h) + aoff + m * 2048 + 1024); dst##8[m] = __builtin_shufflevector(lo_, hi_, 0, 1, 2, 3, 4, 5, 6, 7); } } } while (0)
#define PG8_LDB(dst, b, h) do { _Pragma("unroll") for (int n = 0; n < 2; ++n) { \
        if constexpr (ES == 2) { _Pragma("unroll") for (int k = 0; k < 2; ++k) dst[n][k] = *(const LAS bf16x8*)(lds + PG8_SB(b, h) + boff + n * 2048 + k * 1024); } \
        else { const i32x4 lo_ = *(const LAS i32x4*)(lds + PG8_SB(b, h) + boff + n * 2048), hi_ = *(const LAS i32x4*)(lds + PG8_SB(b, h) + boff + n * 2048 + 1024); dst##8[n] = __builtin_shufflevector(lo_, hi_, 0, 1, 2, 3, 4, 5, 6, 7); } } } while (0)
#define PG8_MMA(ai, bj, At, Bt) do { __builtin_amdgcn_s_setprio(1); _Pragma("unroll") for (int m = 0; m < 4; ++m) _Pragma("unroll") for (int n = 0; n < 2; ++n) { \
        if constexpr (ES == 2) { _Pragma("unroll") for (int k = 0; k < 2; ++k) acc[ai][bj][m][n] = __builtin_amdgcn_mfma_f32_16x16x32_bf16(Bt[n][k], At[m][k], acc[ai][bj][m][n], 0, 0, 0); } \
        else asm volatile("s_nop 1\n\tv_mfma_scale_f32_16x16x128_f8f6f4 %0, %1, %2, %0, %3, %3 op_sel_hi:[0,0,0]" : "+v"(acc[ai][bj][m][n]) : "v"(Bt##8[n]), "v"(At##8[m]), "v"(sc127)); } \
        __builtin_amdgcn_s_setprio(0); } while (0)
#define PG8_WAIT_V(n) asm volatile("s_waitcnt vmcnt(" #n ")" ::: "memory")
#define PG8_WAIT_L(n) do { asm volatile("s_waitcnt lgkmcnt(" #n ")" ::: "memory"); __builtin_amdgcn_s_waitcnt(0xC07F); } while (0)
#define PG8_BAR __builtin_amdgcn_s_barrier()
#define PG8_SCHED __builtin_amdgcn_sched_barrier(0)
    Unit cur, nxt, nn; int ui = 0; int raw[4] = {0, 0, 0, 0};
    if (!P.next(0, cur)) return;
    bool has_next = P.next(1, nxt);
    const char *cA, *cB, *nA, *nB; unsigned va0[2], va1[2], nva0[2], nva1[2];
    P.addr_load(cur, R, raw); P.addr_finish(cur, R, C, raw, cA, cB, va0, va1);
    if (has_next) { P.addr_load(nxt, R, raw); P.addr_finish(nxt, R, C, raw, nA, nB, nva0, nva1); }
    else { nA = cA; nB = cB; nva0[0] = va0[0]; nva0[1] = va0[1]; nva1[0] = va1[0]; nva1[1] = va1[1]; }
    f32x4 acc[2][2][4][2];
#pragma unroll
    for (int a = 0; a < 2; ++a)
#pragma unroll
        for (int b = 0; b < 2; ++b)
#pragma unroll
            for (int m = 0; m < 4; ++m)
#pragma unroll
                for (int n = 0; n < 2; ++n) acc[a][b][m][n] = (f32x4){0.f, 0.f, 0.f, 0.f};
    const int sc127 = 0x7F7F7F7F;
    bf16x8 At[4][2], B0[2][2], B1[2][2]; i32x8 At8[4], B08[2], B18[2];
    PG8_STAGE(PG8_SB(0, 0), cB, voffB); PG8_STAGE(PG8_SB(0, 1), cB + hstep, voffB); PG8_STAGE(PG8_SA(0, 0), cA, va0); PG8_STAGE(PG8_SA(0, 1), cA, va1);
    if (wr == 1) PG8_BAR;
    PG8_WAIT_V(2); PG8_BAR;
    PG8_STAGE(PG8_SB(1, 0), cB + kstep, voffB); PG8_STAGE(PG8_SA(1, 0), cA + kstep, va0); PG8_STAGE(PG8_SB(1, 1), cB + hstep + kstep, voffB);
    PG8_WAIT_V(6); PG8_BAR;
    for (;;) {
        const bool full = cur.nvalid > HALF;
#pragma unroll 1
        for (int t = 0; t < nt; t += 2) {
            const bool last = (t == nt - 2);
            const char* a1 = cA + (size_t)(t + 1) * kstep;
            const char* a2 = last ? nA : cA + (size_t)(t + 2) * kstep; const char* b2 = last ? nB : cB + (size_t)(t + 2) * kstep;
            const char* a3 = a2 + kstep; const char* b3 = b2 + kstep;
            unsigned v2a0[2], v2a1[2];
            v2a0[0] = last ? nva0[0] : va0[0]; v2a0[1] = last ? nva0[1] : va0[1]; v2a1[0] = last ? nva1[0] : va1[0]; v2a1[1] = last ? nva1[1] : va1[1];
            PG8_LDB(B0, 0, 0); PG8_LDB(B1, 0, 1); PG8_SCHED; PG8_LDA(At, 0, 0); PG8_STAGE(PG8_SA(1, 1), a1, va1);
            PG8_WAIT_V(8); PG8_WAIT_L(0); PG8_BAR; PG8_MMA(0, 0, At, B0); PG8_MMA(0, 1, At, B1); PG8_BAR; PG8_SCHED;
            PG8_LDA(At, 0, 1); PG8_STAGE(PG8_SB(0, 0), b2, voffB); PG8_STAGE(PG8_SB(0, 1), b2 + hstep, voffB); PG8_STAGE(PG8_SA(0, 0), a2, v2a0);
            PG8_WAIT_V(8); PG8_WAIT_L(0); PG8_BAR; if (full) { PG8_MMA(1, 0, At, B0); PG8_MMA(1, 1, At, B1); } PG8_BAR; PG8_SCHED;
            PG8_LDB(B0, 1, 0); PG8_LDB(B1, 1, 1); PG8_SCHED; PG8_LDA(At, 1, 0); PG8_STAGE(PG8_SA(0, 1), a2, v2a1);
            PG8_WAIT_V(8); PG8_WAIT_L(0); PG8_BAR; PG8_MMA(0, 0, At, B0); PG8_MMA(0, 1, At, B1); PG8_BAR; PG8_SCHED;
            PG8_LDA(At, 1, 1); PG8_STAGE(PG8_SB(1, 0), b3, voffB); PG8_STAGE(PG8_SB(1, 1), b3 + hstep, voffB); PG8_STAGE(PG8_SA(1, 0), a3, v2a0);
            PG8_WAIT_V(8); PG8_WAIT_L(0); PG8_BAR; if (full) { PG8_MMA(1, 0, At, B0); PG8_MMA(1, 1, At, B1); } PG8_BAR; PG8_SCHED;
        }
        if constexpr (ES == 1) { asm volatile("s_nop 15\n\ts_nop 15" ::: "memory"); __builtin_amdgcn_sched_barrier(0); }
        const bool has_nn = has_next && P.next(ui + 2, nn);
        if (has_nn) P.addr_load(nn, R, raw);
        if (wr == 0) PG8_BAR;
        E(acc, cur, wr, wc, fr, fq);
        if (!has_next) break;
#pragma unroll
        for (int a = 0; a < 2; ++a)
#pragma unroll
            for (int b = 0; b < 2; ++b)
#pragma unroll
                for (int m = 0; m < 4; ++m)
#pragma unroll
                    for (int n = 0; n < 2; ++n) acc[a][b][m][n] = (f32x4){0.f, 0.f, 0.f, 0.f};
        cur = nxt; cA = nA; cB = nB; va0[0] = nva0[0]; va0[1] = nva0[1]; va1[0] = nva1[0]; va1[1] = nva1[1]; ++ui;
        nxt = nn; has_next = has_nn;
        if (has_next) P.addr_finish(nxt, R, C, raw, nA, nB, nva0, nva1);
        if (wr == 1) PG8_BAR;
    }
    PG8_WAIT_V(0);
    PG8_BAR;
#undef PG8_SA
#undef PG8_SB
#undef PG8_STAGE
#undef PG8_LDA
#undef PG8_LDB
#undef PG8_MMA
#undef PG8_WAIT_V
#undef PG8_WAIT_L
#undef PG8_BAR
#undef PG8_SCHED
}

struct EpiOut {
    const float* x; float* out; bf16_t* xn2; unsigned char* xn2f8;
    __device__ __forceinline__ void operator()(const f32x4 (&acc)[2][2][4][2], const Unit& u, int wr, int wc, int fr, int fq) const {
        const int row0 = u.pm * BM + wr * 64 + fr, col0 = u.pn * BM + wc * 32 + 8 * fq;
#pragma unroll
        for (int ai = 0; ai < 2; ++ai)
#pragma unroll
            for (int m = 0; m < 4; ++m) { const size_t off = (size_t)(row0 + ai * HALF + m * 16) * D + col0;
#pragma unroll
                for (int bj = 0; bj < 2; ++bj) { const float* xp = x + off + bj * HALF;
                    const f32x4 h0 = acc[ai][bj][m][0] + *(const f32x4*)xp, h1 = acc[ai][bj][m][1] + *(const f32x4*)(xp + 4);
                    *(u32x4*)(xn2 + off + bj * HALF) = pack8(h0, h1);
                    *(u32x2*)(xn2f8 + off + bj * HALF) = (u32x2){pk4_fp8(h0[0], h0[1], h0[2], h0[3]), pk4_fp8(h1[0], h1[1], h1[2], h1[3])}; }
                asm volatile("" ::: "memory"); }
    }
};
struct EpiIn {
    bf16_t *Qb, *Kb, *VT, *HC; const float *qg, *kg;
    __device__ __forceinline__ void operator()(const f32x4 (&acc)[2][2][4][2], const Unit& u, int wr, int wc, int fr, int fq) const {
        const int rowb = u.pm * BM + wr * 64 + fr;
        if (u.pn <= 2) {
            const bool isv = (u.pn == 2) && (wc >= 2);
            if (!isv) {
                const bool isq = u.pn < 2; const float* g = isq ? qg : kg; const float sc = isq ? QSCALE : 1.f;
                f32x4 gv[2][2];
#pragma unroll
                for (int bj = 0; bj < 2; ++bj)
#pragma unroll
                    for (int n = 0; n < 2; ++n) gv[bj][n] = *(const f32x4*)(g + 32 * bj + 8 * fq + 4 * n) * sc;
                bf16_t* dst = isq ? Qb + (u.pn * 256 + 64 * wc) : Kb + 64 * wc; const int ld = isq ? 512 : 128;
#pragma unroll
                for (int ai = 0; ai < 2; ++ai)
#pragma unroll
                    for (int m = 0; m < 4; ++m) { const int row = rowb + ai * HALF + m * 16; float ss = 0.f;
#pragma unroll
                        for (int bj = 0; bj < 2; ++bj)
#pragma unroll
                            for (int n = 0; n < 2; ++n) { const f32x4 v = acc[ai][bj][m][n]; ss += (v[0] * v[0] + v[1] * v[1]) + (v[2] * v[2] + v[3] * v[3]); }
                        ss += __shfl_xor(ss, 16); ss += __shfl_xor(ss, 32);
                        const float r = __builtin_amdgcn_rsqf(ss * (1.f / 64.f) + 1e-6f);
#pragma unroll
                        for (int bj = 0; bj < 2; ++bj) *(u32x4*)(dst + (size_t)row * ld + 32 * bj + 8 * fq) = pack8(acc[ai][bj][m][0] * r * gv[bj][0], acc[ai][bj][m][1] * r * gv[bj][1]); }
            } else {
                const int hk = wc - 2;
#pragma unroll
                for (int ai = 0; ai < 2; ++ai)
#pragma unroll
                    for (int m = 0; m < 4; ++m) { const int row = rowb + ai * HALF + m * 16;
                        if (row < M_ALL) { int b, kx; if (row < M_REAL) { b = row >> 11; kx = NMETA + (row & 2047); } else { b = (row - M_REAL) >> 4; kx = (row - M_REAL) & 15; }
                            bf16_t* base = VT + (size_t)(b * 2 + hk) * 64 * VT_PITCH + kx;
#pragma unroll
                            for (int bj = 0; bj < 2; ++bj)
#pragma unroll
                                for (int n = 0; n < 2; ++n)
#pragma unroll
                                    for (int e = 0; e < 4; ++e) base[(size_t)(32 * bj + 8 * fq + 4 * n + e) * VT_PITCH] = (bf16_t)f2bf(acc[ai][bj][m][n][e]); } }
            }
        } else {
            const int col = (u.pn - 3) * 128 + 32 * wc + 8 * fq;
#pragma unroll
            for (int ai = 0; ai < 2; ++ai)
#pragma unroll
                for (int m = 0; m < 4; ++m) { const int row = rowb + ai * HALF + m * 16; f32x4 h[2];
#pragma unroll
                    for (int n = 0; n < 2; ++n)
#pragma unroll
                        for (int e = 0; e < 4; ++e) h[n][e] = acc[ai][0][m][n][e] * sigmoidf_fast(acc[ai][1][m][n][e]);
                    *(u32x4*)(HC + (size_t)row * 512 + col) = pack8(h[0], h[1]); }
        }
    }
};
struct EpiGU {
    unsigned char* ACT; const float* lrstd; const float* bgu;
    __device__ __forceinline__ void operator()(const f32x4 (&acc)[2][2][4][2], const Unit& u, int wr, int wc, int fr, int fq) const {
        const int lr0 = wr * 64 + fr, col = u.pn * 128 + 32 * wc + 8 * fq;
        f32x2 bg[2][2], bu[2][2];
#pragma unroll
        for (int n = 0; n < 2; ++n) { const f32x4 g4 = *(const f32x4*)(bgu + u.e * 2048 + col + 4 * n), u4 = *(const f32x4*)(bgu + u.e * 2048 + 1024 + col + 4 * n);
            bg[n][0] = (f32x2){g4[0], g4[1]}; bg[n][1] = (f32x2){g4[2], g4[3]}; bu[n][0] = (f32x2){u4[0], u4[1]}; bu[n][1] = (f32x2){u4[2], u4[3]}; }
        const float* rs = lrstd + u.e * CAP + u.slot0;
#pragma unroll
        for (int ai = 0; ai < 2; ++ai) {
            if (ai == 1 && u.nvalid <= HALF) break;
#pragma unroll
            for (int m = 0; m < 4; ++m) { const int lr = lr0 + ai * HALF + m * 16; const float rstd = lr < u.nvalid ? rs[lr] * (1.f / WSCALE) : 0.f; f32x2 h[2][2];
#pragma unroll
                for (int n = 0; n < 2; ++n)
#pragma unroll
                    for (int p = 0; p < 2; ++p) {
                        f32x2 gt = (f32x2){acc[ai][0][m][n][2 * p], acc[ai][0][m][n][2 * p + 1]} * rstd + bg[n][p];
                        f32x2 up = (f32x2){acc[ai][1][m][n][2 * p], acc[ai][1][m][n][2 * p + 1]} * rstd + bu[n][p];
                        gt.x = fminf(gt.x, 7.f); gt.y = fminf(gt.y, 7.f); up.x = __builtin_amdgcn_fmed3f(up.x, -7.f, 7.f); up.y = __builtin_amdgcn_fmed3f(up.y, -7.f, 7.f);
                        const f32x2 z = gt * (-1.702f * LOG2E); f32x2 ex; ex.x = __builtin_amdgcn_exp2f(z.x); ex.y = __builtin_amdgcn_exp2f(z.y);
                        const f32x2 dn = ex + 1.0f; f32x2 rc; rc.x = __builtin_amdgcn_rcpf(dn.x); rc.y = __builtin_amdgcn_rcpf(dn.y);
                        const f32x2 t = gt * rc; h[n][p] = t * up + t; }
                *(u32x2*)(ACT + (size_t)(u.pm * BM + u.r0 + lr) * D + col) = (u32x2){pk4_fp8(h[0][0].x, h[0][0].y, h[0][1].x, h[0][1].y), pk4_fp8(h[1][0].x, h[1][0].y, h[1][1].x, h[1][1].y)}; }
        }
    }
};
struct EpiDown {
    unsigned char* Y; const float* lgate; const float* bd;
    __device__ __forceinline__ void operator()(const f32x4 (&acc)[2][2][4][2], const Unit& u, int wr, int wc, int fr, int fq) const {
        const int lr0 = wr * 64 + fr, col0 = u.pn * BM + wc * 32 + 8 * fq;
        f32x4 bv[2][2];
#pragma unroll
        for (int bj = 0; bj < 2; ++bj)
#pragma unroll
            for (int n = 0; n < 2; ++n) bv[bj][n] = *(const f32x4*)(bd + u.e * D + col0 + bj * HALF + 4 * n);
        const float* gs = lgate + u.e * CAP + u.slot0;
#pragma unroll
        for (int ai = 0; ai < 2; ++ai)
#pragma unroll
            for (int m = 0; m < 4; ++m) { if (ai == 1 && u.nvalid <= HALF) continue; const int lr = lr0 + ai * HALF + m * 16; const float gt = lr < u.nvalid ? gs[lr] : 0.f;
#pragma unroll
                for (int bj = 0; bj < 2; ++bj) { const f32x4 y0 = (acc[ai][bj][m][0] * (1.f / WSCALE) + bv[bj][0]) * gt, y1 = (acc[ai][bj][m][1] * (1.f / WSCALE) + bv[bj][1]) * gt;
                    *(u32x2*)(Y + (size_t)(u.pm * BM + u.r0 + lr) * D + col0 + bj * HALF) = (u32x2){pk4_fp8(y0[0], y0[1], y0[2], y0[3]), pk4_fp8(y1[0], y1[1], y1[2], y1[3])}; } }
    }
};
}


constexpr int ATT_KIMG = 0, ATT_VIMG = 53248, ATT_VP = 840;
constexpr float ATT_THR = 4.0f;
struct AttHead { float m, l, slope2; f32x16 O0, O1; };
template <int MODE>
__device__ __forceinline__ void att_softmax(f32x16& s, AttHead& H, float Bq, float lim, bf16x8 (&pf)[2]) {
    float tmax = -INFINITY;
#pragma unroll
    for (int r = 0; r < 16; ++r) {
        if (MODE == 0) { if (r >= 8) s[r] = -INFINITY; }
        else { const float dl = fabsf(Bq - (float)((r & 3) + 8 * (r >> 2))); const float v = s[r] - H.slope2 * dl; s[r] = dl <= lim ? v : -INFINITY; }
        tmax = fmaxf(tmax, s[r]);
    }
    tmax = fmaxf(tmax, __shfl_xor(tmax, 32));
    if (__any(tmax > H.m + ATT_THR)) { const float mn = fmaxf(H.m, tmax); const float al = __builtin_amdgcn_exp2f(H.m - mn); H.m = mn; H.l *= al;
#pragma unroll
        for (int r = 0; r < 16; ++r) { H.O0[r] *= al; H.O1[r] *= al; } }
    float ps = 0.f;
#pragma unroll
    for (int r = 0; r < 16; ++r) { s[r] = __builtin_amdgcn_exp2f(s[r] - H.m); ps += s[r]; }
    H.l += ps;
#pragma unroll
    for (int s2 = 0; s2 < 2; ++s2) { u32x4 pw; pw.x = pg8::cvt_pk_bf16(s[8 * s2 + 0], s[8 * s2 + 1]); pw.y = pg8::cvt_pk_bf16(s[8 * s2 + 2], s[8 * s2 + 3]); pw.z = pg8::cvt_pk_bf16(s[8 * s2 + 4], s[8 * s2 + 5]); pw.w = pg8::cvt_pk_bf16(s[8 * s2 + 6], s[8 * s2 + 7]);
        pf[s2] = __builtin_bit_cast(bf16x8, pw); }
}
template <int MODE>
__device__ __forceinline__ void att_tile2(const LAS unsigned char* kbase, const int (&koff)[4], const LAS unsigned char* vbase, const bf16x8 (&qa)[4], const bf16x8 (&qb)[4], float Bq, float lim, AttHead& A, AttHead& B) {
    f32x16 sa, sb;
#pragma unroll
    for (int r = 0; r < 16; ++r) { sa[r] = 0.f; sb[r] = 0.f; }
#pragma unroll
    for (int ks = 0; ks < 4; ++ks) { const bf16x8 kf = *(const LAS bf16x8*)(kbase + koff[ks]);
        sa = __builtin_amdgcn_mfma_f32_32x32x16_bf16(kf, qa[ks], sa, 0, 0, 0); sb = __builtin_amdgcn_mfma_f32_32x32x16_bf16(kf, qb[ks], sb, 0, 0, 0); }
    bf16x8 pa[2], pb[2];
    att_softmax<MODE>(sa, A, Bq, lim, pa);
    att_softmax<MODE>(sb, B, Bq, lim, pb);
#pragma unroll
    for (int s2 = 0; s2 < 2; ++s2) {
        { const u32x2 lo = *(const LAS u32x2*)(vbase + s2 * 32), hi = *(const LAS u32x2*)(vbase + s2 * 32 + 16); const bf16x8 vf = __builtin_bit_cast(bf16x8, (u32x4){lo.x, lo.y, hi.x, hi.y});
          A.O0 = __builtin_amdgcn_mfma_f32_32x32x16_bf16(vf, pa[s2], A.O0, 0, 0, 0); B.O0 = __builtin_amdgcn_mfma_f32_32x32x16_bf16(vf, pb[s2], B.O0, 0, 0, 0); }
        { const u32x2 lo = *(const LAS u32x2*)(vbase + 32 * ATT_VP + s2 * 32), hi = *(const LAS u32x2*)(vbase + 32 * ATT_VP + s2 * 32 + 16); const bf16x8 vf = __builtin_bit_cast(bf16x8, (u32x4){lo.x, lo.y, hi.x, hi.y});
          A.O1 = __builtin_amdgcn_mfma_f32_32x32x16_bf16(vf, pa[s2], A.O1, 0, 0, 0); B.O1 = __builtin_amdgcn_mfma_f32_32x32x16_bf16(vf, pb[s2], B.O1, 0, 0, 0); }
    }
}
__device__ __forceinline__ void att_fast(Frame& F) {
    LAS unsigned char* Kimg = F.lds + ATT_KIMG; LAS unsigned char* Vimg = F.lds + ATT_VIMG;
    const int tid = F.tid, lane = F.lane, wid = F.wave, q = lane & 31, h = lane >> 5, qt = wid & 3, hsel = wid >> 2;
    int koff[4];
#pragma unroll
    for (int ks = 0; ks < 4; ++ks) koff[ks] = ((2 * ks + h) ^ ((q >> 1) & 7)) << 4;
    const int vb = (F.G & 7) == 0 ? (F.bid & 7) * (F.G >> 3) + (F.bid >> 3) : F.bid;
    for (int item = vb; item < NB * 16 * 2; item += F.G) {
        const int hk = item & 1, i = (item >> 1) & 15, b = item >> 5;
        const int row = b * SEQ + i * 128 + 32 * qt + q;
        bf16x8 qf[2][4];
#pragma unroll
        for (int hp = 0; hp < 2; ++hp)
#pragma unroll
            for (int ks = 0; ks < 4; ++ks) qf[hp][ks] = *(const GAS bf16x8*)(F.Qb + (size_t)row * 512 + (hk * 4 + hp * 2 + hsel) * 64 + 16 * ks + 8 * h);
        __syncthreads();
        {
            const int c8 = tid & 7, r64 = tid >> 3; u32x4 kv[7], vv[7];
            const bf16_t* vrow = F.VT + (size_t)((b * 2 + hk) * 64 + r64) * VT_PITCH;
#pragma unroll
            for (int it = 0; it < 7; ++it) { const int kr = r64 + 64 * it; int pos = (i - 1) * 128 + kr - 32; pos = pos < 0 ? 0 : (pos >= SEQ ? SEQ - 1 : pos);
                const int row = kr < 16 ? M_REAL + b * NMETA + kr : b * SEQ + pos;
                kv[it] = *(const GAS u32x4*)(F.Kb + (size_t)row * 128 + hk * 64 + 8 * c8); }
#pragma unroll
            for (int it = 0; it < 7; ++it) { const int c = c8 + 8 * it, cc = c - 4, blk = cc >> 4, w = cc & 15, pos0 = (i - 1 + blk) * 128; const bool inr = c >= 4 && c < 52 && pos0 >= 0 && pos0 < SEQ;
                const bf16_t* src = inr ? vrow + NMETA + pos0 + 8 * w : vrow + 8 * (c & 1);
                vv[it] = *(const GAS u32x4*)src; }
#pragma unroll
            for (int it = 0; it < 7; ++it) { const int kr = r64 + 64 * it; if (kr < 416) *(LAS u32x4*)(Kimg + kr * 128 + ((c8 ^ ((kr >> 1) & 7)) << 4)) = kv[it]; }
#pragma unroll
            for (int it = 0; it < 7; ++it) { const int c = c8 + 8 * it; if (c < 52) { const int cc = c - 4; const int koffs = c < 4 ? 8 * c : 32 + 8 * cc;
                    u32x4 v = vv[it]; if (c >= 2 && c < 4) v = (u32x4){0u, 0u, 0u, 0u};
                    LAS u32x2* dst = (LAS u32x2*)(Vimg + r64 * ATT_VP + koffs * 2); dst[0] = (u32x2){v.x, v.y}; dst[1] = (u32x2){v.z, v.w}; } }
        }
        __syncthreads();
        if (PROBE_PH >= 0 && F.bid == 100 && F.tid == 0) ((volatile LAS unsigned*)(F.lds + RING_BYTES + 1024))[11] = (unsigned)__builtin_amdgcn_s_memrealtime();
        {
            AttHead H[2];
#pragma unroll
            for (int hp = 0; hp < 2; ++hp) { const int head = hk * 4 + hp * 2 + hsel; H[hp].slope2 = exp2f(-(float)(head + 1)) * LOG2E; H[hp].m = F.sink[head] * LOG2E; H[hp].l = h == 0 ? 1.f : 0.f;
#pragma unroll
                for (int r = 0; r < 16; ++r) { H[hp].O0[r] = 0.f; H[hp].O1[r] = 0.f; } }
            const LAS unsigned char* kb0 = Kimg + q * 128; const LAS unsigned char* vb0 = Vimg + q * ATT_VP + 8 * h;
            att_tile2<0>(kb0, koff, vb0, qf[0], qf[1], 0.f, 0.f, H[0], H[1]);
#pragma unroll 1
            for (int kt = qt; kt <= qt + 8; ++kt) { const int blk = kt >> 2; if ((i == 0 && blk == 0) || (i == 15 && blk == 2)) continue;
                const int kr0 = 32 + 32 * kt; const float Bq = (float)(128 + 32 * (qt - kt) + q - 4 * h);
                att_tile2<1>(kb0 + kr0 * 128, koff, vb0 + kr0 * 2, qf[0], qf[1], Bq, (kt == qt || kt == qt + 8) ? 128.f : 1e30f, H[0], H[1]); }
#pragma unroll
            for (int hp = 0; hp < 2; ++hp) { const int head = hk * 4 + hp * 2 + hsel; float l = H[hp].l; l += __shfl_xor(l, 32); const float inv = 1.f / l;
                bf16_t* orow = F.MIX + (size_t)row * D + head * 64 + 4 * h;
#pragma unroll
                for (int g = 0; g < 4; ++g) { *(GAS u32x2*)(orow + 8 * g) = (u32x2){pg8::cvt_pk_bf16(H[hp].O0[4 * g] * inv, H[hp].O0[4 * g + 1] * inv), pg8::cvt_pk_bf16(H[hp].O0[4 * g + 2] * inv, H[hp].O0[4 * g + 3] * inv)};
                    *(GAS u32x2*)(orow + 32 + 8 * g) = (u32x2){pg8::cvt_pk_bf16(H[hp].O1[4 * g] * inv, H[hp].O1[4 * g + 1] * inv), pg8::cvt_pk_bf16(H[hp].O1[4 * g + 2] * inv, H[hp].O1[4 * g + 3] * inv)}; } }
        }
    }
    __syncthreads();
}
__device__ __forceinline__ void conv_fast(Frame& F) {
    const int tid = F.tid, lane = F.lane, wid = F.wave, c2 = tid & 255, th = tid >> 8;
    LAS float* cout = (LAS float*)F.lds;
    float w0[CONV_K], w1[CONV_K];
#pragma unroll
    for (int j = 0; j < CONV_K; ++j) { const f32x2 w = *(const f32x2*)(F.dw_w + j * CONV_W + 2 * c2); w0[j] = w.x; w1[j] = w.y; }
    const f32x2 bias = *(const f32x2*)(F.dw_b + 2 * c2);
    const f32x4 g0 = *(const f32x4*)(F.lng + 8 * lane), g1 = *(const f32x4*)(F.lng + 8 * lane + 4), b0 = *(const f32x4*)(F.lnb + 8 * lane), b1 = *(const f32x4*)(F.lnb + 8 * lane + 4);
    const int vb = (F.G & 7) == 0 ? (F.bid & 7) * (F.G >> 3) + (F.bid >> 3) : F.bid;
    for (int item = vb; item < NB * 32; item += F.G) {
        const int b = item >> 5, t0 = (item & 31) * 64;
        unsigned xin[62];
        const int s0 = NMETA + t0 + 32 * th - 15;
#pragma unroll
        for (int jj = 0; jj < 62; ++jj) { const int sq = s0 + jj; xin[jj] = sq < LSEQ ? *(const GAS unsigned*)(F.HC + (size_t)row_of(b, sq) * 512 + 2 * c2) : 0u; }
        __syncthreads();
#pragma unroll
        for (int t = 0; t < 32; ++t) { float a0 = bias.x, a1 = bias.y;
#pragma unroll
            for (int j = 0; j < CONV_K; ++j) { a0 += w0[j] * bflo(xin[t + j]); a1 += w1[j] * bfhi(xin[t + j]); }
            *(LAS f32x2*)(cout + (32 * th + t) * 512 + 2 * c2) = (f32x2){a0, a1}; }
        __syncthreads();
#pragma unroll 1
        for (int hb = 0; hb < 2; ++hb) {
            f32x4 x0[4], x1[4]; float sm[4], sq[4];
#pragma unroll
            for (int tt = 0; tt < 4; ++tt) { const LAS f32x4* rp = (const LAS f32x4*)(cout + (8 * wid + 4 * hb + tt) * 512 + 8 * lane); x0[tt] = rp[0]; x1[tt] = rp[1];
                sm[tt] = (x0[tt][0] + x0[tt][1]) + (x0[tt][2] + x0[tt][3]) + (x1[tt][0] + x1[tt][1]) + (x1[tt][2] + x1[tt][3]);
                sq[tt] = (x0[tt][0] * x0[tt][0] + x0[tt][1] * x0[tt][1]) + (x0[tt][2] * x0[tt][2] + x0[tt][3] * x0[tt][3]) + (x1[tt][0] * x1[tt][0] + x1[tt][1] * x1[tt][1]) + (x1[tt][2] * x1[tt][2] + x1[tt][3] * x1[tt][3]); }
#pragma unroll
            for (int o = 1; o < 64; o <<= 1)
#pragma unroll
                for (int tt = 0; tt < 4; ++tt) { sm[tt] += __shfl_xor(sm[tt], o); sq[tt] += __shfl_xor(sq[tt], o); }
#pragma unroll
            for (int tt = 0; tt < 4; ++tt) { const float mu = sm[tt] * (1.f / 512.f); const float var = fmaxf(sq[tt] * (1.f / 512.f) - mu * mu, 0.f); const float rstd = __builtin_amdgcn_rsqf(var + 1e-5f);
                f32x4 y0 = (x0[tt] - mu) * rstd * g0 + b0, y1 = (x1[tt] - mu) * rstd * g1 + b1;
#pragma unroll
                for (int e = 0; e < 4; ++e) { y0[e] *= sigmoidf_fast(y0[e]); y1[e] *= sigmoidf_fast(y1[e]); }
                *(GAS u32x4*)(F.MIX + (size_t)(b * SEQ + t0 + 8 * wid + 4 * hb + tt) * D + 512 + 8 * lane) = pg8::pack8(y0, y1); }
        }
    }
    __syncthreads();
}
__device__ __forceinline__ void p4_fast(Frame& F) {
    LAS int* lcnt = (LAS int*)(F.lds + LX_LCNT); LAS int* gbase = (LAS int*)(F.lds + LX_GBASE); LAS float* part = (LAS float*)F.lds;
    const int tid = F.tid, lane = F.lane, wid = F.wave, j = lane & 31, h = lane >> 5, grp = wid >> 2, sub = wid & 3;
    for (int base = 0; base < M_REAL / 32; base += F.G * 2) {
        const int tile = base + F.bid + F.G * grp; const bool active = tile < M_REAL / 32;
        if (tid < NE) lcnt[tid] = 0;
        int tok = 0;
        if (active) {
            tok = tile * 32 + j;
            const bf16_t* xa = F.XN2 + (size_t)tok * D + 256 * sub + 8 * h; const bf16_t* wa = F.WrT + (size_t)j * D + 256 * sub + 8 * h;
            f32x16 acc;
#pragma unroll
            for (int r = 0; r < 16; ++r) acc[r] = 0.f;
            float ssq = 0.f;
#pragma unroll
            for (int ks = 0; ks < 16; ++ks) { const u32x4 xb = *(const GAS u32x4*)(xa + 16 * ks); const bf16x8 wf = *(const GAS bf16x8*)(wa + 16 * ks);
                acc = __builtin_amdgcn_mfma_f32_32x32x16_bf16(wf, __builtin_bit_cast(bf16x8, xb), acc, 0, 0, 0);
                ssq += (bflo(xb.x) * bflo(xb.x) + bfhi(xb.x) * bfhi(xb.x)) + (bflo(xb.y) * bflo(xb.y) + bfhi(xb.y) * bfhi(xb.y)) + (bflo(xb.z) * bflo(xb.z) + bfhi(xb.z) * bfhi(xb.z)) + (bflo(xb.w) * bflo(xb.w) + bfhi(xb.w) * bfhi(xb.w)); }
            LAS float* p = part + (size_t)((grp * 4 + sub) * 17) * 64 + lane;
#pragma unroll
            for (int r = 0; r < 16; ++r) p[r * 64] = acc[r];
            p[16 * 64] = ssq;
        }
        __syncthreads();
        int ea = 0, eb = 0, sa = 0, sb = 0; float ga = 0.f, gb = 0.f, rstd = 0.f;
        const bool fin = active && sub == 0;
        if (fin) {
            float lg[16]; float ssq = 0.f;
#pragma unroll
            for (int r = 0; r < 16; ++r) lg[r] = 0.f;
#pragma unroll
            for (int q = 0; q < 4; ++q) { const LAS float* p = part + (size_t)((grp * 4 + q) * 17) * 64 + lane;
#pragma unroll
                for (int r = 0; r < 16; ++r) lg[r] += p[r * 64];
                ssq += p[16 * 64]; }
            ssq += __shfl_xor(ssq, 32);
            rstd = 1.f / sqrtf(ssq * (1.f / D) + 1e-6f);
#pragma unroll
            for (int r = 0; r < 16; ++r) lg[r] = lg[r] * rstd + F.rb[(r & 3) + 8 * (r >> 2) + 4 * h];
            float tv[4]; int te[4];
#pragma unroll
            for (int kk = 0; kk < 4; ++kk) { float bv = -INFINITY; int be = 0;
#pragma unroll
                for (int r = 0; r < 16; ++r) { const int er = (r & 3) + 8 * (r >> 2) + 4 * h; if (lg[r] > bv) { bv = lg[r]; be = er; } }
                const float pv = __shfl_xor(bv, 32); const int pe = __shfl_xor(be, 32);
                if (pv > bv || (pv == bv && pe < be)) { bv = pv; be = pe; }
#pragma unroll
                for (int r = 0; r < 16; ++r) { const int er = (r & 3) + 8 * (r >> 2) + 4 * h; if (er == be) lg[r] = -INFINITY; }
                tv[kk] = bv; te[kk] = be; }
            const float p1 = __expf(tv[1] - tv[0]), p2 = __expf(tv[2] - tv[0]), p3 = __expf(tv[3] - tv[0]); const float inv = 1.f / (1.f + p1 + p2 + p3);
            ea = h ? te[2] : te[0]; eb = h ? te[3] : te[1]; ga = (h ? p2 : 1.f) * inv; gb = (h ? p3 : p1) * inv;
            sa = __hip_atomic_fetch_add(lcnt + ea, 1, __ATOMIC_RELAXED, __HIP_MEMORY_SCOPE_WORKGROUP); sb = __hip_atomic_fetch_add(lcnt + eb, 1, __ATOMIC_RELAXED, __HIP_MEMORY_SCOPE_WORKGROUP);
        }
        __syncthreads();
        if (tid < NE) gbase[tid] = (int)__hip_atomic_fetch_add((unsigned*)(F.ctl + CW_CNT + tid), (unsigned)lcnt[tid], RLX_AGENT);
        __syncthreads();
        if (fin) {
            sa += gbase[ea]; sb += gbase[eb];
            F.ltok[ea * CAP + sa] = tok; F.lgate[ea * CAP + sa] = ga; F.lrstd[ea * CAP + sa] = rstd; F.where[tok * 4 + 2 * h] = ea * CAP + sa;
            F.ltok[eb * CAP + sb] = tok; F.lgate[eb * CAP + sb] = gb; F.lrstd[eb * CAP + sb] = rstd; F.where[tok * 4 + 2 * h + 1] = eb * CAP + sb;
        }
        __syncthreads();
    }
}

__device__ __forceinline__ void p1_naive(Frame& F) {
    const int gw = F.bid * NWAVES + F.wave, NGW = F.G * NWAVES, lane = F.lane;
    for (int it = gw; it < M_ALL * 20; it += NGW) {
        const int row = it / 20, grp = it % 20;
        const bf16_t* xr = F.XN + (size_t)row * D;
        if (grp < 12) {
            const int col = grp * 64 + lane; float acc = 0.f;
            _Pragma("unroll 4") for (int k = 0; k < D; ++k) acc += bf2f(xr[k]) * F.w_in[(size_t)k * IN_W + col];
            if (grp < 10) {
                const float ssq = wave_sum(acc * acc); const float r = 1.f / sqrtf(ssq * (1.f / 64.f) + 1e-6f);
                if (grp < 8) F.Qb[(size_t)row * 512 + col] = (bf16_t)f2bf(acc * r * F.qg[lane] * QSCALE);
                else F.Kb[(size_t)row * 128 + (col - 512)] = (bf16_t)f2bf(acc * r * F.kg[lane]);
            } else {
                const int hk = grp - 10; int b, kx;
                if (row < M_REAL) { b = row >> 11; kx = NMETA + (row & 2047); } else { b = (row - M_REAL) >> 4; kx = (row - M_REAL) & 15; }
                F.VT[((size_t)(b * 2 + hk) * 64 + lane) * VT_PITCH + kx] = (bf16_t)f2bf(acc);
            }
        } else {
            const int c = (grp - 12) * 64 + lane; float a = 0.f, g = 0.f;
            for (int k = 0; k < D; ++k) { const float xv = bf2f(xr[k]); a += xv * F.w_in[(size_t)k * IN_W + 768 + c]; g += xv * F.w_in[(size_t)k * IN_W + 1280 + c]; }
            F.HC[(size_t)row * 512 + c] = (bf16_t)f2bf(a * sigmoidf_fast(g));
        }
    }
}
__device__ __forceinline__ void att_naive(Frame& F) {
    const int gw = F.bid * NWAVES + F.wave, NGW = F.G * NWAVES, lane = F.lane;
    for (int it = gw; it < M_REAL * NQH; it += NGW) {
        const int row = it >> 3, h = it & 7, hk = h >> 2, b = row >> 11, qp = row & 2047;
        const float q = bf2f(F.Qb[(size_t)row * 512 + h * 64 + lane]);
        const float slope2 = exp2f(-(float)(h + 1)) * LOG2E;
        float m = F.sink[h] * LOG2E, l = 1.f, acc = 0.f;
        const bf16_t* vt = F.VT + ((size_t)(b * 2 + hk) * 64 + lane) * VT_PITCH;
        for (int j = 0; j < NMETA; ++j) {
            const float kv = bf2f(F.Kb[(size_t)(M_REAL + b * NMETA + j) * 128 + hk * 64 + lane]);
            const float s = wave_sum(q * kv);
            const float mn = fmaxf(m, s), al = exp2f(m - mn), p = exp2f(s - mn);
            l = l * al + p; acc = acc * al + p * bf2f(vt[j]); m = mn;
        }
        const int k0 = qp - 128 < 0 ? 0 : qp - 128, k1 = qp + 128 > SEQ - 1 ? SEQ - 1 : qp + 128;
        for (int kp = k0; kp <= k1; ++kp) {
            const float kv = bf2f(F.Kb[(size_t)(b * SEQ + kp) * 128 + hk * 64 + lane]);
            const float dist = (float)(qp > kp ? qp - kp : kp - qp);
            const float s = wave_sum(q * kv) - slope2 * dist;
            const float mn = fmaxf(m, s), al = exp2f(m - mn), p = exp2f(s - mn);
            l = l * al + p; acc = acc * al + p * bf2f(vt[NMETA + kp]); m = mn;
        }
        F.MIX[(size_t)row * D + h * 64 + lane] = (bf16_t)f2bf(acc / l);
    }
}
__device__ __forceinline__ void conv_naive(Frame& F) {
    const int gw = F.bid * NWAVES + F.wave, NGW = F.G * NWAVES, lane = F.lane;
    for (int row = gw; row < M_REAL; row += NGW) {
        const int b = row >> 11, s0 = NMETA + (row & 2047);
        float v[8]; float sum = 0.f;
#pragma unroll
        for (int j = 0; j < 8; ++j) { const int c = lane + 64 * j; float a = F.dw_b[c];
            _Pragma("unroll 1") for (int t = 0; t < CONV_K; ++t) { const int s = s0 - 15 + t; if (s >= 0 && s < LSEQ) a += F.dw_w[t * CONV_W + c] * bf2f(F.HC[(size_t)row_of(b, s) * 512 + c]); }
            v[j] = a; sum += a; }
        const float mu = wave_sum(sum) * (1.f / 512.f); float q = 0.f;
#pragma unroll
        for (int j = 0; j < 8; ++j) { const float d = v[j] - mu; q += d * d; }
        const float rstd = 1.f / sqrtf(wave_sum(q) * (1.f / 512.f) + 1e-5f);
#pragma unroll
        for (int j = 0; j < 8; ++j) { const int c = lane + 64 * j; const float y = (v[j] - mu) * rstd * F.lng[c] + F.lnb[c];
            F.MIX[(size_t)row * D + 512 + c] = (bf16_t)f2bf(y * sigmoidf_fast(y)); }
    }
}
__device__ __forceinline__ void p3_naive(Frame& F) {
    const int gw = F.bid * NWAVES + F.wave, NGW = F.G * NWAVES, lane = F.lane;
    for (int it = gw; it < M_REAL * 16; it += NGW) {
        const int row = it >> 4, col = (it & 15) * 64 + lane; const bf16_t* mr = F.MIX + (size_t)row * D; float acc = 0.f;
        for (int k = 0; k < D; ++k) acc += bf2f(mr[k]) * F.w_out[(size_t)k * D + col];
        const float h2 = F.x[(size_t)row * D + col] + acc;
        F.out[(size_t)row * D + col] = h2; F.XN2[(size_t)row * D + col] = (bf16_t)f2bf(h2); F.XN2F8[(size_t)row * D + col] = (unsigned char)(pk4_fp8(h2, 0.f, 0.f, 0.f) & 0xffu);
    }
}
__device__ __forceinline__ void p4_naive(Frame& F) {
    const int gw = F.bid * NWAVES + F.wave, NGW = F.G * NWAVES, lane = F.lane, e = lane & 31;
    for (int t = gw; t < M_REAL; t += NGW) {
        const bf16_t* xr = F.XN2 + (size_t)t * D; float acc = 0.f, ss = 0.f;
        for (int k = 0; k < D; ++k) { const float xv = bf2f(xr[k]); acc += xv * F.n2g[k] * F.wr[k * NE + e]; ss += xv * xv; }
        const float rstd = 1.f / sqrtf(ss * (1.f / D) + 1e-6f);
        float lg = acc * rstd + F.rb[e];
        float tv[4]; int te[4];
#pragma unroll
        for (int kk = 0; kk < 4; ++kk) {
            float bv = lg; int be = e;
#pragma unroll
            for (int o = 1; o < 32; o <<= 1) { const float pv = __shfl_xor(bv, o); const int pe = __shfl_xor(be, o); if (pv > bv || (pv == bv && pe < be)) { bv = pv; be = pe; } }
            tv[kk] = bv; te[kk] = be; if (e == be) lg = -INFINITY;
        }
        float p[4], ps = 0.f;
#pragma unroll
        for (int kk = 0; kk < 4; ++kk) { p[kk] = __expf(tv[kk] - tv[0]); ps += p[kk]; }
        if (lane < 4) {
            const int ee = lane == 0 ? te[0] : lane == 1 ? te[1] : lane == 2 ? te[2] : te[3];
            const float gg = (lane == 0 ? p[0] : lane == 1 ? p[1] : lane == 2 ? p[2] : p[3]) / ps;
            const unsigned slot = __hip_atomic_fetch_add((unsigned*)(F.ctl + CW_CNT + ee), 1u, RLX_AGENT);
            F.ltok[ee * CAP + slot] = t; F.lgate[ee * CAP + slot] = gg; F.lrstd[ee * CAP + slot] = rstd; F.where[t * 4 + lane] = ee * CAP + (int)slot;
        }
    }
}
__device__ __forceinline__ void build_tile_table(Frame& F) {
    LAS int* tb = (LAS int*)(F.lds + LX_TB); LAS int* cn = (LAS int*)(F.lds + LX_CNT); LAS int* hb = (LAS int*)(F.lds + LX_HB); LAS int* lb = (LAS int*)(F.lds + LX_LB);
    __syncthreads();
    if (F.tid == 0) { int acc = 0, ah = 0, al = 0; for (int e = 0; e < NE; ++e) { int c = (int)__hip_atomic_load(F.ctl + CW_CNT + e, RLX_AGENT); if (c > CAP) c = CAP; if (c < 0) c = 0;
            const int t = (c + 255) >> 8, rem = c & 255, light = (rem != 0 && rem <= 128) ? 1 : 0; cn[e] = c; tb[e] = acc; hb[e] = ah; lb[e] = al; acc += t; ah += t - light; al += light; }
        tb[NE] = acc; hb[NE] = ah; lb[NE] = al; }
    __syncthreads();
}
__device__ __forceinline__ int find_expert(const LAS int* tb, int tile) { int e = 0;
#pragma unroll 1
    for (int j = 1; j < NE; ++j) if (tb[j] <= tile) e = j;
    return e; }
__device__ __forceinline__ f32x4 fp8x4_to_f32(unsigned w) {
    const f32x2 lo = __builtin_amdgcn_cvt_pk_f32_fp8((int)w, false), hi = __builtin_amdgcn_cvt_pk_f32_fp8((int)w, true); return (f32x4){lo.x, lo.y, hi.x, hi.y}; }
__device__ __forceinline__ void p7_combine(Frame& F) {
    build_tile_table(F);
    const LAS int* tb = (const LAS int*)(F.lds + LX_TB);
    const int gw = F.bid * NWAVES + F.wave, NGW = F.G * NWAVES, lane = F.lane;
    const float pscale = PROBE_PH >= 0 ? 1.f + __builtin_bit_cast(float, __hip_atomic_load((unsigned*)(F.ctl + 32), RLX_AGENT)) : 1.f;
    const GAS i32x4* wh = (const GAS i32x4*)F.where;
    int t0 = gw, t1 = gw + NGW;
    i32x4 w0 = t0 < M_REAL ? wh[t0] : (i32x4){0, 0, 0, 0}, w1 = t1 < M_REAL ? wh[t1] : (i32x4){0, 0, 0, 0};
    while (t0 < M_REAL) {
        const int n0 = t0 + 2 * NGW, n1 = t1 + 2 * NGW;
        const i32x4 nw0 = n0 < M_REAL ? wh[n0] : (i32x4){0, 0, 0, 0}, nw1 = n1 < M_REAL ? wh[n1] : (i32x4){0, 0, 0, 0};
        const bool v1 = t1 < M_REAL; const int tt1 = v1 ? t1 : t0;
        u32x4 y[2][4], x[2][2];
#pragma unroll
        for (int u = 0; u < 2; ++u) { const int t = u ? tt1 : t0; const i32x4 w = u ? w1 : w0;
#pragma unroll
            for (int j = 0; j < 2; ++j) x[u][j] = *((const GAS u32x4*)(F.XN2 + (size_t)t * D) + 2 * lane + j);
#pragma unroll
            for (int k = 0; k < 4; ++k) { const int e = w[k] / CAP, slot = w[k] - e * CAP; y[u][k] = *((const GAS u32x4*)(F.Y8 + (size_t)(tb[e] * 256 + slot) * D) + lane); } }
#pragma unroll
        for (int u = 0; u < 2; ++u) { if (u && !v1) break; const int t = u ? tt1 : t0;
            f32x4 a[4] = {(f32x4){0.f, 0.f, 0.f, 0.f}, (f32x4){0.f, 0.f, 0.f, 0.f}, (f32x4){0.f, 0.f, 0.f, 0.f}, (f32x4){0.f, 0.f, 0.f, 0.f}};
#pragma unroll
            for (int k = 0; k < 4; ++k) { a[0] += fp8x4_to_f32(y[u][k].x); a[1] += fp8x4_to_f32(y[u][k].y); a[2] += fp8x4_to_f32(y[u][k].z); a[3] += fp8x4_to_f32(y[u][k].w); }
            a[0] += (f32x4){bflo(x[u][0].x), bfhi(x[u][0].x), bflo(x[u][0].y), bfhi(x[u][0].y)}; a[1] += (f32x4){bflo(x[u][0].z), bfhi(x[u][0].z), bflo(x[u][0].w), bfhi(x[u][0].w)};
            a[2] += (f32x4){bflo(x[u][1].x), bfhi(x[u][1].x), bflo(x[u][1].y), bfhi(x[u][1].y)}; a[3] += (f32x4){bflo(x[u][1].z), bfhi(x[u][1].z), bflo(x[u][1].w), bfhi(x[u][1].w)};
            GAS f32x4* o = (GAS f32x4*)(F.out + (size_t)t * D) + 4 * lane;
#pragma unroll
            for (int j = 0; j < 4; ++j) o[j] = PROBE_PH >= 0 ? a[j] * pscale : a[j]; }
        t0 = n0; t1 = n1; w0 = nw0; w1 = nw1;
    }
}

__global__ void __launch_bounds__(NTHR, 2) mega(Args args) {
    extern __shared__ __attribute__((aligned(16))) unsigned char lds_raw[];
    Frame F;
    F.lds = (LAS unsigned char*)lds_raw;
    F.tid = threadIdx.x; F.lane = F.tid & 63; F.wave = __builtin_amdgcn_readfirstlane(F.tid >> 6); F.G = gridDim.x; F.bid = blockIdx.x;
    F.x = args.in[0]; F.meta = args.in[1]; F.n1g = args.in[2]; F.w_in = args.in[3]; F.qg = args.in[4]; F.kg = args.in[5]; F.sink = args.in[6];
    F.dw_w = args.in[7]; F.dw_b = args.in[8]; F.lng = args.in[9]; F.lnb = args.in[10]; F.w_out = args.in[11]; F.n2g = args.in[12];
    F.wr = args.in[13]; F.rb = args.in[14]; F.wgu = args.in[15]; F.bgu = args.in[16]; F.wd = args.in[17]; F.bd = args.in[18];
    F.out = args.out; F.ws = args.ws; unsigned char* ws = args.ws;
    F.ctl = (gu32*)(ws + WS_CTL);
    F.WinT = (bf16_t*)(ws + WS_WIN_T); F.WoT = (bf16_t*)(ws + WS_WO_T); F.WrT = (bf16_t*)(ws + WS_WR_T); F.WdT8 = ws + WS_WD_T; F.WguT8 = ws + WS_WGU_T; F.XN2F8 = ws + WS_XN2F8;
    F.XN = (bf16_t*)(ws + WS_XN); F.Qb = (bf16_t*)(ws + WS_Q); F.Kb = (bf16_t*)(ws + WS_K); F.VT = (bf16_t*)(ws + WS_VT); F.HC = (bf16_t*)(ws + WS_HC);
    F.MIX = (bf16_t*)(ws + WS_MIX); F.XN2 = (bf16_t*)(ws + WS_XN2); F.ACT8 = ws + WS_ACT; F.Y8 = ws + WS_Y;
    F.where = (int*)(ws + WS_WHERE); F.ltok = (int*)(ws + WS_LTOK); F.lgate = (float*)(ws + WS_LGATE); F.lrstd = (float*)(ws + WS_LRSTD);
    for (int u = F.tid; u < (LDS_BYTES - RING_BYTES) / 4; u += NTHR) ((LAS unsigned*)(F.lds + RING_BYTES))[u] = 0u;
    __syncthreads();
    const int lo = args.ph_lo, hi = args.ph_hi;
    XcdBarrier bar; bar.bar = (unsigned*)(F.ctl + CW_BAR); bar.x = 0; bar.st = nullptr;
    if (hi - lo > 1) bar = xcd_barrier_post((unsigned*)(F.ctl + CW_BAR), (volatile LAS unsigned*)(F.lds + LX_BAR));
#ifndef PH_MASK
#define PH_MASK 0xFF
#endif
#define IN(k) (((PH_MASK >> (k)) & 1) && lo <= (k) && (k) < hi)
#define STAMP(k) do { if (PROBE_PH >= 0 && F.bid == 100 && F.tid == 0) ((volatile LAS unsigned*)(F.lds + RING_BYTES + 1024))[k] = (unsigned)__builtin_amdgcn_s_memrealtime(); } while (0)
#define SEAM(k) do { if (IN(k) && IN((k) + 1)) xcd_barrier(bar); STAMP((k) + 1); } while (0)
#ifndef REP_PH
#define REP_PH -1
#endif
#define REPS(k) _Pragma("unroll") for (int rep = 0; rep < ((REP_PH) == (k) ? 2 : 1); ++rep)
#define REPBAR() do { if (rep) xcd_barrier(bar); } while (0)
    STAMP(0);
    if (IN(0)) { REPS(0) { REPBAR(); p0_prologue(F); } } SEAM(0);
    if (IN(1)) { REPS(1) { REPBAR();
#if FAST_P1
        pg8::DenseProb<IN_W / 256> P{F.XN, F.WinT, M_PAD / 256, F.G, F.bid}; pg8::EpiIn E{F.Qb, F.Kb, F.VT, F.HC, F.qg, F.kg}; pg8::gemm_phase<2>(F.lds, P, E);
        { const int nd = p0_ndef(F.G), first_idle = P1_UNITS - F.G;
          if (nd > 0 && F.bid >= first_idle) { __syncthreads(); p0_items(F, P0_NITEMS - nd + (F.bid - first_idle) * NWAVES + F.wave, (F.G - first_idle) * NWAVES, P0_NITEMS); } }
#else
        p1_naive(F);
#endif
    } } SEAM(1);
    if (IN(2)) { REPS(2) { REPBAR();
#if FAST_ATT
        att_fast(F);
#else
        att_naive(F);
#endif
    } STAMP(9); REPS(8) { REPBAR();
#if FAST_CONV
        conv_fast(F);
#else
        conv_naive(F);
#endif
    } } SEAM(2);
    if (IN(3)) { REPS(3) { REPBAR();
#if FAST_P3
        const int np3 = (F.G & 1) == 0 ? P3_CONV_ITEMS : 0, hw = (F.G >> 1) * NWAVES, hrank = (F.bid >> 1) * NWAVES + F.wave;
        if (np3 && (F.bid & 1)) { p0_items(F, P0_NITEMS - np3 + hrank, hw, P0_NITEMS - np3 / 2); __syncthreads(); }
        pg8::DenseProb<D / 256> P{F.MIX, F.WoT, M_REAL / 256, F.G, F.bid}; pg8::EpiOut E{F.x, F.out, F.XN2, F.XN2F8}; pg8::gemm_phase<2>(F.lds, P, E);
        if (np3 && !(F.bid & 1)) { __syncthreads(); p0_items(F, P0_NITEMS - np3 / 2 + hrank, hw, P0_NITEMS); }
#else
        p3_naive(F);
#endif
    } } SEAM(3);
    if (IN(4)) { REPS(4) { if (rep) { xcd_barrier(bar); if (F.bid == 0 && F.tid < NE) __hip_atomic_store(F.ctl + CW_CNT + F.tid, 0u, RLX_AGENT); xcd_barrier(bar); }
        const int p4end = P0_NITEMS - ((F.G & 1) == 0 ? P3_CONV_ITEMS : 0), p4first = P0_NMOE0 + F.bid * NWAVES + F.wave, p4step = F.G * NWAVES;
        const int npre = ((F.G & 1) == 0 && (F.bid & 1)) ? P4_PRE : 0;
        if (npre) { p0_items(F, p4first, p4step, p4first + npre * p4step < p4end ? p4first + npre * p4step : p4end); __syncthreads(); }
#if FAST_P4
        p4_fast(F);
#else
        p4_naive(F);
#endif
        __syncthreads(); p0_items(F, p4first + npre * p4step, p4step, p4end);
    } } SEAM(4);
    if (IN(5)) { REPS(5) { REPBAR();
        build_tile_table(F); pg8::GroupedProb<true, 1, 8> P{F.XN2F8, F.WguT8, F.ltok, (const LAS int*)(F.lds + LX_TB), (const LAS int*)(F.lds + LX_CNT), F.G, F.bid};
        pg8::EpiGU E{F.ACT8, F.lrstd, F.bgu}; pg8::gemm_phase<1>(F.lds, P, E);
    } } SEAM(5);
    if (IN(6)) { REPS(6) { REPBAR();
        build_tile_table(F); pg8::GroupedProb<false, 1, 4> P{F.ACT8, F.WdT8, F.ltok, (const LAS int*)(F.lds + LX_TB), (const LAS int*)(F.lds + LX_CNT), F.G, F.bid};
        pg8::EpiDown E{F.Y8, F.lgate, F.bd}; pg8::gemm_phase<1>(F.lds, P, E);
    } } SEAM(6);
    if (PROBE_PH >= 0 && hi - lo > 1) {
        if (F.bid == 100 && F.tid == 0) { volatile LAS unsigned* ts = (volatile LAS unsigned*)(F.lds + RING_BYTES + 1024); const unsigned dt = PROBE_PH == 11 ? ts[11] - ts[2] : PROBE_PH == 12 ? ts[9] - ts[11] : PROBE_PH == 9 ? ts[9] - ts[2] : PROBE_PH == 10 ? ts[3] - ts[9] : ts[PROBE_PH + 1] - ts[PROBE_PH];
            const float eps = sqrtf((float)dt * 0.01f * (float)(PROBE_SCALE)); __hip_atomic_store((unsigned*)(F.ctl + 32), __builtin_bit_cast(unsigned, eps), RLX_AGENT); }
        xcd_barrier(bar);
    }
    if (IN(7)) { REPS(7) { REPBAR(); p7_combine(F); } }
#undef IN
#undef SEAM
}

extern "C" void kernel_launch(void* const* d_in, const int* in_sizes, int n_in, void* d_out, int out_size, void* d_ws, size_t ws_size, hipStream_t stream) {
    static int grid = 0;
    if (grid == 0) {
        if (n_in != 19 || in_sizes[0] != M_REAL * D || out_size != M_REAL * D || ws_size < WS_END) {
            fprintf(stderr, "kernel_launch: unexpected shapes/workspace: n_in %d in0 %d out %d ws %zu (need %zu)\n", n_in, n_in > 0 ? in_sizes[0] : -1, out_size, ws_size, (size_t)WS_END); grid = -1; return; }
        int dev = 0, cus = 0, per_cu = 0;
        if (hipGetDevice(&dev) != hipSuccess || hipDeviceGetAttribute(&cus, hipDeviceAttributeMultiprocessorCount, dev) != hipSuccess) { grid = -1; return; }
        if (hipFuncSetAttribute((const void*)mega, hipFuncAttributeMaxDynamicSharedMemorySize, LDS_BYTES) != hipSuccess) { fprintf(stderr, "kernel_launch: hipFuncSetAttribute failed\n"); grid = -1; return; }
        if (hipOccupancyMaxActiveBlocksPerMultiprocessor(&per_cu, (const void*)mega, NTHR, LDS_BYTES) != hipSuccess || per_cu < 1) { fprintf(stderr, "kernel_launch: occupancy query says %d blocks/CU\n", per_cu); (void)hipGetLastError(); grid = -1; return; }
        grid = cus;
    }
    if (grid < 0) return;
    (void)hipMemsetAsync((char*)d_ws + WS_CTL, 0, CTL_ZERO_BYTES, stream);
    Args a{};
    for (int i = 0; i < 19; ++i) a.in[i] = (const float*)d_in[i];
    a.out = (float*)d_out; a.ws = (unsigned char*)d_ws;
#if MK_PER_PHASE
    for (int p = 0; p < 8; ++p) { a.ph_lo = p; a.ph_hi = p + 1; hipLaunchKernelGGL(mega, dim3(grid), dim3(NTHR), LDS_BYTES, stream, a); }
#else
    a.ph_lo = 0; a.ph_hi = 8; hipLaunchKernelGGL(mega, dim3(grid), dim3(NTHR), LDS_BYTES, stream, a);
#endif
}
```

```cpp
#include <hip/hip_runtime.h>
#include <cstdio>
#include <cstdint>

#ifndef MK_PER_PHASE
#define MK_PER_PHASE 0
#endif
#ifndef PROBE_PH
#define PROBE_PH -1
#endif
#ifndef PROBE_SCALE
#define PROBE_SCALE 2e-5
#endif
#ifndef FAST_P1
#define FAST_P1 1
#endif
#ifndef FAST_ATT
#define FAST_ATT 1
#endif
#ifndef FAST_CONV
#define FAST_CONV 1
#endif
#ifndef FAST_P3
#define FAST_P3 1
#endif
#ifndef FAST_P4
#define FAST_P4 1
#endif
#ifndef FAST_P5
#define FAST_P5 1
#endif
#ifndef FAST_P6
#define FAST_P6 1
#endif

#define GAS __attribute__((address_space(1)))
#define LAS __attribute__((address_space(3)))
typedef unsigned short bf16_t;
typedef short bf16x8 __attribute__((ext_vector_type(8)));
typedef float f32x4 __attribute__((ext_vector_type(4)));
typedef float f32x16 __attribute__((ext_vector_type(16)));
typedef int i32x4 __attribute__((ext_vector_type(4)));
typedef int i32x8 __attribute__((ext_vector_type(8)));
typedef unsigned u32x4 __attribute__((ext_vector_type(4)));
typedef unsigned u32x2 __attribute__((ext_vector_type(2)));
typedef float f32x2 __attribute__((ext_vector_type(2)));
typedef GAS unsigned gu32;
#define RLX_AGENT __ATOMIC_RELAXED, __HIP_MEMORY_SCOPE_AGENT

constexpr int NB = 8, SEQ = 2048, D = 1024, NMETA = 16, LSEQ = NMETA + SEQ;
constexpr int M_REAL = NB * SEQ, M_ALL = NB * LSEQ, M_PAD = 16640;
constexpr int IN_W = 1792, HD = 64, NQH = 8, NKV = 2, CONV_W = 512, CONV_K = 31;
constexpr int NE = 32, CAP = 16384, ACT_ROWS = 4 * M_REAL + NE * 256;
constexpr float LOG2E = 1.4426950408889634f;
constexpr float QSCALE = 0.125f * LOG2E;
constexpr float WSCALE = 32.0f;
constexpr int VT_PITCH = LSEQ + 64;

constexpr size_t MiB = 1u << 20;
constexpr size_t WS_CTL = 0, CTL_ZERO_BYTES = 32768;
constexpr size_t WS_WIN_T = 2 * MiB;
constexpr size_t WS_WO_T = 6 * MiB;
constexpr size_t WS_WR_T = 8 * MiB;
constexpr size_t WS_RSTD = 9 * MiB;
constexpr size_t WS_WHERE = 9 * MiB + 512 * 1024;
constexpr size_t WS_LTOK = 10 * MiB;
constexpr size_t WS_LGATE = 12 * MiB;
constexpr size_t WS_LRSTD = 14 * MiB;
constexpr size_t WS_WD_T = 16 * MiB;
constexpr size_t WS_WGU_T = 80 * MiB;
constexpr size_t WS_XN = 208 * MiB;
constexpr size_t WS_Q = 241 * MiB;
constexpr size_t WS_K = 258 * MiB;
constexpr size_t WS_VT = 263 * MiB;
constexpr size_t WS_HC = 268 * MiB;
constexpr size_t WS_MIX = 285 * MiB;
constexpr size_t WS_XN2 = 317 * MiB;
constexpr size_t WS_ACT = 349 * MiB;
constexpr size_t WS_Y = 493 * MiB;
constexpr size_t WS_XN2F8 = 637 * MiB;
constexpr size_t WS_END = 653 * MiB;
constexpr int CW_CNT = 64;
constexpr int CW_BAR = 4096;

constexpr int RING_BYTES = 131072;
constexpr int LX_BAR = RING_BYTES;
constexpr int LX_TB = RING_BYTES + 64;
constexpr int LX_CNT = RING_BYTES + 256;
constexpr int LX_LCNT = RING_BYTES + 512;
constexpr int LX_GBASE = RING_BYTES + 768;
constexpr int LX_HB = RING_BYTES + 1280;
constexpr int LX_LB = RING_BYTES + 1536;
constexpr int LDS_BYTES = 147456;

constexpr int NWAVES = 8, NTHR = 512;

__device__ __forceinline__ unsigned f2bf(float f) { unsigned u = __builtin_bit_cast(unsigned, f); return (u + 0x7fffu + ((u >> 16) & 1u)) >> 16; }
__device__ __forceinline__ unsigned pk2(float lo, float hi) { return f2bf(lo) | (f2bf(hi) << 16); }
__device__ __forceinline__ unsigned pk4_fp8(float a, float b, float c, float d) { int w = __builtin_amdgcn_cvt_pk_fp8_f32(a, b, 0, false); w = __builtin_amdgcn_cvt_pk_fp8_f32(c, d, w, true); return (unsigned)w; }
__device__ __forceinline__ float bf2f(unsigned b) { return __builtin_bit_cast(float, b << 16); }
__device__ __forceinline__ float bflo(unsigned w) { return __builtin_bit_cast(float, w << 16); }
__device__ __forceinline__ float bfhi(unsigned w) { return __builtin_bit_cast(float, w & 0xffff0000u); }
__device__ __forceinline__ float wave_sum(float v) {
#pragma unroll
    for (int o = 1; o < 64; o <<= 1) v += __shfl_xor(v, o);
    return v;
}
__device__ __forceinline__ float sigmoidf_fast(float x) { return __builtin_amdgcn_rcpf(1.0f + __builtin_amdgcn_exp2f(-x * LOG2E)); }
__device__ __forceinline__ int row_of(int b, int s) { return s < NMETA ? M_REAL + b * NMETA + s : b * SEQ + (s - NMETA); }

#define XB_TMO      128
#define XB_XCNT(j)  (256  + 64 * (j))
#define XB_XSUB(j)  (1280 + 64 * (j))
#define XB_XGEN(j)  (2304 + 64 * (j))
#define XB_TOP      3328
#define XB_TOPGEN   3392
#define XCD_BAR_WORDS 3456
#define XB_SPIN_CAP (1u << 18)
__device__ __forceinline__ unsigned xb_ld(unsigned* p)              { return __hip_atomic_load(p, __ATOMIC_RELAXED, __HIP_MEMORY_SCOPE_AGENT); }
__device__ __forceinline__ unsigned xb_add(unsigned* p, unsigned v) { return __hip_atomic_fetch_add(p, v, __ATOMIC_RELAXED, __HIP_MEMORY_SCOPE_AGENT); }
__device__ __forceinline__ unsigned xb_xcc_id() { return (unsigned)__builtin_amdgcn_s_getreg((3 << 11) | 20) & 0xFu; }
#define XB_SPIN(cond, bar) do { unsigned _sp = 0; while (cond) { __builtin_amdgcn_s_sleep(1); \
    if ((++_sp & 255u) == 0u) { if (xb_ld(&(bar)[XB_TMO])) break; if (_sp > XB_SPIN_CAP) { atomicAdd(&(bar)[XB_TMO], 1u); break; } } } } while (0)
struct XcdBarrier { unsigned* bar; unsigned x; volatile LAS unsigned* st; };
__device__ __forceinline__ XcdBarrier xcd_barrier_post(unsigned* bar, volatile LAS unsigned* st) {
    XcdBarrier b; b.bar = bar; b.x = xb_xcc_id(); b.st = st;
    if (threadIdx.x == 0) (void)xb_add(&bar[XB_XCNT(b.x)], 1u);
    return b;
}
__device__ __forceinline__ void xcd_barrier_complete(unsigned* bar, unsigned x, unsigned& nloc, unsigned& nx) {
    const unsigned G = gridDim.x * gridDim.y * gridDim.z;
    unsigned sum, cnt, mine, sp = 0u;
    for (;;) {
        sum = 0u; cnt = 0u; mine = 0u;
#pragma unroll
        for (unsigned j = 0; j < 16; ++j) { const unsigned c = xb_ld(&bar[XB_XCNT(j)]); sum += c; cnt += (c > 0u) ? 1u : 0u; mine = (j == x) ? c : mine; }
        if (sum == G) break;
        __builtin_amdgcn_s_sleep(1);
        if ((++sp & 255u) == 0u) { if (xb_ld(&bar[XB_TMO])) break; if (sp > XB_SPIN_CAP) { atomicAdd(&bar[XB_TMO], 1u); break; } }
    }
    nloc = mine > 0u ? mine : 1u; nx = cnt > 0u ? cnt : 1u;
}
__device__ __forceinline__ void xcd_barrier(const XcdBarrier& b) {
    asm volatile("s_waitcnt vmcnt(0)" ::: "memory");
    __syncthreads();
    if (threadIdx.x == 0) {
        unsigned* bar = b.bar;
        __builtin_amdgcn_s_waitcnt(0);
        unsigned nloc = b.st[0], nx = b.st[1];
        if (nloc == 0u) { xcd_barrier_complete(bar, b.x, nloc, nx); b.st[0] = nloc; b.st[1] = nx; }
        const unsigned old = xb_add(&bar[XB_XSUB(b.x)], 1u);
        const unsigned gen = old / nloc;
        if (old + 1u == (gen + 1u) * nloc) {
            __builtin_amdgcn_fence(__ATOMIC_RELEASE, "agent");
            asm volatile("s_waitcnt vmcnt(0)" ::: "memory");
            const unsigned og = xb_add(&bar[XB_TOP], 1u);
            const unsigned tg = og / nx;
            if (og + 1u == (tg + 1u) * nx) xb_add(&bar[XB_TOPGEN], 1u);
            else XB_SPIN(xb_ld(&bar[XB_TOPGEN]) == tg, bar);
            __builtin_amdgcn_fence(__ATOMIC_ACQUIRE, "agent");
            xb_add(&bar[XB_XGEN(b.x)], 1u);
            asm volatile("s_waitcnt vmcnt(0)" ::: "memory");
        } else {
            XB_SPIN(xb_ld(&bar[XB_XGEN(b.x)]) == gen, bar);
            __builtin_amdgcn_fence(__ATOMIC_ACQUIRE, "agent");
            asm volatile("s_waitcnt vmcnt(0)" ::: "memory");
        }
    }
    __syncthreads();
}

struct Args { const float* in[19]; float* out; unsigned char* ws; int ph_lo, ph_hi; };
struct Frame {
    LAS unsigned char* lds;
    int tid, lane, wave, G, bid;
    const float *x, *meta, *n1g, *w_in, *qg, *kg, *sink, *dw_w, *dw_b, *lng, *lnb, *w_out, *n2g, *wr, *rb, *wgu, *bgu, *wd, *bd;
    float* out;
    unsigned char* ws;
    gu32* ctl;
    unsigned char *WguT8, *XN2F8, *WdT8, *ACT8; bf16_t *WinT, *WoT, *WrT, *XN, *Qb, *Kb, *VT, *HC, *MIX, *XN2; unsigned char* Y8;
    int* where; int* ltok; float* lgate; float* lrstd;
};

__device__ __forceinline__ int perm32(int rho) { const int n = rho >> 4, i = rho & 15; return 8 * (i >> 2) + 4 * n + (i & 3); }
__device__ __forceinline__ int lbase_nat(int pg) { return 32 * pg; }
__device__ __forceinline__ int lbase_in(int pg) { const int tile = pg >> 3, bj = (pg >> 2) & 1, wc = pg & 3; return tile <= 2 ? tile * 256 + 64 * wc + 32 * bj : 768 + bj * 512 + (tile - 3) * 128 + 32 * wc; }
__device__ __forceinline__ int lbase_gu(int pg) { const int tile = pg >> 3, bj = (pg >> 2) & 1, wc = pg & 3; return bj * 1024 + tile * 128 + 32 * wc; }
struct P0Item { const float* W; void* WT; const float* g; int N, pg, n0, k0; bool permute; bool f8; };
__device__ __forceinline__ bool p0_decode(const Frame& F, int it, P0Item& I) {
    constexpr int I_IN = 16 * 56, I_O = 16 * 32, I_R = 16, I_GU = NE * 16 * 64, I_D = NE * 16 * 32;
    int r = it;
    if (r < I_IN) { const int pg = r % 56, kb = r / 56; I = P0Item{F.w_in, F.WinT, nullptr, IN_W, pg, lbase_in(pg), 64 * kb, true, false}; return true; } r -= I_IN;
    if (r < I_O) { const int pg = r % 32, kb = r / 32; I = P0Item{F.w_out, F.WoT, nullptr, D, pg, lbase_nat(pg), 64 * kb, true, false}; return true; } r -= I_O;
    if (r < I_R) { I = P0Item{F.wr, F.WrT, F.n2g, NE, 0, 0, 64 * r, false, false}; return true; } r -= I_R;
    if (r < I_GU) { const int e = r / (16 * 64), q = r % (16 * 64), pg = q % 64, kb = q / 64; I = P0Item{F.wgu + (size_t)e * D * 2048, F.WguT8 + (size_t)e * 2048 * D, F.n2g, 2048, pg, lbase_gu(pg), 64 * kb, true, true}; return true; } r -= I_GU;
    if (r < I_D) { const int e = r / (16 * 32), q = r % (16 * 32), pg = q % 32, kb = q / 32; I = P0Item{F.wd + (size_t)e * D * D, F.WdT8 + (size_t)e * D * D, nullptr, D, pg, lbase_nat(pg), 64 * kb, true, true}; return true; }
    return false;
}
__device__ __forceinline__ void p0_load(const P0Item& I, int lane, f32x4 (&v)[8]) {
    const float* p = I.W + (size_t)(I.k0 + (lane >> 3)) * I.N + I.n0 + 4 * (lane & 7);
#pragma unroll
    for (int i = 0; i < 8; ++i) v[i] = __builtin_nontemporal_load((const f32x4*)(p + (size_t)(8 * i) * I.N));
}
__device__ __forceinline__ void p0_store(const P0Item& I, int lane, LAS float* scr, const f32x4 (&v)[8]) {
    LAS float* w = scr + (lane >> 3) * 33 + 4 * (lane & 7);
#pragma unroll
    for (int i = 0; i < 8; ++i) { w[(8 * i) * 33 + 0] = v[i][0]; w[(8 * i) * 33 + 1] = v[i][1]; w[(8 * i) * 33 + 2] = v[i][2]; w[(8 * i) * 33 + 3] = v[i][3]; }
    asm volatile("s_waitcnt lgkmcnt(0)" ::: "memory");
    const int c = lane & 7;
    f32x4 g0 = {1.f, 1.f, 1.f, 1.f}, g1 = g0;
    if (I.g) { g0 = *(const f32x4*)(I.g + I.k0 + 8 * c); g1 = *(const f32x4*)(I.g + I.k0 + 8 * c + 4); }
    if (I.f8) { g0 *= WSCALE; g1 *= WSCALE; }
#pragma unroll
    for (int j = 0; j < 4; ++j) { const int r = (lane >> 3) + 8 * j; const int sc = I.permute ? perm32(r) : r; const LAS float* s = scr + (8 * c) * 33 + sc;
        if (I.f8) { u32x2 o; o.x = pk4_fp8(s[0 * 33] * g0[0], s[1 * 33] * g0[1], s[2 * 33] * g0[2], s[3 * 33] * g0[3]); o.y = pk4_fp8(s[4 * 33] * g1[0], s[5 * 33] * g1[1], s[6 * 33] * g1[2], s[7 * 33] * g1[3]);
            *(GAS u32x2*)((unsigned char*)I.WT + (size_t)(32 * I.pg + r) * D + I.k0 + 8 * c) = o; }
        else { u32x4 o; o.x = pk2(s[0 * 33] * g0[0], s[1 * 33] * g0[1]); o.y = pk2(s[2 * 33] * g0[2], s[3 * 33] * g0[3]); o.z = pk2(s[4 * 33] * g1[0], s[5 * 33] * g1[1]); o.w = pk2(s[6 * 33] * g1[2], s[7 * 33] * g1[3]);
            *(GAS u32x4*)((bf16_t*)I.WT + (size_t)(32 * I.pg + r) * D + I.k0 + 8 * c) = o; } }
    asm volatile("s_waitcnt lgkmcnt(0)" ::: "memory");
}
constexpr int P0_NITEMS = 16 * 56 + 16 * 32 + 16 + NE * 16 * 64 + NE * 16 * 32, P0_NMOE0 = 16 * 56 + 16 * 32 + 16;
constexpr int P4_PRE = 8;
constexpr int P3_CONV_ITEMS = 12288;
constexpr int P1_UNITS = (M_PAD / 256) * (IN_W / 256);
__device__ __forceinline__ int p0_ndef(int G) { return 0; }
__device__ __forceinline__ void p0_items(Frame& F, int first, int step, int end) {
    LAS float* scr = (LAS float*)(F.lds + F.wave * 16384);
    const int lane = F.lane;
    P0Item c0, c1, c2; f32x4 va[8], vb[8], vc[8];
    int it = first; bool v0 = it < end && p0_decode(F, it, c0);
    if (v0) p0_load(c0, lane, va);
    it += step; bool v1 = v0 && it < end && p0_decode(F, it, c1);
    if (v1) p0_load(c1, lane, vb);
    while (v0) {
        it += step; const bool v2 = v1 && it < end && p0_decode(F, it, c2);
        if (v2) p0_load(c2, lane, vc);
        p0_store(c0, lane, scr, va);
        c0 = c1; c1 = c2; v0 = v1; v1 = v2;
#pragma unroll
        for (int i = 0; i < 8; ++i) { va[i] = vb[i]; vb[i] = vc[i]; }
    }
}
__device__ __forceinline__ void p0_prologue(Frame& F) {
    const int gw = F.bid * NWAVES + F.wave, NGW = F.G * NWAVES, lane = F.lane;
    p0_items(F, gw, NGW, P0_NMOE0);
    const GAS f32x4* gr = (const GAS f32x4*)F.n1g + lane;
    for (int m0 = 2 * gw; m0 < M_PAD; m0 += 2 * NGW) {
        f32x4 v[2][4]; float ss[2];
#pragma unroll
        for (int u = 0; u < 2; ++u) { const int m = m0 + u; ss[u] = 0.f;
            if (m < M_ALL) { const float* src = m < M_REAL ? F.x + (size_t)m * D : F.meta + (size_t)((m - M_REAL) & (NMETA - 1)) * D; const GAS f32x4* xr = (const GAS f32x4*)src + lane;
#pragma unroll
                for (int j = 0; j < 4; ++j) v[u][j] = xr[64 * j]; }
            else {
#pragma unroll
                for (int j = 0; j < 4; ++j) v[u][j] = (f32x4){0.f, 0.f, 0.f, 0.f}; } }
#pragma unroll
        for (int u = 0; u < 2; ++u) {
#pragma unroll
            for (int j = 0; j < 4; ++j) ss[u] += (v[u][j].x * v[u][j].x + v[u][j].y * v[u][j].y) + (v[u][j].z * v[u][j].z + v[u][j].w * v[u][j].w);
            const float rstd = 1.f / sqrtf(wave_sum(ss[u]) * (1.f / D) + 1e-6f);
            GAS unsigned long long* o8 = (GAS unsigned long long*)(F.XN + (size_t)(m0 + u) * D) + lane;
#pragma unroll
            for (int j = 0; j < 4; ++j) { const f32x4 g = gr[64 * j]; o8[64 * j] = (unsigned long long)pk2(v[u][j].x * rstd * g.x, v[u][j].y * rstd * g.y) | ((unsigned long long)pk2(v[u][j].z * rstd * g.z, v[u][j].w * rstd * g.w) << 32); }
        }
    }
}

namespace pg8 {
constexpr int BM = 256, BK = 64, HALF = 128, HTB = HALF * BK * 2, STAGE_BYTES = 8 * HTB, NXCD = 8, WGM = 8, KD = 1024;
__device__ __forceinline__ int lds_byte(int r, int c) { const int st = (r >> 4) * 2 + (c >> 5), rr = r & 15, cc = c & 31, ob = rr * 64 + cc * 2; return st * 1024 + (ob ^ (((ob >> 9) & 1) << 5)); }
__device__ __forceinline__ void stage_rc(int b, int& R, int& C) { const int st = b / 1024, sb = b % 1024, swz = sb ^ (((sb >> 9) & 1) << 5); R = (st >> 1) * 16 + swz / 64; C = (st & 1) * 32 + (swz % 64) / 2; }
struct Unit { int pm, pn, e, slot0, nvalid, r0; };
__device__ __forceinline__ unsigned cvt_pk_bf16(float lo, float hi) { unsigned r; asm volatile("v_cvt_pk_bf16_f32 %0, %1, %2" : "=v"(r) : "v"(lo), "v"(hi)); return r; }
__device__ __forceinline__ u32x4 pack8(const f32x4 a, const f32x4 b) { u32x4 w; w.x = cvt_pk_bf16(a[0], a[1]); w.y = cvt_pk_bf16(a[2], a[3]); w.z = cvt_pk_bf16(b[0], b[1]); w.w = cvt_pk_bf16(b[2], b[3]); return w; }

template <bool HALVES, int nN>
__device__ __forceinline__ bool tile_order(int i, int G, int c, int nM, int& pm, int& pn, int& half) {
    const int nwg = nM * nN; int L = i * G + c; half = -1;
    if (HALVES) { const int nfull = ((G & (G - 1)) == 0) ? (nwg & ~(G - 1)) : (nwg / G) * G, left = nwg - nfull;
        if (left > 0 && 2 * left <= G && L >= nfull) { const int hidx = L - nfull; if (hidx >= 2 * left) return false; L = nfull + (hidx >> 1); half = hidx & 1; } }
    if (L >= nwg) return false;
    int wgid = L; { const int q = nwg >> 3, r = nwg & 7, xcd = wgid & 7, off = wgid >> 3; wgid = (xcd < r ? xcd * (q + 1) : r * (q + 1) + (xcd - r) * q) + off; }
    constexpr int nig = WGM * nN; const int gid = wgid / nig, rem = wgid - gid * nig, fm = gid * WGM, gsz = (nM - fm) < WGM ? (nM - fm) : WGM;
    if (gsz == WGM) { pm = fm + (rem & (WGM - 1)); pn = rem >> 3; } else { pm = fm + rem % gsz; pn = rem / gsz; }
    return true;
}
template <int nN> struct DenseProb {
    static constexpr int RB = KD * 2;
    const bf16_t* A; const bf16_t* Bt; int nM, G, c;
    __device__ __forceinline__ bool next(int i, Unit& u) const { u.e = 0; u.slot0 = 0; u.nvalid = 256; u.r0 = 0; int half; return tile_order<false, nN>(i, G, c, nM, u.pm, u.pn, half); }
    __device__ __forceinline__ void addr_load(const Unit&, const int (&)[2], int (&)[4]) const {}
    __device__ __forceinline__ void addr_finish(const Unit& u, const int (&R)[2], const int (&C)[2], const int (&)[4], const char*& a, const char*& b, unsigned (&va0)[2], unsigned (&va1)[2]) const {
        a = (const char*)A + (size_t)u.pm * (BM * RB); b = (const char*)Bt + (size_t)u.pn * (BM * RB);
#pragma unroll
        for (int i = 0; i < 2; ++i) { va0[i] = (unsigned)(R[i] * RB + C[i] * 2); va1[i] = va0[i] + (unsigned)(HALF * RB); }
    }
};
template <bool GATHER, int ES, int nN> struct GroupedProb {
    static constexpr int RB = KD * ES;
    const void* A; const void* Bt; const int* ltok; const LAS int* tb; const LAS int* cn; int G, c;
    __device__ __forceinline__ bool next(int i, Unit& u) const {
        const LAS int* hb = tb + (LX_HB - LX_TB) / 4; const LAS int* lb = tb + (LX_LB - LX_TB) / 4;
        const int H = __builtin_amdgcn_readfirstlane(hb[NE]), Lt = __builtin_amdgcn_readfirstlane(lb[NE]), HU = H * nN, LU = Lt * nN;
        const int L = i * G + c, nfull = ((G & (G - 1)) == 0) ? (HU & ~(G - 1)) : (HU / G) * G, r = HU - nfull;
        const bool tail_half = r > 0 && 2 * r + LU <= G;
        int half = -1, idx; bool light = false;
        if (L < nfull) idx = L;
        else { const int Lp = L - nfull;
            if (tail_half) { if (Lp < 2 * r) { idx = nfull + (Lp >> 1); half = Lp & 1; } else { light = true; idx = Lp - 2 * r; } }
            else { if (Lp < r) idx = nfull + Lp; else { light = true; idx = Lp - r; } } }
        const int j = (int)(threadIdx.x & 31); int e;
        if (light) { if (idx >= LU) return false; const int le = idx / nN; u.pn = idx % nN;
            const unsigned long long hit = __ballot(lb[j] == le && lb[j + 1] == le + 1); e = __builtin_amdgcn_readfirstlane((int)__builtin_ctzll(hit | (1ull << 63)) & 31);
            u.pm = __builtin_amdgcn_readfirstlane(tb[e + 1]) - 1;
        } else { int wgid = idx; { const int q = HU >> 3, rr = HU & 7, xcd = wgid & 7, off = wgid >> 3; wgid = (xcd < rr ? xcd * (q + 1) : rr * (q + 1) + (xcd - rr) * q) + off; }
            constexpr int nig = WGM * nN; const int gid = wgid / nig, rem = wgid - gid * nig, fm = gid * WGM, gsz = (H - fm) < WGM ? (H - fm) : WGM; int ht;
            if (gsz == WGM) { ht = fm + (rem & (WGM - 1)); u.pn = rem >> 3; } else { ht = fm + rem % gsz; u.pn = rem / gsz; }
            const unsigned long long hit = __ballot(hb[j] <= ht && ht < hb[j + 1]); e = __builtin_amdgcn_readfirstlane((int)__builtin_ctzll(hit | (1ull << 63)) & 31);
            u.pm = __builtin_amdgcn_readfirstlane(tb[e]) + (ht - __builtin_amdgcn_readfirstlane(hb[e])); }
        const int t0 = __builtin_amdgcn_readfirstlane(tb[e]), ce = __builtin_amdgcn_readfirstlane(cn[e]);
        u.e = e; u.r0 = half == 1 ? HALF : 0; u.slot0 = (u.pm - t0) * 256 + u.r0; int rem2 = ce - u.slot0; const int lim = half >= 0 ? HALF : 256; rem2 = rem2 < lim ? rem2 : lim; u.nvalid = rem2 < 0 ? 0 : rem2; return true;
    }
    __device__ __forceinline__ void addr_load(const Unit& u, const int (&R)[2], int (&raw)[4]) const {
        if (GATHER) { const int* lt = ltok + u.e * CAP + u.slot0;
#pragma unroll
            for (int i = 0; i < 2; ++i) { const int r0 = R[i], r1 = R[i] + HALF; raw[2 * i] = r0 < u.nvalid ? lt[r0] : 0; raw[2 * i + 1] = r1 < u.nvalid ? lt[r1] : 0; } }
    }
    __device__ __forceinline__ void addr_finish(const Unit& u, const int (&R)[2], const int (&C)[2], const int (&raw)[4], const char*& a, const char*& b, unsigned (&va0)[2], unsigned (&va1)[2]) const {
        b = (const char*)Bt + ((size_t)u.e * nN + u.pn) * (BM * RB);
        if (GATHER) { a = (const char*)A;
#pragma unroll
            for (int i = 0; i < 2; ++i) { va0[i] = (unsigned)(raw[2 * i] * RB + C[i] * 2); va1[i] = (unsigned)(raw[2 * i + 1] * RB + C[i] * 2); }
        } else { a = (const char*)A + (size_t)(u.pm * BM + u.r0) * RB;
#pragma unroll
            for (int i = 0; i < 2; ++i) { va0[i] = (unsigned)(R[i] * RB + C[i] * 2); va1[i] = va0[i] + (unsigned)(HALF * RB); }
        }
    }
};

template <int ES  , class Prob, class Epi>
__device__ __forceinline__ void gemm_phase(LAS unsigned char* lds, const Prob& P, const Epi& E) {
    const int tid = threadIdx.x, wid = __builtin_amdgcn_readfirstlane(tid >> 6), lane = tid & 63, wr = wid >> 2, wc = wid & 3, fr = lane & 15, fq = lane >> 4;
    constexpr int RB = KD * ES, nt = RB / (BK * 2);
    int R[2], C[2]; unsigned voffB[2];
#pragma unroll
    for (int i = 0; i < 2; ++i) { stage_rc(tid * 16 + i * 8192, R[i], C[i]); voffB[i] = (unsigned)(R[i] * RB + C[i] * 2); }
    constexpr size_t kstep = (size_t)(BK * 2);
    constexpr size_t hstep = (size_t)HALF * RB;
    const unsigned ldsw = (unsigned)wid * 1024u;
    const int aoff = lds_byte(wr * 64 + fr, fq * 8), boff = lds_byte(wc * 32 + fr, fq * 8);
#define PG8_SA(b, h) (((b) * 2 + (h)) * HTB)
#define PG8_SB(b, h) ((4 + (b) * 2 + (h)) * HTB)
#define PG8_STAGE(bufoff, gbase, voff) do { _Pragma("unroll") for (int _i = 0; _i < 2; ++_i) \
        __builtin_amdgcn_global_load_lds((const unsigned*)((const char*)(gbase) + (voff)[_i]), (LAS unsigned*)(lds + (bufoff) + ldsw + _i * 8192), 16, 0, 0); } while (0)
#define PG8_LDA(dst, b, h) do { _Pragma("unroll") for (int m = 0; m < 4; ++m) { \
        if constexpr (ES == 2) { _Pragma("unroll") for (int k = 0; k < 2; ++k) dst[m][k] = *(const LAS bf16x8*)(lds + PG8_SA(b, h) + aoff + m * 2048 + k * 1024); } \
        else { const i32x4 lo_ = *(const LAS i32x4*)(lds + PG8_SA(b, h) + aoff + m * 2048), hi_ = *(const LAS i32x4*)(lds + PG8_SA(b, h) + aoff + m * 2048 + 1024); dst##8[m] = __builtin_shufflevector(lo_, hi_, 0, 1, 2, 3, 4, 5, 6, 7); } } } while (0)
#define PG8_LDB(dst, b, h) do { _Pragma("unroll") for (int n = 0; n < 2; ++n) { \
        if constexpr (ES == 2) { _Pragma("unroll") for (int k = 0; k < 2; ++k) dst[n][k] = *(const LAS bf16x8*)(lds + PG8_SB(b, h) + boff + n * 2048 + k * 1024); } \
        else { const i32x4 lo_ = *(const LAS i32x4*)(lds + PG8_SB(b, h) + boff + n * 2048), hi_ = *(const LAS i32x4*)(lds + PG8_SB(b, h) + boff + n * 2048 + 1024); dst##8[n] = __builtin_shufflevector(lo_, hi_, 0, 1, 2, 3, 4, 5, 6, 7); } } } while (0)
#define PG8_MMA(ai, bj, At, Bt) do { __builtin_amdgcn_s_setprio(1); _Pragma("unroll") for (int m = 0; m < 4; ++m) _Pragma("unroll") for (int n = 0; n < 2; ++n) { \
        if constexpr (ES == 2) { _Pragma("unroll") for (int k = 0; k < 2; ++k) acc[ai][bj][m][n] = __builtin_amdgcn_mfma_f32_16x16x32_bf16(Bt[n][k], At[m][k], acc[ai][bj][m][n], 0, 0, 0); } \
        else asm volatile("s_nop 1\n\tv_mfma_scale_f32_16x16x128_f8f6f4 %0, %1, %2, %0, %3, %3 op_sel_hi:[0,0,0]" : "+v"(acc[ai][bj][m][n]) : "v"(Bt##8[n]), "v"(At##8[m]), "v"(sc127)); } \
        __builtin_amdgcn_s_setprio(0); } while (0)
#define PG8_WAIT_V(n) asm volatile("s_waitcnt vmcnt(" #n ")" ::: "memory")
#define PG8_WAIT_L(n) do { asm volatile("s_waitcnt lgkmcnt(" #n ")" ::: "memory"); __builtin_amdgcn_s_waitcnt(0xC07F); } while (0)
#define PG8_BAR __builtin_amdgcn_s_barrier()
#define PG8_SCHED __builtin_amdgcn_sched_barrier(0)
    Unit cur, nxt, nn; int ui = 0; int raw[4] = {0, 0, 0, 0};
    if (!P.next(0, cur)) return;
    bool has_next = P.next(1, nxt);
    const char *cA, *cB, *nA, *nB; unsigned va0[2], va1[2], nva0[2], nva1[2];
    P.addr_load(cur, R, raw); P.addr_finish(cur, R, C, raw, cA, cB, va0, va1);
    if (has_next) { P.addr_load(nxt, R, raw); P.addr_finish(nxt, R, C, raw, nA, nB, nva0, nva1); }
    else { nA = cA; nB = cB; nva0[0] = va0[0]; nva0[1] = va0[1]; nva1[0] = va1[0]; nva1[1] = va1[1]; }
    f32x4 acc[2][2][4][2];
#pragma unroll
    for (int a = 0; a < 2; ++a)
#pragma unroll
        for (int b = 0; b < 2; ++b)
#pragma unroll
            for (int m = 0; m < 4; ++m)
#pragma unroll
                for (int n = 0; n < 2; ++n) acc[a][b][m][n] = (f32x4){0.f, 0.f, 0.f, 0.f};
    const int sc127 = 0x7F7F7F7F;
    bf16x8 At[4][2], B0[2][2], B1[2][2]; i32x8 At8[4], B08[2], B18[2];
    PG8_STAGE(PG8_SB(0, 0), cB, voffB); PG8_STAGE(PG8_SB(0, 1), cB + hstep, voffB); PG8_STAGE(PG8_SA(0, 0), cA, va0); PG8_STAGE(PG8_SA(0, 1), cA, va1);
    if (wr == 1) PG8_BAR;
    PG8_WAIT_V(2); PG8_BAR;
    PG8_STAGE(PG8_SB(1, 0), cB + kstep, voffB); PG8_STAGE(PG8_SA(1, 0), cA + kstep, va0); PG8_STAGE(PG8_SB(1, 1), cB + hstep + kstep, voffB);
    PG8_WAIT_V(6); PG8_BAR;
    for (;;) {
        const bool full = cur.nvalid > HALF;
#pragma unroll 1
        for (int t = 0; t < nt; t += 2) {
            const bool last = (t == nt - 2);
            const char* a1 = cA + (size_t)(t + 1) * kstep;
            const char* a2 = last ? nA : cA + (size_t)(t + 2) * kstep; const char* b2 = last ? nB : cB + (size_t)(t + 2) * kstep;
            const char* a3 = a2 + kstep; const char* b3 = b2 + kstep;
            unsigned v2a0[2], v2a1[2];
            v2a0[0] = last ? nva0[0] : va0[0]; v2a0[1] = last ? nva0[1] : va0[1]; v2a1[0] = last ? nva1[0] : va1[0]; v2a1[1] = last ? nva1[1] : va1[1];
            PG8_LDB(B0, 0, 0); PG8_LDB(B1, 0, 1); PG8_SCHED; PG8_LDA(At, 0, 0); PG8_STAGE(PG8_SA(1, 1), a1, va1);
            PG8_WAIT_V(8); PG8_WAIT_L(0); PG8_BAR; PG8_MMA(0, 0, At, B0); PG8_MMA(0, 1, At, B1); PG8_BAR; PG8_SCHED;
            PG8_LDA(At, 0, 1); PG8_STAGE(PG8_SB(0, 0), b2, voffB); PG8_STAGE(PG8_SB(0, 1), b2 + hstep, voffB); PG8_STAGE(PG8_SA(0, 0), a2, v2a0);
            PG8_WAIT_V(8); PG8_WAIT_L(0); PG8_BAR; if (full) { PG8_MMA(1, 0, At, B0); PG8_MMA(1, 1, At, B1); } PG8_BAR; PG8_SCHED;
            PG8_LDB(B0, 1, 0); PG8_LDB(B1, 1, 1); PG8_SCHED; PG8_LDA(At, 1, 0); PG8_STAGE(PG8_SA(0, 1), a2, v2a1);
            PG8_WAIT_V(8); PG8_WAIT_L(0); PG8_BAR; PG8_MMA(0, 0, At, B0); PG8_MMA(0, 1, At, B1); PG8_BAR; PG8_SCHED;
            PG8_LDA(At, 1, 1); PG8_STAGE(PG8_SB(1, 0), b3, voffB); PG8_STAGE(PG8_SB(1, 1), b3 + hstep, voffB); PG8_STAGE(PG8_SA(1, 0), a3, v2a0);
            PG8_WAIT_V(8); PG8_WAIT_L(0); PG8_BAR; if (full) { PG8_MMA(1, 0, At, B0); PG8_MMA(1, 1, At, B1); } PG8_BAR; PG8_SCHED;
        }
        if constexpr (ES == 1) { asm volatile("s_nop 15\n\ts_nop 15" ::: "memory"); __builtin_amdgcn_sched_barrier(0); }
        const bool has_nn = has_next && P.next(ui + 2, nn);
        if (has_nn) P.addr_load(nn, R, raw);
        if (wr == 0) PG8_BAR;
        E(acc, cur, wr, wc, fr, fq);
        if (!has_next) break;
#pragma unroll
        for (int a = 0; a < 2; ++a)
#pragma unroll
            for (int b = 0; b < 2; ++b)
#pragma unroll
                for (int m = 0; m < 4; ++m)
#pragma unroll
                    for (int n = 0; n < 2; ++n) acc[a][b][m][n] = (f32x4){0.f, 0.f, 0.f, 0.f};
        cur = nxt; cA = nA; cB = nB; va0[0] = nva0[0]; va0[1] = nva0[1]; va1[0] = nva1[0]; va1[1] = nva1[1]; ++ui;
        nxt = nn; has_next = has_nn;
        if (has_next) P.addr_finish(nxt, R, C, raw, nA, nB, nva0, nva1);
        if (wr == 1) PG8_BAR;
    }
    PG8_WAIT_V(0);
    PG8_BAR;
#undef PG8_SA
#undef PG8_SB
#undef PG8_STAGE
#undef PG8_LDA
#undef PG8_LDB
#undef PG8_MMA
#undef PG8_WAIT_V
#undef PG8_WAIT_L
#undef PG8_BAR
#undef PG8_SCHED
}

struct EpiOut {
    const float* x; float* out; bf16_t* xn2; unsigned char* xn2f8;
    __device__ __forceinline__ void operator()(const f32x4 (&acc)[2][2][4][2], const Unit& u, int wr, int wc, int fr, int fq) const {
        const int row0 = u.pm * BM + wr * 64 + fr, col0 = u.pn * BM + wc * 32 + 8 * fq;
#pragma unroll
        for (int ai = 0; ai < 2; ++ai)
#pragma unroll
            for (int m = 0; m < 4; ++m) { const size_t off = (size_t)(row0 + ai * HALF + m * 16) * D + col0;
#pragma unroll
                for (int bj = 0; bj < 2; ++bj) { const float* xp = x + off + bj * HALF;
                    const f32x4 h0 = acc[ai][bj][m][0] + *(const f32x4*)xp, h1 = acc[ai][bj][m][1] + *(const f32x4*)(xp + 4);
                    *(u32x4*)(xn2 + off + bj * HALF) = pack8(h0, h1);
                    *(u32x2*)(xn2f8 + off + bj * HALF) = (u32x2){pk4_fp8(h0[0], h0[1], h0[2], h0[3]), pk4_fp8(h1[0], h1[1], h1[2], h1[3])}; }
                asm volatile("" ::: "memory"); }
    }
};
struct EpiIn {
    bf16_t *Qb, *Kb, *VT, *HC; const float *qg, *kg;
    __device__ __forceinline__ void operator()(const f32x4 (&acc)[2][2][4][2], const Unit& u, int wr, int wc, int fr, int fq) const {
        const int rowb = u.pm * BM + wr * 64 + fr;
        if (u.pn <= 2) {
            const bool isv = (u.pn == 2) && (wc >= 2);
            if (!isv) {
                const bool isq = u.pn < 2; const float* g = isq ? qg : kg; const float sc = isq ? QSCALE : 1.f;
                f32x4 gv[2][2];
#pragma unroll
                for (int bj = 0; bj < 2; ++bj)
#pragma unroll
                    for (int n = 0; n < 2; ++n) gv[bj][n] = *(const f32x4*)(g + 32 * bj + 8 * fq + 4 * n) * sc;
                bf16_t* dst = isq ? Qb + (u.pn * 256 + 64 * wc) : Kb + 64 * wc; const int ld = isq ? 512 : 128;
#pragma unroll
                for (int ai = 0; ai < 2; ++ai)
#pragma unroll
                    for (int m = 0; m < 4; ++m) { const int row = rowb + ai * HALF + m * 16; float ss = 0.f;
#pragma unroll
                        for (int bj = 0; bj < 2; ++bj)
#pragma unroll
                            for (int n = 0; n < 2; ++n) { const f32x4 v = acc[ai][bj][m][n]; ss += (v[0] * v[0] + v[1] * v[1]) + (v[2] * v[2] + v[3] * v[3]); }
                        ss += __shfl_xor(ss, 16); ss += __shfl_xor(ss, 32);
                        const float r = __builtin_amdgcn_rsqf(ss * (1.f / 64.f) + 1e-6f);
#pragma unroll
                        for (int bj = 0; bj < 2; ++bj) *(u32x4*)(dst + (size_t)row * ld + 32 * bj + 8 * fq) = pack8(acc[ai][bj][m][0] * r * gv[bj][0], acc[ai][bj][m][1] * r * gv[bj][1]); }
            } else {
                const int hk = wc - 2;
#pragma unroll
                for (int ai = 0; ai < 2; ++ai)
#pragma unroll
                    for (int m = 0; m < 4; ++m) { const int row = rowb + ai * HALF + m * 16;
                        if (row < M_ALL) { int b, kx; if (row < M_REAL) { b = row >> 11; kx = NMETA + (row & 2047); } else { b = (row - M_REAL) >> 4; kx = (row - M_REAL) & 15; }
                            bf16_t* base = VT + (size_t)(b * 2 + hk) * 64 * VT_PITCH + kx;
#pragma unroll
                            for (int bj = 0; bj < 2; ++bj)
#pragma unroll
                                for (int n = 0; n < 2; ++n)
#pragma unroll
                                    for (int e = 0; e < 4; ++e) base[(size_t)(32 * bj + 8 * fq + 4 * n + e) * VT_PITCH] = (bf16_t)f2bf(acc[ai][bj][m][n][e]); } }
            }
        } else {
            const int col = (u.pn - 3) * 128 + 32 * wc + 8 * fq;
#pragma unroll
            for (int ai = 0; ai < 2; ++ai)
#pragma unroll
                for (int m = 0; m < 4; ++m) { const int row = rowb + ai * HALF + m * 16; f32x4 h[2];
#pragma unroll
                    for (int n = 0; n < 2; ++n)
#pragma unroll
                        for (int e = 0; e < 4; ++e) h[n][e] = acc[ai][0][m][n][e] * sigmoidf_fast(acc[ai][1][m][n][e]);
                    *(u32x4*)(HC + (size_t)row * 512 + col) = pack8(h[0], h[1]); }
        }
    }
};
struct EpiGU {
    unsigned char* ACT; const float* lrstd; const float* bgu;
    __device__ __forceinline__ void operator()(const f32x4 (&acc)[2][2][4][2], const Unit& u, int wr, int wc, int fr, int fq) const {
        const int lr0 = wr * 64 + fr, col = u.pn * 128 + 32 * wc + 8 * fq;
        f32x2 bg[2][2], bu[2][2];
#pragma unroll
        for (int n = 0; n < 2; ++n) { const f32x4 g4 = *(const f32x4*)(bgu + u.e * 2048 + col + 4 * n), u4 = *(const f32x4*)(bgu + u.e * 2048 + 1024 + col + 4 * n);
            bg[n][0] = (f32x2){g4[0], g4[1]}; bg[n][1] = (f32x2){g4[2], g4[3]}; bu[n][0] = (f32x2){u4[0], u4[1]}; bu[n][1] = (f32x2){u4[2], u4[3]}; }
        const float* rs = lrstd + u.e * CAP + u.slot0;
#pragma unroll
        for (int ai = 0; ai < 2; ++ai) {
            if (ai == 1 && u.nvalid <= HALF) break;
#pragma unroll
            for (int m = 0; m < 4; ++m) { const int lr = lr0 + ai * HALF + m * 16; const float rstd = lr < u.nvalid ? rs[lr] * (1.f / WSCALE) : 0.f; f32x2 h[2][2];
#pragma unroll
                for (int n = 0; n < 2; ++n)
#pragma unroll
                    for (int p = 0; p < 2; ++p) {
                        f32x2 gt = (f32x2){acc[ai][0][m][n][2 * p], acc[ai][0][m][n][2 * p + 1]} * rstd + bg[n][p];
                        f32x2 up = (f32x2){acc[ai][1][m][n][2 * p], acc[ai][1][m][n][2 * p + 1]} * rstd + bu[n][p];
                        gt.x = fminf(gt.x, 7.f); gt.y = fminf(gt.y, 7.f); up.x = __builtin_amdgcn_fmed3f(up.x, -7.f, 7.f); up.y = __builtin_amdgcn_fmed3f(up.y, -7.f, 7.f);
                        const f32x2 z = gt * (-1.702f * LOG2E); f32x2 ex; ex.x = __builtin_amdgcn_exp2f(z.x); ex.y = __builtin_amdgcn_exp2f(z.y);
                        const f32x2 dn = ex + 1.0f; f32x2 rc; rc.x = __builtin_amdgcn_rcpf(dn.x); rc.y = __builtin_amdgcn_rcpf(dn.y);
                        const f32x2 t = gt * rc; h[n][p] = t * up + t; }
                *(u32x2*)(ACT + (size_t)(u.pm * BM + u.r0 + lr) * D + col) = (u32x2){pk4_fp8(h[0][0].x, h[0][0].y, h[0][1].x, h[0][1].y), pk4_fp8(h[1][0].x, h[1][0].y, h[1][1].x, h[1][1].y)}; }
        }
    }
};
struct EpiDown {
    unsigned char* Y; const float* lgate; const float* bd;
    __device__ __forceinline__ void operator()(const f32x4 (&acc)[2][2][4][2], const Unit& u, int wr, int wc, int fr, int fq) const {
        const int lr0 = wr * 64 + fr, col0 = u.pn * BM + wc * 32 + 8 * fq;
        f32x4 bv[2][2];
#pragma unroll
        for (int bj = 0; bj < 2; ++bj)
#pragma unroll
            for (int n = 0; n < 2; ++n) bv[bj][n] = *(const f32x4*)(bd + u.e * D + col0 + bj * HALF + 4 * n);
        const float* gs = lgate + u.e * CAP + u.slot0;
#pragma unroll
        for (int ai = 0; ai < 2; ++ai)
#pragma unroll
            for (int m = 0; m < 4; ++m) { if (ai == 1 && u.nvalid <= HALF) continue; const int lr = lr0 + ai * HALF + m * 16; const float gt = lr < u.nvalid ? gs[lr] : 0.f;
#pragma unroll
                for (int bj = 0; bj < 2; ++bj) { const f32x4 y0 = (acc[ai][bj][m][0] * (1.f / WSCALE) + bv[bj][0]) * gt, y1 = (acc[ai][bj][m][1] * (1.f / WSCALE) + bv[bj][1]) * gt;
                    *(u32x2*)(Y + (size_t)(u.pm * BM + u.r0 + lr) * D + col0 + bj * HALF) = (u32x2){pk4_fp8(y0[0], y0[1], y0[2], y0[3]), pk4_fp8(y1[0], y1[1], y1[2], y1[3])}; } }
    }
};
}


constexpr int ATT_KIMG = 0, ATT_VIMG = 53248, ATT_VP = 840;
constexpr float ATT_THR = 4.0f;
struct AttHead { float m, l, slope2; f32x16 O0, O1; };
template <int MODE>
__device__ __forceinline__ void att_softmax(f32x16& s, AttHead& H, float Bq, float lim, bf16x8 (&pf)[2]) {
    float tmax = -INFINITY;
#pragma unroll
    for (int r = 0; r < 16; ++r) {
        if (MODE == 0) { if (r >= 8) s[r] = -INFINITY; }
        else { const float dl = fabsf(Bq - (float)((r & 3) + 8 * (r >> 2))); const float v = s[r] - H.slope2 * dl; s[r] = dl <= lim ? v : -INFINITY; }
        tmax = fmaxf(tmax, s[r]);
    }
    tmax = fmaxf(tmax, __shfl_xor(tmax, 32));
    if (__any(tmax > H.m + ATT_THR)) { const float mn = fmaxf(H.m, tmax); const float al = __builtin_amdgcn_exp2f(H.m - mn); H.m = mn; H.l *= al;
#pragma unroll
        for (int r = 0; r < 16; ++r) { H.O0[r] *= al; H.O1[r] *= al; } }
    float ps = 0.f;
#pragma unroll
    for (int r = 0; r < 16; ++r) { s[r] = __builtin_amdgcn_exp2f(s[r] - H.m); ps += s[r]; }
    H.l += ps;
#pragma unroll
    for (int s2 = 0; s2 < 2; ++s2) { u32x4 pw; pw.x = pg8::cvt_pk_bf16(s[8 * s2 + 0], s[8 * s2 + 1]); pw.y = pg8::cvt_pk_bf16(s[8 * s2 + 2], s[8 * s2 + 3]); pw.z = pg8::cvt_pk_bf16(s[8 * s2 + 4], s[8 * s2 + 5]); pw.w = pg8::cvt_pk_bf16(s[8 * s2 + 6], s[8 * s2 + 7]);
        pf[s2] = __builtin_bit_cast(bf16x8, pw); }
}
template <int MODE>
__device__ __forceinline__ void att_tile2(const LAS unsigned char* kbase, const int (&koff)[4], const LAS unsigned char* vbase, const bf16x8 (&qa)[4], const bf16x8 (&qb)[4], float Bq, float lim, AttHead& A, AttHead& B) {
    f32x16 sa, sb;
#pragma unroll
    for (int r = 0; r < 16; ++r) { sa[r] = 0.f; sb[r] = 0.f; }
#pragma unroll
    for (int ks = 0; ks < 4; ++ks) { const bf16x8 kf = *(const LAS bf16x8*)(kbase + koff[ks]);
        sa = __builtin_amdgcn_mfma_f32_32x32x16_bf16(kf, qa[ks], sa, 0, 0, 0); sb = __builtin_amdgcn_mfma_f32_32x32x16_bf16(kf, qb[ks], sb, 0, 0, 0); }
    bf16x8 pa[2], pb[2];
    att_softmax<MODE>(sa, A, Bq, lim, pa);
    att_softmax<MODE>(sb, B, Bq, lim, pb);
#pragma unroll
    for (int s2 = 0; s2 < 2; ++s2) {
        { const u32x2 lo = *(const LAS u32x2*)(vbase + s2 * 32), hi = *(const LAS u32x2*)(vbase + s2 * 32 + 16); const bf16x8 vf = __builtin_bit_cast(bf16x8, (u32x4){lo.x, lo.y, hi.x, hi.y});
          A.O0 = __builtin_amdgcn_mfma_f32_32x32x16_bf16(vf, pa[s2], A.O0, 0, 0, 0); B.O0 = __builtin_amdgcn_mfma_f32_32x32x16_bf16(vf, pb[s2], B.O0, 0, 0, 0); }
        { const u32x2 lo = *(const LAS u32x2*)(vbase + 32 * ATT_VP + s2 * 32), hi = *(const LAS u32x2*)(vbase + 32 * ATT_VP + s2 * 32 + 16); const bf16x8 vf = __builtin_bit_cast(bf16x8, (u32x4){lo.x, lo.y, hi.x, hi.y});
          A.O1 = __builtin_amdgcn_mfma_f32_32x32x16_bf16(vf, pa[s2], A.O1, 0, 0, 0); B.O1 = __builtin_amdgcn_mfma_f32_32x32x16_bf16(vf, pb[s2], B.O1, 0, 0, 0); }
    }
}
__device__ __forceinline__ void att_fast(Frame& F) {
    LAS unsigned char* Kimg = F.lds + ATT_KIMG; LAS unsigned char* Vimg = F.lds + ATT_VIMG;
    const int tid = F.tid, lane = F.lane, wid = F.wave, q = lane & 31, h = lane >> 5, qt = wid & 3, hsel = wid >> 2;
    int koff[4];
#pragma unroll
    for (int ks = 0; ks < 4; ++ks) koff[ks] = ((2 * ks + h) ^ ((q >> 1) & 7)) << 4;
    const int vb = (F.G & 7) == 0 ? (F.bid & 7) * (F.G >> 3) + (F.bid >> 3) : F.bid;
    for (int item = vb; item < NB * 16 * 2; item += F.G) {
        const int hk = item & 1, i = (item >> 1) & 15, b = item >> 5;
        const int row = b * SEQ + i * 128 + 32 * qt + q;
        bf16x8 qf[2][4];
#pragma unroll
        for (int hp = 0; hp < 2; ++hp)
#pragma unroll
            for (int ks = 0; ks < 4; ++ks) qf[hp][ks] = *(const GAS bf16x8*)(F.Qb + (size_t)row * 512 + (hk * 4 + hp * 2 + hsel) * 64 + 16 * ks + 8 * h);
        __syncthreads();
        {
            const int c8 = tid & 7, r64 = tid >> 3; u32x4 kv[7], vv[7];
            const bf16_t* vrow = F.VT + (size_t)((b * 2 + hk) * 64 + r64) * VT_PITCH;
#pragma unroll
            for (int it = 0; it < 7; ++it) { const int kr = r64 + 64 * it; int pos = (i - 1) * 128 + kr - 32; pos = pos < 0 ? 0 : (pos >= SEQ ? SEQ - 1 : pos);
                const int row = kr < 16 ? M_REAL + b * NMETA + kr : b * SEQ + pos;
                kv[it] = *(const GAS u32x4*)(F.Kb + (size_t)row * 128 + hk * 64 + 8 * c8); }
#pragma unroll
            for (int it = 0; it < 7; ++it) { const int c = c8 + 8 * it, cc = c - 4, blk = cc >> 4, w = cc & 15, pos0 = (i - 1 + blk) * 128; const bool inr = c >= 4 && c < 52 && pos0 >= 0 && pos0 < SEQ;
                const bf16_t* src = inr ? vrow + NMETA + pos0 + 8 * w : vrow + 8 * (c & 1);
                vv[it] = *(const GAS u32x4*)src; }
#pragma unroll
            for (int it = 0; it < 7; ++it) { const int kr = r64 + 64 * it; if (kr < 416) *(LAS u32x4*)(Kimg + kr * 128 + ((c8 ^ ((kr >> 1) & 7)) << 4)) = kv[it]; }
#pragma unroll
            for (int it = 0; it < 7; ++it) { const int c = c8 + 8 * it; if (c < 52) { const int cc = c - 4; const int koffs = c < 4 ? 8 * c : 32 + 8 * cc;
                    u32x4 v = vv[it]; if (c >= 2 && c < 4) v = (u32x4){0u, 0u, 0u, 0u};
                    LAS u32x2* dst = (LAS u32x2*)(Vimg + r64 * ATT_VP + koffs * 2); dst[0] = (u32x2){v.x, v.y}; dst[1] = (u32x2){v.z, v.w}; } }
        }
        __syncthreads();
        if (PROBE_PH >= 0 && F.bid == 100 && F.tid == 0) ((volatile LAS unsigned*)(F.lds + RING_BYTES + 1024))[11] = (unsigned)__builtin_amdgcn_s_memrealtime();
        {
            AttHead H[2];
#pragma unroll
            for (int hp = 0; hp < 2; ++hp) { const int head = hk * 4 + hp * 2 + hsel; H[hp].slope2 = exp2f(-(float)(head + 1)) * LOG2E; H[hp].m = F.sink[head] * LOG2E; H[hp].l = h == 0 ? 1.f : 0.f;
#pragma unroll
                for (int r = 0; r < 16; ++r) { H[hp].O0[r] = 0.f; H[hp].O1[r] = 0.f; } }
            const LAS unsigned char* kb0 = Kimg + q * 128; const LAS unsigned char* vb0 = Vimg + q * ATT_VP + 8 * h;
            att_tile2<0>(kb0, koff, vb0, qf[0], qf[1], 0.f, 0.f, H[0], H[1]);
#pragma unroll 1
            for (int kt = qt; kt <= qt + 8; ++kt) { const int blk = kt >> 2; if ((i == 0 && blk == 0) || (i == 15 && blk == 2)) continue;
                const int kr0 = 32 + 32 * kt; const float Bq = (float)(128 + 32 * (qt - kt) + q - 4 * h);
                att_tile2<1>(kb0 + kr0 * 128, koff, vb0 + kr0 * 2, qf[0], qf[1], Bq, (kt == qt || kt == qt + 8) ? 128.f : 1e30f, H[0], H[1]); }
#pragma unroll
            for (int hp = 0; hp < 2; ++hp) { const int head = hk * 4 + hp * 2 + hsel; float l = H[hp].l; l += __shfl_xor(l, 32); const float inv = 1.f / l;
                bf16_t* orow = F.MIX + (size_t)row * D + head * 64 + 4 * h;
#pragma unroll
                for (int g = 0; g < 4; ++g) { *(GAS u32x2*)(orow + 8 * g) = (u32x2){pg8::cvt_pk_bf16(H[hp].O0[4 * g] * inv, H[hp].O0[4 * g + 1] * inv), pg8::cvt_pk_bf16(H[hp].O0[4 * g + 2] * inv, H[hp].O0[4 * g + 3] * inv)};
                    *(GAS u32x2*)(orow + 32 + 8 * g) = (u32x2){pg8::cvt_pk_bf16(H[hp].O1[4 * g] * inv, H[hp].O1[4 * g + 1] * inv), pg8::cvt_pk_bf16(H[hp].O1[4 * g + 2] * inv, H[hp].O1[4 * g + 3] * inv)}; } }
        }
    }
    __syncthreads();
}
__device__ __forceinline__ void conv_fast(Frame& F) {
    const int tid = F.tid, lane = F.lane, wid = F.wave, c2 = tid & 255, th = tid >> 8;
    LAS float* cout = (LAS float*)F.lds;
    float w0[CONV_K], w1[CONV_K];
#pragma unroll
    for (int j = 0; j < CONV_K; ++j) { const f32x2 w = *(const f32x2*)(F.dw_w + j * CONV_W + 2 * c2); w0[j] = w.x; w1[j] = w.y; }
    const f32x2 bias = *(const f32x2*)(F.dw_b + 2 * c2);
    const f32x4 g0 = *(const f32x4*)(F.lng + 8 * lane), g1 = *(const f32x4*)(F.lng + 8 * lane + 4), b0 = *(const f32x4*)(F.lnb + 8 * lane), b1 = *(const f32x4*)(F.lnb + 8 * lane + 4);
    const int vb = (F.G & 7) == 0 ? (F.bid & 7) * (F.G >> 3) + (F.bid >> 3) : F.bid;
    for (int item = vb; item < NB * 32; item += F.G) {
        const int b = item >> 5, t0 = (item & 31) * 64;
        unsigned xin[62];
        const int s0 = NMETA + t0 + 32 * th - 15;
#pragma unroll
        for (int jj = 0; jj < 62; ++jj) { const int sq = s0 + jj; xin[jj] = sq < LSEQ ? *(const GAS unsigned*)(F.HC + (size_t)row_of(b, sq) * 512 + 2 * c2) : 0u; }
        __syncthreads();
#pragma unroll
        for (int t = 0; t < 32; ++t) { float a0 = bias.x, a1 = bias.y;
#pragma unroll
            for (int j = 0; j < CONV_K; ++j) { a0 += w0[j] * bflo(xin[t + j]); a1 += w1[j] * bfhi(xin[t + j]); }
            *(LAS f32x2*)(cout + (32 * th + t) * 512 + 2 * c2) = (f32x2){a0, a1}; }
        __syncthreads();
#pragma unroll 1
        for (int hb = 0; hb < 2; ++hb) {
            f32x4 x0[4], x1[4]; float sm[4], sq[4];
#pragma unroll
            for (int tt = 0; tt < 4; ++tt) { const LAS f32x4* rp = (const LAS f32x4*)(cout + (8 * wid + 4 * hb + tt) * 512 + 8 * lane); x0[tt] = rp[0]; x1[tt] = rp[1];
                sm[tt] = (x0[tt][0] + x0[tt][1]) + (x0[tt][2] + x0[tt][3]) + (x1[tt][0] + x1[tt][1]) + (x1[tt][2] + x1[tt][3]);
                sq[tt] = (x0[tt][0] * x0[tt][0] + x0[tt][1] * x0[tt][1]) + (x0[tt][2] * x0[tt][2] + x0[tt][3] * x0[tt][3]) + (x1[tt][0] * x1[tt][0] + x1[tt][1] * x1[tt][1]) + (x1[tt][2] * x1[tt][2] + x1[tt][3] * x1[tt][3]); }
#pragma unroll
            for (int o = 1; o < 64; o <<= 1)
#pragma unroll
                for (int tt = 0; tt < 4; ++tt) { sm[tt] += __shfl_xor(sm[tt], o); sq[tt] += __shfl_xor(sq[tt], o); }
#pragma unroll
            for (int tt = 0; tt < 4; ++tt) { const float mu = sm[tt] * (1.f / 512.f); const float var = fmaxf(sq[tt] * (1.f / 512.f) - mu * mu, 0.f); const float rstd = __builtin_amdgcn_rsqf(var + 1e-5f);
                f32x4 y0 = (x0[tt] - mu) * rstd * g0 + b0, y1 = (x1[tt] - mu) * rstd * g1 + b1;
#pragma unroll
                for (int e = 0; e < 4; ++e) { y0[e] *= sigmoidf_fast(y0[e]); y1[e] *= sigmoidf_fast(y1[e]); }
                *(GAS u32x4*)(F.MIX + (size_t)(b * SEQ + t0 + 8 * wid + 4 * hb + tt) * D + 512 + 8 * lane) = pg8::pack8(y0, y1); }
        }
    }
    __syncthreads();
}
__device__ __forceinline__ void p4_fast(Frame& F) {
    LAS int* lcnt = (LAS int*)(F.lds + LX_LCNT); LAS int* gbase = (LAS int*)(F.lds + LX_GBASE); LAS float* part = (LAS float*)F.lds;
    const int tid = F.tid, lane = F.lane, wid = F.wave, j = lane & 31, h = lane >> 5, grp = wid >> 2, sub = wid & 3;
    for (int base = 0; base < M_REAL / 32; base += F.G * 2) {
        const int tile = base + F.bid + F.G * grp; const bool active = tile < M_REAL / 32;
        if (tid < NE) lcnt[tid] = 0;
        int tok = 0;
        if (active) {
            tok = tile * 32 + j;
            const bf16_t* xa = F.XN2 + (size_t)tok * D + 256 * sub + 8 * h; const bf16_t* wa = F.WrT + (size_t)j * D + 256 * sub + 8 * h;
            f32x16 acc;
#pragma unroll
            for (int r = 0; r < 16; ++r) acc[r] = 0.f;
            float ssq = 0.f;
#pragma unroll
            for (int ks = 0; ks < 16; ++ks) { const u32x4 xb = *(const GAS u32x4*)(xa + 16 * ks); const bf16x8 wf = *(const GAS bf16x8*)(wa + 16 * ks);
                acc = __builtin_amdgcn_mfma_f32_32x32x16_bf16(wf, __builtin_bit_cast(bf16x8, xb), acc, 0, 0, 0);
                ssq += (bflo(xb.x) * bflo(xb.x) + bfhi(xb.x) * bfhi(xb.x)) + (bflo(xb.y) * bflo(xb.y) + bfhi(xb.y) * bfhi(xb.y)) + (bflo(xb.z) * bflo(xb.z) + bfhi(xb.z) * bfhi(xb.z)) + (bflo(xb.w) * bflo(xb.w) + bfhi(xb.w) * bfhi(xb.w)); }
            LAS float* p = part + (size_t)((grp * 4 + sub) * 17) * 64 + lane;
#pragma unroll
            for (int r = 0; r < 16; ++r) p[r * 64] = acc[r];
            p[16 * 64] = ssq;
        }
        __syncthreads();
        int ea = 0, eb = 0, sa = 0, sb = 0; float ga = 0.f, gb = 0.f, rstd = 0.f;
        const bool fin = active && sub == 0;
        if (fin) {
            float lg[16]; float ssq = 0.f;
#pragma unroll
            for (int r = 0; r < 16; ++r) lg[r] = 0.f;
#pragma unroll
            for (int q = 0; q < 4; ++q) { const LAS float* p = part + (size_t)((grp * 4 + q) * 17) * 64 + lane;
#pragma unroll
                for (int r = 0; r < 16; ++r) lg[r] += p[r * 64];
                ssq += p[16 * 64]; }
            ssq += __shfl_xor(ssq, 32);
            rstd = 1.f / sqrtf(ssq * (1.f / D) + 1e-6f);
#pragma unroll
            for (int r = 0; r < 16; ++r) lg[r] = lg[r] * rstd + F.rb[(r & 3) + 8 * (r >> 2) + 4 * h];
            float tv[4]; int te[4];
#pragma unroll
            for (int kk = 0; kk < 4; ++kk) { float bv = -INFINITY; int be = 0;
#pragma unroll
                for (int r = 0; r < 16; ++r) { const int er = (r & 3) + 8 * (r >> 2) + 4 * h; if (lg[r] > bv) { bv = lg[r]; be = er; } }
                const float pv = __shfl_xor(bv, 32); const int pe = __shfl_xor(be, 32);
                if (pv > bv || (pv == bv && pe < be)) { bv = pv; be = pe; }
#pragma unroll
                for (int r = 0; r < 16; ++r) { const int er = (r & 3) + 8 * (r >> 2) + 4 * h; if (er == be) lg[r] = -INFINITY; }
                tv[kk] = bv; te[kk] = be; }
            const float p1 = __expf(tv[1] - tv[0]), p2 = __expf(tv[2] - tv[0]), p3 = __expf(tv[3] - tv[0]); const float inv = 1.f / (1.f + p1 + p2 + p3);
            ea = h ? te[2] : te[0]; eb = h ? te[3] : te[1]; ga = (h ? p2 : 1.f) * inv; gb = (h ? p3 : p1) * inv;
            sa = __hip_atomic_fetch_add(lcnt + ea, 1, __ATOMIC_RELAXED, __HIP_MEMORY_SCOPE_WORKGROUP); sb = __hip_atomic_fetch_add(lcnt + eb, 1, __ATOMIC_RELAXED, __HIP_MEMORY_SCOPE_WORKGROUP);
        }
        __syncthreads();
        if (tid < NE) gbase[tid] = (int)__hip_atomic_fetch_add((unsigned*)(F.ctl + CW_CNT + tid), (unsigned)lcnt[tid], RLX_AGENT);
        __syncthreads();
        if (fin) {
            sa += gbase[ea]; sb += gbase[eb];
            F.ltok[ea * CAP + sa] = tok; F.lgate[ea * CAP + sa] = ga; F.lrstd[ea * CAP + sa] = rstd; F.where[tok * 4 + 2 * h] = ea * CAP + sa;
            F.ltok[eb * CAP + sb] = tok; F.lgate[eb * CAP + sb] = gb; F.lrstd[eb * CAP + sb] = rstd; F.where[tok * 4 + 2 * h + 1] = eb * CAP + sb;
        }
        __syncthreads();
    }
}

__device__ __forceinline__ void p1_naive(Frame& F) {
    const int gw = F.bid * NWAVES + F.wave, NGW = F.G * NWAVES, lane = F.lane;
    for (int it = gw; it < M_ALL * 20; it += NGW) {
        const int row = it / 20, grp = it % 20;
        const bf16_t* xr = F.XN + (size_t)row * D;
        if (grp < 12) {
            const int col = grp * 64 + lane; float acc = 0.f;
            _Pragma("unroll 4") for (int k = 0; k < D; ++k) acc += bf2f(xr[k]) * F.w_in[(size_t)k * IN_W + col];
            if (grp < 10) {
                const float ssq = wave_sum(acc * acc); const float r = 1.f / sqrtf(ssq * (1.f / 64.f) + 1e-6f);
                if (grp < 8) F.Qb[(size_t)row * 512 + col] = (bf16_t)f2bf(acc * r * F.qg[lane] * QSCALE);
                else F.Kb[(size_t)row * 128 + (col - 512)] = (bf16_t)f2bf(acc * r * F.kg[lane]);
            } else {
                const int hk = grp - 10; int b, kx;
                if (row < M_REAL) { b = row >> 11; kx = NMETA + (row & 2047); } else { b = (row - M_REAL) >> 4; kx = (row - M_REAL) & 15; }
                F.VT[((size_t)(b * 2 + hk) * 64 + lane) * VT_PITCH + kx] = (bf16_t)f2bf(acc);
            }
        } else {
            const int c = (grp - 12) * 64 + lane; float a = 0.f, g = 0.f;
            for (int k = 0; k < D; ++k) { const float xv = bf2f(xr[k]); a += xv * F.w_in[(size_t)k * IN_W + 768 + c]; g += xv * F.w_in[(size_t)k * IN_W + 1280 + c]; }
            F.HC[(size_t)row * 512 + c] = (bf16_t)f2bf(a * sigmoidf_fast(g));
        }
    }
}
__device__ __forceinline__ void att_naive(Frame& F) {
    const int gw = F.bid * NWAVES + F.wave, NGW = F.G * NWAVES, lane = F.lane;
    for (int it = gw; it < M_REAL * NQH; it += NGW) {
        const int row = it >> 3, h = it & 7, hk = h >> 2, b = row >> 11, qp = row & 2047;
        const float q = bf2f(F.Qb[(size_t)row * 512 + h * 64 + lane]);
        const float slope2 = exp2f(-(float)(h + 1)) * LOG2E;
        float m = F.sink[h] * LOG2E, l = 1.f, acc = 0.f;
        const bf16_t* vt = F.VT + ((size_t)(b * 2 + hk) * 64 + lane) * VT_PITCH;
        for (int j = 0; j < NMETA; ++j) {
            const float kv = bf2f(F.Kb[(size_t)(M_REAL + b * NMETA + j) * 128 + hk * 64 + lane]);
            const float s = wave_sum(q * kv);
            const float mn = fmaxf(m, s), al = exp2f(m - mn), p = exp2f(s - mn);
            l = l * al + p; acc = acc * al + p * bf2f(vt[j]); m = mn;
        }
        const int k0 = qp - 128 < 0 ? 0 : qp - 128, k1 = qp + 128 > SEQ - 1 ? SEQ - 1 : qp + 128;
        for (int kp = k0; kp <= k1; ++kp) {
            const float kv = bf2f(F.Kb[(size_t)(b * SEQ + kp) * 128 + hk * 64 + lane]);
            const float dist = (float)(qp > kp ? qp - kp : kp - qp);
            const float s = wave_sum(q * kv) - slope2 * dist;
            const float mn = fmaxf(m, s), al = exp2f(m - mn), p = exp2f(s - mn);
            l = l * al + p; acc = acc * al + p * bf2f(vt[NMETA + kp]); m = mn;
        }
        F.MIX[(size_t)row * D + h * 64 + lane] = (bf16_t)f2bf(acc / l);
    }
}
__device__ __forceinline__ void conv_naive(Frame& F) {
    const int gw = F.bid * NWAVES + F.wave, NGW = F.G * NWAVES, lane = F.lane;
    for (int row = gw; row < M_REAL; row += NGW) {
        const int b = row >> 11, s0 = NMETA + (row & 2047);
        float v[8]; float sum = 0.f;
#pragma unroll
        for (int j = 0; j < 8; ++j) { const int c = lane + 64 * j; float a = F.dw_b[c];
            _Pragma("unroll 1") for (int t = 0; t < CONV_K; ++t) { const int s = s0 - 15 + t; if (s >= 0 && s < LSEQ) a += F.dw_w[t * CONV_W + c] * bf2f(F.HC[(size_t)row_of(b, s) * 512 + c]); }
            v[j] = a; sum += a; }
        const float mu = wave_sum(sum) * (1.f / 512.f); float q = 0.f;
#pragma unroll
        for (int j = 0; j < 8; ++j) { const float d = v[j] - mu; q += d * d; }
        const float rstd = 1.f / sqrtf(wave_sum(q) * (1.f / 512.f) + 1e-5f);
#pragma unroll
        for (int j = 0; j < 8; ++j) { const int c = lane + 64 * j; const float y = (v[j] - mu) * rstd * F.lng[c] + F.lnb[c];
            F.MIX[(size_t)row * D + 512 + c] = (bf16_t)f2bf(y * sigmoidf_fast(y)); }
    }
}
__device__ __forceinline__ void p3_naive(Frame& F) {
    const int gw = F.bid * NWAVES + F.wave, NGW = F.G * NWAVES, lane = F.lane;
    for (int it = gw; it < M_REAL * 16; it += NGW) {
        const int row = it >> 4, col = (it & 15) * 64 + lane; const bf16_t* mr = F.MIX + (size_t)row * D; float acc = 0.f;
        for (int k = 0; k < D; ++k) acc += bf2f(mr[k]) * F.w_out[(size_t)k * D + col];
        const float h2 = F.x[(size_t)row * D + col] + acc;
        F.out[(size_t)row * D + col] = h2; F.XN2[(size_t)row * D + col] = (bf16_t)f2bf(h2); F.XN2F8[(size_t)row * D + col] = (unsigned char)(pk4_fp8(h2, 0.f, 0.f, 0.f) & 0xffu);
    }
}
__device__ __forceinline__ void p4_naive(Frame& F) {
    const int gw = F.bid * NWAVES + F.wave, NGW = F.G * NWAVES, lane = F.lane, e = lane & 31;
    for (int t = gw; t < M_REAL; t += NGW) {
        const bf16_t* xr = F.XN2 + (size_t)t * D; float acc = 0.f, ss = 0.f;
        for (int k = 0; k < D; ++k) { const float xv = bf2f(xr[k]); acc += xv * F.n2g[k] * F.wr[k * NE + e]; ss += xv * xv; }
        const float rstd = 1.f / sqrtf(ss * (1.f / D) + 1e-6f);
        float lg = acc * rstd + F.rb[e];
        float tv[4]; int te[4];
#pragma unroll
        for (int kk = 0; kk < 4; ++kk) {
            float bv = lg; int be = e;
#pragma unroll
            for (int o = 1; o < 32; o <<= 1) { const float pv = __shfl_xor(bv, o); const int pe = __shfl_xor(be, o); if (pv > bv || (pv == bv && pe < be)) { bv = pv; be = pe; } }
            tv[kk] = bv; te[kk] = be; if (e == be) lg = -INFINITY;
        }
        float p[4], ps = 0.f;
#pragma unroll
        for (int kk = 0; kk < 4; ++kk) { p[kk] = __expf(tv[kk] - tv[0]); ps += p[kk]; }
        if (lane < 4) {
            const int ee = lane == 0 ? te[0] : lane == 1 ? te[1] : lane == 2 ? te[2] : te[3];
            const float gg = (lane == 0 ? p[0] : lane == 1 ? p[1] : lane == 2 ? p[2] : p[3]) / ps;
            const unsigned slot = __hip_atomic_fetch_add((unsigned*)(F.ctl + CW_CNT + ee), 1u, RLX_AGENT);
            F.ltok[ee * CAP + slot] = t; F.lgate[ee * CAP + slot] = gg; F.lrstd[ee * CAP + slot] = rstd; F.where[t * 4 + lane] = ee * CAP + (int)slot;
        }
    }
}
__device__ __forceinline__ void build_tile_table(Frame& F) {
    LAS int* tb = (LAS int*)(F.lds + LX_TB); LAS int* cn = (LAS int*)(F.lds + LX_CNT); LAS int* hb = (LAS int*)(F.lds + LX_HB); LAS int* lb = (LAS int*)(F.lds + LX_LB);
    __syncthreads();
    if (F.tid < NE) { int c = (int)__hip_atomic_load(F.ctl + CW_CNT + F.tid, RLX_AGENT); c = c > CAP ? CAP : (c < 0 ? 0 : c); cn[F.tid] = c; }
    __syncthreads();
    if (F.tid == 0) { int acc = 0, ah = 0, al = 0; for (int e = 0; e < NE; ++e) { const int c = cn[e];
            const int t = (c + 255) >> 8, rem = c & 255, light = (rem != 0 && rem <= 128) ? 1 : 0; tb[e] = acc; hb[e] = ah; lb[e] = al; acc += t; ah += t - light; al += light; }
        tb[NE] = acc; hb[NE] = ah; lb[NE] = al; }
    __syncthreads();
}
__device__ __forceinline__ int find_expert(const LAS int* tb, int tile) { int e = 0;
#pragma unroll 1
    for (int j = 1; j < NE; ++j) if (tb[j] <= tile) e = j;
    return e; }
__device__ __forceinline__ f32x4 fp8x4_to_f32(unsigned w) {
    const f32x2 lo = __builtin_amdgcn_cvt_pk_f32_fp8((int)w, false), hi = __builtin_amdgcn_cvt_pk_f32_fp8((int)w, true); return (f32x4){lo.x, lo.y, hi.x, hi.y}; }
__device__ __forceinline__ void p7_combine(Frame& F) {
    build_tile_table(F);
    const LAS int* tb = (const LAS int*)(F.lds + LX_TB);
    const int gw = F.bid * NWAVES + F.wave, NGW = F.G * NWAVES, lane = F.lane;
    const float pscale = PROBE_PH >= 0 ? 1.f + __builtin_bit_cast(float, __hip_atomic_load((unsigned*)(F.ctl + 32), RLX_AGENT)) : 1.f;
    const GAS i32x4* wh = (const GAS i32x4*)F.where;
    int t0 = gw, t1 = gw + NGW;
    i32x4 w0 = t0 < M_REAL ? wh[t0] : (i32x4){0, 0, 0, 0}, w1 = t1 < M_REAL ? wh[t1] : (i32x4){0, 0, 0, 0};
    while (t0 < M_REAL) {
        const int n0 = t0 + 2 * NGW, n1 = t1 + 2 * NGW;
        const i32x4 nw0 = n0 < M_REAL ? wh[n0] : (i32x4){0, 0, 0, 0}, nw1 = n1 < M_REAL ? wh[n1] : (i32x4){0, 0, 0, 0};
        const bool v1 = t1 < M_REAL; const int tt1 = v1 ? t1 : t0;
        u32x4 y[2][4], x[2][2];
#pragma unroll
        for (int u = 0; u < 2; ++u) { const int t = u ? tt1 : t0; const i32x4 w = u ? w1 : w0;
#pragma unroll
            for (int j = 0; j < 2; ++j) x[u][j] = *((const GAS u32x4*)(F.XN2 + (size_t)t * D) + 2 * lane + j);
#pragma unroll
            for (int k = 0; k < 4; ++k) { const int e = w[k] / CAP, slot = w[k] - e * CAP; y[u][k] = *((const GAS u32x4*)(F.Y8 + (size_t)(tb[e] * 256 + slot) * D) + lane); } }
#pragma unroll
        for (int u = 0; u < 2; ++u) { if (u && !v1) break; const int t = u ? tt1 : t0;
            f32x4 a[4] = {(f32x4){0.f, 0.f, 0.f, 0.f}, (f32x4){0.f, 0.f, 0.f, 0.f}, (f32x4){0.f, 0.f, 0.f, 0.f}, (f32x4){0.f, 0.f, 0.f, 0.f}};
#pragma unroll
            for (int k = 0; k < 4; ++k) { a[0] += fp8x4_to_f32(y[u][k].x); a[1] += fp8x4_to_f32(y[u][k].y); a[2] += fp8x4_to_f32(y[u][k].z); a[3] += fp8x4_to_f32(y[u][k].w); }
            a[0] += (f32x4){bflo(x[u][0].x), bfhi(x[u][0].x), bflo(x[u][0].y), bfhi(x[u][0].y)}; a[1] += (f32x4){bflo(x[u][0].z), bfhi(x[u][0].z), bflo(x[u][0].w), bfhi(x[u][0].w)};
            a[2] += (f32x4){bflo(x[u][1].x), bfhi(x[u][1].x), bflo(x[u][1].y), bfhi(x[u][1].y)}; a[3] += (f32x4){bflo(x[u][1].z), bfhi(x[u][1].z), bflo(x[u][1].w), bfhi(x[u][1].w)};
            GAS f32x4* o = (GAS f32x4*)(F.out + (size_t)t * D) + 4 * lane;
#pragma unroll
            for (int j = 0; j < 4; ++j) o[j] = PROBE_PH >= 0 ? a[j] * pscale : a[j]; }
        t0 = n0; t1 = n1; w0 = nw0; w1 = nw1;
    }
}

__global__ void __launch_bounds__(NTHR, 2) mega(Args args) {
    extern __shared__ __attribute__((aligned(16))) unsigned char lds_raw[];
    Frame F;
    F.lds = (LAS unsigned char*)lds_raw;
    F.tid = threadIdx.x; F.lane = F.tid & 63; F.wave = __builtin_amdgcn_readfirstlane(F.tid >> 6); F.G = gridDim.x; F.bid = blockIdx.x;
    F.x = args.in[0]; F.meta = args.in[1]; F.n1g = args.in[2]; F.w_in = args.in[3]; F.qg = args.in[4]; F.kg = args.in[5]; F.sink = args.in[6];
    F.dw_w = args.in[7]; F.dw_b = args.in[8]; F.lng = args.in[9]; F.lnb = args.in[10]; F.w_out = args.in[11]; F.n2g = args.in[12];
    F.wr = args.in[13]; F.rb = args.in[14]; F.wgu = args.in[15]; F.bgu = args.in[16]; F.wd = args.in[17]; F.bd = args.in[18];
    F.out = args.out; F.ws = args.ws; unsigned char* ws = args.ws;
    F.ctl = (gu32*)(ws + WS_CTL);
    F.WinT = (bf16_t*)(ws + WS_WIN_T); F.WoT = (bf16_t*)(ws + WS_WO_T); F.WrT = (bf16_t*)(ws + WS_WR_T); F.WdT8 = ws + WS_WD_T; F.WguT8 = ws + WS_WGU_T; F.XN2F8 = ws + WS_XN2F8;
    F.XN = (bf16_t*)(ws + WS_XN); F.Qb = (bf16_t*)(ws + WS_Q); F.Kb = (bf16_t*)(ws + WS_K); F.VT = (bf16_t*)(ws + WS_VT); F.HC = (bf16_t*)(ws + WS_HC);
    F.MIX = (bf16_t*)(ws + WS_MIX); F.XN2 = (bf16_t*)(ws + WS_XN2); F.ACT8 = ws + WS_ACT; F.Y8 = ws + WS_Y;
    F.where = (int*)(ws + WS_WHERE); F.ltok = (int*)(ws + WS_LTOK); F.lgate = (float*)(ws + WS_LGATE); F.lrstd = (float*)(ws + WS_LRSTD);
    for (int u = F.tid; u < (LDS_BYTES - RING_BYTES) / 4; u += NTHR) ((LAS unsigned*)(F.lds + RING_BYTES))[u] = 0u;
    __syncthreads();
    const int lo = args.ph_lo, hi = args.ph_hi;
    XcdBarrier bar; bar.bar = (unsigned*)(F.ctl + CW_BAR); bar.x = 0; bar.st = nullptr;
    if (hi - lo > 1) bar = xcd_barrier_post((unsigned*)(F.ctl + CW_BAR), (volatile LAS unsigned*)(F.lds + LX_BAR));
#ifndef PH_MASK
#define PH_MASK 0xFF
#endif
#define IN(k) (((PH_MASK >> (k)) & 1) && lo <= (k) && (k) < hi)
#define STAMP(k) do { if (PROBE_PH >= 0 && F.bid == 100 && F.tid == 0) ((volatile LAS unsigned*)(F.lds + RING_BYTES + 1024))[k] = (unsigned)__builtin_amdgcn_s_memrealtime(); } while (0)
#define SEAM(k) do { if (IN(k) && IN((k) + 1)) xcd_barrier(bar); STAMP((k) + 1); } while (0)
#ifndef REP_PH
#define REP_PH -1
#endif
#define REPS(k) _Pragma("unroll") for (int rep = 0; rep < ((REP_PH) == (k) ? 2 : 1); ++rep)
#define REPBAR() do { if (rep) xcd_barrier(bar); } while (0)
    STAMP(0);
    if (IN(0)) { REPS(0) { REPBAR(); p0_prologue(F); } } SEAM(0);
    if (IN(1)) { REPS(1) { REPBAR();
#if FAST_P1
        pg8::DenseProb<IN_W / 256> P{F.XN, F.WinT, M_PAD / 256, F.G, F.bid}; pg8::EpiIn E{F.Qb, F.Kb, F.VT, F.HC, F.qg, F.kg}; pg8::gemm_phase<2>(F.lds, P, E);
        { const int nd = p0_ndef(F.G), first_idle = P1_UNITS - F.G;
          if (nd > 0 && F.bid >= first_idle) { __syncthreads(); p0_items(F, P0_NITEMS - nd + (F.bid - first_idle) * NWAVES + F.wave, (F.G - first_idle) * NWAVES, P0_NITEMS); } }
#else
        p1_naive(F);
#endif
    } } SEAM(1);
    if (IN(2)) { REPS(2) { REPBAR();
#if FAST_ATT
        att_fast(F);
#else
        att_naive(F);
#endif
    } STAMP(9); REPS(8) { REPBAR();
#if FAST_CONV
        conv_fast(F);
#else
        conv_naive(F);
#endif
    } } SEAM(2);
    if (IN(3)) { REPS(3) { REPBAR();
#if FAST_P3
        const int np3 = (F.G & 1) == 0 ? P3_CONV_ITEMS : 0, hw = (F.G >> 1) * NWAVES, hrank = (F.bid >> 1) * NWAVES + F.wave;
        if (np3 && (F.bid & 1)) { p0_items(F, P0_NITEMS - np3 + hrank, hw, P0_NITEMS - np3 / 2); __syncthreads(); }
        pg8::DenseProb<D / 256> P{F.MIX, F.WoT, M_REAL / 256, F.G, F.bid}; pg8::EpiOut E{F.x, F.out, F.XN2, F.XN2F8}; pg8::gemm_phase<2>(F.lds, P, E);
        if (np3 && !(F.bid & 1)) { __syncthreads(); p0_items(F, P0_NITEMS - np3 / 2 + hrank, hw, P0_NITEMS); }
#else
        p3_naive(F);
#endif
    } } SEAM(3);
    if (IN(4)) { REPS(4) { if (rep) { xcd_barrier(bar); if (F.bid == 0 && F.tid < NE) __hip_atomic_store(F.ctl + CW_CNT + F.tid, 0u, RLX_AGENT); xcd_barrier(bar); }
        const int p4end = P0_NITEMS - ((F.G & 1) == 0 ? P3_CONV_ITEMS : 0), p4first = P0_NMOE0 + F.bid * NWAVES + F.wave, p4step = F.G * NWAVES;
        const int npre = ((F.G & 1) == 0 && (F.bid & 1)) ? P4_PRE : 0;
        if (npre) { p0_items(F, p4first, p4step, p4first + npre * p4step < p4end ? p4first + npre * p4step : p4end); __syncthreads(); }
#if FAST_P4
        p4_fast(F);
#else
        p4_naive(F);
#endif
        __syncthreads(); p0_items(F, p4first + npre * p4step, p4step, p4end);
    } } SEAM(4);
    if (IN(5)) { REPS(5) { REPBAR();
        build_tile_table(F); pg8::GroupedProb<true, 1, 8> P{F.XN2F8, F.WguT8, F.ltok, (const LAS int*)(F.lds + LX_TB), (const LAS int*)(F.lds + LX_CNT), F.G, F.bid};
        pg8::EpiGU E{F.ACT8, F.lrstd, F.bgu}; pg8::gemm_phase<1>(F.lds, P, E);
    } } SEAM(5);
    if (IN(6)) { REPS(6) { REPBAR();
        build_tile_table(F); pg8::GroupedProb<false, 1, 4> P{F.ACT8, F.WdT8, F.ltok, (const LAS int*)(F.lds + LX_TB), (const LAS int*)(F.lds + LX_CNT), F.G, F.bid};
        pg8::EpiDown E{F.Y8, F.lgate, F.bd}; pg8::gemm_phase<1>(F.lds, P, E);
    } } SEAM(6);
    if (PROBE_PH >= 0 && hi - lo > 1) {
        if (F.bid == 100 && F.tid == 0) { volatile LAS unsigned* ts = (volatile LAS unsigned*)(F.lds + RING_BYTES + 1024); const unsigned dt = PROBE_PH == 11 ? ts[11] - ts[2] : PROBE_PH == 12 ? ts[9] - ts[11] : PROBE_PH == 9 ? ts[9] - ts[2] : PROBE_PH == 10 ? ts[3] - ts[9] : ts[PROBE_PH + 1] - ts[PROBE_PH];
            const float eps = sqrtf((float)dt * 0.01f * (float)(PROBE_SCALE)); __hip_atomic_store((unsigned*)(F.ctl + 32), __builtin_bit_cast(unsigned, eps), RLX_AGENT); }
        xcd_barrier(bar);
    }
    if (IN(7)) { REPS(7) { REPBAR(); p7_combine(F); } }
#undef IN
#undef SEAM
}

extern "C" void kernel_launch(void* const* d_in, const int* in_sizes, int n_in, void* d_out, int out_size, void* d_ws, size_t ws_size, hipStream_t stream) {
    static int grid = 0;
    if (grid == 0) {
        if (n_in != 19 || in_sizes[0] != M_REAL * D || out_size != M_REAL * D || ws_size < WS_END) {
            fprintf(stderr, "kernel_launch: unexpected shapes/workspace: n_in %d in0 %d out %d ws %zu (need %zu)\n", n_in, n_in > 0 ? in_sizes[0] : -1, out_size, ws_size, (size_t)WS_END); grid = -1; return; }
        int dev = 0, cus = 0, per_cu = 0;
        if (hipGetDevice(&dev) != hipSuccess || hipDeviceGetAttribute(&cus, hipDeviceAttributeMultiprocessorCount, dev) != hipSuccess) { grid = -1; return; }
        if (hipFuncSetAttribute((const void*)mega, hipFuncAttributeMaxDynamicSharedMemorySize, LDS_BYTES) != hipSuccess) { fprintf(stderr, "kernel_launch: hipFuncSetAttribute failed\n"); grid = -1; return; }
        if (hipOccupancyMaxActiveBlocksPerMultiprocessor(&per_cu, (const void*)mega, NTHR, LDS_BYTES) != hipSuccess || per_cu < 1) { fprintf(stderr, "kernel_launch: occupancy query says %d blocks/CU\n", per_cu); (void)hipGetLastError(); grid = -1; return; }
        grid = cus;
    }
    if (grid < 0) return;
    (void)hipMemsetAsync((char*)d_ws + WS_CTL, 0, CTL_ZERO_BYTES, stream);
    Args a{};
    for (int i = 0; i < 19; ++i) a.in[i] = (const float*)d_in[i];
    a.out = (float*)d_out; a.ws = (unsigned char*)d_ws;
#if MK_PER_PHASE
    for (int p = 0; p < 8; ++p) { a.ph_lo = p; a.ph_hi = p + 1; hipLaunchKernelGGL(mega, dim3(grid), dim3(NTHR), LDS_BYTES, stream, a); }
#else
    a.ph_lo = 0; a.ph_hi = 8; hipLaunchKernelGGL(mega, dim3(grid), dim3(NTHR), LDS_BYTES, stream, a);
#endif
}
```
